# Optimizing an MI355X kernel written in HIP

```python
import math
import jax, jax.numpy as jnp
from jax import lax
import numpy as np

D_MODEL = 1024
BATCH = 16
SEQ = 256
DEPTH = 4
DEC_BATCH = 4
DEC_SEQ = 4096
PAST_LEN = 256

GRID_W = 64
N_MIXERS = 4
RMS_EPS = 1e-6
CONV_W = 3
POOL_WINDOWS = (2, 4, 8, 16)
POOL_GROUP = D_MODEL // len(POOL_WINDOWS)
SGU_CHUNK = 128
SGU_GROUPS = 8
SGU_DIM = D_MODEL // SGU_GROUPS
HGRN_HEADS = 8
HGRN_DK = D_MODEL // HGRN_HEADS
HGRN_DV = D_MODEL // HGRN_HEADS
HGRN_CHUNK = 32
D_FF = 2816
POS_BASE = 10000.0

kernel_name = 'hybrid_diffusion_interleaved_step'


def _layers_of(kind):
    return len(range(kind, DEPTH, N_MIXERS))


def rmsnorm(x, g):
    xf = x.astype(jnp.float32)
    y = xf * lax.rsqrt(jnp.mean(xf * xf, axis=-1, keepdims=True) + RMS_EPS)
    return (y * g.astype(jnp.float32)).astype(x.dtype)


def adaln_params(cvec, w, b):
    m = jax.nn.silu(cvec) @ w + b
    return jnp.split(m[:, None, :], 6, axis=-1)


def modulate(h, shift, scale):
    return h * (1.0 + scale) + shift


def dwconv3(h, w):
    hp = jnp.pad(h, ((0, 0), (1, 1), (0, 0)))
    return hp[:, :-2] * w[0] + hp[:, 1:-1] * w[1] + hp[:, 2:] * w[2]


def grid_pos_embed(n_tokens):
    rows = n_tokens // GRID_W
    rr, cc = jnp.meshgrid(jnp.arange(rows, dtype=jnp.float32), jnp.arange(GRID_W, dtype=jnp.float32), indexing='ij')
    rr, cc = rr.reshape(-1, 1), cc.reshape(-1, 1)
    quarter = D_MODEL // 4
    freq = jnp.exp(-math.log(POS_BASE) * jnp.arange(quarter, dtype=jnp.float32) / quarter)
    return jnp.concatenate([jnp.sin(rr * freq), jnp.cos(rr * freq), jnp.sin(cc * freq), jnp.cos(cc * freq)], axis=-1)


def short_conv_mixer(h, w_in, w_dw, w_out):
    bg, cg, xh = jnp.split(h @ w_in, 3, axis=-1)
    return (bg * dwconv3(cg * xh, w_dw)) @ w_out


def pool_mixer(h, w_group, scale):
    B, T, D = h.shape
    hf = h.astype(jnp.float32)
    csum = jnp.concatenate([jnp.zeros((B, 1, D), jnp.float32), jnp.cumsum(hf, axis=1)], axis=1)
    t = jnp.arange(T)
    outs = []
    for g, w in enumerate(POOL_WINDOWS):
        lo = jnp.maximum(t - w // 2, 0)
        hi = jnp.minimum(t + w // 2, T)
        sl = slice(g * POOL_GROUP, (g + 1) * POOL_GROUP)
        cg = csum[:, :, sl]
        mean = (cg[:, hi] - cg[:, lo]) / (hi - lo).astype(jnp.float32)[None, :, None]
        pooled = (mean - hf[:, :, sl]).astype(h.dtype)
        outs.append(pooled @ w_group[g])
    return jnp.concatenate(outs, axis=-1) * scale


def sgu_mixer(h, w_in, norm_g, w_s, b_s, w_out):
    B, T, D = h.shape
    u, v = jnp.split(jax.nn.gelu(h @ w_in), 2, axis=-1)
    v = rmsnorm(v, norm_g).reshape(B, T // SGU_CHUNK, SGU_CHUNK, SGU_GROUPS, SGU_DIM)
    s = jnp.einsum('gpq,bnqgc->bnpgc', w_s, v) + b_s.T[None, None, :, :, None]
    return (u * s.reshape(B, T, D)) @ w_out


def hgrn_lower_bounds(lb_param):
    p = jax.nn.softmax(lb_param.astype(jnp.float32), axis=0)
    return jnp.cumsum(p, axis=0) - p[0:1]


def hgrn_scan(q, k, v, logf, s0):
    B, T, H, _ = q.shape

    def to_chunks(a):
        return a.reshape(B, T // HGRN_CHUNK, HGRN_CHUNK, H, a.shape[-1]).transpose(1, 0, 3, 2, 4)

    mask = jnp.tril(jnp.ones((HGRN_CHUNK, HGRN_CHUNK), dtype=bool))

    def step(S, xs):
        qc, kc, vc, lfc = xs
        bc = jnp.cumsum(lfc, axis=2)
        o_inter = jnp.einsum('bhtd,bhde->bhte', qc * jnp.exp(bc), S)
        diff = bc[:, :, :, None, :] - bc[:, :, None, :, :]
        decay = jnp.where(mask[:, :, None], jnp.exp(jnp.minimum(diff, 0.0)), 0.0)
        scores = jnp.einsum('bhtd,bhtsd,bhsd->bhts', qc, decay, kc)
        o_intra = jnp.einsum('bhts,bhse->bhte', scores, vc)
        last = bc[:, :, -1:, :]
        S_new = jnp.exp(last[:, :, 0])[..., None] * S + jnp.einsum('bhsd,bhse->bhde', kc * jnp.exp(last - bc), vc)
        return S_new, o_inter + o_intra

    s_final, o = lax.scan(step, s0, (to_chunks(q), to_chunks(k), to_chunks(v), to_chunks(logf)))
    o = o.transpose(1, 0, 3, 2, 4).reshape(B, T, H, -1)
    return o, s_final


def hgrn_mixer(h, w_in, lb, norm_g, w_out, s0):
    B, T, D = h.shape
    q, zf, zb, inp, g = jnp.split(h @ w_in, 5, axis=-1)

    def heads(a):
        return a.reshape(B, T, HGRN_HEADS, -1).astype(jnp.float32)

    def gates(z, lb_d):
        lbh = lb_d.reshape(HGRN_HEADS, HGRN_DK)
        logf = jnp.logaddexp(jnp.log(lbh), jnp.log1p(-lbh) + jax.nn.log_sigmoid(z))
        k = (1.0 - lbh) * jax.nn.sigmoid(-z)
        return logf, k

    qh, ih = heads(q), heads(inp)
    lf_f, k_f = gates(heads(zf), lb[0])
    lf_b, k_b = gates(heads(zb), lb[1])
    s0 = s0.astype(jnp.float32)
    o_f, s_f = hgrn_scan(qh, k_f, ih, lf_f, s0[:, 0])
    o_b, s_b = hgrn_scan(qh[:, ::-1], k_b[:, ::-1], ih[:, ::-1], lf_b[:, ::-1], s0[:, 1])
    o = o_f + o_b[:, ::-1]
    o = rmsnorm(o, norm_g.reshape(HGRN_HEADS, HGRN_DV)).astype(h.dtype).reshape(B, T, D)
    return (o * jax.nn.silu(g)) @ w_out, jnp.stack([s_f, s_b], axis=1)


def conv_ffn(h, w_up, w_dw, w_down):
    a, b = jnp.split(dwconv3(h @ w_up, w_dw), 2, axis=-1)
    return (jax.nn.silu(a) * b) @ w_down


def setup_inputs(seed: int = 0) -> dict:
    key = jax.random.key(seed)
    ks = iter(jax.random.split(key, 32))

    def nrm(shape, scale):
        return scale * jax.random.normal(next(ks), shape, jnp.float32)

    n_a, n_b, n_c, n_d = (_layers_of(k) for k in range(N_MIXERS))
    D = D_MODEL
    return {
        'x_prompt': nrm((BATCH, SEQ, D), 1.0),
        'x_sample': nrm((DEC_BATCH, DEC_SEQ, D), 1.0),
        'state_rec': nrm((DEC_BATCH, n_d, 2, HGRN_HEADS, HGRN_DK, HGRN_DV), 0.5),
        'c': nrm((DEC_BATCH, D), 1.0),
        'c_ctx': nrm((D,), 1.0),
        'ada_w': nrm((DEPTH, D, 6 * D), 0.5 * D ** -0.5),
        'ada_b': nrm((DEPTH, 6 * D), 0.01),
        'norm_g': 1.0 + nrm((DEPTH, 2, D), 0.1),
        'final_g': 1.0 + nrm((D,), 0.1),
        'conv_w_in': nrm((n_a, D, 3 * D), D ** -0.5),
        'conv_w_dw': nrm((n_a, CONV_W, D), CONV_W ** -0.5),
        'conv_w_out': nrm((n_a, D, D), D ** -0.5),
        'pool_w': nrm((n_b, len(POOL_WINDOWS), POOL_GROUP, POOL_GROUP), POOL_GROUP ** -0.5),
        'pool_scale': 1.0 + nrm((n_b, D), 0.1),
        'sgu_w_in': nrm((n_c, D, 2 * D), D ** -0.5),
        'sgu_norm_g': 1.0 + nrm((n_c, D), 0.1),
        'sgu_w_s': nrm((n_c, SGU_GROUPS, SGU_CHUNK, SGU_CHUNK), SGU_CHUNK ** -0.5),
        'sgu_b_s': 1.0 + nrm((n_c, SGU_GROUPS, SGU_CHUNK), 0.1),
        'sgu_w_out': nrm((n_c, D, D), D ** -0.5),
        'hgrn_w_in': nrm((n_d, D, 5 * D), D ** -0.5),
        'hgrn_lb': nrm((DEPTH, 2, D), 0.1),
        'hgrn_norm_g': 1.0 + nrm((n_d, D), 0.1),
        'hgrn_w_out': nrm((n_d, D, D), D ** -0.5),
        'ffn_w_up': nrm((DEPTH, D, 2 * D_FF), D ** -0.5),
        'ffn_w_dw': nrm((DEPTH, CONV_W, 2 * D_FF), CONV_W ** -0.5),
        'ffn_w_down': nrm((DEPTH, D_FF, D), D_FF ** -0.5),
    }


def reference(x_prompt, x_sample, state_rec, c, c_ctx, ada_w, ada_b, norm_g, final_g,
              conv_w_in, conv_w_dw, conv_w_out, pool_w, pool_scale,
              sgu_w_in, sgu_norm_g, sgu_w_s, sgu_b_s, sgu_w_out,
              hgrn_w_in, hgrn_lb, hgrn_norm_g, hgrn_w_out,
              ffn_w_up, ffn_w_dw, ffn_w_down):
    xp = x_prompt
    xs = x_sample + grid_pos_embed(x_sample.shape[1]).astype(x_sample.dtype)[None]
    lbs = hgrn_lower_bounds(hgrn_lb)
    ctx_states = []
    for i in range(DEPTH):
        kind, j = i % N_MIXERS, i // N_MIXERS
        mp = adaln_params(c_ctx[None], ada_w[i], ada_b[i])
        ms = adaln_params(c, ada_w[i], ada_b[i])
        hp = modulate(rmsnorm(xp, norm_g[i, 0]), mp[0], mp[1])
        hs = modulate(rmsnorm(xs, norm_g[i, 0]), ms[0], ms[1])
        if kind == 0:
            yp = short_conv_mixer(hp, conv_w_in[j], conv_w_dw[j], conv_w_out[j])
            ys = short_conv_mixer(hs, conv_w_in[j], conv_w_dw[j], conv_w_out[j])
        elif kind == 1:
            yp = pool_mixer(hp, pool_w[j], pool_scale[j])
            ys = pool_mixer(hs, pool_w[j], pool_scale[j])
        elif kind == 2:
            yp = sgu_mixer(hp, sgu_w_in[j], sgu_norm_g[j], sgu_w_s[j], sgu_b_s[j], sgu_w_out[j])
            ys = sgu_mixer(hs, sgu_w_in[j], sgu_norm_g[j], sgu_w_s[j], sgu_b_s[j], sgu_w_out[j])
        else:
            zero_state = jnp.zeros((xp.shape[0], 2, HGRN_HEADS, HGRN_DK, HGRN_DV), jnp.float32)
            yp, sp = hgrn_mixer(hp, hgrn_w_in[j], lbs[i], hgrn_norm_g[j], hgrn_w_out[j], zero_state)
            ys, _ = hgrn_mixer(hs, hgrn_w_in[j], lbs[i], hgrn_norm_g[j], hgrn_w_out[j], state_rec[:, j])
            ctx_states.append(sp)
        xp = xp + mp[2] * yp
        xs = xs + ms[2] * ys
        hp = modulate(rmsnorm(xp, norm_g[i, 1]), mp[3], mp[4])
        hs = modulate(rmsnorm(xs, norm_g[i, 1]), ms[3], ms[4])
        xp = xp + mp[5] * conv_ffn(hp, ffn_w_up[i], ffn_w_dw[i], ffn_w_down[i])
        xs = xs + ms[5] * conv_ffn(hs, ffn_w_up[i], ffn_w_dw[i], ffn_w_down[i])
    new_state_rec = jnp.stack(ctx_states, axis=1)
    y_prompt = rmsnorm(xp, final_g)
    y_sample = rmsnorm(xs, final_g)
    return (y_prompt, y_sample, new_state_rec)
```

```cpp
#include <hip/hip_runtime.h>
#include <hip/hip_cooperative_groups.h>
#include <stdint.h>
#include <stdio.h>
namespace cg = cooperative_groups;

#define DEVINL __device__ __forceinline__
typedef unsigned short bfr;
using bf16x8 = __attribute__((ext_vector_type(8))) short;
using f32x4 = __attribute__((ext_vector_type(4))) float;
using u32x4 = __attribute__((ext_vector_type(4))) unsigned int;

constexpr int DM = 1024;
constexpr int MTOK = 20480;
constexpr int NPROMPT = 4096;
constexpr int DFF = 2816;
constexpr int HALF_FF = 1408;
constexpr float EPS = 1e-6f;

constexpr size_t OFF_MODP = 0;
constexpr size_t OFF_MOD = 7864320;
constexpr size_t OFF_LBS = OFF_MOD + 491520;
constexpr size_t OFF_WB = 8388608;
constexpr size_t OFF_H = 41943040;
constexpr size_t OFF_BIG = 83886080;
constexpr size_t WS_NEED = OFF_BIG + 251658240ull;
constexpr size_t WB_IN = 0, WB_OUT = 5242880, WB_UP = 6291456, WB_DOWN = 12058624;

struct Params {
  const float* in[26];
  float* out;
  char* ws;
};

DEVINL int otid() { int t = threadIdx.x; asm volatile("" : "+v"(t)); return t; }
DEVINL int osg(int x) { asm volatile("" : "+s"(x)); return x; }
DEVINL bfr f2bf(float f) {
  uint32_t u = __float_as_uint(f);
  u += 0x7fffu + ((u >> 16) & 1u);
  return (bfr)(u >> 16);
}
DEVINL float bf2f(bfr h) { return __uint_as_float(((uint32_t)h) << 16); }
DEVINL uint32_t pk2(float a, float b) { return (uint32_t)f2bf(a) | ((uint32_t)f2bf(b) << 16); }
DEVINL float bflo(uint32_t u) { return __uint_as_float(u << 16); }
DEVINL float bfhi(uint32_t u) { return __uint_as_float(u & 0xffff0000u); }
DEVINL int cond_of(int m) { return m < NPROMPT ? 0 : 1 + ((m - NPROMPT) >> 12); }
DEVINL float silu_f(float x) { return x / (1.f + __expf(-x)); }
DEVINL float gelu_tanh_f(float x) {
  float y = 0.7978845608028654f * (x + 0.044715f * x * x * x);
  float t = 1.f - 2.f / (__expf(2.f * y) + 1.f);
  return 0.5f * x * (1.f + t);
}
DEVINL float wave_sum(float v) {
#pragma unroll
  for (int o = 32; o > 0; o >>= 1) v += __shfl_xor(v, o);
  return v;
}

struct EpiStore {
  bfr* C; int ldc;
  DEVINL void operator()(int m, int n, f32x4 v) const {
    uint2 o; o.x = pk2(v[0], v[1]); o.y = pk2(v[2], v[3]);
    *(uint2*)(C + (size_t)m * ldc + n) = o;
  }
};
struct EpiGelu {
  bfr* C; int ldc;
  DEVINL void operator()(int m, int n, f32x4 v) const {
    uint2 o; o.x = pk2(gelu_tanh_f(v[0]), gelu_tanh_f(v[1])); o.y = pk2(gelu_tanh_f(v[2]), gelu_tanh_f(v[3]));
    *(uint2*)(C + (size_t)m * ldc + n) = o;
  }
};
struct EpiResid {
  float* X; const float* gate; const float* cscale; int coff;
  DEVINL void operator()(int m, int n, f32x4 v) const {
    const int cond = cond_of(m);
    const float4 g = *(const float4*)(gate + cond * 6144 + n);
    float4* xp = (float4*)(X + (size_t)m * DM + coff + n);
    float4 x = *xp;
    float s0 = 1.f, s1 = 1.f, s2 = 1.f, s3 = 1.f;
    if (cscale) { const float4 s = *(const float4*)(cscale + n); s0 = s.x; s1 = s.y; s2 = s.z; s3 = s.w; }
    x.x += g.x * v[0] * s0; x.y += g.y * v[1] * s1; x.z += g.z * v[2] * s2; x.w += g.w * v[3] * s3;
    *xp = x;
  }
};

template <class Epi>
DEVINL void gemm_phase(const bfr* __restrict__ A, int lda, const bfr* __restrict__ Bt, int ldb, int N, int K,
                       const Epi& epi, char* smem, int bid, int nblk) {
  constexpr int LS = 72;
  bfr* sA = (bfr*)smem;
  bfr* sB = sA + 2 * 128 * LS;
  const int tid = otid(), lane = tid & 63, wave = tid >> 6;
  const int wm = wave >> 1, wn = wave & 1, l15 = lane & 15, quad = lane >> 4;
  const int tilesN = N >> 7;
  const int ntiles = (MTOK >> 7) * tilesN;
  const int nk = K >> 6;
  const int lrow = tid >> 3, lch = tid & 7;
  for (int tile = bid; tile < ntiles; tile += nblk) {
    const int tm = tile / tilesN, tn = tile - tm * tilesN;
    const int m0 = tm << 7, n0 = tn << 7;
    const bfr* gA = A + (size_t)(m0 + lrow) * lda + lch * 8;
    const bfr* gB = Bt + (size_t)(n0 + lrow) * ldb + lch * 8;
    f32x4 acc[4][4];
#pragma unroll
    for (int i = 0; i < 4; ++i)
#pragma unroll
      for (int j = 0; j < 4; ++j) acc[i][j] = f32x4{0.f, 0.f, 0.f, 0.f};
    u32x4 ra0, ra1, ra2, ra3, rb0, rb1, rb2, rb3;
    ra0 = *(const u32x4*)(gA); ra1 = *(const u32x4*)(gA + (size_t)32 * lda);
    ra2 = *(const u32x4*)(gA + (size_t)64 * lda); ra3 = *(const u32x4*)(gA + (size_t)96 * lda);
    rb0 = *(const u32x4*)(gB); rb1 = *(const u32x4*)(gB + (size_t)32 * ldb);
    rb2 = *(const u32x4*)(gB + (size_t)64 * ldb); rb3 = *(const u32x4*)(gB + (size_t)96 * ldb);
    __syncthreads();
    {
      bfr* dA = sA + lrow * LS + lch * 8;
      bfr* dB = sB + lrow * LS + lch * 8;
      *(u32x4*)(dA) = ra0; *(u32x4*)(dA + 32 * LS) = ra1; *(u32x4*)(dA + 64 * LS) = ra2; *(u32x4*)(dA + 96 * LS) = ra3;
      *(u32x4*)(dB) = rb0; *(u32x4*)(dB + 32 * LS) = rb1; *(u32x4*)(dB + 64 * LS) = rb2; *(u32x4*)(dB + 96 * LS) = rb3;
    }
    __syncthreads();
    for (int kt = 0; kt < nk; ++kt) {
      const int buf = kt & 1;
      const int ktn = (kt + 1 < nk) ? kt + 1 : kt;
      {
        const bfr* pA = gA + ktn * 64;
        const bfr* pB = gB + ktn * 64;
        ra0 = *(const u32x4*)(pA); ra1 = *(const u32x4*)(pA + (size_t)32 * lda);
        ra2 = *(const u32x4*)(pA + (size_t)64 * lda); ra3 = *(const u32x4*)(pA + (size_t)96 * lda);
        rb0 = *(const u32x4*)(pB); rb1 = *(const u32x4*)(pB + (size_t)32 * ldb);
        rb2 = *(const u32x4*)(pB + (size_t)64 * ldb); rb3 = *(const u32x4*)(pB + (size_t)96 * ldb);
      }
      const bfr* cA = sA + buf * 128 * LS + (wm * 64 + l15) * LS + quad * 8;
      const bfr* cB = sB + buf * 128 * LS + (wn * 64 + l15) * LS + quad * 8;
#pragma unroll
      for (int kk = 0; kk < 2; ++kk) {
        bf16x8 af[4], bfg[4];
#pragma unroll
        for (int i = 0; i < 4; ++i) {
          af[i] = *(const bf16x8*)(cA + i * 16 * LS + kk * 32);
          bfg[i] = *(const bf16x8*)(cB + i * 16 * LS + kk * 32);
        }
#pragma unroll
        for (int mt = 0; mt < 4; ++mt)
#pragma unroll
          for (int nt = 0; nt < 4; ++nt)
            acc[mt][nt] = __builtin_amdgcn_mfma_f32_16x16x32_bf16(bfg[nt], af[mt], acc[mt][nt], 0, 0, 0);
      }
      {
        bfr* dA = sA + (buf ^ 1) * 128 * LS + lrow * LS + lch * 8;
        bfr* dB = sB + (buf ^ 1) * 128 * LS + lrow * LS + lch * 8;
        *(u32x4*)(dA) = ra0; *(u32x4*)(dA + 32 * LS) = ra1; *(u32x4*)(dA + 64 * LS) = ra2; *(u32x4*)(dA + 96 * LS) = ra3;
        *(u32x4*)(dB) = rb0; *(u32x4*)(dB + 32 * LS) = rb1; *(u32x4*)(dB + 64 * LS) = rb2; *(u32x4*)(dB + 96 * LS) = rb3;
      }
      __syncthreads();
    }
#pragma unroll
    for (int mt = 0; mt < 4; ++mt)
#pragma unroll
      for (int nt = 0; nt < 4; ++nt)
        epi(m0 + wm * 64 + mt * 16 + l15, n0 + wn * 64 + nt * 16 + quad * 4, acc[mt][nt]);
  }
}

DEVINL int up_perm(int n0) {
  if (n0 < DFF) { int h = n0 >= HALF_FF; return h * DFF + (n0 - h * HALF_FF); }
  int j = n0 - DFF; int h = j >= HALF_FF; return h * DFF + HALF_FF + (j - h * HALF_FF);
}
DEVINL void conv_matrix(const float* __restrict__ src, int K, int N, bfr* __restrict__ dst, int perm,
                        char* smem, int bid, int nblk) {
  float* sT = (float*)smem;
  const int tid = otid();
  const int tilesN = N >> 6;
  const int ntiles = (K >> 6) * tilesN;
  for (int t = bid; t < ntiles; t += nblk) {
    const int tk = t / tilesN, tn = t - tk * tilesN;
    const int k0 = tk << 6, n0 = tn << 6;
    const int r = tid >> 4, c4 = tid & 15;
    __syncthreads();
#pragma unroll
    for (int i = 0; i < 4; ++i) {
      const float4 v = *(const float4*)(src + (size_t)(k0 + r + i * 16) * N + n0 + c4 * 4);
      float* d = sT + (r + i * 16) * 65 + c4 * 4;
      d[0] = v.x; d[1] = v.y; d[2] = v.z; d[3] = v.w;
    }
    __syncthreads();
    const int n = tid >> 2, kc = tid & 3;
    uint32_t w[8];
#pragma unroll
    for (int j = 0; j < 8; ++j)
      w[j] = pk2(sT[(kc * 16 + 2 * j) * 65 + n], sT[(kc * 16 + 2 * j + 1) * 65 + n]);
    const int nd = (perm ? up_perm(n0) : n0) + n;
    bfr* dp = dst + (size_t)nd * K + k0 + kc * 16;
    *(uint4*)dp = make_uint4(w[0], w[1], w[2], w[3]);
    *(uint4*)(dp + 8) = make_uint4(w[4], w[5], w[6], w[7]);
  }
}

DEVINL void phase0a(const Params& p, char* smem, int bid, int nblk) {
  const int tid = otid();
  float* sc = (float*)smem;
  float* modp = (float*)(p.ws + OFF_MODP);
  const float* cvec = p.in[3];
  const float* cctx = p.in[4];
  const float* ada_w = p.in[5];
  for (int job = bid; job < 384; job += nblk) {
    const int l = job / 96, r = job - l * 96, ks = r / 6, cgp = r - ks * 6;
    __syncthreads();
    for (int i = tid; i < 320; i += 256) {
      const int cond = i >> 6, kk = i & 63;
      const float v = cond == 0 ? cctx[ks * 64 + kk] : cvec[(cond - 1) * DM + ks * 64 + kk];
      sc[i] = silu_f(v);
    }
    __syncthreads();
    const int col = cgp * 1024 + tid * 4;
    const float* wp = ada_w + ((size_t)l * DM + ks * 64) * 6144 + col;
    float a[5][4];
#pragma unroll
    for (int c = 0; c < 5; ++c)
#pragma unroll
      for (int j = 0; j < 4; ++j) a[c][j] = 0.f;
#pragma unroll 8
    for (int kk = 0; kk < 64; ++kk) {
      const float4 w = *(const float4*)(wp + (size_t)kk * 6144);
#pragma unroll
      for (int c = 0; c < 5; ++c) {
        const float s = sc[c * 64 + kk];
        a[c][0] += s * w.x; a[c][1] += s * w.y; a[c][2] += s * w.z; a[c][3] += s * w.w;
      }
    }
#pragma unroll
    for (int c = 0; c < 5; ++c)
      *(float4*)(modp + ((size_t)(ks * 4 + l) * 5 + c) * 6144 + col) = make_float4(a[c][0], a[c][1], a[c][2], a[c][3]);
  }
  const int gt = bid * 256 + tid, nt = nblk * 256;
  {
    const float* lb = p.in[20];
    float* lbs = (float*)(p.ws + OFF_LBS);
    for (int i = gt; i < 2048; i += nt) {
      const float v0 = lb[i], v1 = lb[2048 + i], v2 = lb[4096 + i], v3 = lb[6144 + i];
      const float mx = fmaxf(fmaxf(v0, v1), fmaxf(v2, v3));
      const float e0 = expf(v0 - mx), e1 = expf(v1 - mx), e2 = expf(v2 - mx), e3 = expf(v3 - mx);
      lbs[i] = (e1 + e2 + e3) / (e0 + e1 + e2 + e3);
    }
  }
  float* X = p.out;
  {
    const float4* xp = (const float4*)p.in[0];
    float4* xo = (float4*)X;
    for (int i = gt; i < NPROMPT * DM / 4; i += nt) xo[i] = xp[i];
    const float* xs = p.in[1];
    for (int i = gt; i < 4096 * 256; i += nt) {
      const int t = i >> 8, c = (i & 255) * 4;
      const int part = c >> 8;
      const float pos = (float)((part < 2) ? (t >> 6) : (t & 63));
      float pe[4];
#pragma unroll
      for (int j = 0; j < 4; ++j) {
        const int jj = (c + j) & 255;
        const float freq = expf((-9.210340371976184f * (float)jj) / 256.0f);
        const float arg = pos * freq;
        pe[j] = (part & 1) ? cosf(arg) : sinf(arg);
      }
#pragma unroll
      for (int b = 0; b < 4; ++b) {
        const size_t off = ((size_t)b * 4096 + t) * DM + c;
        float4 v = *(const float4*)(xs + off);
        v.x += pe[0]; v.y += pe[1]; v.z += pe[2]; v.w += pe[3];
        *(float4*)(X + (size_t)NPROMPT * DM + off) = v;
      }
    }
  }
}

DEVINL void phase0b(const Params& p, int bid, int nblk) {
  const int gt = bid * 256 + otid(), nt = nblk * 256;
  const float* modp = (const float*)(p.ws + OFF_MODP);
  float* mod = (float*)(p.ws + OFF_MOD);
  const float* ada_b = p.in[6];
  for (int i = gt; i < 4 * 5 * 6144; i += nt) {
    const int l = i / 30720, col = i % 6144;
    float s = ada_b[l * 6144 + col];
#pragma unroll
    for (int ks = 0; ks < 16; ++ks) s += modp[(size_t)ks * 122880 + i];
    mod[i] = s;
  }
}

DEVINL void norm_phase(const float* __restrict__ X, const float* __restrict__ g, const float* __restrict__ modl,
                       int shift_off, int scale_off, bfr* __restrict__ H, int bid, int nblk) {
  const int tid = otid(); const int lane = tid & 63;
  const int gw = bid * 4 + (tid >> 6), nw = nblk * 4;
  for (int row = gw; row < MTOK; row += nw) {
    const float* xr = X + (size_t)row * DM;
    float4 x[4];
    float ss = 0.f;
#pragma unroll
    for (int i = 0; i < 4; ++i) {
      x[i] = *(const float4*)(xr + i * 256 + lane * 4);
      ss += x[i].x * x[i].x + x[i].y * x[i].y + x[i].z * x[i].z + x[i].w * x[i].w;
    }
    ss = wave_sum(ss);
    const float rstd = rsqrtf(ss * (1.f / DM) + EPS);
    const float* mc = modl + cond_of(row) * 6144;
#pragma unroll
    for (int i = 0; i < 4; ++i) {
      const int c = i * 256 + lane * 4;
      const float4 gg = *(const float4*)(g + c);
      const float4 sh = *(const float4*)(mc + shift_off + c);
      const float4 sc = *(const float4*)(mc + scale_off + c);
      const float h0 = x[i].x * rstd * gg.x * (1.f + sc.x) + sh.x;
      const float h1 = x[i].y * rstd * gg.y * (1.f + sc.y) + sh.y;
      const float h2 = x[i].z * rstd * gg.z * (1.f + sc.z) + sh.z;
      const float h3 = x[i].w * rstd * gg.w * (1.f + sc.w) + sh.w;
      uint2 o; o.x = pk2(h0, h1); o.y = pk2(h2, h3);
      *(uint2*)(H + (size_t)row * DM + c) = o;
    }
  }
}

DEVINL void final_norm_phase(float* X, const float* __restrict__ g, int bid, int nblk) {
  const int tid = otid(); const int lane = tid & 63;
  const int gw = bid * 4 + (tid >> 6), nw = nblk * 4;
  for (int row = gw; row < MTOK; row += nw) {
    float* xr = X + (size_t)row * DM;
    float4 x[4];
    float ss = 0.f;
#pragma unroll
    for (int i = 0; i < 4; ++i) {
      x[i] = *(const float4*)(xr + i * 256 + lane * 4);
      ss += x[i].x * x[i].x + x[i].y * x[i].y + x[i].z * x[i].z + x[i].w * x[i].w;
    }
    ss = wave_sum(ss);
    const float rstd = rsqrtf(ss * (1.f / DM) + EPS);
#pragma unroll
    for (int i = 0; i < 4; ++i) {
      const int c = i * 256 + lane * 4;
      const float4 gg = *(const float4*)(g + c);
      float4 o;
      o.x = x[i].x * rstd * gg.x; o.y = x[i].y * rstd * gg.y; o.z = x[i].z * rstd * gg.z; o.w = x[i].w * rstd * gg.w;
      *(float4*)(xr + c) = o;
    }
  }
}

DEVINL void tok_pos(int m, int& tl, int& T) {
  if (m < NPROMPT) { tl = m & 255; T = 256; } else { tl = (m - NPROMPT) & 4095; T = 4096; }
}

DEVINL void shortconv_ew_phase(const bfr* __restrict__ G, const float* __restrict__ wdw, bfr* __restrict__ U, int bid, int nblk) {
  const int gt = bid * 256 + otid(), nt = nblk * 256;
  for (int i = gt; i < MTOK * 128; i += nt) {
    const int m = i >> 7, c = (i & 127) * 8;
    int tl, T; tok_pos(m, tl, T);
    const bfr* gr = G + (size_t)m * 3072;
    const uint4 bg = *(const uint4*)(gr + c);
    float accv[8];
#pragma unroll
    for (int j = 0; j < 8; ++j) accv[j] = 0.f;
#pragma unroll
    for (int tap = 0; tap < 3; ++tap) {
      const int d = tap - 1;
      if ((d < 0 && tl == 0) || (d > 0 && tl == T - 1)) continue;
      const bfr* nr = gr + (ptrdiff_t)d * 3072;
      const uint4 cgv = *(const uint4*)(nr + 1024 + c);
      const uint4 xhv = *(const uint4*)(nr + 2048 + c);
      const float4 w0 = *(const float4*)(wdw + tap * DM + c);
      const float4 w1 = *(const float4*)(wdw + tap * DM + c + 4);
      accv[0] += w0.x * bflo(cgv.x) * bflo(xhv.x); accv[1] += w0.y * bfhi(cgv.x) * bfhi(xhv.x);
      accv[2] += w0.z * bflo(cgv.y) * bflo(xhv.y); accv[3] += w0.w * bfhi(cgv.y) * bfhi(xhv.y);
      accv[4] += w1.x * bflo(cgv.z) * bflo(xhv.z); accv[5] += w1.y * bfhi(cgv.z) * bfhi(xhv.z);
      accv[6] += w1.z * bflo(cgv.w) * bflo(xhv.w); accv[7] += w1.w * bfhi(cgv.w) * bfhi(xhv.w);
    }
    uint4 o;
    o.x = pk2(bflo(bg.x) * accv[0], bfhi(bg.x) * accv[1]);
    o.y = pk2(bflo(bg.y) * accv[2], bfhi(bg.y) * accv[3]);
    o.z = pk2(bflo(bg.z) * accv[4], bfhi(bg.z) * accv[5]);
    o.w = pk2(bflo(bg.w) * accv[6], bfhi(bg.w) * accv[7]);
    *(uint4*)(U + (size_t)m * DM + c) = o;
  }
}

DEVINL void pool_ew_phase(const bfr* __restrict__ H, bfr* __restrict__ P, int bid, int nblk) {
  const int gt = bid * 256 + otid(), nt = nblk * 256;
  for (int i = gt; i < MTOK * 128; i += nt) {
    const int m = i >> 7, ch = i & 127, c = ch * 8;
    int tl, T; tok_pos(m, tl, T);
    const int hw = 1 << (ch >> 5);
    const int lo = max(tl - hw, 0), hi = min(tl + hw, T);
    float s[8];
#pragma unroll
    for (int j = 0; j < 8; ++j) s[j] = 0.f;
    const bfr* base = H + (size_t)(m - tl) * DM + c;
    for (int q = lo; q < hi; ++q) {
      const uint4 v = *(const uint4*)(base + (size_t)q * DM);
      s[0] += bflo(v.x); s[1] += bfhi(v.x); s[2] += bflo(v.y); s[3] += bfhi(v.y);
      s[4] += bflo(v.z); s[5] += bfhi(v.z); s[6] += bflo(v.w); s[7] += bfhi(v.w);
    }
    const float inv = 1.f / (float)(hi - lo);
    const uint4 v = *(const uint4*)(base + (size_t)tl * DM);
    uint4 o;
    o.x = pk2(s[0] * inv - bflo(v.x), s[1] * inv - bfhi(v.x));
    o.y = pk2(s[2] * inv - bflo(v.y), s[3] * inv - bfhi(v.y));
    o.z = pk2(s[4] * inv - bflo(v.z), s[5] * inv - bfhi(v.z));
    o.w = pk2(s[6] * inv - bflo(v.w), s[7] * inv - bfhi(v.w));
    *(uint4*)(P + (size_t)m * DM + c) = o;
  }
}

DEVINL void sgu_norm_phase(bfr* UV, const float* __restrict__ g, int bid, int nblk) {
  const int tid = otid(); const int lane = tid & 63;
  const int gw = bid * 4 + (tid >> 6), nw = nblk * 4;
  for (int row = gw; row < MTOK; row += nw) {
    bfr* vr = UV + (size_t)row * 2048 + 1024;
    float x[4][4];
    float ss = 0.f;
#pragma unroll
    for (int i = 0; i < 4; ++i) {
      const uint2 v = *(const uint2*)(vr + i * 256 + lane * 4);
      x[i][0] = bflo(v.x); x[i][1] = bfhi(v.x); x[i][2] = bflo(v.y); x[i][3] = bfhi(v.y);
      ss += x[i][0] * x[i][0] + x[i][1] * x[i][1] + x[i][2] * x[i][2] + x[i][3] * x[i][3];
    }
    ss = wave_sum(ss);
    const float rstd = rsqrtf(ss * (1.f / DM) + EPS);
#pragma unroll
    for (int i = 0; i < 4; ++i) {
      const int c = i * 256 + lane * 4;
      const float4 gg = *(const float4*)(g + c);
      uint2 o;
      o.x = pk2(x[i][0] * rstd * gg.x, x[i][1] * rstd * gg.y);
      o.y = pk2(x[i][2] * rstd * gg.z, x[i][3] * rstd * gg.w);
      *(uint2*)(vr + c) = o;
    }
  }
}

DEVINL void sgu_spatial_phase(bfr* UV, const float* __restrict__ ws_, const float* __restrict__ bs_, char* smem, int bid, int nblk) {
  bfr* sV = (bfr*)smem;
  bfr* sW = sV + 128 * 136;
  const int tid = otid(), lane = tid & 63, wave = tid >> 6, l15 = lane & 15, quad = lane >> 4;
  for (int item = bid; item < 160 * 8; item += nblk) {
    const int chunk = item >> 3, g = item & 7;
    __syncthreads();
    const float* wg = ws_ + (size_t)g * 16384;
#pragma unroll 4
    for (int i = 0; i < 16; ++i) {
      const int idx = tid + 256 * i;
      const int row = idx >> 5, chn = idx & 31;
      const float4 v = *(const float4*)(wg + row * 128 + chn * 4);
      uint2 o; o.x = pk2(v.x, v.y); o.y = pk2(v.z, v.w);
      *(uint2*)(sW + row * 136 + chn * 4) = o;
    }
#pragma unroll 2
    for (int i = 0; i < 8; ++i) {
      const int idx = tid + 256 * i;
      const int q = idx >> 4, chn = idx & 15;
      const uint4 v = *(const uint4*)(UV + (size_t)(chunk * 128 + q) * 2048 + 1024 + g * 128 + chn * 8);
      bfr* d = sV + (chn * 8) * 136 + q;
      d[0 * 136] = (bfr)(v.x & 0xffff); d[1 * 136] = (bfr)(v.x >> 16);
      d[2 * 136] = (bfr)(v.y & 0xffff); d[3 * 136] = (bfr)(v.y >> 16);
      d[4 * 136] = (bfr)(v.z & 0xffff); d[5 * 136] = (bfr)(v.z >> 16);
      d[6 * 136] = (bfr)(v.w & 0xffff); d[7 * 136] = (bfr)(v.w >> 16);
    }
    __syncthreads();
    f32x4 acc[8][2];
#pragma unroll
    for (int i = 0; i < 8; ++i) { acc[i][0] = f32x4{0.f, 0.f, 0.f, 0.f}; acc[i][1] = f32x4{0.f, 0.f, 0.f, 0.f}; }
#pragma unroll
    for (int kk = 0; kk < 4; ++kk) {
      bf16x8 bw[2];
#pragma unroll
      for (int pt = 0; pt < 2; ++pt) bw[pt] = *(const bf16x8*)(sW + (wave * 32 + pt * 16 + l15) * 136 + kk * 32 + quad * 8);
#pragma unroll
      for (int ct = 0; ct < 8; ++ct) {
        const bf16x8 av = *(const bf16x8*)(sV + (ct * 16 + l15) * 136 + kk * 32 + quad * 8);
#pragma unroll
        for (int pt = 0; pt < 2; ++pt)
          acc[ct][pt] = __builtin_amdgcn_mfma_f32_16x16x32_bf16(av, bw[pt], acc[ct][pt], 0, 0, 0);
      }
    }
#pragma unroll
    for (int pt = 0; pt < 2; ++pt) {
      const int pp = wave * 32 + pt * 16 + l15;
      const float bias = bs_[g * 128 + pp];
      bfr* ur = UV + (size_t)(chunk * 128 + pp) * 2048 + g * 128 + quad * 4;
#pragma unroll
      for (int ct = 0; ct < 8; ++ct) {
        const uint2 u = *(const uint2*)(ur + ct * 16);
        uint2 o;
        o.x = pk2(bflo(u.x) * (acc[ct][pt][0] + bias), bfhi(u.x) * (acc[ct][pt][1] + bias));
        o.y = pk2(bflo(u.y) * (acc[ct][pt][2] + bias), bfhi(u.y) * (acc[ct][pt][3] + bias));
        *(uint2*)(ur + ct * 16) = o;
      }
    }
  }
}

DEVINL void hgrn_scan_phase(const Params& p, char* smem, int bid, int nblk) {
  bfr* sQe = (bfr*)smem;
  bfr* sKe = sQe + 32 * 136;
  bfr* sKeT = sKe + 32 * 136;
  bfr* sVT = sKeT + 128 * 40;
  bfr* sP = sVT + 64 * 40;
  bfr* sST = sP + 32 * 40;
  float* sLast = (float*)(sST + 64 * 136);
  float* sTot = sLast + 128;
  const int tid = otid(), lane = tid & 63, wave = tid >> 6, l15 = lane & 15, quad = lane >> 4;
  const int cp = lane, qt = wave, i0 = qt * 8;
  const bfr* QZ = (const bfr*)(p.ws + OFF_BIG);
  bfr* Of = (bfr*)(p.ws + OFF_H);
  bfr* Ob = (bfr*)(p.ws + OFF_BIG + 209715200ull);
  const float* lbs = (const float*)(p.ws + OFF_LBS);
  const float* state_rec = p.in[2];
  float* out_state = p.out + (size_t)MTOK * DM;

  for (int item = bid; item < 640; item += nblk) {
    int seq, rem;
    if (item < 128) { seq = 16 + (item >> 5); rem = item & 31; } else { seq = (item - 128) >> 5; rem = (item - 128) & 31; }
    const int h = rem >> 2, dir = (rem >> 1) & 1, eh = rem & 1;
    const bool is_prompt = seq < 16;
    const int base = is_prompt ? seq * 256 : NPROMPT + (seq - 16) * 4096;
    const int T = is_prompt ? 256 : 4096;
    const int nchunks = T >> 5;
    bfr* Od = dir ? Ob : Of;
    const float lbv0 = lbs[dir * 1024 + h * 128 + 2 * cp], lbv1 = lbs[dir * 1024 + h * 128 + 2 * cp + 1];
    const int eloc = wave * 16 + l15;
    const int eglob = eh * 64 + eloc;

    f32x4 S[8];
    if (is_prompt) {
#pragma unroll
      for (int dt = 0; dt < 8; ++dt) S[dt] = f32x4{0.f, 0.f, 0.f, 0.f};
    } else {
      const float* s0 = state_rec + ((size_t)((seq - 16) * 2 + dir) * 8 + h) * 16384;
#pragma unroll
      for (int dt = 0; dt < 8; ++dt)
#pragma unroll
        for (int j = 0; j < 4; ++j) S[dt][j] = s0[(dt * 16 + quad * 4 + j) * 128 + eglob];
    }
    __syncthreads();
#pragma unroll
    for (int dt = 0; dt < 8; ++dt) {
      uint2 o; o.x = pk2(S[dt][0], S[dt][1]); o.y = pk2(S[dt][2], S[dt][3]);
      *(uint2*)(sST + eloc * 136 + dt * 16 + quad * 4) = o;
    }

    const int qoff = h * 128 + 2 * cp, zoff = (1 + dir) * 1024 + h * 128 + 2 * cp;
    const int voff = 3072 + h * 128 + eh * 64 + 2 * (cp & 31);
    uint32_t rq[8], rz[8], rv[8];
#pragma unroll
    for (int ii = 0; ii < 8; ++ii) {
      const int pos = i0 + ii;
      const int tok = dir ? base + T - 1 - pos : base + pos;
      const bfr* rowp = QZ + (size_t)tok * 5120;
      rq[ii] = *(const uint32_t*)(rowp + qoff); rz[ii] = *(const uint32_t*)(rowp + zoff); rv[ii] = *(const uint32_t*)(rowp + voff);
    }

    for (int c = 0; c < nchunks; ++c) {
      float bc0[8], bc1[8], kv0[8], kv1[8];
      float run0 = 0.f, run1 = 0.f;
#pragma unroll
      for (int ii = 0; ii < 8; ++ii) {
        const float z0 = bflo(rz[ii]), z1 = bfhi(rz[ii]);
        const float f0 = lbv0 + (1.f - lbv0) / (1.f + __expf(-z0));
        const float f1 = lbv1 + (1.f - lbv1) / (1.f + __expf(-z1));
        run0 += __logf(f0); run1 += __logf(f1);
        bc0[ii] = run0; bc1[ii] = run1;
        kv0[ii] = 1.f - f0; kv1[ii] = 1.f - f1;
      }
      *(float2*)(sTot + qt * 128 + 2 * cp) = make_float2(run0, run1);
      __syncthreads();
      {
        float off0 = 0.f, off1 = 0.f, tot0 = 0.f, tot1 = 0.f;
#pragma unroll
        for (int q = 0; q < 4; ++q) {
          const float2 t = *(const float2*)(sTot + q * 128 + 2 * cp);
          if (q < qt) { off0 += t.x; off1 += t.y; }
          tot0 += t.x; tot1 += t.y;
        }
        uint32_t wk0[4], wk1[4], wv0[4], wv1[4];
#pragma unroll
        for (int ii = 0; ii < 8; ii += 2) {
          uint32_t kp[2];
#pragma unroll
          for (int u = 0; u < 2; ++u) {
            const float b0 = bc0[ii + u] + off0, b1 = bc1[ii + u] + off1;
            const uint32_t qp = pk2(bflo(rq[ii + u]) * __expf(b0), bfhi(rq[ii + u]) * __expf(b1));
            kp[u] = pk2(kv0[ii + u] * __expf(-b0), kv1[ii + u] * __expf(-b1));
            *(uint32_t*)(sQe + (i0 + ii + u) * 136 + 2 * cp) = qp;
            *(uint32_t*)(sKe + (i0 + ii + u) * 136 + 2 * cp) = kp[u];
          }
          wk0[ii >> 1] = (kp[0] & 0xffffu) | (kp[1] << 16);
          wk1[ii >> 1] = (kp[0] >> 16) | (kp[1] & 0xffff0000u);
          wv0[ii >> 1] = (rv[ii] & 0xffffu) | (rv[ii + 1] << 16);
          wv1[ii >> 1] = (rv[ii] >> 16) | (rv[ii + 1] & 0xffff0000u);
        }
        *(u32x4*)(sKeT + (2 * cp) * 40 + i0) = u32x4{wk0[0], wk0[1], wk0[2], wk0[3]};
        *(u32x4*)(sKeT + (2 * cp + 1) * 40 + i0) = u32x4{wk1[0], wk1[1], wk1[2], wk1[3]};
        if (cp < 32) {
          *(u32x4*)(sVT + (2 * cp) * 40 + i0) = u32x4{wv0[0], wv0[1], wv0[2], wv0[3]};
          *(u32x4*)(sVT + (2 * cp + 1) * 40 + i0) = u32x4{wv1[0], wv1[1], wv1[2], wv1[3]};
        }
        if (qt == 0) *(float2*)(sLast + 2 * cp) = make_float2(__expf(tot0), __expf(tot1));
      }
      if (c + 1 < nchunks) {
#pragma unroll
        for (int ii = 0; ii < 8; ++ii) {
          const int pos = (c + 1) * 32 + i0 + ii;
          const int tok = dir ? base + T - 1 - pos : base + pos;
          const bfr* rowp = QZ + (size_t)tok * 5120;
          rq[ii] = *(const uint32_t*)(rowp + qoff); rz[ii] = *(const uint32_t*)(rowp + zoff); rv[ii] = *(const uint32_t*)(rowp + voff);
        }
      }
      __syncthreads();
      {
        const int ti = wave >> 1, si = wave & 1;
        f32x4 sc = f32x4{0.f, 0.f, 0.f, 0.f};
        if (si <= ti) {
#pragma unroll
          for (int kk = 0; kk < 4; ++kk) {
            const bf16x8 a = *(const bf16x8*)(sQe + (ti * 16 + l15) * 136 + kk * 32 + quad * 8);
            const bf16x8 b = *(const bf16x8*)(sKe + (si * 16 + l15) * 136 + kk * 32 + quad * 8);
            sc = __builtin_amdgcn_mfma_f32_16x16x32_bf16(a, b, sc, 0, 0, 0);
          }
        }
#pragma unroll
        for (int j = 0; j < 4; ++j) {
          const int t = ti * 16 + quad * 4 + j, s2 = si * 16 + l15;
          sP[t * 40 + s2] = (s2 <= t) ? f2bf(sc[j]) : (bfr)0;
        }
      }
      f32x4 oacc[2];
      oacc[0] = f32x4{0.f, 0.f, 0.f, 0.f}; oacc[1] = f32x4{0.f, 0.f, 0.f, 0.f};
#pragma unroll
      for (int kk = 0; kk < 4; ++kk) {
        const bf16x8 sb = *(const bf16x8*)(sST + eloc * 136 + kk * 32 + quad * 8);
#pragma unroll
        for (int tt = 0; tt < 2; ++tt) {
          const bf16x8 qa = *(const bf16x8*)(sQe + (tt * 16 + l15) * 136 + kk * 32 + quad * 8);
          oacc[tt] = __builtin_amdgcn_mfma_f32_16x16x32_bf16(sb, qa, oacc[tt], 0, 0, 0);
        }
      }
      __syncthreads();
      {
        const bf16x8 vb = *(const bf16x8*)(sVT + eloc * 40 + quad * 8);
#pragma unroll
        for (int tt = 0; tt < 2; ++tt) {
          const bf16x8 pb = *(const bf16x8*)(sP + (tt * 16 + l15) * 40 + quad * 8);
          oacc[tt] = __builtin_amdgcn_mfma_f32_16x16x32_bf16(vb, pb, oacc[tt], 0, 0, 0);
          const int pos = c * 32 + tt * 16 + l15;
          const int tok = dir ? base + T - 1 - pos : base + pos;
          uint2 o; o.x = pk2(oacc[tt][0], oacc[tt][1]); o.y = pk2(oacc[tt][2], oacc[tt][3]);
          *(uint2*)(Od + (size_t)tok * DM + h * 128 + eh * 64 + wave * 16 + quad * 4) = o;
        }
#pragma unroll
        for (int dt = 0; dt < 8; ++dt) {
          const bf16x8 ka = *(const bf16x8*)(sKeT + (dt * 16 + l15) * 40 + quad * 8);
          const float4 dl = *(const float4*)(sLast + dt * 16 + quad * 4);
          f32x4 sn = __builtin_amdgcn_mfma_f32_16x16x32_bf16(ka, vb, S[dt], 0, 0, 0);
          sn[0] *= dl.x; sn[1] *= dl.y; sn[2] *= dl.z; sn[3] *= dl.w;
          S[dt] = sn;
          uint2 o; o.x = pk2(sn[0], sn[1]); o.y = pk2(sn[2], sn[3]);
          *(uint2*)(sST + eloc * 136 + dt * 16 + quad * 4) = o;
        }
      }
    }
    if (is_prompt) {
      float* so = out_state + ((size_t)(seq * 2 + dir) * 8 + h) * 16384;
#pragma unroll
      for (int dt = 0; dt < 8; ++dt)
#pragma unroll
        for (int j = 0; j < 4; ++j) so[(dt * 16 + quad * 4 + j) * 128 + eglob] = S[dt][j];
    }
  }
}

DEVINL void hgrn_gate_phase(const Params& p, const float* __restrict__ ng, int bid, int nblk) {
  const int tid = otid(); const int lane = tid & 63;
  const int gw = bid * 4 + (tid >> 6), nw = nblk * 4;
  bfr* Of = (bfr*)(p.ws + OFF_H);
  const bfr* Ob = (const bfr*)(p.ws + OFF_BIG + 209715200ull);
  const bfr* QZ = (const bfr*)(p.ws + OFF_BIG);
  for (int row = gw; row < MTOK; row += nw) {
#pragma unroll
    for (int seg = 0; seg < 4; ++seg) {
      const int c = seg * 256 + lane * 4;
      const uint2 a = *(const uint2*)(Of + (size_t)row * DM + c);
      const uint2 b = *(const uint2*)(Ob + (size_t)row * DM + c);
      const uint2 gq = *(const uint2*)(QZ + (size_t)row * 5120 + 4096 + c);
      const float o0 = bflo(a.x) + bflo(b.x), o1 = bfhi(a.x) + bfhi(b.x), o2 = bflo(a.y) + bflo(b.y), o3 = bfhi(a.y) + bfhi(b.y);
      float ss = o0 * o0 + o1 * o1 + o2 * o2 + o3 * o3;
#pragma unroll
      for (int o = 16; o > 0; o >>= 1) ss += __shfl_xor(ss, o);
      const float rstd = rsqrtf(ss * (1.f / 128.f) + EPS);
      const float4 gg = *(const float4*)(ng + c);
      uint2 o;
      o.x = pk2(o0 * rstd * gg.x * silu_f(bflo(gq.x)), o1 * rstd * gg.y * silu_f(bfhi(gq.x)));
      o.y = pk2(o2 * rstd * gg.z * silu_f(bflo(gq.y)), o3 * rstd * gg.w * silu_f(bfhi(gq.y)));
      *(uint2*)(Of + (size_t)row * DM + c) = o;
    }
  }
}

DEVINL void ffn_act_phase(const bfr* __restrict__ UP, const float* __restrict__ wdw, int hf, bfr* __restrict__ ACT, int bid, int nblk) {
  const int gt = bid * 256 + otid(), nt = nblk * 256;
  for (int i = gt; i < MTOK * 176; i += nt) {
    const int m = i / 176, j = (i - m * 176) * 8;
    int tl, T; tok_pos(m, tl, T);
    const bfr* ur = UP + (size_t)m * DFF;
    float a[8], b[8];
#pragma unroll
    for (int q = 0; q < 8; ++q) { a[q] = 0.f; b[q] = 0.f; }
#pragma unroll
    for (int tap = 0; tap < 3; ++tap) {
      const int d = tap - 1;
      if ((d < 0 && tl == 0) || (d > 0 && tl == T - 1)) continue;
      const bfr* nr = ur + (ptrdiff_t)d * DFF;
      const uint4 av = *(const uint4*)(nr + j);
      const uint4 bv = *(const uint4*)(nr + HALF_FF + j);
      const float* wa = wdw + tap * (2 * DFF) + hf * HALF_FF + j;
      const float* wb = wdw + tap * (2 * DFF) + DFF + hf * HALF_FF + j;
      const float4 wa0 = *(const float4*)wa, wa1 = *(const float4*)(wa + 4);
      const float4 wb0 = *(const float4*)wb, wb1 = *(const float4*)(wb + 4);
      a[0] += wa0.x * bflo(av.x); a[1] += wa0.y * bfhi(av.x); a[2] += wa0.z * bflo(av.y); a[3] += wa0.w * bfhi(av.y);
      a[4] += wa1.x * bflo(av.z); a[5] += wa1.y * bfhi(av.z); a[6] += wa1.z * bflo(av.w); a[7] += wa1.w * bfhi(av.w);
      b[0] += wb0.x * bflo(bv.x); b[1] += wb0.y * bfhi(bv.x); b[2] += wb0.z * bflo(bv.y); b[3] += wb0.w * bfhi(bv.y);
      b[4] += wb1.x * bflo(bv.z); b[5] += wb1.y * bfhi(bv.z); b[6] += wb1.z * bflo(bv.w); b[7] += wb1.w * bfhi(bv.w);
    }
    uint4 o;
    o.x = pk2(silu_f(a[0]) * b[0], silu_f(a[1]) * b[1]);
    o.y = pk2(silu_f(a[2]) * b[2], silu_f(a[3]) * b[3]);
    o.z = pk2(silu_f(a[4]) * b[4], silu_f(a[5]) * b[5]);
    o.w = pk2(silu_f(a[6]) * b[6], silu_f(a[7]) * b[7]);
    *(uint4*)(ACT + (size_t)m * DFF + hf * HALF_FF + j) = o;
  }
}

constexpr int SMEM_BYTES = 77824;

__global__ void __launch_bounds__(256, 2) mega_kernel(Params p) {
  __shared__ __attribute__((aligned(16))) char smem[SMEM_BYTES];
  cg::grid_group grid = cg::this_grid();
  const int bid = blockIdx.x, nblk = gridDim.x;
  float* X = p.out;
  bfr* WB = (bfr*)(p.ws + OFF_WB);
  bfr* H = (bfr*)(p.ws + OFF_H);
  bfr* BIG = (bfr*)(p.ws + OFF_BIG);
  const float* MOD = (const float*)(p.ws + OFF_MOD);

  phase0a(p, smem, osg(bid), nblk);
  grid.sync();
  phase0b(p, osg(bid), nblk);
  grid.sync();

  for (int layer = 0; layer < 4; ++layer) {
    const float* modl = MOD + layer * 30720;
    if (layer == 0) {
      conv_matrix(p.in[9], 1024, 3072, WB + WB_IN, 0, smem, osg(bid), nblk);
      conv_matrix(p.in[11], 1024, 1024, WB + WB_OUT, 0, smem, osg(bid), nblk);
    } else if (layer == 1) {
      for (int g = 0; g < 4; ++g) conv_matrix(p.in[12] + g * 65536, 256, 256, WB + WB_IN + g * 65536, 0, smem, osg(bid), nblk);
    } else if (layer == 2) {
      conv_matrix(p.in[14], 1024, 2048, WB + WB_IN, 0, smem, osg(bid), nblk);
      conv_matrix(p.in[18], 1024, 1024, WB + WB_OUT, 0, smem, osg(bid), nblk);
    } else {
      conv_matrix(p.in[19], 1024, 5120, WB + WB_IN, 0, smem, osg(bid), nblk);
      conv_matrix(p.in[22], 1024, 1024, WB + WB_OUT, 0, smem, osg(bid), nblk);
    }
    conv_matrix(p.in[23] + (size_t)layer * 1024 * 5632, 1024, 5632, WB + WB_UP, 1, smem, osg(bid), nblk);
    conv_matrix(p.in[25] + (size_t)layer * DFF * 1024, DFF, 1024, WB + WB_DOWN, 0, smem, osg(bid), nblk);
    norm_phase(X, p.in[7] + (layer * 2 + 0) * DM, modl, 0, 1024, H, osg(bid), nblk);
    grid.sync();

    if (layer == 0) {
      bfr* G = BIG;
      bfr* U = BIG + (size_t)MTOK * 3072;
      gemm_phase(H, DM, WB + WB_IN, 1024, 3072, 1024, EpiStore{G, 3072}, smem, osg(bid), nblk);
      grid.sync();
      shortconv_ew_phase(G, p.in[10], U, osg(bid), nblk);
      grid.sync();
      gemm_phase(U, DM, WB + WB_OUT, 1024, 1024, 1024, EpiResid{X, modl + 2048, nullptr, 0}, smem, osg(bid), nblk);
      grid.sync();
    } else if (layer == 1) {
      bfr* P = BIG;
      pool_ew_phase(H, P, osg(bid), nblk);
      grid.sync();
      for (int g = 0; g < 4; ++g)
        gemm_phase(P + g * 256, DM, WB + WB_IN + g * 65536, 256, 256, 256,
                   EpiResid{X, modl + 2048 + g * 256, p.in[13] + g * 256, g * 256}, smem, osg(bid), nblk);
      grid.sync();
    } else if (layer == 2) {
      bfr* UV = BIG;
      gemm_phase(H, DM, WB + WB_IN, 1024, 2048, 1024, EpiGelu{UV, 2048}, smem, osg(bid), nblk);
      grid.sync();
      sgu_norm_phase(UV, p.in[15], osg(bid), nblk);
      grid.sync();
      sgu_spatial_phase(UV, p.in[16], p.in[17], smem, osg(bid), nblk);
      grid.sync();
      gemm_phase(UV, 2048, WB + WB_OUT, 1024, 1024, 1024, EpiResid{X, modl + 2048, nullptr, 0}, smem, osg(bid), nblk);
      grid.sync();
    } else {
      bfr* QZ = BIG;
      gemm_phase(H, DM, WB + WB_IN, 1024, 5120, 1024, EpiStore{QZ, 5120}, smem, osg(bid), nblk);
      grid.sync();
      hgrn_scan_phase(p, smem, osg(bid), nblk);
      grid.sync();
      hgrn_gate_phase(p, p.in[21], osg(bid), nblk);
      grid.sync();
      gemm_phase(H, DM, WB + WB_OUT, 1024, 1024, 1024, EpiResid{X, modl + 2048, nullptr, 0}, smem, osg(bid), nblk);
      grid.sync();
    }

    norm_phase(X, p.in[7] + (layer * 2 + 1) * DM, modl, 3072, 4096, H, osg(bid), nblk);
    grid.sync();
    bfr* UP = BIG;
    bfr* ACT = BIG + (size_t)MTOK * DFF;
    const float* wdw = p.in[24] + (size_t)layer * 3 * 2 * DFF;
    for (int hf = 0; hf < 2; ++hf) {
      gemm_phase(H, DM, WB + WB_UP + (size_t)hf * DFF * 1024, 1024, DFF, 1024, EpiStore{UP, DFF}, smem, osg(bid), nblk);
      grid.sync();
      ffn_act_phase(UP, wdw, hf, ACT, osg(bid), nblk);
      grid.sync();
    }
    gemm_phase(ACT, DFF, WB + WB_DOWN, DFF, 1024, DFF, EpiResid{X, modl + 5120, nullptr, 0}, smem, osg(bid), nblk);
    grid.sync();
  }
  final_norm_phase(X, p.in[8], osg(bid), nblk);
}

extern "C" void kernel_launch(void* const* d_in, const int* in_sizes, int n_in, void* d_out, int out_size,
                              void* d_ws, size_t ws_size, hipStream_t stream) {
  static int grid_blocks = 0;
  if (!grid_blocks) {
    int dev = 0, cus = 0, per_cu = 0;
    hipGetDevice(&dev);
    hipDeviceGetAttribute(&cus, hipDeviceAttributeMultiprocessorCount, dev);
    hipOccupancyMaxActiveBlocksPerMultiprocessor(&per_cu, mega_kernel, 256, 0);
    if (per_cu > 2) per_cu = 2;
    if (per_cu < 1) per_cu = 1;
    grid_blocks = cus * per_cu;
  }
  if (ws_size < WS_NEED) { fprintf(stderr, "workspace too small: %zu < %zu\n", ws_size, (size_t)WS_NEED); return; }
  Params p{};
  for (int i = 0; i < 26; ++i) p.in[i] = (const float*)d_in[i];
  p.out = (float*)d_out;
  p.ws = (char*)d_ws;
  void* args[] = {&p};
  hipError_t e = hipLaunchCooperativeKernel((void*)mega_kernel, dim3(grid_blocks), dim3(256), args, 0, stream);
  if (e != hipSuccess) fprintf(stderr, "cooperative launch failed: %s (grid %d)\n", hipGetErrorString(e), grid_blocks);
}
```

```cpp
#include <hip/hip_runtime.h>
#include <hip/hip_cooperative_groups.h>
#include <stdint.h>
#include <stdio.h>
namespace cg = cooperative_groups;

#define DEVINL __device__ __forceinline__
typedef unsigned short bfr;
using bf16x8 = __attribute__((ext_vector_type(8))) short;
using f32x4 = __attribute__((ext_vector_type(4))) float;
using u32x4 = __attribute__((ext_vector_type(4))) unsigned int;

constexpr int DM = 1024;
constexpr int MTOK = 20480;
constexpr int NPROMPT = 4096;
constexpr int DFF = 2816;
constexpr int HALF_FF = 1408;
constexpr float EPS = 1e-6f;

constexpr size_t OFF_MODP = 0;
constexpr size_t OFF_MOD = 7864320;
constexpr size_t OFF_LBS = OFF_MOD + 491520;
constexpr size_t OFF_BAR = OFF_LBS + 8192;
constexpr size_t OFF_WB = 8388608;
constexpr size_t OFF_H = 41943040;
constexpr size_t OFF_BIG = 83886080;
constexpr size_t WS_NEED = OFF_BIG + 251658240ull;
constexpr size_t WB_IN = 0, WB_OUT = 5242880, WB_UP = 6291456, WB_DOWN = 12058624;

struct Params {
  const float* in[26];
  float* out;
  char* ws;
};

DEVINL int otid() { int t = threadIdx.x; asm volatile("" : "+v"(t)); return t; }
DEVINL int osg(int x) { asm volatile("" : "+s"(x)); return x; }
DEVINL bfr f2bf(float f) {
  uint32_t u = __float_as_uint(f);
  u += 0x7fffu + ((u >> 16) & 1u);
  return (bfr)(u >> 16);
}
DEVINL float bf2f(bfr h) { return __uint_as_float(((uint32_t)h) << 16); }
DEVINL uint32_t pk2(float a, float b) { return (uint32_t)f2bf(a) | ((uint32_t)f2bf(b) << 16); }
DEVINL float bflo(uint32_t u) { return __uint_as_float(u << 16); }
DEVINL float bfhi(uint32_t u) { return __uint_as_float(u & 0xffff0000u); }
DEVINL int cond_of(int m) { return m < NPROMPT ? 0 : 1 + ((m - NPROMPT) >> 12); }
DEVINL float silu_f(float x) { return x / (1.f + __expf(-x)); }
DEVINL float gelu_tanh_f(float x) {
  float y = 0.7978845608028654f * (x + 0.044715f * x * x * x);
  float t = 1.f - 2.f / (__expf(2.f * y) + 1.f);
  return 0.5f * x * (1.f + t);
}
DEVINL float shx(float v, int o, int lane) {
  return __int_as_float(__builtin_amdgcn_ds_bpermute((lane ^ o) << 2, __float_as_int(v)));
}
DEVINL float wave_sum(float v, int lane) {
#pragma unroll
  for (int o = 32; o > 0; o >>= 1) v += shx(v, o, lane);
  return v;
}

struct EpiStore {
  bfr* C; int ldc;
  DEVINL void operator()(int m, int n, f32x4 v) const {
    uint2 o; o.x = pk2(v[0], v[1]); o.y = pk2(v[2], v[3]);
    *(uint2*)(C + (size_t)m * ldc + n) = o;
  }
};
struct EpiGelu {
  bfr* C; int ldc;
  DEVINL void operator()(int m, int n, f32x4 v) const {
    uint2 o; o.x = pk2(gelu_tanh_f(v[0]), gelu_tanh_f(v[1])); o.y = pk2(gelu_tanh_f(v[2]), gelu_tanh_f(v[3]));
    *(uint2*)(C + (size_t)m * ldc + n) = o;
  }
};
struct EpiResid {
  float* X; const float* gate; const float* cscale; int coff;
  DEVINL void operator()(int m, int n, f32x4 v) const {
    const int cond = cond_of(m);
    const float4 g = *(const float4*)(gate + cond * 6144 + n);
    float4* xp = (float4*)(X + (size_t)m * DM + coff + n);
    float4 x = *xp;
    float s0 = 1.f, s1 = 1.f, s2 = 1.f, s3 = 1.f;
    if (cscale) { const float4 s = *(const float4*)(cscale + n); s0 = s.x; s1 = s.y; s2 = s.z; s3 = s.w; }
    x.x += g.x * v[0] * s0; x.y += g.y * v[1] * s1; x.z += g.z * v[2] * s2; x.w += g.w * v[3] * s3;
    *xp = x;
  }
};

#define GLOAD(R, kt_)                                                                             \
  {                                                                                               \
    const bfr* pA = gA + (kt_) * 64;                                                              \
    const bfr* pB = gB + (kt_) * 64;                                                              \
    R##a0 = *(const u32x4*)(pA); R##a1 = *(const u32x4*)(pA + (size_t)32 * lda);                  \
    R##a2 = *(const u32x4*)(pA + (size_t)64 * lda); R##a3 = *(const u32x4*)(pA + (size_t)96 * lda); \
    R##b0 = *(const u32x4*)(pB); R##b1 = *(const u32x4*)(pB + (size_t)32 * ldb);                  \
    R##b2 = *(const u32x4*)(pB + (size_t)64 * ldb); R##b3 = *(const u32x4*)(pB + (size_t)96 * ldb); \
  }
#define LSTORE(R, buf_)                                                                           \
  {                                                                                               \
    bfr* dA = sA + (buf_) * 128 * LS + lrow * LS + lch * 8;                                       \
    bfr* dB = sB + (buf_) * 128 * LS + lrow * LS + lch * 8;                                       \
    *(u32x4*)(dA) = R##a0; *(u32x4*)(dA + 32 * LS) = R##a1; *(u32x4*)(dA + 64 * LS) = R##a2; *(u32x4*)(dA + 96 * LS) = R##a3; \
    *(u32x4*)(dB) = R##b0; *(u32x4*)(dB + 32 * LS) = R##b1; *(u32x4*)(dB + 64 * LS) = R##b2; *(u32x4*)(dB + 96 * LS) = R##b3; \
  }
#define COMPUTE(buf_)                                                                             \
  {                                                                                               \
    const bfr* cA = sA + (buf_) * 128 * LS + (wm * 64 + l15) * LS + quad * 8;                     \
    const bfr* cB = sB + (buf_) * 128 * LS + (wn * 64 + l15) * LS + quad * 8;                     \
    _Pragma("unroll") for (int kk = 0; kk < 2; ++kk) {                                            \
      bf16x8 af[4], bfg[4];                                                                       \
      _Pragma("unroll") for (int i = 0; i < 4; ++i) {                                             \
        af[i] = *(const bf16x8*)(cA + i * 16 * LS + kk * 32);                                     \
        bfg[i] = *(const bf16x8*)(cB + i * 16 * LS + kk * 32);                                    \
      }                                                                                           \
      _Pragma("unroll") for (int mt = 0; mt < 4; ++mt)                                            \
        _Pragma("unroll") for (int nt = 0; nt < 4; ++nt)                                          \
          acc[mt][nt] = __builtin_amdgcn_mfma_f32_16x16x32_bf16(bfg[nt], af[mt], acc[mt][nt], 0, 0, 0); \
    }                                                                                             \
  }

template <class Epi>
DEVINL void gemm_phase(const bfr* __restrict__ A, int lda, const bfr* __restrict__ Bt, int ldb, int N, int K,
                       const Epi& epi, char* smem, int bid, int nblk) {
  constexpr int LS = 72;
  bfr* sA = (bfr*)smem;
  bfr* sB = sA + 2 * 128 * LS;
  const int tid = otid(), lane = tid & 63, wave = tid >> 6;
  const int wm = wave >> 1, wn = wave & 1, l15 = lane & 15, quad = lane >> 4;
  const int tilesN = N >> 7;
  const int ntiles = (MTOK >> 7) * tilesN;
  const int nk = K >> 6;
  const int lrow = tid >> 3, lch = tid & 7;
  for (int tile = bid; tile < ntiles; tile += nblk) {
    const int xcd = tile & 7, u = tile >> 3;
    const int ur = u / tilesN;
    const int tn = u - ur * tilesN, tm = ur * 8 + xcd;
    const int m0 = tm << 7, n0 = tn << 7;
    const bfr* gA = A + (size_t)(m0 + lrow) * lda + lch * 8;
    const bfr* gB = Bt + (size_t)(n0 + lrow) * ldb + lch * 8;
    f32x4 acc[4][4];
#pragma unroll
    for (int i = 0; i < 4; ++i)
#pragma unroll
      for (int j = 0; j < 4; ++j) acc[i][j] = f32x4{0.f, 0.f, 0.f, 0.f};
    u32x4 Pa0, Pa1, Pa2, Pa3, Pb0, Pb1, Pb2, Pb3;
    u32x4 Qa0, Qa1, Qa2, Qa3, Qb0, Qb1, Qb2, Qb3;
    GLOAD(P, 0)
    GLOAD(Q, 1)
    __syncthreads();
    LSTORE(P, 0)
    __syncthreads();
    for (int kt = 0; kt < nk; kt += 2) {
      const int k2 = (kt + 2 < nk) ? kt + 2 : nk - 1;
      const int k3 = (kt + 3 < nk) ? kt + 3 : nk - 1;
      GLOAD(P, k2)
      COMPUTE(0)
      LSTORE(Q, 1)
      __syncthreads();
      GLOAD(Q, k3)
      COMPUTE(1)
      LSTORE(P, 0)
      __syncthreads();
    }
#pragma unroll
    for (int mt = 0; mt < 4; ++mt)
#pragma unroll
      for (int nt = 0; nt < 4; ++nt)
        epi(m0 + wm * 64 + mt * 16 + l15, n0 + wn * 64 + nt * 16 + quad * 4, acc[mt][nt]);
  }
}

DEVINL int up_perm(int n0) {
  if (n0 < DFF) { int h = n0 >= HALF_FF; return h * DFF + (n0 - h * HALF_FF); }
  int j = n0 - DFF; int h = j >= HALF_FF; return h * DFF + HALF_FF + (j - h * HALF_FF);
}
DEVINL void conv_matrix(const float* __restrict__ src, int K, int N, bfr* __restrict__ dst, int perm,
                        char* smem, int bid, int nblk) {
  float* sT = (float*)smem;
  const int tid = otid();
  const int tilesN = N >> 6;
  const int ntiles = (K >> 6) * tilesN;
  for (int t = bid; t < ntiles; t += nblk) {
    const int tk = t / tilesN, tn = t - tk * tilesN;
    const int k0 = tk << 6, n0 = tn << 6;
    const int r = tid >> 4, c4 = tid & 15;
    __syncthreads();
#pragma unroll
    for (int i = 0; i < 4; ++i) {
      const float4 v = *(const float4*)(src + (size_t)(k0 + r + i * 16) * N + n0 + c4 * 4);
      float* d = sT + (r + i * 16) * 65 + c4 * 4;
      d[0] = v.x; d[1] = v.y; d[2] = v.z; d[3] = v.w;
    }
    __syncthreads();
    const int n = tid >> 2, kc = tid & 3;
    uint32_t w[8];
#pragma unroll
    for (int j = 0; j < 8; ++j)
      w[j] = pk2(sT[(kc * 16 + 2 * j) * 65 + n], sT[(kc * 16 + 2 * j + 1) * 65 + n]);
    const int nd = (perm ? up_perm(n0) : n0) + n;
    bfr* dp = dst + (size_t)nd * K + k0 + kc * 16;
    *(uint4*)dp = make_uint4(w[0], w[1], w[2], w[3]);
    *(uint4*)(dp + 8) = make_uint4(w[4], w[5], w[6], w[7]);
  }
}

DEVINL void phase0a(const Params& p, char* smem, int bid, int nblk) {
  const int tid = otid();
  float* sc = (float*)smem;
  float* modp = (float*)(p.ws + OFF_MODP);
  const float* cvec = p.in[3];
  const float* cctx = p.in[4];
  const float* ada_w = p.in[5];
  for (int job = bid; job < 384; job += nblk) {
    const int l = job / 96, r = job - l * 96, ks = r / 6, cgp = r - ks * 6;
    __syncthreads();
    for (int i = tid; i < 320; i += 256) {
      const int cond = i >> 6, kk = i & 63;
      const float v = cond == 0 ? cctx[ks * 64 + kk] : cvec[(cond - 1) * DM + ks * 64 + kk];
      sc[i] = silu_f(v);
    }
    __syncthreads();
    const int col = cgp * 1024 + tid * 4;
    const float* wp = ada_w + ((size_t)l * DM + ks * 64) * 6144 + col;
    float a[5][4];
#pragma unroll
    for (int c = 0; c < 5; ++c)
#pragma unroll
      for (int j = 0; j < 4; ++j) a[c][j] = 0.f;
#pragma unroll 8
    for (int kk = 0; kk < 64; ++kk) {
      const float4 w = *(const float4*)(wp + (size_t)kk * 6144);
#pragma unroll
      for (int c = 0; c < 5; ++c) {
        const float s = sc[c * 64 + kk];
        a[c][0] += s * w.x; a[c][1] += s * w.y; a[c][2] += s * w.z; a[c][3] += s * w.w;
      }
    }
#pragma unroll
    for (int c = 0; c < 5; ++c)
      *(float4*)(modp + ((size_t)(ks * 4 + l) * 5 + c) * 6144 + col) = make_float4(a[c][0], a[c][1], a[c][2], a[c][3]);
  }
  const int gt = bid * 256 + tid, nt = nblk * 256;
  {
    const float* lb = p.in[20];
    float* lbs = (float*)(p.ws + OFF_LBS);
    for (int i = gt; i < 2048; i += nt) {
      const float v0 = lb[i], v1 = lb[2048 + i], v2 = lb[4096 + i], v3 = lb[6144 + i];
      const float mx = fmaxf(fmaxf(v0, v1), fmaxf(v2, v3));
      const float e0 = expf(v0 - mx), e1 = expf(v1 - mx), e2 = expf(v2 - mx), e3 = expf(v3 - mx);
      lbs[i] = (e1 + e2 + e3) / (e0 + e1 + e2 + e3);
    }
  }
  float* X = p.out;
  {
    const float4* xp = (const float4*)p.in[0];
    float4* xo = (float4*)X;
    for (int i = gt; i < NPROMPT * DM / 4; i += nt) xo[i] = xp[i];
    const float* xs = p.in[1];
    for (int i = gt; i < 4096 * 256; i += nt) {
      const int t = i >> 8, c = (i & 255) * 4;
      const int part = c >> 8;
      const float pos = (float)((part < 2) ? (t >> 6) : (t & 63));
      float pe[4];
#pragma unroll
      for (int j = 0; j < 4; ++j) {
        const int jj = (c + j) & 255;
        const float freq = expf((-9.210340371976184f * (float)jj) / 256.0f);
        const float arg = pos * freq;
        pe[j] = (part & 1) ? cosf(arg) : sinf(arg);
      }
#pragma unroll
      for (int b = 0; b < 4; ++b) {
        const size_t off = ((size_t)b * 4096 + t) * DM + c;
        float4 v = *(const float4*)(xs + off);
        v.x += pe[0]; v.y += pe[1]; v.z += pe[2]; v.w += pe[3];
        *(float4*)(X + (size_t)NPROMPT * DM + off) = v;
      }
    }
  }
}

DEVINL void phase0b(const Params& p, int bid, int nblk) {
  const int gt = bid * 256 + otid(), nt = nblk * 256;
  const float* modp = (const float*)(p.ws + OFF_MODP);
  float* mod = (float*)(p.ws + OFF_MOD);
  const float* ada_b = p.in[6];
  for (int i = gt; i < 4 * 5 * 6144; i += nt) {
    const int l = i / 30720, col = i % 6144;
    float s = ada_b[l * 6144 + col];
#pragma unroll
    for (int ks = 0; ks < 16; ++ks) s += modp[(size_t)ks * 122880 + i];
    mod[i] = s;
  }
}

DEVINL void norm_phase(const float* __restrict__ X, const float* __restrict__ g, const float* __restrict__ modl,
                       int shift_off, int scale_off, bfr* __restrict__ H, int bid, int nblk) {
  const int tid = otid(); const int lane = tid & 63;
  const int gw = bid * 4 + (tid >> 6), nw = nblk * 4;
  for (int row = gw; row < MTOK; row += nw) {
    const float* xr = X + (size_t)row * DM;
    float4 x[4];
    float ss = 0.f;
#pragma unroll
    for (int i = 0; i < 4; ++i) {
      x[i] = *(const float4*)(xr + i * 256 + lane * 4);
      ss += x[i].x * x[i].x + x[i].y * x[i].y + x[i].z * x[i].z + x[i].w * x[i].w;
    }
    ss = wave_sum(ss, lane);
    const float rstd = rsqrtf(ss * (1.f / DM) + EPS);
    const float* mc = modl + cond_of(row) * 6144;
#pragma unroll
    for (int i = 0; i < 4; ++i) {
      const int c = i * 256 + lane * 4;
      const float4 gg = *(const float4*)(g + c);
      const float4 sh = *(const float4*)(mc + shift_off + c);
      const float4 sc = *(const float4*)(mc + scale_off + c);
      const float h0 = x[i].x * rstd * gg.x * (1.f + sc.x) + sh.x;
      const float h1 = x[i].y * rstd * gg.y * (1.f + sc.y) + sh.y;
      const float h2 = x[i].z * rstd * gg.z * (1.f + sc.z) + sh.z;
      const float h3 = x[i].w * rstd * gg.w * (1.f + sc.w) + sh.w;
      uint2 o; o.x = pk2(h0, h1); o.y = pk2(h2, h3);
      *(uint2*)(H + (size_t)row * DM + c) = o;
    }
  }
}

DEVINL void final_norm_phase(float* X, const float* __restrict__ g, int bid, int nblk) {
  const int tid = otid(); const int lane = tid & 63;
  const int gw = bid * 4 + (tid >> 6), nw = nblk * 4;
  for (int row = gw; row < MTOK; row += nw) {
    float* xr = X + (size_t)row * DM;
    float4 x[4];
    float ss = 0.f;
#pragma unroll
    for (int i = 0; i < 4; ++i) {
      x[i] = *(const float4*)(xr + i * 256 + lane * 4);
      ss += x[i].x * x[i].x + x[i].y * x[i].y + x[i].z * x[i].z + x[i].w * x[i].w;
    }
    ss = wave_sum(ss, lane);
    const float rstd = rsqrtf(ss * (1.f / DM) + EPS);
#pragma unroll
    for (int i = 0; i < 4; ++i) {
      const int c = i * 256 + lane * 4;
      const float4 gg = *(const float4*)(g + c);
      float4 o;
      o.x = x[i].x * rstd * gg.x; o.y = x[i].y * rstd * gg.y; o.z = x[i].z * rstd * gg.z; o.w = x[i].w * rstd * gg.w;
      *(float4*)(xr + c) = o;
    }
  }
}

DEVINL void tok_pos(int m, int& tl, int& T) {
  if (m < NPROMPT) { tl = m & 255; T = 256; } else { tl = (m - NPROMPT) & 4095; T = 4096; }
}

DEVINL void shortconv_ew_phase(const bfr* __restrict__ G, const float* __restrict__ wdw, bfr* __restrict__ U, int bid, int nblk) {
  const int gt = bid * 256 + otid(), nt = nblk * 256;
  for (int i = gt; i < MTOK * 128; i += nt) {
    const int m = i >> 7, c = (i & 127) * 8;
    int tl, T; tok_pos(m, tl, T);
    const bfr* gr = G + (size_t)m * 3072;
    const uint4 bg = *(const uint4*)(gr + c);
    float accv[8];
#pragma unroll
    for (int j = 0; j < 8; ++j) accv[j] = 0.f;
#pragma unroll
    for (int tap = 0; tap < 3; ++tap) {
      const int d = tap - 1;
      if ((d < 0 && tl == 0) || (d > 0 && tl == T - 1)) continue;
      const bfr* nr = gr + (ptrdiff_t)d * 3072;
      const uint4 cgv = *(const uint4*)(nr + 1024 + c);
      const uint4 xhv = *(const uint4*)(nr + 2048 + c);
      const float4 w0 = *(const float4*)(wdw + tap * DM + c);
      const float4 w1 = *(const float4*)(wdw + tap * DM + c + 4);
      accv[0] += w0.x * bflo(cgv.x) * bflo(xhv.x); accv[1] += w0.y * bfhi(cgv.x) * bfhi(xhv.x);
      accv[2] += w0.z * bflo(cgv.y) * bflo(xhv.y); accv[3] += w0.w * bfhi(cgv.y) * bfhi(xhv.y);
      accv[4] += w1.x * bflo(cgv.z) * bflo(xhv.z); accv[5] += w1.y * bfhi(cgv.z) * bfhi(xhv.z);
      accv[6] += w1.z * bflo(cgv.w) * bflo(xhv.w); accv[7] += w1.w * bfhi(cgv.w) * bfhi(xhv.w);
    }
    uint4 o;
    o.x = pk2(bflo(bg.x) * accv[0], bfhi(bg.x) * accv[1]);
    o.y = pk2(bflo(bg.y) * accv[2], bfhi(bg.y) * accv[3]);
    o.z = pk2(bflo(bg.z) * accv[4], bfhi(bg.z) * accv[5]);
    o.w = pk2(bflo(bg.w) * accv[6], bfhi(bg.w) * accv[7]);
    *(uint4*)(U + (size_t)m * DM + c) = o;
  }
}

DEVINL void pool_ew_phase(const bfr* __restrict__ H, bfr* __restrict__ P, int bid, int nblk) {
  const int gt = bid * 256 + otid(), nt = nblk * 256;
  for (int i = gt; i < MTOK * 128; i += nt) {
    const int m = i >> 7, ch = i & 127, c = ch * 8;
    int tl, T; tok_pos(m, tl, T);
    const int hw = 1 << (ch >> 5);
    const int lo = max(tl - hw, 0), hi = min(tl + hw, T);
    float s[8];
#pragma unroll
    for (int j = 0; j < 8; ++j) s[j] = 0.f;
    const bfr* base = H + (size_t)(m - tl) * DM + c;
    for (int q = lo; q < hi; ++q) {
      const uint4 v = *(const uint4*)(base + (size_t)q * DM);
      s[0] += bflo(v.x); s[1] += bfhi(v.x); s[2] += bflo(v.y); s[3] += bfhi(v.y);
      s[4] += bflo(v.z); s[5] += bfhi(v.z); s[6] += bflo(v.w); s[7] += bfhi(v.w);
    }
    const float inv = 1.f / (float)(hi - lo);
    const uint4 v = *(const uint4*)(base + (size_t)tl * DM);
    uint4 o;
    o.x = pk2(s[0] * inv - bflo(v.x), s[1] * inv - bfhi(v.x));
    o.y = pk2(s[2] * inv - bflo(v.y), s[3] * inv - bfhi(v.y));
    o.z = pk2(s[4] * inv - bflo(v.z), s[5] * inv - bfhi(v.z));
    o.w = pk2(s[6] * inv - bflo(v.w), s[7] * inv - bfhi(v.w));
    *(uint4*)(P + (size_t)m * DM + c) = o;
  }
}

DEVINL void sgu_norm_phase(bfr* UV, const float* __restrict__ g, int bid, int nblk) {
  const int tid = otid(); const int lane = tid & 63;
  const int gw = bid * 4 + (tid >> 6), nw = nblk * 4;
  for (int row = gw; row < MTOK; row += nw) {
    bfr* vr = UV + (size_t)row * 2048 + 1024;
    float x[4][4];
    float ss = 0.f;
#pragma unroll
    for (int i = 0; i < 4; ++i) {
      const uint2 v = *(const uint2*)(vr + i * 256 + lane * 4);
      x[i][0] = bflo(v.x); x[i][1] = bfhi(v.x); x[i][2] = bflo(v.y); x[i][3] = bfhi(v.y);
      ss += x[i][0] * x[i][0] + x[i][1] * x[i][1] + x[i][2] * x[i][2] + x[i][3] * x[i][3];
    }
    ss = wave_sum(ss, lane);
    const float rstd = rsqrtf(ss * (1.f / DM) + EPS);
#pragma unroll
    for (int i = 0; i < 4; ++i) {
      const int c = i * 256 + lane * 4;
      const float4 gg = *(const float4*)(g + c);
      uint2 o;
      o.x = pk2(x[i][0] * rstd * gg.x, x[i][1] * rstd * gg.y);
      o.y = pk2(x[i][2] * rstd * gg.z, x[i][3] * rstd * gg.w);
      *(uint2*)(vr + c) = o;
    }
  }
}

DEVINL void sgu_spatial_phase(bfr* UV, const float* __restrict__ ws_, const float* __restrict__ bs_, char* smem, int bid, int nblk) {
  bfr* sV = (bfr*)smem;
  bfr* sW = sV + 128 * 136;
  const int tid = otid(), lane = tid & 63, wave = tid >> 6, l15 = lane & 15, quad = lane >> 4;
  for (int item = bid; item < 160 * 8; item += nblk) {
    const int chunk = item >> 3, g = item & 7;
    __syncthreads();
    const float* wg = ws_ + (size_t)g * 16384;
#pragma unroll 4
    for (int i = 0; i < 16; ++i) {
      const int idx = tid + 256 * i;
      const int row = idx >> 5, chn = idx & 31;
      const float4 v = *(const float4*)(wg + row * 128 + chn * 4);
      uint2 o; o.x = pk2(v.x, v.y); o.y = pk2(v.z, v.w);
      *(uint2*)(sW + row * 136 + chn * 4) = o;
    }
#pragma unroll 2
    for (int i = 0; i < 8; ++i) {
      const int idx = tid + 256 * i;
      const int q = idx >> 4, chn = idx & 15;
      const uint4 v = *(const uint4*)(UV + (size_t)(chunk * 128 + q) * 2048 + 1024 + g * 128 + chn * 8);
      bfr* d = sV + (chn * 8) * 136 + q;
      d[0 * 136] = (bfr)(v.x & 0xffff); d[1 * 136] = (bfr)(v.x >> 16);
      d[2 * 136] = (bfr)(v.y & 0xffff); d[3 * 136] = (bfr)(v.y >> 16);
      d[4 * 136] = (bfr)(v.z & 0xffff); d[5 * 136] = (bfr)(v.z >> 16);
      d[6 * 136] = (bfr)(v.w & 0xffff); d[7 * 136] = (bfr)(v.w >> 16);
    }
    __syncthreads();
    f32x4 acc[8][2];
#pragma unroll
    for (int i = 0; i < 8; ++i) { acc[i][0] = f32x4{0.f, 0.f, 0.f, 0.f}; acc[i][1] = f32x4{0.f, 0.f, 0.f, 0.f}; }
#pragma unroll
    for (int kk = 0; kk < 4; ++kk) {
      bf16x8 bw[2];
#pragma unroll
      for (int pt = 0; pt < 2; ++pt) bw[pt] = *(const bf16x8*)(sW + (wave * 32 + pt * 16 + l15) * 136 + kk * 32 + quad * 8);
#pragma unroll
      for (int ct = 0; ct < 8; ++ct) {
        const bf16x8 av = *(const bf16x8*)(sV + (ct * 16 + l15) * 136 + kk * 32 + quad * 8);
#pragma unroll
        for (int pt = 0; pt < 2; ++pt)
          acc[ct][pt] = __builtin_amdgcn_mfma_f32_16x16x32_bf16(av, bw[pt], acc[ct][pt], 0, 0, 0);
      }
    }
#pragma unroll
    for (int pt = 0; pt < 2; ++pt) {
      const int pp = wave * 32 + pt * 16 + l15;
      const float bias = bs_[g * 128 + pp];
      bfr* ur = UV + (size_t)(chunk * 128 + pp) * 2048 + g * 128 + quad * 4;
#pragma unroll
      for (int ct = 0; ct < 8; ++ct) {
        const uint2 u = *(const uint2*)(ur + ct * 16);
        uint2 o;
        o.x = pk2(bflo(u.x) * (acc[ct][pt][0] + bias), bfhi(u.x) * (acc[ct][pt][1] + bias));
        o.y = pk2(bflo(u.y) * (acc[ct][pt][2] + bias), bfhi(u.y) * (acc[ct][pt][3] + bias));
        *(uint2*)(ur + ct * 16) = o;
      }
    }
  }
}

DEVINL void hgrn_scan_phase(const Params& p, char* smem, int bid, int nblk) {
  bfr* sQe = (bfr*)smem;
  bfr* sKe = sQe + 32 * 136;
  bfr* sKeT = sKe + 32 * 136;
  bfr* sVT = sKeT + 128 * 40;
  bfr* sP = sVT + 64 * 40;
  bfr* sST = sP + 32 * 40;
  float* sLast = (float*)(sST + 64 * 136);
  float* sTot = sLast + 128;
  const int tid = otid(), lane = tid & 63, wave = tid >> 6, l15 = lane & 15, quad = lane >> 4;
  const int cp = lane, qt = wave, i0 = qt * 8;
  const bfr* QZ = (const bfr*)(p.ws + OFF_BIG);
  bfr* Of = (bfr*)(p.ws + OFF_H);
  bfr* Ob = (bfr*)(p.ws + OFF_BIG + 209715200ull);
  const float* lbs = (const float*)(p.ws + OFF_LBS);
  const float* state_rec = p.in[2];
  float* out_state = p.out + (size_t)MTOK * DM;

  for (int item = bid; item < 640; item += nblk) {
    int seq, rem;
    if (item < 128) { seq = 16 + (item >> 5); rem = item & 31; } else { seq = (item - 128) >> 5; rem = (item - 128) & 31; }
    const int h = rem >> 2, dir = (rem >> 1) & 1, eh = rem & 1;
    const bool is_prompt = seq < 16;
    const int base = is_prompt ? seq * 256 : NPROMPT + (seq - 16) * 4096;
    const int T = is_prompt ? 256 : 4096;
    const int nchunks = T >> 5;
    bfr* Od = dir ? Ob : Of;
    const float lbv0 = lbs[dir * 1024 + h * 128 + 2 * cp], lbv1 = lbs[dir * 1024 + h * 128 + 2 * cp + 1];
    const int eloc = wave * 16 + l15;
    const int eglob = eh * 64 + eloc;

    f32x4 S[8];
    if (is_prompt) {
#pragma unroll
      for (int dt = 0; dt < 8; ++dt) S[dt] = f32x4{0.f, 0.f, 0.f, 0.f};
    } else {
      const float* s0 = state_rec + ((size_t)((seq - 16) * 2 + dir) * 8 + h) * 16384;
#pragma unroll
      for (int dt = 0; dt < 8; ++dt)
#pragma unroll
        for (int j = 0; j < 4; ++j) S[dt][j] = s0[(dt * 16 + quad * 4 + j) * 128 + eglob];
    }
    __syncthreads();
#pragma unroll
    for (int dt = 0; dt < 8; ++dt) {
      uint2 o; o.x = pk2(S[dt][0], S[dt][1]); o.y = pk2(S[dt][2], S[dt][3]);
      *(uint2*)(sST + eloc * 136 + dt * 16 + quad * 4) = o;
    }

    const unsigned qoff2 = h * 64 + cp, zoff2 = (1 + dir) * 512 + h * 64 + cp;
    const unsigned voff2 = 1536 + h * 64 + eh * 32 + (cp & 31);
    const uint32_t* __restrict__ QZ32 = (const uint32_t*)QZ;
    uint32_t rq[8], rz[8], rv[8];
#pragma unroll
    for (int ii = 0; ii < 8; ++ii) {
      const int pos = i0 + ii;
      const unsigned tok = dir ? base + T - 1 - pos : base + pos;
      const unsigned ri = tok * 2560u;
      rq[ii] = QZ32[ri + qoff2]; rz[ii] = QZ32[ri + zoff2]; rv[ii] = QZ32[ri + voff2];
    }

    for (int c = 0; c < nchunks; ++c) {
      float bc0[8], bc1[8], kv0[8], kv1[8];
      float run0 = 0.f, run1 = 0.f;
#pragma unroll
      for (int ii = 0; ii < 8; ++ii) {
        const float z0 = bflo(rz[ii]), z1 = bfhi(rz[ii]);
        const float f0 = lbv0 + (1.f - lbv0) / (1.f + __expf(-z0));
        const float f1 = lbv1 + (1.f - lbv1) / (1.f + __expf(-z1));
        run0 += __logf(f0); run1 += __logf(f1);
        bc0[ii] = run0; bc1[ii] = run1;
        kv0[ii] = 1.f - f0; kv1[ii] = 1.f - f1;
      }
      *(float2*)(sTot + qt * 128 + 2 * cp) = make_float2(run0, run1);
      __syncthreads();
      {
        float off0 = 0.f, off1 = 0.f, tot0 = 0.f, tot1 = 0.f;
#pragma unroll
        for (int q = 0; q < 4; ++q) {
          const float2 t = *(const float2*)(sTot + q * 128 + 2 * cp);
          if (q < qt) { off0 += t.x; off1 += t.y; }
          tot0 += t.x; tot1 += t.y;
        }
        uint32_t wk0[4], wk1[4], wv0[4], wv1[4];
#pragma unroll
        for (int ii = 0; ii < 8; ii += 2) {
          uint32_t kp[2];
#pragma unroll
          for (int u = 0; u < 2; ++u) {
            const float b0 = bc0[ii + u] + off0, b1 = bc1[ii + u] + off1;
            const uint32_t qp = pk2(bflo(rq[ii + u]) * __expf(b0), bfhi(rq[ii + u]) * __expf(b1));
            kp[u] = pk2(kv0[ii + u] * __expf(-b0), kv1[ii + u] * __expf(-b1));
            *(uint32_t*)(sQe + (i0 + ii + u) * 136 + 2 * cp) = qp;
            *(uint32_t*)(sKe + (i0 + ii + u) * 136 + 2 * cp) = kp[u];
          }
          wk0[ii >> 1] = (kp[0] & 0xffffu) | (kp[1] << 16);
          wk1[ii >> 1] = (kp[0] >> 16) | (kp[1] & 0xffff0000u);
          wv0[ii >> 1] = (rv[ii] & 0xffffu) | (rv[ii + 1] << 16);
          wv1[ii >> 1] = (rv[ii] >> 16) | (rv[ii + 1] & 0xffff0000u);
        }
        *(u32x4*)(sKeT + (2 * cp) * 40 + i0) = u32x4{wk0[0], wk0[1], wk0[2], wk0[3]};
        *(u32x4*)(sKeT + (2 * cp + 1) * 40 + i0) = u32x4{wk1[0], wk1[1], wk1[2], wk1[3]};
        if (cp < 32) {
          *(u32x4*)(sVT + (2 * cp) * 40 + i0) = u32x4{wv0[0], wv0[1], wv0[2], wv0[3]};
          *(u32x4*)(sVT + (2 * cp + 1) * 40 + i0) = u32x4{wv1[0], wv1[1], wv1[2], wv1[3]};
        }
        if (qt == 0) *(float2*)(sLast + 2 * cp) = make_float2(__expf(tot0), __expf(tot1));
      }
      if (c + 1 < nchunks) {
#pragma unroll
        for (int ii = 0; ii < 8; ++ii) {
          const int pos = (c + 1) * 32 + i0 + ii;
          const unsigned tok = dir ? base + T - 1 - pos : base + pos;
          const unsigned ri = tok * 2560u;
          rq[ii] = QZ32[ri + qoff2]; rz[ii] = QZ32[ri + zoff2]; rv[ii] = QZ32[ri + voff2];
        }
      }
      __syncthreads();
      {
        const int ti = wave >> 1, si = wave & 1;
        f32x4 sc = f32x4{0.f, 0.f, 0.f, 0.f};
        if (si <= ti) {
#pragma unroll
          for (int kk = 0; kk < 4; ++kk) {
            const bf16x8 a = *(const bf16x8*)(sQe + (ti * 16 + l15) * 136 + kk * 32 + quad * 8);
            const bf16x8 b = *(const bf16x8*)(sKe + (si * 16 + l15) * 136 + kk * 32 + quad * 8);
            sc = __builtin_amdgcn_mfma_f32_16x16x32_bf16(a, b, sc, 0, 0, 0);
          }
        }
#pragma unroll
        for (int j = 0; j < 4; ++j) {
          const int t = ti * 16 + quad * 4 + j, s2 = si * 16 + l15;
          sP[t * 40 + s2] = (s2 <= t) ? f2bf(sc[j]) : (bfr)0;
        }
      }
      f32x4 oacc[2];
      oacc[0] = f32x4{0.f, 0.f, 0.f, 0.f}; oacc[1] = f32x4{0.f, 0.f, 0.f, 0.f};
#pragma unroll
      for (int kk = 0; kk < 4; ++kk) {
        const bf16x8 sb = *(const bf16x8*)(sST + eloc * 136 + kk * 32 + quad * 8);
#pragma unroll
        for (int tt = 0; tt < 2; ++tt) {
          const bf16x8 qa = *(const bf16x8*)(sQe + (tt * 16 + l15) * 136 + kk * 32 + quad * 8);
          oacc[tt] = __builtin_amdgcn_mfma_f32_16x16x32_bf16(sb, qa, oacc[tt], 0, 0, 0);
        }
      }
      __syncthreads();
      {
        const bf16x8 vb = *(const bf16x8*)(sVT + eloc * 40 + quad * 8);
#pragma unroll
        for (int tt = 0; tt < 2; ++tt) {
          const bf16x8 pb = *(const bf16x8*)(sP + (tt * 16 + l15) * 40 + quad * 8);
          oacc[tt] = __builtin_amdgcn_mfma_f32_16x16x32_bf16(vb, pb, oacc[tt], 0, 0, 0);
          const int pos = c * 32 + tt * 16 + l15;
          const int tok = dir ? base + T - 1 - pos : base + pos;
          uint2 o; o.x = pk2(oacc[tt][0], oacc[tt][1]); o.y = pk2(oacc[tt][2], oacc[tt][3]);
          *(uint2*)(Od + (size_t)tok * DM + h * 128 + eh * 64 + wave * 16 + quad * 4) = o;
        }
#pragma unroll
        for (int dt = 0; dt < 8; ++dt) {
          const bf16x8 ka = *(const bf16x8*)(sKeT + (dt * 16 + l15) * 40 + quad * 8);
          const float4 dl = *(const float4*)(sLast + dt * 16 + quad * 4);
          f32x4 sn = __builtin_amdgcn_mfma_f32_16x16x32_bf16(ka, vb, S[dt], 0, 0, 0);
          sn[0] *= dl.x; sn[1] *= dl.y; sn[2] *= dl.z; sn[3] *= dl.w;
          S[dt] = sn;
          uint2 o; o.x = pk2(sn[0], sn[1]); o.y = pk2(sn[2], sn[3]);
          *(uint2*)(sST + eloc * 136 + dt * 16 + quad * 4) = o;
        }
      }
    }
    if (is_prompt) {
      float* so = out_state + ((size_t)(seq * 2 + dir) * 8 + h) * 16384;
#pragma unroll
      for (int dt = 0; dt < 8; ++dt)
#pragma unroll
        for (int j = 0; j < 4; ++j) so[(dt * 16 + quad * 4 + j) * 128 + eglob] = S[dt][j];
    }
  }
}

DEVINL void hgrn_gate_phase(const Params& p, const float* __restrict__ ng, int bid, int nblk) {
  const int tid = otid(); const int lane = tid & 63;
  const int gw = bid * 4 + (tid >> 6), nw = nblk * 4;
  bfr* Of = (bfr*)(p.ws + OFF_H);
  const bfr* Ob = (const bfr*)(p.ws + OFF_BIG + 209715200ull);
  const bfr* QZ = (const bfr*)(p.ws + OFF_BIG);
  for (int row = gw; row < MTOK; row += nw) {
#pragma unroll
    for (int seg = 0; seg < 4; ++seg) {
      const int c = seg * 256 + lane * 4;
      const uint2 a = *(const uint2*)(Of + (size_t)row * DM + c);
      const uint2 b = *(const uint2*)(Ob + (size_t)row * DM + c);
      const uint2 gq = *(const uint2*)(QZ + (size_t)row * 5120 + 4096 + c);
      const float o0 = bflo(a.x) + bflo(b.x), o1 = bfhi(a.x) + bfhi(b.x), o2 = bflo(a.y) + bflo(b.y), o3 = bfhi(a.y) + bfhi(b.y);
      float ss = o0 * o0 + o1 * o1 + o2 * o2 + o3 * o3;
#pragma unroll
      for (int o = 16; o > 0; o >>= 1) ss += shx(ss, o, lane);
      const float rstd = rsqrtf(ss * (1.f / 128.f) + EPS);
      const float4 gg = *(const float4*)(ng + c);
      uint2 o;
      o.x = pk2(o0 * rstd * gg.x * silu_f(bflo(gq.x)), o1 * rstd * gg.y * silu_f(bfhi(gq.x)));
      o.y = pk2(o2 * rstd * gg.z * silu_f(bflo(gq.y)), o3 * rstd * gg.w * silu_f(bfhi(gq.y)));
      *(uint2*)(Of + (size_t)row * DM + c) = o;
    }
  }
}

DEVINL void ffn_act_phase(const bfr* __restrict__ UP, const float* __restrict__ wdw, int hf, bfr* __restrict__ ACT, int bid, int nblk) {
  const int gt = bid * 256 + otid(), nt = nblk * 256;
  for (int i = gt; i < MTOK * 176; i += nt) {
    const int m = i / 176, j = (i - m * 176) * 8;
    int tl, T; tok_pos(m, tl, T);
    const bfr* ur = UP + (size_t)m * DFF;
    float a[8], b[8];
#pragma unroll
    for (int q = 0; q < 8; ++q) { a[q] = 0.f; b[q] = 0.f; }
#pragma unroll
    for (int tap = 0; tap < 3; ++tap) {
      const int d = tap - 1;
      if ((d < 0 && tl == 0) || (d > 0 && tl == T - 1)) continue;
      const bfr* nr = ur + (ptrdiff_t)d * DFF;
      const uint4 av = *(const uint4*)(nr + j);
      const uint4 bv = *(const uint4*)(nr + HALF_FF + j);
      const float* wa = wdw + tap * (2 * DFF) + hf * HALF_FF + j;
      const float* wb = wdw + tap * (2 * DFF) + DFF + hf * HALF_FF + j;
      const float4 wa0 = *(const float4*)wa, wa1 = *(const float4*)(wa + 4);
      const float4 wb0 = *(const float4*)wb, wb1 = *(const float4*)(wb + 4);
      a[0] += wa0.x * bflo(av.x); a[1] += wa0.y * bfhi(av.x); a[2] += wa0.z * bflo(av.y); a[3] += wa0.w * bfhi(av.y);
      a[4] += wa1.x * bflo(av.z); a[5] += wa1.y * bfhi(av.z); a[6] += wa1.z * bflo(av.w); a[7] += wa1.w * bfhi(av.w);
      b[0] += wb0.x * bflo(bv.x); b[1] += wb0.y * bfhi(bv.x); b[2] += wb0.z * bflo(bv.y); b[3] += wb0.w * bfhi(bv.y);
      b[4] += wb1.x * bflo(bv.z); b[5] += wb1.y * bfhi(bv.z); b[6] += wb1.z * bflo(bv.w); b[7] += wb1.w * bfhi(bv.w);
    }
    uint4 o;
    o.x = pk2(silu_f(a[0]) * b[0], silu_f(a[1]) * b[1]);
    o.y = pk2(silu_f(a[2]) * b[2], silu_f(a[3]) * b[3]);
    o.z = pk2(silu_f(a[4]) * b[4], silu_f(a[5]) * b[5]);
    o.w = pk2(silu_f(a[6]) * b[6], silu_f(a[7]) * b[7]);
    *(uint4*)(ACT + (size_t)m * DFF + hf * HALF_FF + j) = o;
  }
}


#define XB_TMO      128
#define XB_XCNT(j)  (256  + 64 * (j))
#define XB_XSUB(j)  (1280 + 64 * (j))
#define XB_XGEN(j)  (2304 + 64 * (j))
#define XB_TOP      3328
#define XB_TOPGEN   3392
#define XCD_BAR_WORDS 3456
#define XB_SPIN_CAP (1u << 22)
#define LAS __attribute__((address_space(3)))
DEVINL unsigned xb_ld(unsigned* p) { return __hip_atomic_load(p, __ATOMIC_RELAXED, __HIP_MEMORY_SCOPE_AGENT); }
DEVINL unsigned xb_add(unsigned* p, unsigned v) { return __hip_atomic_fetch_add(p, v, __ATOMIC_RELAXED, __HIP_MEMORY_SCOPE_AGENT); }
DEVINL unsigned xb_xcc_id() { return (unsigned)__builtin_amdgcn_s_getreg((3 << 11) | 20) & 0xFu; }
#define XB_SPIN(cond, bar) do { unsigned _sp = 0; while (cond) { __builtin_amdgcn_s_sleep(1); \
    if ((++_sp & 255u) == 0u) { if (xb_ld(&(bar)[XB_TMO])) break; if (_sp > XB_SPIN_CAP) { atomicAdd(&(bar)[XB_TMO], 1u); break; } } } } while (0)
struct XcdBarrier { unsigned* bar; unsigned x; volatile LAS unsigned* st; };
DEVINL XcdBarrier xcd_barrier_post(unsigned* bar, volatile LAS unsigned* st) {
  XcdBarrier b; b.bar = bar; b.x = xb_xcc_id(); b.st = st;
  if (threadIdx.x == 0) (void)xb_add(&bar[XB_XCNT(b.x)], 1u);
  return b;
}
DEVINL void xcd_barrier_complete(unsigned* bar, unsigned x, unsigned& nloc, unsigned& nx) {
  const unsigned G = gridDim.x * gridDim.y * gridDim.z;
  unsigned sum, cnt, mine, sp = 0u;
  for (;;) {
    sum = 0u; cnt = 0u; mine = 0u;
#pragma unroll
    for (unsigned j = 0; j < 16; ++j) { const unsigned c = xb_ld(&bar[XB_XCNT(j)]); sum += c; cnt += (c > 0u) ? 1u : 0u; mine = (j == x) ? c : mine; }
    if (sum == G) break;
    __builtin_amdgcn_s_sleep(1);
    if ((++sp & 255u) == 0u) { if (xb_ld(&bar[XB_TMO])) break; if (sp > XB_SPIN_CAP) { atomicAdd(&bar[XB_TMO], 1u); break; } }
  }
  nloc = mine > 0u ? mine : 1u; nx = cnt > 0u ? cnt : 1u;
}
DEVINL void xcd_barrier(const XcdBarrier& b) {
  asm volatile("s_waitcnt vmcnt(0)" ::: "memory");
  __syncthreads();
  if (threadIdx.x == 0) {
    unsigned* bar = b.bar;
    __builtin_amdgcn_s_waitcnt(0);
    unsigned nloc = b.st[0], nx = b.st[1];
    if (nloc == 0u) { xcd_barrier_complete(bar, b.x, nloc, nx); b.st[0] = nloc; b.st[1] = nx; }
    const unsigned old = xb_add(&bar[XB_XSUB(b.x)], 1u);
    const unsigned gen = old / nloc;
    if (old + 1u == (gen + 1u) * nloc) {
      __builtin_amdgcn_fence(__ATOMIC_RELEASE, "agent");
      asm volatile("s_waitcnt vmcnt(0)" ::: "memory");
      const unsigned og = xb_add(&bar[XB_TOP], 1u);
      const unsigned tg = og / nx;
      if (og + 1u == (tg + 1u) * nx) xb_add(&bar[XB_TOPGEN], 1u);
      else XB_SPIN(xb_ld(&bar[XB_TOPGEN]) == tg, bar);
      __builtin_amdgcn_fence(__ATOMIC_ACQUIRE, "agent");
      xb_add(&bar[XB_XGEN(b.x)], 1u);
      asm volatile("s_waitcnt vmcnt(0)" ::: "memory");
    } else {
      XB_SPIN(xb_ld(&bar[XB_XGEN(b.x)]) == gen, bar);
      __builtin_amdgcn_fence(__ATOMIC_ACQUIRE, "agent");
      asm volatile("s_waitcnt vmcnt(0)" ::: "memory");
    }
  }
  __syncthreads();
}

constexpr int SMEM_BYTES = 77824;

__global__ void __launch_bounds__(256, 2) mega_kernel(Params p) {
  __shared__ __attribute__((aligned(16))) char smem[SMEM_BYTES];
  cg::grid_group grid = cg::this_grid();
  __shared__ uint4 xb_words;
  if (threadIdx.x == 0) xb_words = make_uint4(0u, 0u, 0u, 0u);
  __syncthreads();
  XcdBarrier xb = xcd_barrier_post((unsigned*)(p.ws + OFF_BAR), (volatile LAS unsigned*)&xb_words);
  const int bid = blockIdx.x, nblk = gridDim.x;

  phase0a(p, smem, osg(bid), nblk);
  grid.sync();
  phase0b(p, osg(bid), nblk);
  xcd_barrier(xb);

  for (int layer = 0; layer < 4; ++layer) {
    Params q = p;
    asm volatile("" : "+s"(q.ws), "+s"(q.out));
    float* X = q.out;
    bfr* WB = (bfr*)(q.ws + OFF_WB);
    bfr* H = (bfr*)(q.ws + OFF_H);
    bfr* BIG = (bfr*)(q.ws + OFF_BIG);
    const float* MOD = (const float*)(q.ws + OFF_MOD);
    const float* modl = MOD + layer * 30720;
    if (layer == 0) {
      conv_matrix(q.in[9], 1024, 3072, WB + WB_IN, 0, smem, osg(bid), nblk);
      conv_matrix(q.in[11], 1024, 1024, WB + WB_OUT, 0, smem, osg(bid), nblk);
    } else if (layer == 1) {
      for (int g = 0; g < 4; ++g) conv_matrix(q.in[12] + g * 65536, 256, 256, WB + WB_IN + g * 65536, 0, smem, osg(bid), nblk);
    } else if (layer == 2) {
      conv_matrix(q.in[14], 1024, 2048, WB + WB_IN, 0, smem, osg(bid), nblk);
      conv_matrix(q.in[18], 1024, 1024, WB + WB_OUT, 0, smem, osg(bid), nblk);
    } else {
      conv_matrix(q.in[19], 1024, 5120, WB + WB_IN, 0, smem, osg(bid), nblk);
      conv_matrix(q.in[22], 1024, 1024, WB + WB_OUT, 0, smem, osg(bid), nblk);
    }
    conv_matrix(q.in[23] + (size_t)layer * 1024 * 5632, 1024, 5632, WB + WB_UP, 1, smem, osg(bid), nblk);
    conv_matrix(q.in[25] + (size_t)layer * DFF * 1024, DFF, 1024, WB + WB_DOWN, 0, smem, osg(bid), nblk);
    norm_phase(X, q.in[7] + (layer * 2 + 0) * DM, modl, 0, 1024, H, osg(bid), nblk);
    xcd_barrier(xb);

    if (layer == 0) {
      bfr* G = BIG;
      bfr* U = BIG + (size_t)MTOK * 3072;
      gemm_phase(H, DM, WB + WB_IN, 1024, 3072, 1024, EpiStore{G, 3072}, smem, osg(bid), nblk);
      xcd_barrier(xb);
      shortconv_ew_phase(G, q.in[10], U, osg(bid), nblk);
      xcd_barrier(xb);
      gemm_phase(U, DM, WB + WB_OUT, 1024, 1024, 1024, EpiResid{X, modl + 2048, nullptr, 0}, smem, osg(bid), nblk);
      xcd_barrier(xb);
    } else if (layer == 1) {
      bfr* P = BIG;
      pool_ew_phase(H, P, osg(bid), nblk);
      xcd_barrier(xb);
      for (int g = 0; g < 4; ++g)
        gemm_phase(P + g * 256, DM, WB + WB_IN + g * 65536, 256, 256, 256,
                   EpiResid{X, modl + 2048 + g * 256, q.in[13] + g * 256, g * 256}, smem, osg(bid), nblk);
      xcd_barrier(xb);
    } else if (layer == 2) {
      bfr* UV = BIG;
      gemm_phase(H, DM, WB + WB_IN, 1024, 2048, 1024, EpiGelu{UV, 2048}, smem, osg(bid), nblk);
      xcd_barrier(xb);
      sgu_norm_phase(UV, q.in[15], osg(bid), nblk);
      xcd_barrier(xb);
      sgu_spatial_phase(UV, q.in[16], q.in[17], smem, osg(bid), nblk);
      xcd_barrier(xb);
      gemm_phase(UV, 2048, WB + WB_OUT, 1024, 1024, 1024, EpiResid{X, modl + 2048, nullptr, 0}, smem, osg(bid), nblk);
      xcd_barrier(xb);
    } else {
      bfr* QZ = BIG;
      gemm_phase(H, DM, WB + WB_IN, 1024, 5120, 1024, EpiStore{QZ, 5120}, smem, osg(bid), nblk);
      xcd_barrier(xb);
      hgrn_scan_phase(q, smem, osg(bid), nblk);
      xcd_barrier(xb);
      hgrn_gate_phase(q, q.in[21], osg(bid), nblk);
      xcd_barrier(xb);
      gemm_phase(H, DM, WB + WB_OUT, 1024, 1024, 1024, EpiResid{X, modl + 2048, nullptr, 0}, smem, osg(bid), nblk);
      xcd_barrier(xb);
    }

    norm_phase(X, q.in[7] + (layer * 2 + 1) * DM, modl, 3072, 4096, H, osg(bid), nblk);
    xcd_barrier(xb);
    bfr* UP = BIG;
    bfr* ACT = BIG + (size_t)MTOK * DFF;
    const float* wdw = q.in[24] + (size_t)layer * 3 * 2 * DFF;
    for (int hf = 0; hf < 2; ++hf) {
      gemm_phase(H, DM, WB + WB_UP + (size_t)hf * DFF * 1024, 1024, DFF, 1024, EpiStore{UP, DFF}, smem, osg(bid), nblk);
      xcd_barrier(xb);
      ffn_act_phase(UP, wdw, hf, ACT, osg(bid), nblk);
      xcd_barrier(xb);
    }
    gemm_phase(ACT, DFF, WB + WB_DOWN, DFF, 1024, DFF, EpiResid{X, modl + 5120, nullptr, 0}, smem, osg(bid), nblk);
    xcd_barrier(xb);
  }
  final_norm_phase(p.out, p.in[8], osg(bid), nblk);
}

extern "C" void kernel_launch(void* const* d_in, const int* in_sizes, int n_in, void* d_out, int out_size,
                              void* d_ws, size_t ws_size, hipStream_t stream) {
  static int grid_blocks = 0;
  if (!grid_blocks) {
    int dev = 0, cus = 0, per_cu = 0;
    hipGetDevice(&dev);
    hipDeviceGetAttribute(&cus, hipDeviceAttributeMultiprocessorCount, dev);
    hipOccupancyMaxActiveBlocksPerMultiprocessor(&per_cu, mega_kernel, 256, 0);
    if (per_cu > 2) per_cu = 2;
    if (per_cu < 1) per_cu = 1;
    grid_blocks = cus * per_cu;
  }
  if (ws_size < WS_NEED) { fprintf(stderr, "workspace too small: %zu < %zu\n", ws_size, (size_t)WS_NEED); return; }
  Params p{};
  for (int i = 0; i < 26; ++i) p.in[i] = (const float*)d_in[i];
  p.out = (float*)d_out;
  p.ws = (char*)d_ws;
  hipMemsetAsync((char*)d_ws + OFF_BAR, 0, XCD_BAR_WORDS * 4, stream);
  void* args[] = {&p};
  hipError_t e = hipLaunchCooperativeKernel((void*)mega_kernel, dim3(grid_blocks), dim3(256), args, 0, stream);
  if (e != hipSuccess) fprintf(stderr, "cooperative launch failed: %s (grid %d)\n", hipGetErrorString(e), grid_blocks);
}
```

```cpp
#include <hip/hip_runtime.h>
#include <hip/hip_cooperative_groups.h>
#include <stdint.h>
#include <stdio.h>
namespace cg = cooperative_groups;

#define DEVINL __device__ __forceinline__
typedef unsigned short bfr;
using bf16x8 = __attribute__((ext_vector_type(8))) short;
using f32x4 = __attribute__((ext_vector_type(4))) float;
using u32x4 = __attribute__((ext_vector_type(4))) unsigned int;

constexpr int DM = 1024;
constexpr int MTOK = 20480;
constexpr int NPROMPT = 4096;
constexpr int DFF = 2816;
constexpr int HALF_FF = 1408;
constexpr float EPS = 1e-6f;

constexpr size_t OFF_MODP = 0;
constexpr size_t OFF_MOD = 7864320;
constexpr size_t OFF_LBS = OFF_MOD + 491520;
constexpr size_t OFF_BAR = OFF_LBS + 8192;
constexpr size_t OFF_WB = 8388608;
constexpr size_t OFF_H = 41943040;
constexpr size_t OFF_BIG = 83886080;
constexpr size_t WS_NEED = OFF_BIG + 251658240ull + 33554432ull + 262144ull;
constexpr size_t WB_IN = 0, WB_OUT = 5242880, WB_UP = 6291456, WB_DOWN = 12058624;

struct Params {
  const float* in[26];
  float* out;
  char* ws;
};

DEVINL int otid() { int t = threadIdx.x; asm volatile("" : "+v"(t)); return t; }
DEVINL int osg(int x) { asm volatile("" : "+s"(x)); return x; }
typedef __bf16 hbf16x2 __attribute__((ext_vector_type(2)));
typedef float hf32x2 __attribute__((ext_vector_type(2)));
DEVINL uint32_t pk2(float a, float b) {
  hf32x2 v = {a, b};
  hbf16x2 r = __builtin_convertvector(v, hbf16x2);
  return __builtin_bit_cast(uint32_t, r);
}
DEVINL bfr f2bf(float f) { return (bfr)(pk2(f, 0.f) & 0xffffu); }
DEVINL float bf2f(bfr h) { return __uint_as_float(((uint32_t)h) << 16); }
DEVINL float frcp(float x) { return __builtin_amdgcn_rcpf(x); }
DEVINL float bflo(uint32_t u) { return __uint_as_float(u << 16); }
DEVINL float bfhi(uint32_t u) { return __uint_as_float(u & 0xffff0000u); }
DEVINL int cond_of(int m) { return m < NPROMPT ? 0 : 1 + ((m - NPROMPT) >> 12); }
DEVINL float silu_f(float x) { return x * frcp(1.f + __expf(-x)); }
DEVINL float gelu_tanh_f(float x) {
  float y = 0.7978845608028654f * (x + 0.044715f * x * x * x);
  float t = 1.f - 2.f * frcp(__expf(2.f * y) + 1.f);
  return 0.5f * x * (1.f + t);
}
DEVINL float shx(float v, int o, int lane) {
  return __int_as_float(__builtin_amdgcn_ds_bpermute((lane ^ o) << 2, __float_as_int(v)));
}
DEVINL float wave_sum(float v, int lane) {
#pragma unroll
  for (int o = 32; o > 0; o >>= 1) v += shx(v, o, lane);
  return v;
}

DEVINL void tok_pos(int m, int& tl, int& T) {
  if (m < NPROMPT) { tl = m & 255; T = 256; } else { tl = (m - NPROMPT) & 4095; T = 4096; }
}

#define EPI_ELEMENTWISE_TILE                                                                       \
  DEVINL void tile(const f32x4 (&acc)[4][4], int m0, int n0, int tn, int wm, int wn, int l15, int quad, \
                   int tid, char* smem) const {                                                     \
    _Pragma("unroll") for (int mt = 0; mt < 4; ++mt)                                                \
      _Pragma("unroll") for (int nt = 0; nt < 4; ++nt)                                              \
        (*this)(m0 + wm * 64 + mt * 16 + l15, n0 + wn * 64 + nt * 16 + quad * 4, acc[mt][nt]);      \
  }
struct EpiStore {
  bfr* C; int ldc;
  DEVINL void operator()(int m, int n, f32x4 v) const {
    uint2 o; o.x = pk2(v[0], v[1]); o.y = pk2(v[2], v[3]);
    *(uint2*)(C + (size_t)m * ldc + n) = o;
  }
  EPI_ELEMENTWISE_TILE
};
struct EpiGelu {
  bfr* C; int ldc;
  DEVINL void operator()(int m, int n, f32x4 v) const {
    uint2 o; o.x = pk2(gelu_tanh_f(v[0]), gelu_tanh_f(v[1])); o.y = pk2(gelu_tanh_f(v[2]), gelu_tanh_f(v[3]));
    *(uint2*)(C + (size_t)m * ldc + n) = o;
  }
  EPI_ELEMENTWISE_TILE
};
struct EpiResid {
  float* X; const float* gate; const float* cscale; int coff;
  DEVINL void operator()(int m, int n, f32x4 v) const {
    const int cond = cond_of(m);
    const float4 g = *(const float4*)(gate + cond * 6144 + n);
    float4* xp = (float4*)(X + (size_t)m * DM + coff + n);
    float4 x = *xp;
    float s0 = 1.f, s1 = 1.f, s2 = 1.f, s3 = 1.f;
    if (cscale) { const float4 s = *(const float4*)(cscale + n); s0 = s.x; s1 = s.y; s2 = s.z; s3 = s.w; }
    x.x += g.x * v[0] * s0; x.y += g.y * v[1] * s1; x.z += g.z * v[2] * s2; x.w += g.w * v[3] * s3;
    *xp = x;
  }
  EPI_ELEMENTWISE_TILE
};

#define GLOAD(R, kt_)                                                                             \
  {                                                                                               \
    const bfr* pA = gA + (kt_) * 64;                                                              \
    const bfr* pB = gB + (kt_) * 64;                                                              \
    R##a0 = *(const u32x4*)(pA); R##a1 = *(const u32x4*)(pA + (size_t)32 * lda);                  \
    R##a2 = *(const u32x4*)(pA + (size_t)64 * lda); R##a3 = *(const u32x4*)(pA + (size_t)96 * lda); \
    R##b0 = *(const u32x4*)(pB); R##b1 = *(const u32x4*)(pB + (size_t)32 * ldb);                  \
    R##b2 = *(const u32x4*)(pB + (size_t)64 * ldb); R##b3 = *(const u32x4*)(pB + (size_t)96 * ldb); \
  }
#define LSTORE(R, buf_)                                                                           \
  {                                                                                               \
    bfr* dA = sA + (buf_) * 128 * LS + lrow * LS + lch * 8;                                       \
    bfr* dB = sB + (buf_) * 128 * LS + lrow * LS + lch * 8;                                       \
    *(u32x4*)(dA) = R##a0; *(u32x4*)(dA + 32 * LS) = R##a1; *(u32x4*)(dA + 64 * LS) = R##a2; *(u32x4*)(dA + 96 * LS) = R##a3; \
    *(u32x4*)(dB) = R##b0; *(u32x4*)(dB + 32 * LS) = R##b1; *(u32x4*)(dB + 64 * LS) = R##b2; *(u32x4*)(dB + 96 * LS) = R##b3; \
  }
#define COMPUTE(buf_)                                                                             \
  {                                                                                               \
    const bfr* cA = sA + (buf_) * 128 * LS + (wm * 64 + l15) * LS + quad * 8;                     \
    const bfr* cB = sB + (buf_) * 128 * LS + (wn * 64 + l15) * LS + quad * 8;                     \
    _Pragma("unroll") for (int kk = 0; kk < 2; ++kk) {                                            \
      bf16x8 af[4], bfg[4];                                                                       \
      _Pragma("unroll") for (int i = 0; i < 4; ++i) {                                             \
        af[i] = *(const bf16x8*)(cA + i * 16 * LS + kk * 32);                                     \
        bfg[i] = *(const bf16x8*)(cB + i * 16 * LS + kk * 32);                                    \
      }                                                                                           \
      _Pragma("unroll") for (int mt = 0; mt < 4; ++mt)                                            \
        _Pragma("unroll") for (int nt = 0; nt < 4; ++nt)                                          \
          acc[mt][nt] = __builtin_amdgcn_mfma_f32_16x16x32_bf16(bfg[nt], af[mt], acc[mt][nt], 0, 0, 0); \
    }                                                                                             \
  }

template <class Epi>
DEVINL void gemm_phase(const bfr* __restrict__ A, int lda, const bfr* __restrict__ Bt, int ldb, int N, int K,
                       const Epi& epi, char* smem, int bid, int nblk) {
  constexpr int LS = 72;
  bfr* sA = (bfr*)smem;
  bfr* sB = sA + 2 * 128 * LS;
  const int tid = otid(), lane = tid & 63, wave = tid >> 6;
  const int wm = wave >> 1, wn = wave & 1, l15 = lane & 15, quad = lane >> 4;
  const int tilesN = N >> 7;
  const int ntiles = (MTOK >> 7) * tilesN;
  const int nk = K >> 6;
  const int lrow = tid >> 3, lch = tid & 7;
  for (int tile = bid; tile < ntiles; tile += nblk) {
    const int xcd = tile & 7, u = tile >> 3;
    const int ur = u / tilesN;
    const int tn = u - ur * tilesN, tm = ur * 8 + xcd;
    const int m0 = tm << 7, n0 = tn << 7;
    const bfr* gA = A + (size_t)(m0 + lrow) * lda + lch * 8;
    const bfr* gB = Bt + (size_t)(n0 + lrow) * ldb + lch * 8;
    f32x4 acc[4][4];
#pragma unroll
    for (int i = 0; i < 4; ++i)
#pragma unroll
      for (int j = 0; j < 4; ++j) acc[i][j] = f32x4{0.f, 0.f, 0.f, 0.f};
    u32x4 Pa0, Pa1, Pa2, Pa3, Pb0, Pb1, Pb2, Pb3;
    u32x4 Qa0, Qa1, Qa2, Qa3, Qb0, Qb1, Qb2, Qb3;
    GLOAD(P, 0)
    GLOAD(Q, 1)
    __syncthreads();
    LSTORE(P, 0)
    __syncthreads();
    for (int kt = 0; kt < nk; kt += 2) {
      const int k2 = (kt + 2 < nk) ? kt + 2 : nk - 1;
      const int k3 = (kt + 3 < nk) ? kt + 3 : nk - 1;
      GLOAD(P, k2)
      COMPUTE(0)
      LSTORE(Q, 1)
      __syncthreads();
      GLOAD(Q, k3)
      COMPUTE(1)
      LSTORE(P, 0)
      __syncthreads();
    }
    epi.tile(acc, m0, n0, tn, wm, wn, l15, quad, tid, smem);
  }
}


constexpr int EDGE_LD = 2 * DFF;
struct EpiFfnUp {
  bfr* ACT; float* EDGE; const float* wdw;
  DEVINL void tile(const f32x4 (&acc)[4][4], int m0, int n0, int tn, int wm, int wn, int l15, int quad,
                   int tid, char* smem) const {
    float* T = (float*)smem;
#pragma unroll
    for (int mt = 0; mt < 4; ++mt)
#pragma unroll
      for (int nt = 0; nt < 4; ++nt)
        *(f32x4*)(T + (wm * 64 + mt * 16 + l15) * 132 + wn * 64 + nt * 16 + quad * 4) = acc[mt][nt];
    __syncthreads();
    int tl, Tlen; tok_pos(m0, tl, Tlen);
    const bool top_ok = (tl == 0), bot_ok = (tl + 128 == Tlen);
    if (tid < 128) {
      const int e = tid >> 5, c = (tid & 31) * 4;
      const int r = (e < 2) ? e : 124 + e;
      *(f32x4*)(EDGE + ((size_t)(m0 >> 7) * 4 + e) * EDGE_LD + n0 + c) = *(const f32x4*)(T + r * 132 + c);
    }
    const int c4 = (tid & 15) * 4, r0 = (tid >> 4) * 8;
    const int ja = tn * 64 + c4;
    f32x4 wa[3], wb[3];
#pragma unroll
    for (int t = 0; t < 3; ++t) {
      wa[t] = *(const f32x4*)(wdw + t * (2 * DFF) + ja);
      wb[t] = *(const f32x4*)(wdw + t * (2 * DFF) + DFF + ja);
    }
    const f32x4 zero = f32x4{0.f, 0.f, 0.f, 0.f};
    f32x4 pa = zero, pb = zero, ca, cb, na, nb;
    if (r0 > 0) { pa = *(const f32x4*)(T + (r0 - 1) * 132 + c4); pb = *(const f32x4*)(T + (r0 - 1) * 132 + 64 + c4); }
    ca = *(const f32x4*)(T + r0 * 132 + c4); cb = *(const f32x4*)(T + r0 * 132 + 64 + c4);
#pragma unroll
    for (int i = 0; i < 8; ++i) {
      const int r = r0 + i;
      if (r < 127) { na = *(const f32x4*)(T + (r + 1) * 132 + c4); nb = *(const f32x4*)(T + (r + 1) * 132 + 64 + c4); }
      else { na = zero; nb = zero; }
      const bool ok = (r > 0 || top_ok) && (r < 127 || bot_ok);
      if (ok) {
        const f32x4 a = wa[0] * pa + wa[1] * ca + wa[2] * na;
        const f32x4 b = wb[0] * pb + wb[1] * cb + wb[2] * nb;
        uint2 o;
        o.x = pk2(silu_f(a[0]) * b[0], silu_f(a[1]) * b[1]);
        o.y = pk2(silu_f(a[2]) * b[2], silu_f(a[3]) * b[3]);
        *(uint2*)(ACT + (size_t)(m0 + r) * DFF + ja) = o;
      }
      pa = ca; pb = cb; ca = na; cb = nb;
    }
    __syncthreads();
  }
};

DEVINL void ffn_edge_phase(const float* __restrict__ EDGE, const float* __restrict__ wdw, bfr* __restrict__ ACT, int bid, int nblk) {
  const int gt = bid * 256 + otid(), nt = nblk * 256;
  for (int i = gt; i < 160 * 2 * 704; i += nt) {
    const int cg4 = i % 704, r2 = i / 704, side = r2 & 1, tm = r2 >> 1;
    const int m0 = tm << 7;
    int tl, Tlen; tok_pos(m0, tl, Tlen);
    if (side == 0 ? (tl == 0) : (tl + 128 == Tlen)) continue;
    const int ja = cg4 * 4;
    const int nb_ = ja >> 6, cc = ja & 63;
    const int ea = nb_ * 128 + cc, eb = ea + 64;
    const float* prev; const float* cur; const float* next;
    if (side == 0) {
      prev = EDGE + ((size_t)(tm - 1) * 4 + 3) * EDGE_LD; cur = EDGE + ((size_t)tm * 4 + 0) * EDGE_LD; next = EDGE + ((size_t)tm * 4 + 1) * EDGE_LD;
    } else {
      prev = EDGE + ((size_t)tm * 4 + 2) * EDGE_LD; cur = EDGE + ((size_t)tm * 4 + 3) * EDGE_LD; next = EDGE + ((size_t)(tm + 1) * 4 + 0) * EDGE_LD;
    }
    const f32x4 a = *(const f32x4*)(wdw + ja) * *(const f32x4*)(prev + ea) + *(const f32x4*)(wdw + 2 * DFF + ja) * *(const f32x4*)(cur + ea) +
                    *(const f32x4*)(wdw + 4 * DFF + ja) * *(const f32x4*)(next + ea);
    const f32x4 b = *(const f32x4*)(wdw + DFF + ja) * *(const f32x4*)(prev + eb) + *(const f32x4*)(wdw + 3 * DFF + ja) * *(const f32x4*)(cur + eb) +
                    *(const f32x4*)(wdw + 5 * DFF + ja) * *(const f32x4*)(next + eb);
    uint2 o;
    o.x = pk2(silu_f(a[0]) * b[0], silu_f(a[1]) * b[1]);
    o.y = pk2(silu_f(a[2]) * b[2], silu_f(a[3]) * b[3]);
    const int m = m0 + (side ? 127 : 0);
    *(uint2*)(ACT + (size_t)m * DFF + ja) = o;
  }
}

DEVINL int up_perm(int n0) {
  if (n0 < DFF) return (n0 >> 6) * 128;
  return ((n0 - DFF) >> 6) * 128 + 64;
}
DEVINL void conv_matrix(const float* __restrict__ src, int K, int N, bfr* __restrict__ dst, int perm,
                        char* smem, int bid, int nblk) {
  float* sT = (float*)smem;
  const int tid = otid();
  const int tilesN = N >> 6;
  const int ntiles = (K >> 6) * tilesN;
  for (int t = bid; t < ntiles; t += nblk) {
    const int tk = t / tilesN, tn = t - tk * tilesN;
    const int k0 = tk << 6, n0 = tn << 6;
    const int r = tid >> 4, c4 = tid & 15;
    __syncthreads();
#pragma unroll
    for (int i = 0; i < 4; ++i) {
      const float4 v = *(const float4*)(src + (size_t)(k0 + r + i * 16) * N + n0 + c4 * 4);
      float* d = sT + (r + i * 16) * 65 + c4 * 4;
      d[0] = v.x; d[1] = v.y; d[2] = v.z; d[3] = v.w;
    }
    __syncthreads();
    const int n = tid >> 2, kc = tid & 3;
    uint32_t w[8];
#pragma unroll
    for (int j = 0; j < 8; ++j)
      w[j] = pk2(sT[(kc * 16 + 2 * j) * 65 + n], sT[(kc * 16 + 2 * j + 1) * 65 + n]);
    const int nd = (perm ? up_perm(n0) : n0) + n;
    bfr* dp = dst + (size_t)nd * K + k0 + kc * 16;
    *(uint4*)dp = make_uint4(w[0], w[1], w[2], w[3]);
    *(uint4*)(dp + 8) = make_uint4(w[4], w[5], w[6], w[7]);
  }
}

DEVINL void phase0a(const Params& p, char* smem, int bid, int nblk) {
  const int tid = otid();
  float* sc = (float*)smem;
  float* modp = (float*)(p.ws + OFF_MODP);
  const float* cvec = p.in[3];
  const float* cctx = p.in[4];
  const float* ada_w = p.in[5];
  for (int job = bid; job < 384; job += nblk) {
    const int l = job / 96, r = job - l * 96, ks = r / 6, cgp = r - ks * 6;
    __syncthreads();
    for (int i = tid; i < 320; i += 256) {
      const int cond = i >> 6, kk = i & 63;
      const float v = cond == 0 ? cctx[ks * 64 + kk] : cvec[(cond - 1) * DM + ks * 64 + kk];
      sc[i] = silu_f(v);
    }
    __syncthreads();
    const int col = cgp * 1024 + tid * 4;
    const float* wp = ada_w + ((size_t)l * DM + ks * 64) * 6144 + col;
    float a[5][4];
#pragma unroll
    for (int c = 0; c < 5; ++c)
#pragma unroll
      for (int j = 0; j < 4; ++j) a[c][j] = 0.f;
#pragma unroll 8
    for (int kk = 0; kk < 64; ++kk) {
      const float4 w = *(const float4*)(wp + (size_t)kk * 6144);
#pragma unroll
      for (int c = 0; c < 5; ++c) {
        const float s = sc[c * 64 + kk];
        a[c][0] += s * w.x; a[c][1] += s * w.y; a[c][2] += s * w.z; a[c][3] += s * w.w;
      }
    }
#pragma unroll
    for (int c = 0; c < 5; ++c)
      *(float4*)(modp + ((size_t)(ks * 4 + l) * 5 + c) * 6144 + col) = make_float4(a[c][0], a[c][1], a[c][2], a[c][3]);
  }
  const int gt = bid * 256 + tid, nt = nblk * 256;
  {
    const float* lb = p.in[20];
    float* lbs = (float*)(p.ws + OFF_LBS);
    for (int i = gt; i < 2048; i += nt) {
      const float v0 = lb[i], v1 = lb[2048 + i], v2 = lb[4096 + i], v3 = lb[6144 + i];
      const float mx = fmaxf(fmaxf(v0, v1), fmaxf(v2, v3));
      const float e0 = expf(v0 - mx), e1 = expf(v1 - mx), e2 = expf(v2 - mx), e3 = expf(v3 - mx);
      lbs[i] = (e1 + e2 + e3) / (e0 + e1 + e2 + e3);
    }
  }
  float* X = p.out;
  {
    const float4* xp = (const float4*)p.in[0];
    float4* xo = (float4*)X;
    for (int i = gt; i < NPROMPT * DM / 4; i += nt) xo[i] = xp[i];
    const float* xs = p.in[1];
    for (int i = gt; i < 4096 * 256; i += nt) {
      const int t = i >> 8, c = (i & 255) * 4;
      const int part = c >> 8;
      const float pos = (float)((part < 2) ? (t >> 6) : (t & 63));
      float pe[4];
#pragma unroll
      for (int j = 0; j < 4; ++j) {
        const int jj = (c + j) & 255;
        const float freq = expf((-9.210340371976184f * (float)jj) / 256.0f);
        const float arg = pos * freq;
        pe[j] = (part & 1) ? cosf(arg) : sinf(arg);
      }
#pragma unroll
      for (int b = 0; b < 4; ++b) {
        const size_t off = ((size_t)b * 4096 + t) * DM + c;
        float4 v = *(const float4*)(xs + off);
        v.x += pe[0]; v.y += pe[1]; v.z += pe[2]; v.w += pe[3];
        *(float4*)(X + (size_t)NPROMPT * DM + off) = v;
      }
    }
  }
}

DEVINL void phase0b(const Params& p, int bid, int nblk) {
  const int gt = bid * 256 + otid(), nt = nblk * 256;
  const float* modp = (const float*)(p.ws + OFF_MODP);
  float* mod = (float*)(p.ws + OFF_MOD);
  const float* ada_b = p.in[6];
  for (int i = gt; i < 4 * 5 * 6144; i += nt) {
    const int l = i / 30720, col = i % 6144;
    float s = ada_b[l * 6144 + col];
#pragma unroll
    for (int ks = 0; ks < 16; ++ks) s += modp[(size_t)ks * 122880 + i];
    mod[i] = s;
  }
}

DEVINL void norm_phase(const float* __restrict__ X, const float* __restrict__ g, const float* __restrict__ modl,
                       int shift_off, int scale_off, bfr* __restrict__ H, int bid, int nblk) {
  const int tid = otid(); const int lane = tid & 63;
  const int gw = bid * 4 + (tid >> 6), nw = nblk * 4;
  for (int row = gw; row < MTOK; row += nw) {
    const float* xr = X + (size_t)row * DM;
    float4 x[4];
    float ss = 0.f;
#pragma unroll
    for (int i = 0; i < 4; ++i) {
      x[i] = *(const float4*)(xr + i * 256 + lane * 4);
      ss += x[i].x * x[i].x + x[i].y * x[i].y + x[i].z * x[i].z + x[i].w * x[i].w;
    }
    ss = wave_sum(ss, lane);
    const float rstd = rsqrtf(ss * (1.f / DM) + EPS);
    const float* mc = modl + cond_of(row) * 6144;
#pragma unroll
    for (int i = 0; i < 4; ++i) {
      const int c = i * 256 + lane * 4;
      const float4 gg = *(const float4*)(g + c);
      const float4 sh = *(const float4*)(mc + shift_off + c);
      const float4 sc = *(const float4*)(mc + scale_off + c);
      const float h0 = x[i].x * rstd * gg.x * (1.f + sc.x) + sh.x;
      const float h1 = x[i].y * rstd * gg.y * (1.f + sc.y) + sh.y;
      const float h2 = x[i].z * rstd * gg.z * (1.f + sc.z) + sh.z;
      const float h3 = x[i].w * rstd * gg.w * (1.f + sc.w) + sh.w;
      uint2 o; o.x = pk2(h0, h1); o.y = pk2(h2, h3);
      *(uint2*)(H + (size_t)row * DM + c) = o;
    }
  }
}

DEVINL void final_norm_phase(float* X, const float* __restrict__ g, int bid, int nblk) {
  const int tid = otid(); const int lane = tid & 63;
  const int gw = bid * 4 + (tid >> 6), nw = nblk * 4;
  for (int row = gw; row < MTOK; row += nw) {
    float* xr = X + (size_t)row * DM;
    float4 x[4];
    float ss = 0.f;
#pragma unroll
    for (int i = 0; i < 4; ++i) {
      x[i] = *(const float4*)(xr + i * 256 + lane * 4);
      ss += x[i].x * x[i].x + x[i].y * x[i].y + x[i].z * x[i].z + x[i].w * x[i].w;
    }
    ss = wave_sum(ss, lane);
    const float rstd = rsqrtf(ss * (1.f / DM) + EPS);
#pragma unroll
    for (int i = 0; i < 4; ++i) {
      const int c = i * 256 + lane * 4;
      const float4 gg = *(const float4*)(g + c);
      float4 o;
      o.x = x[i].x * rstd * gg.x; o.y = x[i].y * rstd * gg.y; o.z = x[i].z * rstd * gg.z; o.w = x[i].w * rstd * gg.w;
      *(float4*)(xr + c) = o;
    }
  }
}

DEVINL void shortconv_ew_phase(const bfr* __restrict__ G, const float* __restrict__ wdw, bfr* __restrict__ U, int bid, int nblk) {
  const int gt = bid * 256 + otid(), nt = nblk * 256;
  for (int i = gt; i < MTOK * 128; i += nt) {
    const int m = i >> 7, c = (i & 127) * 8;
    int tl, T; tok_pos(m, tl, T);
    const bfr* gr = G + (size_t)m * 3072;
    const uint4 bg = *(const uint4*)(gr + c);
    float accv[8];
#pragma unroll
    for (int j = 0; j < 8; ++j) accv[j] = 0.f;
#pragma unroll
    for (int tap = 0; tap < 3; ++tap) {
      const int d = tap - 1;
      if ((d < 0 && tl == 0) || (d > 0 && tl == T - 1)) continue;
      const bfr* nr = gr + (ptrdiff_t)d * 3072;
      const uint4 cgv = *(const uint4*)(nr + 1024 + c);
      const uint4 xhv = *(const uint4*)(nr + 2048 + c);
      const float4 w0 = *(const float4*)(wdw + tap * DM + c);
      const float4 w1 = *(const float4*)(wdw + tap * DM + c + 4);
      accv[0] += w0.x * bflo(cgv.x) * bflo(xhv.x); accv[1] += w0.y * bfhi(cgv.x) * bfhi(xhv.x);
      accv[2] += w0.z * bflo(cgv.y) * bflo(xhv.y); accv[3] += w0.w * bfhi(cgv.y) * bfhi(xhv.y);
      accv[4] += w1.x * bflo(cgv.z) * bflo(xhv.z); accv[5] += w1.y * bfhi(cgv.z) * bfhi(xhv.z);
      accv[6] += w1.z * bflo(cgv.w) * bflo(xhv.w); accv[7] += w1.w * bfhi(cgv.w) * bfhi(xhv.w);
    }
    uint4 o;
    o.x = pk2(bflo(bg.x) * accv[0], bfhi(bg.x) * accv[1]);
    o.y = pk2(bflo(bg.y) * accv[2], bfhi(bg.y) * accv[3]);
    o.z = pk2(bflo(bg.z) * accv[4], bfhi(bg.z) * accv[5]);
    o.w = pk2(bflo(bg.w) * accv[6], bfhi(bg.w) * accv[7]);
    *(uint4*)(U + (size_t)m * DM + c) = o;
  }
}

DEVINL void pool_ew_phase(const bfr* __restrict__ H, bfr* __restrict__ P, int bid, int nblk) {
  const int gt = bid * 256 + otid(), nt = nblk * 256;
  for (int i = gt; i < MTOK * 128; i += nt) {
    const int m = i >> 7, ch = i & 127, c = ch * 8;
    int tl, T; tok_pos(m, tl, T);
    const int hw = 1 << (ch >> 5);
    const int lo = max(tl - hw, 0), hi = min(tl + hw, T);
    float s[8];
#pragma unroll
    for (int j = 0; j < 8; ++j) s[j] = 0.f;
    const bfr* base = H + (size_t)(m - tl) * DM + c;
    for (int q = lo; q < hi; ++q) {
      const uint4 v = *(const uint4*)(base + (size_t)q * DM);
      s[0] += bflo(v.x); s[1] += bfhi(v.x); s[2] += bflo(v.y); s[3] += bfhi(v.y);
      s[4] += bflo(v.z); s[5] += bfhi(v.z); s[6] += bflo(v.w); s[7] += bfhi(v.w);
    }
    const float inv = 1.f / (float)(hi - lo);
    const uint4 v = *(const uint4*)(base + (size_t)tl * DM);
    uint4 o;
    o.x = pk2(s[0] * inv - bflo(v.x), s[1] * inv - bfhi(v.x));
    o.y = pk2(s[2] * inv - bflo(v.y), s[3] * inv - bfhi(v.y));
    o.z = pk2(s[4] * inv - bflo(v.z), s[5] * inv - bfhi(v.z));
    o.w = pk2(s[6] * inv - bflo(v.w), s[7] * inv - bfhi(v.w));
    *(uint4*)(P + (size_t)m * DM + c) = o;
  }
}

DEVINL void sgu_norm_phase(bfr* UV, const float* __restrict__ g, int bid, int nblk) {
  const int tid = otid(); const int lane = tid & 63;
  const int gw = bid * 4 + (tid >> 6), nw = nblk * 4;
  for (int row = gw; row < MTOK; row += nw) {
    bfr* vr = UV + (size_t)row * 2048 + 1024;
    float x[4][4];
    float ss = 0.f;
#pragma unroll
    for (int i = 0; i < 4; ++i) {
      const uint2 v = *(const uint2*)(vr + i * 256 + lane * 4);
      x[i][0] = bflo(v.x); x[i][1] = bfhi(v.x); x[i][2] = bflo(v.y); x[i][3] = bfhi(v.y);
      ss += x[i][0] * x[i][0] + x[i][1] * x[i][1] + x[i][2] * x[i][2] + x[i][3] * x[i][3];
    }
    ss = wave_sum(ss, lane);
    const float rstd = rsqrtf(ss * (1.f / DM) + EPS);
#pragma unroll
    for (int i = 0; i < 4; ++i) {
      const int c = i * 256 + lane * 4;
      const float4 gg = *(const float4*)(g + c);
      uint2 o;
      o.x = pk2(x[i][0] * rstd * gg.x, x[i][1] * rstd * gg.y);
      o.y = pk2(x[i][2] * rstd * gg.z, x[i][3] * rstd * gg.w);
      *(uint2*)(vr + c) = o;
    }
  }
}

DEVINL void sgu_spatial_phase(bfr* UV, const float* __restrict__ ws_, const float* __restrict__ bs_, char* smem, int bid, int nblk) {
  bfr* sV = (bfr*)smem;
  bfr* sW = sV + 128 * 136;
  const int tid = otid(), lane = tid & 63, wave = tid >> 6, l15 = lane & 15, quad = lane >> 4;
  for (int item = bid; item < 160 * 8; item += nblk) {
    const int chunk = item >> 3, g = item & 7;
    __syncthreads();
    const float* wg = ws_ + (size_t)g * 16384;
#pragma unroll 4
    for (int i = 0; i < 16; ++i) {
      const int idx = tid + 256 * i;
      const int row = idx >> 5, chn = idx & 31;
      const float4 v = *(const float4*)(wg + row * 128 + chn * 4);
      uint2 o; o.x = pk2(v.x, v.y); o.y = pk2(v.z, v.w);
      *(uint2*)(sW + row * 136 + chn * 4) = o;
    }
#pragma unroll 2
    for (int i = 0; i < 8; ++i) {
      const int idx = tid + 256 * i;
      const int q = idx >> 4, chn = idx & 15;
      const uint4 v = *(const uint4*)(UV + (size_t)(chunk * 128 + q) * 2048 + 1024 + g * 128 + chn * 8);
      bfr* d = sV + (chn * 8) * 136 + q;
      d[0 * 136] = (bfr)(v.x & 0xffff); d[1 * 136] = (bfr)(v.x >> 16);
      d[2 * 136] = (bfr)(v.y & 0xffff); d[3 * 136] = (bfr)(v.y >> 16);
      d[4 * 136] = (bfr)(v.z & 0xffff); d[5 * 136] = (bfr)(v.z >> 16);
      d[6 * 136] = (bfr)(v.w & 0xffff); d[7 * 136] = (bfr)(v.w >> 16);
    }
    __syncthreads();
    f32x4 acc[8][2];
#pragma unroll
    for (int i = 0; i < 8; ++i) { acc[i][0] = f32x4{0.f, 0.f, 0.f, 0.f}; acc[i][1] = f32x4{0.f, 0.f, 0.f, 0.f}; }
#pragma unroll
    for (int kk = 0; kk < 4; ++kk) {
      bf16x8 bw[2];
#pragma unroll
      for (int pt = 0; pt < 2; ++pt) bw[pt] = *(const bf16x8*)(sW + (wave * 32 + pt * 16 + l15) * 136 + kk * 32 + quad * 8);
#pragma unroll
      for (int ct = 0; ct < 8; ++ct) {
        const bf16x8 av = *(const bf16x8*)(sV + (ct * 16 + l15) * 136 + kk * 32 + quad * 8);
#pragma unroll
        for (int pt = 0; pt < 2; ++pt)
          acc[ct][pt] = __builtin_amdgcn_mfma_f32_16x16x32_bf16(av, bw[pt], acc[ct][pt], 0, 0, 0);
      }
    }
#pragma unroll
    for (int pt = 0; pt < 2; ++pt) {
      const int pp = wave * 32 + pt * 16 + l15;
      const float bias = bs_[g * 128 + pp];
      bfr* ur = UV + (size_t)(chunk * 128 + pp) * 2048 + g * 128 + quad * 4;
#pragma unroll
      for (int ct = 0; ct < 8; ++ct) {
        const uint2 u = *(const uint2*)(ur + ct * 16);
        uint2 o;
        o.x = pk2(bflo(u.x) * (acc[ct][pt][0] + bias), bfhi(u.x) * (acc[ct][pt][1] + bias));
        o.y = pk2(bflo(u.y) * (acc[ct][pt][2] + bias), bfhi(u.y) * (acc[ct][pt][3] + bias));
        *(uint2*)(ur + ct * 16) = o;
      }
    }
  }
}

DEVINL void hgrn_scan_phase(const Params& p, char* smem, int bid, int nblk, const int mode) {
  bfr* sQe = (bfr*)smem;
  bfr* sKe = sQe + 32 * 136;
  bfr* sKeT = sKe + 32 * 136;
  bfr* sVT = sKeT + 128 * 40;
  bfr* sP = sVT + 64 * 40;
  bfr* sST = sP + 32 * 40;
  float* sLast = (float*)(sST + 64 * 136);
  float* sTot = sLast + 128;
  const int tid = otid(), lane = tid & 63, wave = tid >> 6, l15 = lane & 15, quad = lane >> 4;
  const int cp = lane, qt = wave, i0 = qt * 8;
  const bfr* QZ = (const bfr*)(p.ws + OFF_BIG);
  bfr* Of = (bfr*)(p.ws + OFF_H);
  bfr* Ob = (bfr*)(p.ws + OFF_BIG + 209715200ull);
  const float* lbs = (const float*)(p.ws + OFF_LBS);
  const float* state_rec = p.in[2];
  float* out_state = p.out + (size_t)MTOK * DM;

  float* SLOC = (float*)(p.ws + OFF_BIG + 251658240ull);
  float* DLOC = (float*)(p.ws + OFF_BIG + 251658240ull + 33554432ull);
  const int nitems = mode ? 1536 : 896;
  for (int item = bid; item < nitems; item += nblk) {
    const int eh = item & 1, dir = (item >> 1) & 1, h = (item >> 2) & 7;
    int base, T, nchunks, pos0, slot, seq;
    bool is_prompt = false;
    if (!mode) {
      const int r = item >> 5, seqb = r / 7, j = r - seqb * 7;
      seq = 16 + seqb; base = NPROMPT + seqb * 4096; T = 4096; nchunks = 16; pos0 = j * 512;
      slot = ((seqb * 8 + j) * 8 + h) * 2 + dir;
    } else if (item < 1024) {
      const int r = item >> 5, seqb = r >> 3, j = r & 7;
      seq = 16 + seqb; base = NPROMPT + seqb * 4096; T = 4096; nchunks = 16; pos0 = j * 512;
      slot = ((seqb * 8 + j) * 8 + h) * 2 + dir;
    } else {
      seq = (item - 1024) >> 5; base = seq * 256; T = 256; nchunks = 8; pos0 = 0; slot = 0;
      is_prompt = true;
    }
    bfr* Od = dir ? Ob : Of;
    const float lbv0 = lbs[dir * 1024 + h * 128 + 2 * cp], lbv1 = lbs[dir * 1024 + h * 128 + 2 * cp + 1];
    const int eloc = wave * 16 + l15;
    const int eglob = eh * 64 + eloc;

    f32x4 S[8];
    if (is_prompt || !mode) {
#pragma unroll
      for (int dt = 0; dt < 8; ++dt) S[dt] = f32x4{0.f, 0.f, 0.f, 0.f};
    } else {
      const float* s0 = SLOC + (size_t)slot * 16384;
#pragma unroll
      for (int dt = 0; dt < 8; ++dt)
#pragma unroll
        for (int j = 0; j < 4; ++j) S[dt][j] = s0[(dt * 16 + quad * 4 + j) * 128 + eglob];
    }
    float cum0 = 1.f, cum1 = 1.f;
    __syncthreads();
#pragma unroll
    for (int dt = 0; dt < 8; ++dt) {
      uint2 o; o.x = pk2(S[dt][0], S[dt][1]); o.y = pk2(S[dt][2], S[dt][3]);
      *(uint2*)(sST + eloc * 136 + dt * 16 + quad * 4) = o;
    }

    const unsigned qoff2 = h * 64 + cp, zoff2 = (1 + dir) * 512 + h * 64 + cp;
    const unsigned voff2 = 1536 + h * 64 + eh * 32 + (cp & 31);
    const uint32_t* __restrict__ QZ32 = (const uint32_t*)QZ;
    uint32_t rq[8], rz[8], rv[8];
#pragma unroll
    for (int ii = 0; ii < 8; ++ii) {
      const int pos = pos0 + i0 + ii;
      const unsigned tok = dir ? base + T - 1 - pos : base + pos;
      const unsigned ri = tok * 2560u;
      rq[ii] = QZ32[ri + qoff2]; rz[ii] = QZ32[ri + zoff2]; rv[ii] = QZ32[ri + voff2];
    }

    for (int c = 0; c < nchunks; ++c) {
      float pc0[8], pc1[8], kv0[8], kv1[8];
      float run0 = 1.f, run1 = 1.f;
#pragma unroll
      for (int ii = 0; ii < 8; ++ii) {
        const float z0 = bflo(rz[ii]), z1 = bfhi(rz[ii]);
        const float f0 = lbv0 + (1.f - lbv0) * frcp(1.f + __expf(-z0));
        const float f1 = lbv1 + (1.f - lbv1) * frcp(1.f + __expf(-z1));
        run0 *= f0; run1 *= f1;
        pc0[ii] = run0; pc1[ii] = run1;
        kv0[ii] = 1.f - f0; kv1[ii] = 1.f - f1;
      }
      *(float2*)(sTot + qt * 128 + 2 * cp) = make_float2(run0, run1);
      __syncthreads();
      {
        float off0 = 1.f, off1 = 1.f, tot0 = 1.f, tot1 = 1.f;
#pragma unroll
        for (int q = 0; q < 4; ++q) {
          const float2 t = *(const float2*)(sTot + q * 128 + 2 * cp);
          if (q < qt) { off0 *= t.x; off1 *= t.y; }
          tot0 *= t.x; tot1 *= t.y;
        }
        uint32_t wk0[4], wk1[4], wv0[4], wv1[4];
#pragma unroll
        for (int ii = 0; ii < 8; ii += 2) {
          uint32_t kp[2];
#pragma unroll
          for (int u = 0; u < 2; ++u) {
            const float e0 = pc0[ii + u] * off0, e1 = pc1[ii + u] * off1;
            kp[u] = pk2(kv0[ii + u] * frcp(e0), kv1[ii + u] * frcp(e1));
            *(uint32_t*)(sKe + (i0 + ii + u) * 136 + 2 * cp) = kp[u];
            if (mode) *(uint32_t*)(sQe + (i0 + ii + u) * 136 + 2 * cp) = pk2(bflo(rq[ii + u]) * e0, bfhi(rq[ii + u]) * e1);
          }
          wk0[ii >> 1] = (kp[0] & 0xffffu) | (kp[1] << 16);
          wk1[ii >> 1] = (kp[0] >> 16) | (kp[1] & 0xffff0000u);
          wv0[ii >> 1] = (rv[ii] & 0xffffu) | (rv[ii + 1] << 16);
          wv1[ii >> 1] = (rv[ii] >> 16) | (rv[ii + 1] & 0xffff0000u);
        }
        *(u32x4*)(sKeT + (2 * cp) * 40 + i0) = u32x4{wk0[0], wk0[1], wk0[2], wk0[3]};
        *(u32x4*)(sKeT + (2 * cp + 1) * 40 + i0) = u32x4{wk1[0], wk1[1], wk1[2], wk1[3]};
        if (cp < 32) {
          *(u32x4*)(sVT + (2 * cp) * 40 + i0) = u32x4{wv0[0], wv0[1], wv0[2], wv0[3]};
          *(u32x4*)(sVT + (2 * cp + 1) * 40 + i0) = u32x4{wv1[0], wv1[1], wv1[2], wv1[3]};
        }
        if (qt == 0) *(float2*)(sLast + 2 * cp) = make_float2(tot0, tot1);
        cum0 *= tot0; cum1 *= tot1;
      }
      if (c + 1 < nchunks) {
#pragma unroll
        for (int ii = 0; ii < 8; ++ii) {
          const int pos = pos0 + (c + 1) * 32 + i0 + ii;
          const unsigned tok = dir ? base + T - 1 - pos : base + pos;
          const unsigned ri = tok * 2560u;
          rq[ii] = QZ32[ri + qoff2]; rz[ii] = QZ32[ri + zoff2]; rv[ii] = QZ32[ri + voff2];
        }
      }
      __syncthreads();
      if (mode) {
        const int ti = wave >> 1, si = wave & 1;
        f32x4 sc = f32x4{0.f, 0.f, 0.f, 0.f};
        if (si <= ti) {
#pragma unroll
          for (int kk = 0; kk < 4; ++kk) {
            const bf16x8 a = *(const bf16x8*)(sQe + (ti * 16 + l15) * 136 + kk * 32 + quad * 8);
            const bf16x8 b = *(const bf16x8*)(sKe + (si * 16 + l15) * 136 + kk * 32 + quad * 8);
            sc = __builtin_amdgcn_mfma_f32_16x16x32_bf16(a, b, sc, 0, 0, 0);
          }
        }
#pragma unroll
        for (int j = 0; j < 4; ++j) {
          const int t = ti * 16 + quad * 4 + j, s2 = si * 16 + l15;
          sP[t * 40 + s2] = (s2 <= t) ? f2bf(sc[j]) : (bfr)0;
        }
      }
      f32x4 oacc[2];
      oacc[0] = f32x4{0.f, 0.f, 0.f, 0.f}; oacc[1] = f32x4{0.f, 0.f, 0.f, 0.f};
      if (mode) {
#pragma unroll
      for (int kk = 0; kk < 4; ++kk) {
        const bf16x8 sb = *(const bf16x8*)(sST + eloc * 136 + kk * 32 + quad * 8);
#pragma unroll
        for (int tt = 0; tt < 2; ++tt) {
          const bf16x8 qa = *(const bf16x8*)(sQe + (tt * 16 + l15) * 136 + kk * 32 + quad * 8);
          oacc[tt] = __builtin_amdgcn_mfma_f32_16x16x32_bf16(sb, qa, oacc[tt], 0, 0, 0);
        }
      }
      }
      __syncthreads();
      {
        const bf16x8 vb = *(const bf16x8*)(sVT + eloc * 40 + quad * 8);
        if (mode) {
#pragma unroll
        for (int tt = 0; tt < 2; ++tt) {
          const bf16x8 pb = *(const bf16x8*)(sP + (tt * 16 + l15) * 40 + quad * 8);
          oacc[tt] = __builtin_amdgcn_mfma_f32_16x16x32_bf16(vb, pb, oacc[tt], 0, 0, 0);
          const int pos = pos0 + c * 32 + tt * 16 + l15;
          const int tok = dir ? base + T - 1 - pos : base + pos;
          uint2 o; o.x = pk2(oacc[tt][0], oacc[tt][1]); o.y = pk2(oacc[tt][2], oacc[tt][3]);
          *(uint2*)(Od + (size_t)tok * DM + h * 128 + eh * 64 + wave * 16 + quad * 4) = o;
        }
        }
#pragma unroll
        for (int dt = 0; dt < 8; ++dt) {
          const bf16x8 ka = *(const bf16x8*)(sKeT + (dt * 16 + l15) * 40 + quad * 8);
          const float4 dl = *(const float4*)(sLast + dt * 16 + quad * 4);
          f32x4 sn = __builtin_amdgcn_mfma_f32_16x16x32_bf16(ka, vb, S[dt], 0, 0, 0);
          sn[0] *= dl.x; sn[1] *= dl.y; sn[2] *= dl.z; sn[3] *= dl.w;
          S[dt] = sn;
          uint2 o; o.x = pk2(sn[0], sn[1]); o.y = pk2(sn[2], sn[3]);
          *(uint2*)(sST + eloc * 136 + dt * 16 + quad * 4) = o;
        }
      }
    }
    if (is_prompt || !mode) {
      float* so = is_prompt ? out_state + ((size_t)(seq * 2 + dir) * 8 + h) * 16384 : SLOC + (size_t)slot * 16384;
#pragma unroll
      for (int dt = 0; dt < 8; ++dt)
#pragma unroll
        for (int j = 0; j < 4; ++j) so[(dt * 16 + quad * 4 + j) * 128 + eglob] = S[dt][j];
      if (!mode && eh == 0 && qt == 0) *(float2*)(DLOC + slot * 128 + 2 * cp) = make_float2(cum0, cum1);
    }
  }
}

DEVINL void hgrn_combine_phase(const Params& p, int bid, int nblk) {
  const int gt = bid * 256 + otid(), nt = nblk * 256;
  float* SLOC = (float*)(p.ws + OFF_BIG + 251658240ull);
  const float* DLOC = (const float*)(p.ws + OFF_BIG + 251658240ull + 33554432ull);
  const float* state_rec = p.in[2];
  for (int idx = gt; idx < 4 * 8 * 2 * 16384; idx += nt) {
    const int de = idx & 16383, r = idx >> 14;
    const int dir = r & 1, h = (r >> 1) & 7, seqb = r >> 4;
    const int d = de >> 7;
    float prev = state_rec[((size_t)(seqb * 2 + dir) * 8 + h) * 16384 + de];
#pragma unroll
    for (int j = 0; j < 8; ++j) {
      const int slot = ((seqb * 8 + j) * 8 + h) * 2 + dir;
      float* ptr = SLOC + (size_t)slot * 16384 + de;
      const float a = (j < 7) ? *ptr : 0.f;
      *ptr = prev;
      if (j < 7) prev = DLOC[slot * 128 + d] * prev + a;
    }
  }
}

DEVINL void hgrn_gate_phase(const Params& p, const float* __restrict__ ng, int bid, int nblk) {
  const int tid = otid(); const int lane = tid & 63;
  const int gw = bid * 4 + (tid >> 6), nw = nblk * 4;
  bfr* Of = (bfr*)(p.ws + OFF_H);
  const bfr* Ob = (const bfr*)(p.ws + OFF_BIG + 209715200ull);
  const bfr* QZ = (const bfr*)(p.ws + OFF_BIG);
  for (int row = gw; row < MTOK; row += nw) {
#pragma unroll
    for (int seg = 0; seg < 4; ++seg) {
      const int c = seg * 256 + lane * 4;
      const uint2 a = *(const uint2*)(Of + (size_t)row * DM + c);
      const uint2 b = *(const uint2*)(Ob + (size_t)row * DM + c);
      const uint2 gq = *(const uint2*)(QZ + (size_t)row * 5120 + 4096 + c);
      const float o0 = bflo(a.x) + bflo(b.x), o1 = bfhi(a.x) + bfhi(b.x), o2 = bflo(a.y) + bflo(b.y), o3 = bfhi(a.y) + bfhi(b.y);
      float ss = o0 * o0 + o1 * o1 + o2 * o2 + o3 * o3;
#pragma unroll
      for (int o = 16; o > 0; o >>= 1) ss += shx(ss, o, lane);
      const float rstd = rsqrtf(ss * (1.f / 128.f) + EPS);
      const float4 gg = *(const float4*)(ng + c);
      uint2 o;
      o.x = pk2(o0 * rstd * gg.x * silu_f(bflo(gq.x)), o1 * rstd * gg.y * silu_f(bfhi(gq.x)));
      o.y = pk2(o2 * rstd * gg.z * silu_f(bflo(gq.y)), o3 * rstd * gg.w * silu_f(bfhi(gq.y)));
      *(uint2*)(Of + (size_t)row * DM + c) = o;
    }
  }
}

DEVINL void ffn_act_phase(const bfr* __restrict__ UP, const float* __restrict__ wdw, int hf, bfr* __restrict__ ACT, int bid, int nblk) {
  const int gt = bid * 256 + otid(), nt = nblk * 256;
  for (int i = gt; i < MTOK * 176; i += nt) {
    const int m = i / 176, j = (i - m * 176) * 8;
    int tl, T; tok_pos(m, tl, T);
    const bfr* ur = UP + (size_t)m * DFF;
    float a[8], b[8];
#pragma unroll
    for (int q = 0; q < 8; ++q) { a[q] = 0.f; b[q] = 0.f; }
#pragma unroll
    for (int tap = 0; tap < 3; ++tap) {
      const int d = tap - 1;
      if ((d < 0 && tl == 0) || (d > 0 && tl == T - 1)) continue;
      const bfr* nr = ur + (ptrdiff_t)d * DFF;
      const uint4 av = *(const uint4*)(nr + j);
      const uint4 bv = *(const uint4*)(nr + HALF_FF + j);
      const float* wa = wdw + tap * (2 * DFF) + hf * HALF_FF + j;
      const float* wb = wdw + tap * (2 * DFF) + DFF + hf * HALF_FF + j;
      const float4 wa0 = *(const float4*)wa, wa1 = *(const float4*)(wa + 4);
      const float4 wb0 = *(const float4*)wb, wb1 = *(const float4*)(wb + 4);
      a[0] += wa0.x * bflo(av.x); a[1] += wa0.y * bfhi(av.x); a[2] += wa0.z * bflo(av.y); a[3] += wa0.w * bfhi(av.y);
      a[4] += wa1.x * bflo(av.z); a[5] += wa1.y * bfhi(av.z); a[6] += wa1.z * bflo(av.w); a[7] += wa1.w * bfhi(av.w);
      b[0] += wb0.x * bflo(bv.x); b[1] += wb0.y * bfhi(bv.x); b[2] += wb0.z * bflo(bv.y); b[3] += wb0.w * bfhi(bv.y);
      b[4] += wb1.x * bflo(bv.z); b[5] += wb1.y * bfhi(bv.z); b[6] += wb1.z * bflo(bv.w); b[7] += wb1.w * bfhi(bv.w);
    }
    uint4 o;
    o.x = pk2(silu_f(a[0]) * b[0], silu_f(a[1]) * b[1]);
    o.y = pk2(silu_f(a[2]) * b[2], silu_f(a[3]) * b[3]);
    o.z = pk2(silu_f(a[4]) * b[4], silu_f(a[5]) * b[5]);
    o.w = pk2(silu_f(a[6]) * b[6], silu_f(a[7]) * b[7]);
    *(uint4*)(ACT + (size_t)m * DFF + hf * HALF_FF + j) = o;
  }
}


#define XB_TMO      128
#define XB_XCNT(j)  (256  + 64 * (j))
#define XB_XSUB(j)  (1280 + 64 * (j))
#define XB_XGEN(j)  (2304 + 64 * (j))
#define XB_TOP      3328
#define XB_TOPGEN   3392
#define XCD_BAR_WORDS 3456
#define XB_SPIN_CAP (1u << 22)
#define LAS __attribute__((address_space(3)))
DEVINL unsigned xb_ld(unsigned* p) { return __hip_atomic_load(p, __ATOMIC_RELAXED, __HIP_MEMORY_SCOPE_AGENT); }
DEVINL unsigned xb_add(unsigned* p, unsigned v) { return __hip_atomic_fetch_add(p, v, __ATOMIC_RELAXED, __HIP_MEMORY_SCOPE_AGENT); }
DEVINL unsigned xb_xcc_id() { return (unsigned)__builtin_amdgcn_s_getreg((3 << 11) | 20) & 0xFu; }
#define XB_SPIN(cond, bar) do { unsigned _sp = 0; while (cond) { __builtin_amdgcn_s_sleep(1); \
    if ((++_sp & 255u) == 0u) { if (xb_ld(&(bar)[XB_TMO])) break; if (_sp > XB_SPIN_CAP) { atomicAdd(&(bar)[XB_TMO], 1u); break; } } } } while (0)
struct XcdBarrier { unsigned* bar; unsigned x; volatile LAS unsigned* st; };
DEVINL XcdBarrier xcd_barrier_post(unsigned* bar, volatile LAS unsigned* st) {
  XcdBarrier b; b.bar = bar; b.x = xb_xcc_id(); b.st = st;
  if (threadIdx.x == 0) (void)xb_add(&bar[XB_XCNT(b.x)], 1u);
  return b;
}
DEVINL void xcd_barrier_complete(unsigned* bar, unsigned x, unsigned& nloc, unsigned& nx) {
  const unsigned G = gridDim.x * gridDim.y * gridDim.z;
  unsigned sum, cnt, mine, sp = 0u;
  for (;;) {
    sum = 0u; cnt = 0u; mine = 0u;
#pragma unroll
    for (unsigned j = 0; j < 16; ++j) { const unsigned c = xb_ld(&bar[XB_XCNT(j)]); sum += c; cnt += (c > 0u) ? 1u : 0u; mine = (j == x) ? c : mine; }
    if (sum == G) break;
    __builtin_amdgcn_s_sleep(1);
    if ((++sp & 255u) == 0u) { if (xb_ld(&bar[XB_TMO])) break; if (sp > XB_SPIN_CAP) { atomicAdd(&bar[XB_TMO], 1u); break; } }
  }
  nloc = mine > 0u ? mine : 1u; nx = cnt > 0u ? cnt : 1u;
}
DEVINL void xcd_barrier(const XcdBarrier& b) {
  asm volatile("s_waitcnt vmcnt(0)" ::: "memory");
  __syncthreads();
  if (threadIdx.x == 0) {
    unsigned* bar = b.bar;
    __builtin_amdgcn_s_waitcnt(0);
    unsigned nloc = b.st[0], nx = b.st[1];
    if (nloc == 0u) { xcd_barrier_complete(bar, b.x, nloc, nx); b.st[0] = nloc; b.st[1] = nx; }
    const unsigned old = xb_add(&bar[XB_XSUB(b.x)], 1u);
    const unsigned gen = old / nloc;
    if (old + 1u == (gen + 1u) * nloc) {
      __builtin_amdgcn_fence(__ATOMIC_RELEASE, "agent");
      asm volatile("s_waitcnt vmcnt(0)" ::: "memory");
      const unsigned og = xb_add(&bar[XB_TOP], 1u);
      const unsigned tg = og / nx;
      if (og + 1u == (tg + 1u) * nx) xb_add(&bar[XB_TOPGEN], 1u);
      else XB_SPIN(xb_ld(&bar[XB_TOPGEN]) == tg, bar);
      __builtin_amdgcn_fence(__ATOMIC_ACQUIRE, "agent");
      xb_add(&bar[XB_XGEN(b.x)], 1u);
      asm volatile("s_waitcnt vmcnt(0)" ::: "memory");
    } else {
      XB_SPIN(xb_ld(&bar[XB_XGEN(b.x)]) == gen, bar);
      __builtin_amdgcn_fence(__ATOMIC_ACQUIRE, "agent");
      asm volatile("s_waitcnt vmcnt(0)" ::: "memory");
    }
  }
  __syncthreads();
}

constexpr int SMEM_BYTES = 77824;

__global__ void __launch_bounds__(256, 2) mega_kernel(Params p) {
  __shared__ __attribute__((aligned(16))) char smem[SMEM_BYTES];
  cg::grid_group grid = cg::this_grid();
  __shared__ uint4 xb_words;
  if (threadIdx.x == 0) xb_words = make_uint4(0u, 0u, 0u, 0u);
  __syncthreads();
  XcdBarrier xb = xcd_barrier_post((unsigned*)(p.ws + OFF_BAR), (volatile LAS unsigned*)&xb_words);
  const int bid = blockIdx.x, nblk = gridDim.x;

  phase0a(p, smem, osg(bid), nblk);
  grid.sync();
  phase0b(p, osg(bid), nblk);
  xcd_barrier(xb);

  for (int layer = 0; layer < 4; ++layer) {
    Params q = p;
    asm volatile("" : "+s"(q.ws), "+s"(q.out));
    float* X = q.out;
    bfr* WB = (bfr*)(q.ws + OFF_WB);
    bfr* H = (bfr*)(q.ws + OFF_H);
    bfr* BIG = (bfr*)(q.ws + OFF_BIG);
    const float* MOD = (const float*)(q.ws + OFF_MOD);
    const float* modl = MOD + layer * 30720;
    if (layer == 0) {
      conv_matrix(q.in[9], 1024, 3072, WB + WB_IN, 0, smem, osg(bid), nblk);
      conv_matrix(q.in[11], 1024, 1024, WB + WB_OUT, 0, smem, osg(bid), nblk);
    } else if (layer == 1) {
      for (int g = 0; g < 4; ++g) conv_matrix(q.in[12] + g * 65536, 256, 256, WB + WB_IN + g * 65536, 0, smem, osg(bid), nblk);
    } else if (layer == 2) {
      conv_matrix(q.in[14], 1024, 2048, WB + WB_IN, 0, smem, osg(bid), nblk);
      conv_matrix(q.in[18], 1024, 1024, WB + WB_OUT, 0, smem, osg(bid), nblk);
    } else {
      conv_matrix(q.in[19], 1024, 5120, WB + WB_IN, 0, smem, osg(bid), nblk);
      conv_matrix(q.in[22], 1024, 1024, WB + WB_OUT, 0, smem, osg(bid), nblk);
    }
    conv_matrix(q.in[23] + (size_t)layer * 1024 * 5632, 1024, 5632, WB + WB_UP, 1, smem, osg(bid), nblk);
    conv_matrix(q.in[25] + (size_t)layer * DFF * 1024, DFF, 1024, WB + WB_DOWN, 0, smem, osg(bid), nblk);
    norm_phase(X, q.in[7] + (layer * 2 + 0) * DM, modl, 0, 1024, H, osg(bid), nblk);
    xcd_barrier(xb);

    if (layer == 0) {
      bfr* G = BIG;
      bfr* U = BIG + (size_t)MTOK * 3072;
      gemm_phase(H, DM, WB + WB_IN, 1024, 3072, 1024, EpiStore{G, 3072}, smem, osg(bid), nblk);
      xcd_barrier(xb);
      shortconv_ew_phase(G, q.in[10], U, osg(bid), nblk);
      xcd_barrier(xb);
      gemm_phase(U, DM, WB + WB_OUT, 1024, 1024, 1024, EpiResid{X, modl + 2048, nullptr, 0}, smem, osg(bid), nblk);
      xcd_barrier(xb);
    } else if (layer == 1) {
      bfr* P = BIG;
      pool_ew_phase(H, P, osg(bid), nblk);
      xcd_barrier(xb);
      for (int g = 0; g < 4; ++g)
        gemm_phase(P + g * 256, DM, WB + WB_IN + g * 65536, 256, 256, 256,
                   EpiResid{X, modl + 2048 + g * 256, q.in[13] + g * 256, g * 256}, smem, osg(bid), nblk);
      xcd_barrier(xb);
    } else if (layer == 2) {
      bfr* UV = BIG;
      gemm_phase(H, DM, WB + WB_IN, 1024, 2048, 1024, EpiGelu{UV, 2048}, smem, osg(bid), nblk);
      xcd_barrier(xb);
      sgu_norm_phase(UV, q.in[15], osg(bid), nblk);
      xcd_barrier(xb);
      sgu_spatial_phase(UV, q.in[16], q.in[17], smem, osg(bid), nblk);
      xcd_barrier(xb);
      gemm_phase(UV, 2048, WB + WB_OUT, 1024, 1024, 1024, EpiResid{X, modl + 2048, nullptr, 0}, smem, osg(bid), nblk);
      xcd_barrier(xb);
    } else {
      bfr* QZ = BIG;
      gemm_phase(H, DM, WB + WB_IN, 1024, 5120, 1024, EpiStore{QZ, 5120}, smem, osg(bid), nblk);
      xcd_barrier(xb);
      hgrn_scan_phase(q, smem, osg(bid), nblk, 0);
      xcd_barrier(xb);
      hgrn_combine_phase(q, osg(bid), nblk);
      xcd_barrier(xb);
      hgrn_scan_phase(q, smem, osg(bid), nblk, 1);
      xcd_barrier(xb);
      hgrn_gate_phase(q, q.in[21], osg(bid), nblk);
      xcd_barrier(xb);
      gemm_phase(H, DM, WB + WB_OUT, 1024, 1024, 1024, EpiResid{X, modl + 2048, nullptr, 0}, smem, osg(bid), nblk);
      xcd_barrier(xb);
    }

    norm_phase(X, q.in[7] + (layer * 2 + 1) * DM, modl, 3072, 4096, H, osg(bid), nblk);
    xcd_barrier(xb);
    bfr* ACT = BIG;
    float* EDGE = (float*)(q.ws + OFF_BIG + 115343360ull);
    const float* wdw = q.in[24] + (size_t)layer * 3 * 2 * DFF;
    gemm_phase(H, DM, WB + WB_UP, 1024, 2 * DFF, 1024, EpiFfnUp{ACT, EDGE, wdw}, smem, osg(bid), nblk);
    xcd_barrier(xb);
    ffn_edge_phase(EDGE, wdw, ACT, osg(bid), nblk);
    xcd_barrier(xb);
    gemm_phase(ACT, DFF, WB + WB_DOWN, DFF, 1024, DFF, EpiResid{X, modl + 5120, nullptr, 0}, smem, osg(bid), nblk);
    xcd_barrier(xb);
  }
  final_norm_phase(p.out, p.in[8], osg(bid), nblk);
}

extern "C" void kernel_launch(void* const* d_in, const int* in_sizes, int n_in, void* d_out, int out_size,
                              void* d_ws, size_t ws_size, hipStream_t stream) {
  static int grid_blocks = 0;
  if (!grid_blocks) {
    int dev = 0, cus = 0, per_cu = 0;
    hipGetDevice(&dev);
    hipDeviceGetAttribute(&cus, hipDeviceAttributeMultiprocessorCount, dev);
    hipOccupancyMaxActiveBlocksPerMultiprocessor(&per_cu, mega_kernel, 256, 0);
    if (per_cu > 2) per_cu = 2;
    if (per_cu < 1) per_cu = 1;
    grid_blocks = cus * per_cu;
  }
  if (ws_size < WS_NEED) { fprintf(stderr, "workspace too small: %zu < %zu\n", ws_size, (size_t)WS_NEED); return; }
  Params p{};
  for (int i = 0; i < 26; ++i) p.in[i] = (const float*)d_in[i];
  p.out = (float*)d_out;
  p.ws = (char*)d_ws;
  hipMemsetAsync((char*)d_ws + OFF_BAR, 0, XCD_BAR_WORDS * 4, stream);
  void* args[] = {&p};
  hipError_t e = hipLaunchCooperativeKernel((void*)mega_kernel, dim3(grid_blocks), dim3(256), args, 0, stream);
  if (e != hipSuccess) fprintf(stderr, "cooperative launch failed: %s (grid %d)\n", hipGetErrorString(e), grid_blocks);
}
```

```cpp
#include <hip/hip_runtime.h>
#include <hip/hip_cooperative_groups.h>
#include <stdint.h>
#include <stdio.h>
namespace cg = cooperative_groups;

#define DEVINL __device__ __forceinline__
typedef unsigned short bfr;
using bf16x8 = __attribute__((ext_vector_type(8))) short;
using f32x4 = __attribute__((ext_vector_type(4))) float;
using u32x4 = __attribute__((ext_vector_type(4))) unsigned int;

constexpr int DM = 1024;
constexpr int MTOK = 20480;
constexpr int NPROMPT = 4096;
constexpr int DFF = 2816;
constexpr int HALF_FF = 1408;
constexpr float EPS = 1e-6f;

constexpr size_t OFF_MODP = 0;
constexpr size_t OFF_MOD = 7864320;
constexpr size_t OFF_LBS = OFF_MOD + 491520;
constexpr size_t OFF_BAR = OFF_LBS + 8192;
constexpr size_t OFF_WB = 8388608;
constexpr size_t OFF_H = 41943040;
constexpr size_t OFF_BIG = 83886080;
constexpr size_t WS_NEED = OFF_BIG + 251658240ull + 33554432ull + 262144ull;
constexpr size_t WB_IN = 0, WB_OUT = 5242880, WB_UP = 6291456, WB_DOWN = 12058624;

struct Params {
  const float* in[26];
  float* out;
  char* ws;
};

DEVINL int otid() { int t = threadIdx.x; asm volatile("" : "+v"(t)); return t; }
DEVINL int osg(int x) { asm volatile("" : "+s"(x)); return x; }
typedef __bf16 hbf16x2 __attribute__((ext_vector_type(2)));
typedef float hf32x2 __attribute__((ext_vector_type(2)));
DEVINL uint32_t pk2(float a, float b) {
  hf32x2 v = {a, b};
  hbf16x2 r = __builtin_convertvector(v, hbf16x2);
  return __builtin_bit_cast(uint32_t, r);
}
DEVINL bfr f2bf(float f) { return (bfr)(pk2(f, 0.f) & 0xffffu); }
DEVINL float bf2f(bfr h) { return __uint_as_float(((uint32_t)h) << 16); }
DEVINL float frcp(float x) { return __builtin_amdgcn_rcpf(x); }
DEVINL float bflo(uint32_t u) { return __uint_as_float(u << 16); }
DEVINL float bfhi(uint32_t u) { return __uint_as_float(u & 0xffff0000u); }
DEVINL int cond_of(int m) { return m < NPROMPT ? 0 : 1 + ((m - NPROMPT) >> 12); }
DEVINL float silu_f(float x) { return x * frcp(1.f + __expf(-x)); }
DEVINL float gelu_tanh_f(float x) {
  float y = 0.7978845608028654f * (x + 0.044715f * x * x * x);
  float t = 1.f - 2.f * frcp(__expf(2.f * y) + 1.f);
  return 0.5f * x * (1.f + t);
}
DEVINL float shx(float v, int o, int lane) {
  return __int_as_float(__builtin_amdgcn_ds_bpermute((lane ^ o) << 2, __float_as_int(v)));
}
DEVINL float wave_sum(float v, int lane) {
#pragma unroll
  for (int o = 32; o > 0; o >>= 1) v += shx(v, o, lane);
  return v;
}

DEVINL void tok_pos(int m, int& tl, int& T) {
  if (m < NPROMPT) { tl = m & 255; T = 256; } else { tl = (m - NPROMPT) & 4095; T = 4096; }
}

struct EpiNoPre {};
#define EPI_ELEMENTWISE_TILE                                                                       \
  typedef EpiNoPre Pre;                                                                             \
  DEVINL Pre pre(int tn, int tid) const { return Pre{}; }                                           \
  DEVINL void tile(const f32x4 (&acc)[4][4], const Pre& pre_, int m0, int n0, int tn, int wm, int wn, int l15, \
                   int quad, int tid, char* smem) const {                                           \
    _Pragma("unroll") for (int mt = 0; mt < 4; ++mt)                                                \
      _Pragma("unroll") for (int nt = 0; nt < 4; ++nt)                                              \
        (*this)(m0 + wm * 64 + mt * 16 + l15, n0 + wn * 64 + nt * 16 + quad * 4, acc[mt][nt]);      \
  }
struct EpiStore {
  bfr* C; int ldc;
  DEVINL void tile256(const f32x4 (&acc)[8][4], const EpiNoPre& pre_, int m0, int n0, int tn, int wm, int wn, int l15,
                      int quad, int tid, char* smem) const {
#pragma unroll
    for (int mt = 0; mt < 8; ++mt)
#pragma unroll
      for (int nt = 0; nt < 4; ++nt)
        (*this)(m0 + wm * 128 + mt * 16 + l15, n0 + wn * 64 + nt * 16 + quad * 4, acc[mt][nt]);
  }
  DEVINL void operator()(int m, int n, f32x4 v) const {
    uint2 o; o.x = pk2(v[0], v[1]); o.y = pk2(v[2], v[3]);
    *(uint2*)(C + (size_t)m * ldc + n) = o;
  }
  EPI_ELEMENTWISE_TILE
};
struct EpiGelu {
  bfr* C; int ldc;
  DEVINL void operator()(int m, int n, f32x4 v) const {
    uint2 o; o.x = pk2(gelu_tanh_f(v[0]), gelu_tanh_f(v[1])); o.y = pk2(gelu_tanh_f(v[2]), gelu_tanh_f(v[3]));
    *(uint2*)(C + (size_t)m * ldc + n) = o;
  }
  EPI_ELEMENTWISE_TILE
};
struct EpiResid {
  float* X; const float* gate; const float* cscale; int coff;
  DEVINL void operator()(int m, int n, f32x4 v) const {
    const int cond = cond_of(m);
    const float4 g = *(const float4*)(gate + cond * 6144 + n);
    float4* xp = (float4*)(X + (size_t)m * DM + coff + n);
    float4 x = *xp;
    float s0 = 1.f, s1 = 1.f, s2 = 1.f, s3 = 1.f;
    if (cscale) { const float4 s = *(const float4*)(cscale + n); s0 = s.x; s1 = s.y; s2 = s.z; s3 = s.w; }
    x.x += g.x * v[0] * s0; x.y += g.y * v[1] * s1; x.z += g.z * v[2] * s2; x.w += g.w * v[3] * s3;
    *xp = x;
  }
  EPI_ELEMENTWISE_TILE
};

#define LDS3 __attribute__((address_space(3)))
DEVINL void lds_barrier() { asm volatile("s_waitcnt lgkmcnt(0)\n\ts_barrier" ::: "memory"); }
template <class Epi>
DEVINL void gemm_phase(const bfr* __restrict__ A, int lda, const bfr* __restrict__ Bt, int ldb, int N, int K,
                       const Epi& epi, char* smem, int bid, int nblk) {
  const int tid = otid(), lane = tid & 63, wave = tid >> 6;
  const int wm = wave >> 1, wn = wave & 1, l15 = lane & 15, quad = lane >> 4;
  const int tilesN = N >> 7;
  const int ntiles = (MTOK >> 7) * tilesN;
  const int nk = K >> 6;
  const int srow0 = wave * 8 + (lane >> 3);
  const int lc = (lane & 7) ^ ((srow0 >> 1) & 7);
  const int fsw = (l15 >> 1) & 7;
  char* const dst0 = smem + wave * 1024 + lane * 16;
#define TILE_DECODE(t_, tm_, tn_) { const int xcd_ = (t_) & 7, u_ = (t_) >> 3; const int ur_ = u_ / tilesN; tn_ = u_ - ur_ * tilesN; tm_ = ur_ * 8 + xcd_; }
#define GLDS_STAGE(pa_, pb_, st_, kt_)                                                                    \
  {                                                                                                       \
    _Pragma("unroll") for (int i = 0; i < 4; ++i) {                                                       \
      __builtin_amdgcn_global_load_lds((const unsigned*)((pa_) + (size_t)(i * 32) * lda + (kt_) * 64),    \
                                       (LDS3 unsigned*)(dst0 + (st_) * 32768 + i * 4096), 16, 0, 0);      \
      __builtin_amdgcn_global_load_lds((const unsigned*)((pb_) + (size_t)(i * 32) * ldb + (kt_) * 64),    \
                                       (LDS3 unsigned*)(dst0 + (st_) * 32768 + 16384 + i * 4096), 16, 0, 0); \
    }                                                                                                     \
  }
  int tile = bid;
  if (tile >= ntiles) return;
  int tm, tn;
  TILE_DECODE(tile, tm, tn)
  const bfr* gA = A + (size_t)((tm << 7) + srow0) * lda + lc * 8;
  const bfr* gB = Bt + (size_t)((tn << 7) + srow0) * ldb + lc * 8;
  __syncthreads();
  GLDS_STAGE(gA, gB, 0, 0)
  for (; tile < ntiles; tile += nblk) {
    const int m0 = tm << 7, n0 = tn << 7, tn_cur = tn;
    const bool has_next = (tile + nblk < ntiles);
    const bfr* gAn = gA; const bfr* gBn = gB;
    if (has_next) {
      TILE_DECODE(tile + nblk, tm, tn)
      gAn = A + (size_t)((tm << 7) + srow0) * lda + lc * 8;
      gBn = Bt + (size_t)((tn << 7) + srow0) * ldb + lc * 8;
    }
    typename Epi::Pre pre = epi.pre(tn_cur, tid);
    f32x4 acc[4][4];
#pragma unroll
    for (int i = 0; i < 4; ++i)
#pragma unroll
      for (int j = 0; j < 4; ++j) acc[i][j] = f32x4{0.f, 0.f, 0.f, 0.f};
    __syncthreads();
    for (int kt = 0; kt < nk; ++kt) {
      const int st = kt & 1;
      if (kt + 1 < nk) GLDS_STAGE(gA, gB, st ^ 1, kt + 1)
      else if (has_next) GLDS_STAGE(gAn, gBn, 0, 0)
      const char* cA = smem + st * 32768 + (wm * 64 + l15) * 128;
      const char* cB = smem + st * 32768 + 16384 + (wn * 64 + l15) * 128;
      {
        const int co0 = (quad ^ fsw) * 16, co1 = ((4 + quad) ^ fsw) * 16;
        bf16x8 af0[4], bf0[4], af1[4], bf1[4];
#pragma unroll
        for (int i = 0; i < 4; ++i) {
          af0[i] = *(const bf16x8*)(cA + i * 2048 + co0);
          bf0[i] = *(const bf16x8*)(cB + i * 2048 + co0);
        }
#pragma unroll
        for (int i = 0; i < 4; ++i) {
          af1[i] = *(const bf16x8*)(cA + i * 2048 + co1);
          bf1[i] = *(const bf16x8*)(cB + i * 2048 + co1);
        }
        __builtin_amdgcn_sched_barrier(0);
#pragma unroll
        for (int mt = 0; mt < 4; ++mt)
#pragma unroll
          for (int nt = 0; nt < 4; ++nt)
            acc[mt][nt] = __builtin_amdgcn_mfma_f32_16x16x32_bf16(bf0[nt], af0[mt], acc[mt][nt], 0, 0, 0);
#pragma unroll
        for (int mt = 0; mt < 4; ++mt)
#pragma unroll
          for (int nt = 0; nt < 4; ++nt)
            acc[mt][nt] = __builtin_amdgcn_mfma_f32_16x16x32_bf16(bf1[nt], af1[mt], acc[mt][nt], 0, 0, 0);
        __builtin_amdgcn_sched_barrier(0);
      }
      if (kt + 1 < nk) __syncthreads();
    }
    epi.tile(acc, pre, m0, n0, tn_cur, wm, wn, l15, quad, tid, smem);
    gA = gAn; gB = gBn;
  }
}

constexpr int EDGE_LD = 2 * DFF;
struct FfnPre { f32x4 wa[3], wb[3]; };
DEVINL void ffn_conv_rows(const bfr* T, const FfnPre& pre_, bfr* ACT, float* EDGE, int m0, int n0, int tn, int tid) {
  const int c4 = (tid & 15) * 4, r0 = (tid >> 4) * 8;
  const int ja = tn * 64 + c4;
  int tl, Tlen; tok_pos(m0, tl, Tlen);
  const bool top_ok = (tl == 0), bot_ok = (tl + 128 == Tlen);
  if (tid < 128) {
    const int e = tid >> 5, c = (tid & 31) * 4;
    const int r = (e < 2) ? e : 124 + e;
    const uint2 v = *(const uint2*)(T + r * 136 + c);
    *(f32x4*)(EDGE + ((size_t)(m0 >> 7) * 4 + e) * EDGE_LD + n0 + c) = f32x4{bflo(v.x), bfhi(v.x), bflo(v.y), bfhi(v.y)};
  }
  const f32x4 zero = f32x4{0.f, 0.f, 0.f, 0.f};
#define LDT(dst, row, col) { const uint2 v_ = *(const uint2*)(T + (row) * 136 + (col)); dst = f32x4{bflo(v_.x), bfhi(v_.x), bflo(v_.y), bfhi(v_.y)}; }
  f32x4 pa = zero, pb = zero, ca, cb, na, nb;
  if (r0 > 0) { LDT(pa, r0 - 1, c4) LDT(pb, r0 - 1, 64 + c4) }
  LDT(ca, r0, c4) LDT(cb, r0, 64 + c4)
#pragma unroll
  for (int i = 0; i < 8; ++i) {
    const int r = r0 + i;
    if (r < 127) { LDT(na, r + 1, c4) LDT(nb, r + 1, 64 + c4) }
    else { na = zero; nb = zero; }
    const bool ok = (r > 0 || top_ok) && (r < 127 || bot_ok);
    if (ok) {
      const f32x4 a = pre_.wa[0] * pa + pre_.wa[1] * ca + pre_.wa[2] * na;
      const f32x4 b = pre_.wb[0] * pb + pre_.wb[1] * cb + pre_.wb[2] * nb;
      uint2 o;
      o.x = pk2(silu_f(a[0]) * b[0], silu_f(a[1]) * b[1]);
      o.y = pk2(silu_f(a[2]) * b[2], silu_f(a[3]) * b[3]);
      *(uint2*)(ACT + (size_t)(m0 + r) * DFF + ja) = o;
    }
    pa = ca; pb = cb; ca = na; cb = nb;
  }
#undef LDT
}
struct EpiFfnUp {
  bfr* ACT; float* EDGE; const float* wdw;
  typedef FfnPre Pre;
  DEVINL Pre pre(int tn, int tid) const {
    Pre q;
    const int ja = tn * 64 + (tid & 15) * 4;
#pragma unroll
    for (int t = 0; t < 3; ++t) {
      q.wa[t] = *(const f32x4*)(wdw + t * (2 * DFF) + ja);
      q.wb[t] = *(const f32x4*)(wdw + t * (2 * DFF) + DFF + ja);
    }
    return q;
  }
  DEVINL void tile(const f32x4 (&acc)[4][4], const Pre& pre_, int m0, int n0, int tn, int wm, int wn, int l15, int quad,
                   int tid, char* smem) const {
    bfr* T = (bfr*)(smem + 32768);
    lds_barrier();
#pragma unroll
    for (int mt = 0; mt < 4; ++mt)
#pragma unroll
      for (int nt = 0; nt < 4; ++nt) {
        uint2 o; o.x = pk2(acc[mt][nt][0], acc[mt][nt][1]); o.y = pk2(acc[mt][nt][2], acc[mt][nt][3]);
        *(uint2*)(T + (wm * 64 + mt * 16 + l15) * 136 + wn * 64 + nt * 16 + quad * 4) = o;
      }
    lds_barrier();
    ffn_conv_rows(T, pre_, ACT, EDGE, m0, n0, tn, tid);
  }
  DEVINL void tile256(const f32x4 (&acc)[8][4], const Pre& pre_, int m0, int n0, int tn, int wm, int wn, int l15, int quad,
                      int tid, char* smem) const {
    bfr* T = (bfr*)(smem + 24576);
#pragma unroll
    for (int hh = 0; hh < 2; ++hh) {
      lds_barrier();
      if (wm == hh) {
#pragma unroll
        for (int mt = 0; mt < 8; ++mt)
#pragma unroll
          for (int nt = 0; nt < 4; ++nt) {
            uint2 o; o.x = pk2(acc[mt][nt][0], acc[mt][nt][1]); o.y = pk2(acc[mt][nt][2], acc[mt][nt][3]);
            *(uint2*)(T + (mt * 16 + l15) * 136 + wn * 64 + nt * 16 + quad * 4) = o;
          }
      }
      lds_barrier();
      ffn_conv_rows(T, pre_, ACT, EDGE, m0 + hh * 128, n0, tn, tid);
    }
  }
};


template <class Epi>
DEVINL void gemm256_phase(const bfr* __restrict__ A, int lda, const bfr* __restrict__ Bt, int ldb, int N, int K,
                          const Epi& epi, char* smem, int bid, int nblk) {
  const int tid = otid(), lane = tid & 63, wave = tid >> 6;
  const int wm = wave >> 1, wn = wave & 1, l15 = lane & 15, quad = lane >> 4;
  const int tilesN = N >> 7;
  const int ntiles = (MTOK >> 8) * tilesN;
  const int nk = K >> 5;
  const int srow0 = wave * 16 + (lane >> 2);
  const int lc = (lane & 3) ^ ((0 - (lane >> 4)) & 3);
  const int fsw = (0 - (l15 >> 2)) & 3;
  char* const dst0 = smem + wave * 1024 + lane * 16;
#define TILE_DECODE2(t_, tm_, tn_) { const int xcd_ = (t_) & 7, u_ = (t_) >> 3; const int ur_ = u_ / tilesN; tn_ = u_ - ur_ * tilesN; tm_ = ur_ * 8 + xcd_; }
#define GLDS_STAGE2(pa_, pb_, st_, kt_)                                                                   \
  {                                                                                                       \
    _Pragma("unroll") for (int i = 0; i < 4; ++i)                                                         \
      __builtin_amdgcn_global_load_lds((const unsigned*)((pa_) + (size_t)(i * 64) * lda + (kt_) * 32),    \
                                       (LDS3 unsigned*)(dst0 + (st_) * 24576 + i * 4096), 16, 0, 0);      \
    _Pragma("unroll") for (int i = 0; i < 2; ++i)                                                         \
      __builtin_amdgcn_global_load_lds((const unsigned*)((pb_) + (size_t)(i * 64) * ldb + (kt_) * 32),    \
                                       (LDS3 unsigned*)(dst0 + (st_) * 24576 + 16384 + i * 4096), 16, 0, 0); \
  }
  int tile = bid;
  if (tile >= ntiles) return;
  int tm, tn;
  TILE_DECODE2(tile, tm, tn)
  const bfr* gA = A + (size_t)((tm << 8) + srow0) * lda + lc * 8;
  const bfr* gB = Bt + (size_t)((tn << 7) + srow0) * ldb + lc * 8;
  __syncthreads();
  GLDS_STAGE2(gA, gB, 0, 0)
  for (; tile < ntiles; tile += nblk) {
    const int m0 = tm << 8, n0 = tn << 7, tn_cur = tn;
    const bool has_next = (tile + nblk < ntiles);
    const bfr* gAn = gA; const bfr* gBn = gB;
    if (has_next) {
      TILE_DECODE2(tile + nblk, tm, tn)
      gAn = A + (size_t)((tm << 8) + srow0) * lda + lc * 8;
      gBn = Bt + (size_t)((tn << 7) + srow0) * ldb + lc * 8;
    }
    f32x4 acc[8][4];
#pragma unroll
    for (int i = 0; i < 8; ++i)
#pragma unroll
      for (int j = 0; j < 4; ++j) acc[i][j] = f32x4{0.f, 0.f, 0.f, 0.f};
    __syncthreads();
    for (int kt = 0; kt < nk; ++kt) {
      const int st = kt & 1;
      if (kt + 1 < nk) GLDS_STAGE2(gA, gB, st ^ 1, kt + 1)
      else if (has_next) GLDS_STAGE2(gAn, gBn, 0, 0)
      const char* cA = smem + st * 24576 + (wm * 128 + l15) * 64 + ((quad ^ fsw) * 16);
      const char* cB = smem + st * 24576 + 16384 + (wn * 64 + l15) * 64 + ((quad ^ fsw) * 16);
      bf16x8 bfg[4];
#pragma unroll
      for (int i = 0; i < 4; ++i) bfg[i] = *(const bf16x8*)(cB + i * 1024);
#pragma unroll
      for (int hm = 0; hm < 2; ++hm) {
        bf16x8 af[4];
#pragma unroll
        for (int i = 0; i < 4; ++i) af[i] = *(const bf16x8*)(cA + (hm * 4 + i) * 1024);
#pragma unroll
        for (int mt = 0; mt < 4; ++mt)
#pragma unroll
          for (int nt = 0; nt < 4; ++nt)
            acc[hm * 4 + mt][nt] = __builtin_amdgcn_mfma_f32_16x16x32_bf16(bfg[nt], af[mt], acc[hm * 4 + mt][nt], 0, 0, 0);
        __builtin_amdgcn_sched_barrier(0);
      }
      if (kt + 1 < nk) __syncthreads();
    }
    {
      typename Epi::Pre pre = epi.pre(tn_cur, tid);
      epi.tile256(acc, pre, m0, n0, tn_cur, wm, wn, l15, quad, tid, smem);
    }
    gA = gAn; gB = gBn;
  }
}

DEVINL void ffn_edge_phase(const float* __restrict__ EDGE, const float* __restrict__ wdw, bfr* __restrict__ ACT, int bid, int nblk) {
  const int gt = bid * 256 + otid(), nt = nblk * 256;
  for (int i = gt; i < 160 * 2 * 704; i += nt) {
    const int cg4 = i % 704, r2 = i / 704, side = r2 & 1, tm = r2 >> 1;
    const int m0 = tm << 7;
    int tl, Tlen; tok_pos(m0, tl, Tlen);
    if (side == 0 ? (tl == 0) : (tl + 128 == Tlen)) continue;
    const int ja = cg4 * 4;
    const int nb_ = ja >> 6, cc = ja & 63;
    const int ea = nb_ * 128 + cc, eb = ea + 64;
    const float* prev; const float* cur; const float* next;
    if (side == 0) {
      prev = EDGE + ((size_t)(tm - 1) * 4 + 3) * EDGE_LD; cur = EDGE + ((size_t)tm * 4 + 0) * EDGE_LD; next = EDGE + ((size_t)tm * 4 + 1) * EDGE_LD;
    } else {
      prev = EDGE + ((size_t)tm * 4 + 2) * EDGE_LD; cur = EDGE + ((size_t)tm * 4 + 3) * EDGE_LD; next = EDGE + ((size_t)(tm + 1) * 4 + 0) * EDGE_LD;
    }
    const f32x4 a = *(const f32x4*)(wdw + ja) * *(const f32x4*)(prev + ea) + *(const f32x4*)(wdw + 2 * DFF + ja) * *(const f32x4*)(cur + ea) +
                    *(const f32x4*)(wdw + 4 * DFF + ja) * *(const f32x4*)(next + ea);
    const f32x4 b = *(const f32x4*)(wdw + DFF + ja) * *(const f32x4*)(prev + eb) + *(const f32x4*)(wdw + 3 * DFF + ja) * *(const f32x4*)(cur + eb) +
                    *(const f32x4*)(wdw + 5 * DFF + ja) * *(const f32x4*)(next + eb);
    uint2 o;
    o.x = pk2(silu_f(a[0]) * b[0], silu_f(a[1]) * b[1]);
    o.y = pk2(silu_f(a[2]) * b[2], silu_f(a[3]) * b[3]);
    const int m = m0 + (side ? 127 : 0);
    *(uint2*)(ACT + (size_t)m * DFF + ja) = o;
  }
}

DEVINL int up_perm(int n0) {
  if (n0 < DFF) return (n0 >> 6) * 128;
  return ((n0 - DFF) >> 6) * 128 + 64;
}
DEVINL void conv_matrix(const float* __restrict__ src, int K, int N, bfr* __restrict__ dst, int perm,
                        char* smem, int bid, int nblk) {
  float* sT = (float*)smem;
  const int tid = otid();
  const int tilesN = N >> 6;
  const int ntiles = (K >> 6) * tilesN;
  for (int t = bid; t < ntiles; t += nblk) {
    const int tk = t / tilesN, tn = t - tk * tilesN;
    const int k0 = tk << 6, n0 = tn << 6;
    const int r = tid >> 4, c4 = tid & 15;
    __syncthreads();
#pragma unroll
    for (int i = 0; i < 4; ++i) {
      const float4 v = *(const float4*)(src + (size_t)(k0 + r + i * 16) * N + n0 + c4 * 4);
      float* d = sT + (r + i * 16) * 65 + c4 * 4;
      d[0] = v.x; d[1] = v.y; d[2] = v.z; d[3] = v.w;
    }
    __syncthreads();
    const int n = tid >> 2, kc = tid & 3;
    uint32_t w[8];
#pragma unroll
    for (int j = 0; j < 8; ++j)
      w[j] = pk2(sT[(kc * 16 + 2 * j) * 65 + n], sT[(kc * 16 + 2 * j + 1) * 65 + n]);
    const int nd = (perm ? up_perm(n0) : n0) + n;
    bfr* dp = dst + (size_t)nd * K + k0 + kc * 16;
    *(uint4*)dp = make_uint4(w[0], w[1], w[2], w[3]);
    *(uint4*)(dp + 8) = make_uint4(w[4], w[5], w[6], w[7]);
  }
}

DEVINL void phase0a(const Params& p, char* smem, int bid, int nblk) {
  const int tid = otid();
  float* sc = (float*)smem;
  float* modp = (float*)(p.ws + OFF_MODP);
  const float* cvec = p.in[3];
  const float* cctx = p.in[4];
  const float* ada_w = p.in[5];
  for (int job = bid; job < 384; job += nblk) {
    const int l = job / 96, r = job - l * 96, ks = r / 6, cgp = r - ks * 6;
    __syncthreads();
    for (int i = tid; i < 320; i += 256) {
      const int cond = i >> 6, kk = i & 63;
      const float v = cond == 0 ? cctx[ks * 64 + kk] : cvec[(cond - 1) * DM + ks * 64 + kk];
      sc[i] = silu_f(v);
    }
    __syncthreads();
    const int col = cgp * 1024 + tid * 4;
    const float* wp = ada_w + ((size_t)l * DM + ks * 64) * 6144 + col;
    float a[5][4];
#pragma unroll
    for (int c = 0; c < 5; ++c)
#pragma unroll
      for (int j = 0; j < 4; ++j) a[c][j] = 0.f;
#pragma unroll 8
    for (int kk = 0; kk < 64; ++kk) {
      const float4 w = *(const float4*)(wp + (size_t)kk * 6144);
#pragma unroll
      for (int c = 0; c < 5; ++c) {
        const float s = sc[c * 64 + kk];
        a[c][0] += s * w.x; a[c][1] += s * w.y; a[c][2] += s * w.z; a[c][3] += s * w.w;
      }
    }
#pragma unroll
    for (int c = 0; c < 5; ++c)
      *(float4*)(modp + ((size_t)(ks * 4 + l) * 5 + c) * 6144 + col) = make_float4(a[c][0], a[c][1], a[c][2], a[c][3]);
  }
  const int gt = bid * 256 + tid, nt = nblk * 256;
  {
    const float* lb = p.in[20];
    float* lbs = (float*)(p.ws + OFF_LBS);
    for (int i = gt; i < 2048; i += nt) {
      const float v0 = lb[i], v1 = lb[2048 + i], v2 = lb[4096 + i], v3 = lb[6144 + i];
      const float mx = fmaxf(fmaxf(v0, v1), fmaxf(v2, v3));
      const float e0 = expf(v0 - mx), e1 = expf(v1 - mx), e2 = expf(v2 - mx), e3 = expf(v3 - mx);
      lbs[i] = (e1 + e2 + e3) / (e0 + e1 + e2 + e3);
    }
  }
  float* X = p.out;
  {
    const float4* xp = (const float4*)p.in[0];
    float4* xo = (float4*)X;
    for (int i = gt; i < NPROMPT * DM / 4; i += nt) xo[i] = xp[i];
    const float* xs = p.in[1];
    for (int i = gt; i < 4096 * 256; i += nt) {
      const int t = i >> 8, c = (i & 255) * 4;
      const int part = c >> 8;
      const float pos = (float)((part < 2) ? (t >> 6) : (t & 63));
      float pe[4];
#pragma unroll
      for (int j = 0; j < 4; ++j) {
        const int jj = (c + j) & 255;
        const float freq = expf((-9.210340371976184f * (float)jj) / 256.0f);
        const float arg = pos * freq;
        pe[j] = (part & 1) ? cosf(arg) : sinf(arg);
      }
#pragma unroll
      for (int b = 0; b < 4; ++b) {
        const size_t off = ((size_t)b * 4096 + t) * DM + c;
        float4 v = *(const float4*)(xs + off);
        v.x += pe[0]; v.y += pe[1]; v.z += pe[2]; v.w += pe[3];
        *(float4*)(X + (size_t)NPROMPT * DM + off) = v;
      }
    }
  }
}

DEVINL void phase0b(const Params& p, int bid, int nblk) {
  const int gt = bid * 256 + otid(), nt = nblk * 256;
  const float* modp = (const float*)(p.ws + OFF_MODP);
  float* mod = (float*)(p.ws + OFF_MOD);
  const float* ada_b = p.in[6];
  for (int i = gt; i < 4 * 5 * 6144; i += nt) {
    const int l = i / 30720, col = i % 6144;
    float s = ada_b[l * 6144 + col];
#pragma unroll
    for (int ks = 0; ks < 16; ++ks) s += modp[(size_t)ks * 122880 + i];
    mod[i] = s;
  }
}

DEVINL void norm_phase(const float* __restrict__ X, const float* __restrict__ g, const float* __restrict__ modl,
                       int shift_off, int scale_off, bfr* __restrict__ H, int bid, int nblk) {
  const int tid = otid(); const int lane = tid & 63;
  const int gw = bid * 4 + (tid >> 6), nw = nblk * 4;
  for (int row = gw; row < MTOK; row += nw) {
    const float* xr = X + (size_t)row * DM;
    float4 x[4];
    float ss = 0.f;
#pragma unroll
    for (int i = 0; i < 4; ++i) {
      x[i] = *(const float4*)(xr + i * 256 + lane * 4);
      ss += x[i].x * x[i].x + x[i].y * x[i].y + x[i].z * x[i].z + x[i].w * x[i].w;
    }
    ss = wave_sum(ss, lane);
    const float rstd = rsqrtf(ss * (1.f / DM) + EPS);
    const float* mc = modl + cond_of(row) * 6144;
#pragma unroll
    for (int i = 0; i < 4; ++i) {
      const int c = i * 256 + lane * 4;
      const float4 gg = *(const float4*)(g + c);
      const float4 sh = *(const float4*)(mc + shift_off + c);
      const float4 sc = *(const float4*)(mc + scale_off + c);
      const float h0 = x[i].x * rstd * gg.x * (1.f + sc.x) + sh.x;
      const float h1 = x[i].y * rstd * gg.y * (1.f + sc.y) + sh.y;
      const float h2 = x[i].z * rstd * gg.z * (1.f + sc.z) + sh.z;
      const float h3 = x[i].w * rstd * gg.w * (1.f + sc.w) + sh.w;
      uint2 o; o.x = pk2(h0, h1); o.y = pk2(h2, h3);
      *(uint2*)(H + (size_t)row * DM + c) = o;
    }
  }
}

DEVINL void final_norm_phase(float* X, const float* __restrict__ g, int bid, int nblk) {
  const int tid = otid(); const int lane = tid & 63;
  const int gw = bid * 4 + (tid >> 6), nw = nblk * 4;
  for (int row = gw; row < MTOK; row += nw) {
    float* xr = X + (size_t)row * DM;
    float4 x[4];
    float ss = 0.f;
#pragma unroll
    for (int i = 0; i < 4; ++i) {
      x[i] = *(const float4*)(xr + i * 256 + lane * 4);
      ss += x[i].x * x[i].x + x[i].y * x[i].y + x[i].z * x[i].z + x[i].w * x[i].w;
    }
    ss = wave_sum(ss, lane);
    const float rstd = rsqrtf(ss * (1.f / DM) + EPS);
#pragma unroll
    for (int i = 0; i < 4; ++i) {
      const int c = i * 256 + lane * 4;
      const float4 gg = *(const float4*)(g + c);
      float4 o;
      o.x = x[i].x * rstd * gg.x; o.y = x[i].y * rstd * gg.y; o.z = x[i].z * rstd * gg.z; o.w = x[i].w * rstd * gg.w;
      *(float4*)(xr + c) = o;
    }
  }
}

DEVINL void shortconv_ew_phase(const bfr* __restrict__ G, const float* __restrict__ wdw, bfr* __restrict__ U, int bid, int nblk) {
  const int gt = bid * 256 + otid(), nt = nblk * 256;
  for (int i = gt; i < MTOK * 128; i += nt) {
    const int m = i >> 7, c = (i & 127) * 8;
    int tl, T; tok_pos(m, tl, T);
    const bfr* gr = G + (size_t)m * 3072;
    const uint4 bg = *(const uint4*)(gr + c);
    float accv[8];
#pragma unroll
    for (int j = 0; j < 8; ++j) accv[j] = 0.f;
#pragma unroll
    for (int tap = 0; tap < 3; ++tap) {
      const int d = tap - 1;
      if ((d < 0 && tl == 0) || (d > 0 && tl == T - 1)) continue;
      const bfr* nr = gr + (ptrdiff_t)d * 3072;
      const uint4 cgv = *(const uint4*)(nr + 1024 + c);
      const uint4 xhv = *(const uint4*)(nr + 2048 + c);
      const float4 w0 = *(const float4*)(wdw + tap * DM + c);
      const float4 w1 = *(const float4*)(wdw + tap * DM + c + 4);
      accv[0] += w0.x * bflo(cgv.x) * bflo(xhv.x); accv[1] += w0.y * bfhi(cgv.x) * bfhi(xhv.x);
      accv[2] += w0.z * bflo(cgv.y) * bflo(xhv.y); accv[3] += w0.w * bfhi(cgv.y) * bfhi(xhv.y);
      accv[4] += w1.x * bflo(cgv.z) * bflo(xhv.z); accv[5] += w1.y * bfhi(cgv.z) * bfhi(xhv.z);
      accv[6] += w1.z * bflo(cgv.w) * bflo(xhv.w); accv[7] += w1.w * bfhi(cgv.w) * bfhi(xhv.w);
    }
    uint4 o;
    o.x = pk2(bflo(bg.x) * accv[0], bfhi(bg.x) * accv[1]);
    o.y = pk2(bflo(bg.y) * accv[2], bfhi(bg.y) * accv[3]);
    o.z = pk2(bflo(bg.z) * accv[4], bfhi(bg.z) * accv[5]);
    o.w = pk2(bflo(bg.w) * accv[6], bfhi(bg.w) * accv[7]);
    *(uint4*)(U + (size_t)m * DM + c) = o;
  }
}

DEVINL void pool_ew_phase(const bfr* __restrict__ H, bfr* __restrict__ P, int bid, int nblk) {
  const int gt = bid * 256 + otid(), nt = nblk * 256;
  for (int i = gt; i < MTOK * 128; i += nt) {
    const int m = i >> 7, ch = i & 127, c = ch * 8;
    int tl, T; tok_pos(m, tl, T);
    const int hw = 1 << (ch >> 5);
    const int lo = max(tl - hw, 0), hi = min(tl + hw, T);
    float s[8];
#pragma unroll
    for (int j = 0; j < 8; ++j) s[j] = 0.f;
    const bfr* base = H + (size_t)(m - tl) * DM + c;
    for (int q = lo; q < hi; ++q) {
      const uint4 v = *(const uint4*)(base + (size_t)q * DM);
      s[0] += bflo(v.x); s[1] += bfhi(v.x); s[2] += bflo(v.y); s[3] += bfhi(v.y);
      s[4] += bflo(v.z); s[5] += bfhi(v.z); s[6] += bflo(v.w); s[7] += bfhi(v.w);
    }
    const float inv = 1.f / (float)(hi - lo);
    const uint4 v = *(const uint4*)(base + (size_t)tl * DM);
    uint4 o;
    o.x = pk2(s[0] * inv - bflo(v.x), s[1] * inv - bfhi(v.x));
    o.y = pk2(s[2] * inv - bflo(v.y), s[3] * inv - bfhi(v.y));
    o.z = pk2(s[4] * inv - bflo(v.z), s[5] * inv - bfhi(v.z));
    o.w = pk2(s[6] * inv - bflo(v.w), s[7] * inv - bfhi(v.w));
    *(uint4*)(P + (size_t)m * DM + c) = o;
  }
}

DEVINL void sgu_norm_phase(bfr* UV, const float* __restrict__ g, int bid, int nblk) {
  const int tid = otid(); const int lane = tid & 63;
  const int gw = bid * 4 + (tid >> 6), nw = nblk * 4;
  for (int row = gw; row < MTOK; row += nw) {
    bfr* vr = UV + (size_t)row * 2048 + 1024;
    float x[4][4];
    float ss = 0.f;
#pragma unroll
    for (int i = 0; i < 4; ++i) {
      const uint2 v = *(const uint2*)(vr + i * 256 + lane * 4);
      x[i][0] = bflo(v.x); x[i][1] = bfhi(v.x); x[i][2] = bflo(v.y); x[i][3] = bfhi(v.y);
      ss += x[i][0] * x[i][0] + x[i][1] * x[i][1] + x[i][2] * x[i][2] + x[i][3] * x[i][3];
    }
    ss = wave_sum(ss, lane);
    const float rstd = rsqrtf(ss * (1.f / DM) + EPS);
#pragma unroll
    for (int i = 0; i < 4; ++i) {
      const int c = i * 256 + lane * 4;
      const float4 gg = *(const float4*)(g + c);
      uint2 o;
      o.x = pk2(x[i][0] * rstd * gg.x, x[i][1] * rstd * gg.y);
      o.y = pk2(x[i][2] * rstd * gg.z, x[i][3] * rstd * gg.w);
      *(uint2*)(vr + c) = o;
    }
  }
}

DEVINL void sgu_spatial_phase(bfr* UV, const float* __restrict__ ws_, const float* __restrict__ bs_, char* smem, int bid, int nblk) {
  bfr* sV = (bfr*)smem;
  bfr* sW = sV + 128 * 136;
  const int tid = otid(), lane = tid & 63, wave = tid >> 6, l15 = lane & 15, quad = lane >> 4;
  for (int item = bid; item < 160 * 8; item += nblk) {
    const int chunk = item >> 3, g = item & 7;
    __syncthreads();
    const float* wg = ws_ + (size_t)g * 16384;
#pragma unroll 4
    for (int i = 0; i < 16; ++i) {
      const int idx = tid + 256 * i;
      const int row = idx >> 5, chn = idx & 31;
      const float4 v = *(const float4*)(wg + row * 128 + chn * 4);
      uint2 o; o.x = pk2(v.x, v.y); o.y = pk2(v.z, v.w);
      *(uint2*)(sW + row * 136 + chn * 4) = o;
    }
#pragma unroll 2
    for (int i = 0; i < 8; ++i) {
      const int idx = tid + 256 * i;
      const int q = idx >> 4, chn = idx & 15;
      const uint4 v = *(const uint4*)(UV + (size_t)(chunk * 128 + q) * 2048 + 1024 + g * 128 + chn * 8);
      bfr* d = sV + (chn * 8) * 136 + q;
      d[0 * 136] = (bfr)(v.x & 0xffff); d[1 * 136] = (bfr)(v.x >> 16);
      d[2 * 136] = (bfr)(v.y & 0xffff); d[3 * 136] = (bfr)(v.y >> 16);
      d[4 * 136] = (bfr)(v.z & 0xffff); d[5 * 136] = (bfr)(v.z >> 16);
      d[6 * 136] = (bfr)(v.w & 0xffff); d[7 * 136] = (bfr)(v.w >> 16);
    }
    __syncthreads();
    f32x4 acc[8][2];
#pragma unroll
    for (int i = 0; i < 8; ++i) { acc[i][0] = f32x4{0.f, 0.f, 0.f, 0.f}; acc[i][1] = f32x4{0.f, 0.f, 0.f, 0.f}; }
#pragma unroll
    for (int kk = 0; kk < 4; ++kk) {
      bf16x8 bw[2];
#pragma unroll
      for (int pt = 0; pt < 2; ++pt) bw[pt] = *(const bf16x8*)(sW + (wave * 32 + pt * 16 + l15) * 136 + kk * 32 + quad * 8);
#pragma unroll
      for (int ct = 0; ct < 8; ++ct) {
        const bf16x8 av = *(const bf16x8*)(sV + (ct * 16 + l15) * 136 + kk * 32 + quad * 8);
#pragma unroll
        for (int pt = 0; pt < 2; ++pt)
          acc[ct][pt] = __builtin_amdgcn_mfma_f32_16x16x32_bf16(av, bw[pt], acc[ct][pt], 0, 0, 0);
      }
    }
#pragma unroll
    for (int pt = 0; pt < 2; ++pt) {
      const int pp = wave * 32 + pt * 16 + l15;
      const float bias = bs_[g * 128 + pp];
      bfr* ur = UV + (size_t)(chunk * 128 + pp) * 2048 + g * 128 + quad * 4;
#pragma unroll
      for (int ct = 0; ct < 8; ++ct) {
        const uint2 u = *(const uint2*)(ur + ct * 16);
        uint2 o;
        o.x = pk2(bflo(u.x) * (acc[ct][pt][0] + bias), bfhi(u.x) * (acc[ct][pt][1] + bias));
        o.y = pk2(bflo(u.y) * (acc[ct][pt][2] + bias), bfhi(u.y) * (acc[ct][pt][3] + bias));
        *(uint2*)(ur + ct * 16) = o;
      }
    }
  }
}

DEVINL void hgrn_scan_phase(const Params& p, char* smem, int bid, int nblk, const int mode) {
  bfr* sQe = (bfr*)smem;
  bfr* sKe = sQe + 32 * 136;
  bfr* sKeT = sKe + 32 * 136;
  bfr* sVT = sKeT + 128 * 40;
  bfr* sP = sVT + 64 * 40;
  bfr* sST = sP + 32 * 40;
  float* sLast = (float*)(sST + 64 * 136);
  float* sTot = sLast + 128;
  const int tid = otid(), lane = tid & 63, wave = tid >> 6, l15 = lane & 15, quad = lane >> 4;
  const int cp = lane, qt = wave, i0 = qt * 8;
  const bfr* QZ = (const bfr*)(p.ws + OFF_BIG);
  bfr* Of = (bfr*)(p.ws + OFF_H);
  bfr* Ob = (bfr*)(p.ws + OFF_BIG + 209715200ull);
  const float* lbs = (const float*)(p.ws + OFF_LBS);
  const float* state_rec = p.in[2];
  float* out_state = p.out + (size_t)MTOK * DM;

  float* SLOC = (float*)(p.ws + OFF_BIG + 251658240ull);
  float* DLOC = (float*)(p.ws + OFF_BIG + 251658240ull + 33554432ull);
  const int nitems = mode ? 1536 : 896;
  for (int item = bid; item < nitems; item += nblk) {
    const int eh = item & 1, dir = (item >> 1) & 1, h = (item >> 2) & 7;
    int base, T, nchunks, pos0, slot, seq;
    bool is_prompt = false;
    if (!mode) {
      const int r = item >> 5, seqb = r / 7, j = r - seqb * 7;
      seq = 16 + seqb; base = NPROMPT + seqb * 4096; T = 4096; nchunks = 16; pos0 = j * 512;
      slot = ((seqb * 8 + j) * 8 + h) * 2 + dir;
    } else if (item < 1024) {
      const int r = item >> 5, seqb = r >> 3, j = r & 7;
      seq = 16 + seqb; base = NPROMPT + seqb * 4096; T = 4096; nchunks = 16; pos0 = j * 512;
      slot = ((seqb * 8 + j) * 8 + h) * 2 + dir;
    } else {
      seq = (item - 1024) >> 5; base = seq * 256; T = 256; nchunks = 8; pos0 = 0; slot = 0;
      is_prompt = true;
    }
    bfr* Od = dir ? Ob : Of;
    const float lbv0 = lbs[dir * 1024 + h * 128 + 2 * cp], lbv1 = lbs[dir * 1024 + h * 128 + 2 * cp + 1];
    const int eloc = wave * 16 + l15;
    const int eglob = eh * 64 + eloc;

    f32x4 S[8];
    if (is_prompt || !mode) {
#pragma unroll
      for (int dt = 0; dt < 8; ++dt) S[dt] = f32x4{0.f, 0.f, 0.f, 0.f};
    } else {
      const float* s0 = SLOC + (size_t)slot * 16384;
#pragma unroll
      for (int dt = 0; dt < 8; ++dt)
#pragma unroll
        for (int j = 0; j < 4; ++j) S[dt][j] = s0[(dt * 16 + quad * 4 + j) * 128 + eglob];
    }
    float cum0 = 1.f, cum1 = 1.f;
    __syncthreads();
#pragma unroll
    for (int dt = 0; dt < 8; ++dt) {
      uint2 o; o.x = pk2(S[dt][0], S[dt][1]); o.y = pk2(S[dt][2], S[dt][3]);
      *(uint2*)(sST + eloc * 136 + dt * 16 + quad * 4) = o;
    }

    const unsigned qoff2 = h * 64 + cp, zoff2 = (1 + dir) * 512 + h * 64 + cp;
    const unsigned voff2 = 1536 + h * 64 + eh * 32 + (cp & 31);
    const uint32_t* __restrict__ QZ32 = (const uint32_t*)QZ;
    uint32_t rq[8], rz[8], rv[8];
#pragma unroll
    for (int ii = 0; ii < 8; ++ii) {
      const int pos = pos0 + i0 + ii;
      const unsigned tok = dir ? base + T - 1 - pos : base + pos;
      const unsigned ri = tok * 2560u;
      rq[ii] = QZ32[ri + qoff2]; rz[ii] = QZ32[ri + zoff2]; rv[ii] = QZ32[ri + voff2];
    }

    for (int c = 0; c < nchunks; ++c) {
      float pc0[8], pc1[8], kv0[8], kv1[8];
      float run0 = 1.f, run1 = 1.f;
#pragma unroll
      for (int ii = 0; ii < 8; ++ii) {
        const float z0 = bflo(rz[ii]), z1 = bfhi(rz[ii]);
        const float f0 = lbv0 + (1.f - lbv0) * frcp(1.f + __expf(-z0));
        const float f1 = lbv1 + (1.f - lbv1) * frcp(1.f + __expf(-z1));
        run0 *= f0; run1 *= f1;
        pc0[ii] = run0; pc1[ii] = run1;
        kv0[ii] = 1.f - f0; kv1[ii] = 1.f - f1;
      }
      *(float2*)(sTot + qt * 128 + 2 * cp) = make_float2(run0, run1);
      __syncthreads();
      {
        float off0 = 1.f, off1 = 1.f, tot0 = 1.f, tot1 = 1.f;
#pragma unroll
        for (int q = 0; q < 4; ++q) {
          const float2 t = *(const float2*)(sTot + q * 128 + 2 * cp);
          if (q < qt) { off0 *= t.x; off1 *= t.y; }
          tot0 *= t.x; tot1 *= t.y;
        }
        uint32_t wk0[4], wk1[4], wv0[4], wv1[4];
#pragma unroll
        for (int ii = 0; ii < 8; ii += 2) {
          uint32_t kp[2];
#pragma unroll
          for (int u = 0; u < 2; ++u) {
            const float e0 = pc0[ii + u] * off0, e1 = pc1[ii + u] * off1;
            kp[u] = pk2(kv0[ii + u] * frcp(e0), kv1[ii + u] * frcp(e1));
            *(uint32_t*)(sKe + (i0 + ii + u) * 136 + 2 * cp) = kp[u];
            if (mode) *(uint32_t*)(sQe + (i0 + ii + u) * 136 + 2 * cp) = pk2(bflo(rq[ii + u]) * e0, bfhi(rq[ii + u]) * e1);
          }
          wk0[ii >> 1] = (kp[0] & 0xffffu) | (kp[1] << 16);
          wk1[ii >> 1] = (kp[0] >> 16) | (kp[1] & 0xffff0000u);
          wv0[ii >> 1] = (rv[ii] & 0xffffu) | (rv[ii + 1] << 16);
          wv1[ii >> 1] = (rv[ii] >> 16) | (rv[ii + 1] & 0xffff0000u);
        }
        *(u32x4*)(sKeT + (2 * cp) * 40 + i0) = u32x4{wk0[0], wk0[1], wk0[2], wk0[3]};
        *(u32x4*)(sKeT + (2 * cp + 1) * 40 + i0) = u32x4{wk1[0], wk1[1], wk1[2], wk1[3]};
        if (cp < 32) {
          *(u32x4*)(sVT + (2 * cp) * 40 + i0) = u32x4{wv0[0], wv0[1], wv0[2], wv0[3]};
          *(u32x4*)(sVT + (2 * cp + 1) * 40 + i0) = u32x4{wv1[0], wv1[1], wv1[2], wv1[3]};
        }
        if (qt == 0) *(float2*)(sLast + 2 * cp) = make_float2(tot0, tot1);
        cum0 *= tot0; cum1 *= tot1;
      }
      if (c + 1 < nchunks) {
#pragma unroll
        for (int ii = 0; ii < 8; ++ii) {
          const int pos = pos0 + (c + 1) * 32 + i0 + ii;
          const unsigned tok = dir ? base + T - 1 - pos : base + pos;
          const unsigned ri = tok * 2560u;
          rq[ii] = QZ32[ri + qoff2]; rz[ii] = QZ32[ri + zoff2]; rv[ii] = QZ32[ri + voff2];
        }
      }
      __syncthreads();
      if (mode) {
        const int ti = wave >> 1, si = wave & 1;
        f32x4 sc = f32x4{0.f, 0.f, 0.f, 0.f};
        if (si <= ti) {
#pragma unroll
          for (int kk = 0; kk < 4; ++kk) {
            const bf16x8 a = *(const bf16x8*)(sQe + (ti * 16 + l15) * 136 + kk * 32 + quad * 8);
            const bf16x8 b = *(const bf16x8*)(sKe + (si * 16 + l15) * 136 + kk * 32 + quad * 8);
            sc = __builtin_amdgcn_mfma_f32_16x16x32_bf16(a, b, sc, 0, 0, 0);
          }
        }
#pragma unroll
        for (int j = 0; j < 4; ++j) {
          const int t = ti * 16 + quad * 4 + j, s2 = si * 16 + l15;
          sP[t * 40 + s2] = (s2 <= t) ? f2bf(sc[j]) : (bfr)0;
        }
      }
      f32x4 oacc[2];
      oacc[0] = f32x4{0.f, 0.f, 0.f, 0.f}; oacc[1] = f32x4{0.f, 0.f, 0.f, 0.f};
      if (mode) {
#pragma unroll
      for (int kk = 0; kk < 4; ++kk) {
        const bf16x8 sb = *(const bf16x8*)(sST + eloc * 136 + kk * 32 + quad * 8);
#pragma unroll
        for (int tt = 0; tt < 2; ++tt) {
          const bf16x8 qa = *(const bf16x8*)(sQe + (tt * 16 + l15) * 136 + kk * 32 + quad * 8);
          oacc[tt] = __builtin_amdgcn_mfma_f32_16x16x32_bf16(sb, qa, oacc[tt], 0, 0, 0);
        }
      }
      }
      __syncthreads();
      {
        const bf16x8 vb = *(const bf16x8*)(sVT + eloc * 40 + quad * 8);
        if (mode) {
#pragma unroll
        for (int tt = 0; tt < 2; ++tt) {
          const bf16x8 pb = *(const bf16x8*)(sP + (tt * 16 + l15) * 40 + quad * 8);
          oacc[tt] = __builtin_amdgcn_mfma_f32_16x16x32_bf16(vb, pb, oacc[tt], 0, 0, 0);
          const int pos = pos0 + c * 32 + tt * 16 + l15;
          const int tok = dir ? base + T - 1 - pos : base + pos;
          uint2 o; o.x = pk2(oacc[tt][0], oacc[tt][1]); o.y = pk2(oacc[tt][2], oacc[tt][3]);
          *(uint2*)(Od + (size_t)tok * DM + h * 128 + eh * 64 + wave * 16 + quad * 4) = o;
        }
        }
#pragma unroll
        for (int dt = 0; dt < 8; ++dt) {
          const bf16x8 ka = *(const bf16x8*)(sKeT + (dt * 16 + l15) * 40 + quad * 8);
          const float4 dl = *(const float4*)(sLast + dt * 16 + quad * 4);
          f32x4 sn = __builtin_amdgcn_mfma_f32_16x16x32_bf16(ka, vb, S[dt], 0, 0, 0);
          sn[0] *= dl.x; sn[1] *= dl.y; sn[2] *= dl.z; sn[3] *= dl.w;
          S[dt] = sn;
          uint2 o; o.x = pk2(sn[0], sn[1]); o.y = pk2(sn[2], sn[3]);
          *(uint2*)(sST + eloc * 136 + dt * 16 + quad * 4) = o;
        }
      }
    }
    if (is_prompt || !mode) {
      float* so = is_prompt ? out_state + ((size_t)(seq * 2 + dir) * 8 + h) * 16384 : SLOC + (size_t)slot * 16384;
#pragma unroll
      for (int dt = 0; dt < 8; ++dt)
#pragma unroll
        for (int j = 0; j < 4; ++j) so[(dt * 16 + quad * 4 + j) * 128 + eglob] = S[dt][j];
      if (!mode && eh == 0 && qt == 0) *(float2*)(DLOC + slot * 128 + 2 * cp) = make_float2(cum0, cum1);
    }
  }
}

DEVINL void hgrn_combine_phase(const Params& p, int bid, int nblk) {
  const int gt = bid * 256 + otid(), nt = nblk * 256;
  float* SLOC = (float*)(p.ws + OFF_BIG + 251658240ull);
  const float* DLOC = (const float*)(p.ws + OFF_BIG + 251658240ull + 33554432ull);
  const float* state_rec = p.in[2];
  for (int idx = gt; idx < 4 * 8 * 2 * 16384; idx += nt) {
    const int de = idx & 16383, r = idx >> 14;
    const int dir = r & 1, h = (r >> 1) & 7, seqb = r >> 4;
    const int d = de >> 7;
    float prev = state_rec[((size_t)(seqb * 2 + dir) * 8 + h) * 16384 + de];
#pragma unroll
    for (int j = 0; j < 8; ++j) {
      const int slot = ((seqb * 8 + j) * 8 + h) * 2 + dir;
      float* ptr = SLOC + (size_t)slot * 16384 + de;
      const float a = (j < 7) ? *ptr : 0.f;
      *ptr = prev;
      if (j < 7) prev = DLOC[slot * 128 + d] * prev + a;
    }
  }
}

DEVINL void hgrn_gate_phase(const Params& p, const float* __restrict__ ng, int bid, int nblk) {
  const int tid = otid(); const int lane = tid & 63;
  const int gw = bid * 4 + (tid >> 6), nw = nblk * 4;
  bfr* Of = (bfr*)(p.ws + OFF_H);
  const bfr* Ob = (const bfr*)(p.ws + OFF_BIG + 209715200ull);
  const bfr* QZ = (const bfr*)(p.ws + OFF_BIG);
  for (int row = gw; row < MTOK; row += nw) {
#pragma unroll
    for (int seg = 0; seg < 4; ++seg) {
      const int c = seg * 256 + lane * 4;
      const uint2 a = *(const uint2*)(Of + (size_t)row * DM + c);
      const uint2 b = *(const uint2*)(Ob + (size_t)row * DM + c);
      const uint2 gq = *(const uint2*)(QZ + (size_t)row * 5120 + 4096 + c);
      const float o0 = bflo(a.x) + bflo(b.x), o1 = bfhi(a.x) + bfhi(b.x), o2 = bflo(a.y) + bflo(b.y), o3 = bfhi(a.y) + bfhi(b.y);
      float ss = o0 * o0 + o1 * o1 + o2 * o2 + o3 * o3;
#pragma unroll
      for (int o = 16; o > 0; o >>= 1) ss += shx(ss, o, lane);
      const float rstd = rsqrtf(ss * (1.f / 128.f) + EPS);
      const float4 gg = *(const float4*)(ng + c);
      uint2 o;
      o.x = pk2(o0 * rstd * gg.x * silu_f(bflo(gq.x)), o1 * rstd * gg.y * silu_f(bfhi(gq.x)));
      o.y = pk2(o2 * rstd * gg.z * silu_f(bflo(gq.y)), o3 * rstd * gg.w * silu_f(bfhi(gq.y)));
      *(uint2*)(Of + (size_t)row * DM + c) = o;
    }
  }
}

DEVINL void ffn_act_phase(const bfr* __restrict__ UP, const float* __restrict__ wdw, int hf, bfr* __restrict__ ACT, int bid, int nblk) {
  const int gt = bid * 256 + otid(), nt = nblk * 256;
  for (int i = gt; i < MTOK * 176; i += nt) {
    const int m = i / 176, j = (i - m * 176) * 8;
    int tl, T; tok_pos(m, tl, T);
    const bfr* ur = UP + (size_t)m * DFF;
    float a[8], b[8];
#pragma unroll
    for (int q = 0; q < 8; ++q) { a[q] = 0.f; b[q] = 0.f; }
#pragma unroll
    for (int tap = 0; tap < 3; ++tap) {
      const int d = tap - 1;
      if ((d < 0 && tl == 0) || (d > 0 && tl == T - 1)) continue;
      const bfr* nr = ur + (ptrdiff_t)d * DFF;
      const uint4 av = *(const uint4*)(nr + j);
      const uint4 bv = *(const uint4*)(nr + HALF_FF + j);
      const float* wa = wdw + tap * (2 * DFF) + hf * HALF_FF + j;
      const float* wb = wdw + tap * (2 * DFF) + DFF + hf * HALF_FF + j;
      const float4 wa0 = *(const float4*)wa, wa1 = *(const float4*)(wa + 4);
      const float4 wb0 = *(const float4*)wb, wb1 = *(const float4*)(wb + 4);
      a[0] += wa0.x * bflo(av.x); a[1] += wa0.y * bfhi(av.x); a[2] += wa0.z * bflo(av.y); a[3] += wa0.w * bfhi(av.y);
      a[4] += wa1.x * bflo(av.z); a[5] += wa1.y * bfhi(av.z); a[6] += wa1.z * bflo(av.w); a[7] += wa1.w * bfhi(av.w);
      b[0] += wb0.x * bflo(bv.x); b[1] += wb0.y * bfhi(bv.x); b[2] += wb0.z * bflo(bv.y); b[3] += wb0.w * bfhi(bv.y);
      b[4] += wb1.x * bflo(bv.z); b[5] += wb1.y * bfhi(bv.z); b[6] += wb1.z * bflo(bv.w); b[7] += wb1.w * bfhi(bv.w);
    }
    uint4 o;
    o.x = pk2(silu_f(a[0]) * b[0], silu_f(a[1]) * b[1]);
    o.y = pk2(silu_f(a[2]) * b[2], silu_f(a[3]) * b[3]);
    o.z = pk2(silu_f(a[4]) * b[4], silu_f(a[5]) * b[5]);
    o.w = pk2(silu_f(a[6]) * b[6], silu_f(a[7]) * b[7]);
    *(uint4*)(ACT + (size_t)m * DFF + hf * HALF_FF + j) = o;
  }
}


#define XB_TMO      128
#define XB_XCNT(j)  (256  + 64 * (j))
#define XB_XSUB(j)  (1280 + 64 * (j))
#define XB_XGEN(j)  (2304 + 64 * (j))
#define XB_TOP      3328
#define XB_TOPGEN   3392
#define XCD_BAR_WORDS 3456
#define XB_SPIN_CAP (1u << 22)
#define LAS __attribute__((address_space(3)))
DEVINL unsigned xb_ld(unsigned* p) { return __hip_atomic_load(p, __ATOMIC_RELAXED, __HIP_MEMORY_SCOPE_AGENT); }
DEVINL unsigned xb_add(unsigned* p, unsigned v) { return __hip_atomic_fetch_add(p, v, __ATOMIC_RELAXED, __HIP_MEMORY_SCOPE_AGENT); }
DEVINL unsigned xb_xcc_id() { return (unsigned)__builtin_amdgcn_s_getreg((3 << 11) | 20) & 0xFu; }
#define XB_SPIN(cond, bar) do { unsigned _sp = 0; while (cond) { __builtin_amdgcn_s_sleep(1); \
    if ((++_sp & 255u) == 0u) { if (xb_ld(&(bar)[XB_TMO])) break; if (_sp > XB_SPIN_CAP) { atomicAdd(&(bar)[XB_TMO], 1u); break; } } } } while (0)
struct XcdBarrier { unsigned* bar; unsigned x; volatile LAS unsigned* st; };
DEVINL XcdBarrier xcd_barrier_post(unsigned* bar, volatile LAS unsigned* st) {
  XcdBarrier b; b.bar = bar; b.x = xb_xcc_id(); b.st = st;
  if (threadIdx.x == 0) (void)xb_add(&bar[XB_XCNT(b.x)], 1u);
  return b;
}
DEVINL void xcd_barrier_complete(unsigned* bar, unsigned x, unsigned& nloc, unsigned& nx) {
  const unsigned G = gridDim.x * gridDim.y * gridDim.z;
  unsigned sum, cnt, mine, sp = 0u;
  for (;;) {
    sum = 0u; cnt = 0u; mine = 0u;
#pragma unroll
    for (unsigned j = 0; j < 16; ++j) { const unsigned c = xb_ld(&bar[XB_XCNT(j)]); sum += c; cnt += (c > 0u) ? 1u : 0u; mine = (j == x) ? c : mine; }
    if (sum == G) break;
    __builtin_amdgcn_s_sleep(1);
    if ((++sp & 255u) == 0u) { if (xb_ld(&bar[XB_TMO])) break; if (sp > XB_SPIN_CAP) { atomicAdd(&bar[XB_TMO], 1u); break; } }
  }
  nloc = mine > 0u ? mine : 1u; nx = cnt > 0u ? cnt : 1u;
}
DEVINL void xcd_barrier(const XcdBarrier& b) {
  asm volatile("s_waitcnt vmcnt(0)" ::: "memory");
  __syncthreads();
  if (threadIdx.x == 0) {
    unsigned* bar = b.bar;
    unsigned bx = b.x;
    asm volatile("" : "+s"(bar), "+s"(bx));
    __builtin_amdgcn_s_waitcnt(0);
    unsigned nloc = b.st[0], nx = b.st[1];
    if (nloc == 0u) { xcd_barrier_complete(bar, bx, nloc, nx); b.st[0] = nloc; b.st[1] = nx; }
    const unsigned old = xb_add(&bar[XB_XSUB(bx)], 1u);
    const unsigned gen = old / nloc;
    if (old + 1u == (gen + 1u) * nloc) {
      __builtin_amdgcn_fence(__ATOMIC_RELEASE, "agent");
      asm volatile("s_waitcnt vmcnt(0)" ::: "memory");
      const unsigned og = xb_add(&bar[XB_TOP], 1u);
      const unsigned tg = og / nx;
      if (og + 1u == (tg + 1u) * nx) xb_add(&bar[XB_TOPGEN], 1u);
      else XB_SPIN(xb_ld(&bar[XB_TOPGEN]) == tg, bar);
      __builtin_amdgcn_fence(__ATOMIC_ACQUIRE, "agent");
      xb_add(&bar[XB_XGEN(bx)], 1u);
      asm volatile("s_waitcnt vmcnt(0)" ::: "memory");
    } else {
      XB_SPIN(xb_ld(&bar[XB_XGEN(bx)]) == gen, bar);
      __builtin_amdgcn_fence(__ATOMIC_ACQUIRE, "agent");
      asm volatile("s_waitcnt vmcnt(0)" ::: "memory");
    }
  }
  __syncthreads();
}

constexpr int SMEM_BYTES = 77824;

__global__ void __launch_bounds__(256, 2) mega_kernel(Params p) {
  __shared__ __attribute__((aligned(16))) char smem[SMEM_BYTES];
  cg::grid_group grid = cg::this_grid();
  __shared__ uint4 xb_words;
  if (threadIdx.x == 0) xb_words = make_uint4(0u, 0u, 0u, 0u);
  __syncthreads();
  XcdBarrier xb = xcd_barrier_post((unsigned*)(p.ws + OFF_BAR), (volatile LAS unsigned*)&xb_words);
  const int bid = blockIdx.x, nblk = gridDim.x;

  phase0a(p, smem, osg(bid), nblk);
  grid.sync();
  phase0b(p, osg(bid), nblk);
  xcd_barrier(xb);

  for (int layer = 0; layer < 4; ++layer) {
    Params q = p;
    {
      size_t oz = 0;
      asm volatile("" : "+s"(oz));
      q.ws = p.ws + oz;
      q.out = p.out + oz;
    }
    float* X = q.out;
    bfr* WB = (bfr*)(q.ws + OFF_WB);
    bfr* H = (bfr*)(q.ws + OFF_H);
    bfr* BIG = (bfr*)(q.ws + OFF_BIG);
    const float* MOD = (const float*)(q.ws + OFF_MOD);
    const float* modl = MOD + layer * 30720;
    if (layer == 0) {
      conv_matrix(q.in[9], 1024, 3072, WB + WB_IN, 0, smem, osg(bid), nblk);
      conv_matrix(q.in[11], 1024, 1024, WB + WB_OUT, 0, smem, osg(bid), nblk);
    } else if (layer == 1) {
      for (int g = 0; g < 4; ++g) conv_matrix(q.in[12] + g * 65536, 256, 256, WB + WB_IN + g * 65536, 0, smem, osg(bid), nblk);
    } else if (layer == 2) {
      conv_matrix(q.in[14], 1024, 2048, WB + WB_IN, 0, smem, osg(bid), nblk);
      conv_matrix(q.in[18], 1024, 1024, WB + WB_OUT, 0, smem, osg(bid), nblk);
    } else {
      conv_matrix(q.in[19], 1024, 5120, WB + WB_IN, 0, smem, osg(bid), nblk);
      conv_matrix(q.in[22], 1024, 1024, WB + WB_OUT, 0, smem, osg(bid), nblk);
    }
    conv_matrix(q.in[23] + (size_t)layer * 1024 * 5632, 1024, 5632, WB + WB_UP, 1, smem, osg(bid), nblk);
    conv_matrix(q.in[25] + (size_t)layer * DFF * 1024, DFF, 1024, WB + WB_DOWN, 0, smem, osg(bid), nblk);
    norm_phase(X, q.in[7] + (layer * 2 + 0) * DM, modl, 0, 1024, H, osg(bid), nblk);
    xcd_barrier(xb);

    if (layer == 0) {
      bfr* G = BIG;
      bfr* U = BIG + (size_t)MTOK * 3072;
      gemm256_phase(H, DM, WB + WB_IN, 1024, 3072, 1024, EpiStore{G, 3072}, smem, osg(bid), nblk);
      xcd_barrier(xb);
      shortconv_ew_phase(G, q.in[10], U, osg(bid), nblk);
      xcd_barrier(xb);
      gemm_phase(U, DM, WB + WB_OUT, 1024, 1024, 1024, EpiResid{X, modl + 2048, nullptr, 0}, smem, osg(bid), nblk);
      xcd_barrier(xb);
    } else if (layer == 1) {
      bfr* P = BIG;
      pool_ew_phase(H, P, osg(bid), nblk);
      xcd_barrier(xb);
      for (int g = 0; g < 4; ++g)
        gemm_phase(P + g * 256, DM, WB + WB_IN + g * 65536, 256, 256, 256,
                   EpiResid{X, modl + 2048 + g * 256, q.in[13] + g * 256, g * 256}, smem, osg(bid), nblk);
      xcd_barrier(xb);
    } else if (layer == 2) {
      bfr* UV = BIG;
      gemm_phase(H, DM, WB + WB_IN, 1024, 2048, 1024, EpiGelu{UV, 2048}, smem, osg(bid), nblk);
      xcd_barrier(xb);
      sgu_norm_phase(UV, q.in[15], osg(bid), nblk);
      xcd_barrier(xb);
      sgu_spatial_phase(UV, q.in[16], q.in[17], smem, osg(bid), nblk);
      xcd_barrier(xb);
      gemm_phase(UV, 2048, WB + WB_OUT, 1024, 1024, 1024, EpiResid{X, modl + 2048, nullptr, 0}, smem, osg(bid), nblk);
      xcd_barrier(xb);
    } else {
      bfr* QZ = BIG;
      gemm256_phase(H, DM, WB + WB_IN, 1024, 5120, 1024, EpiStore{QZ, 5120}, smem, osg(bid), nblk);
      xcd_barrier(xb);
      hgrn_scan_phase(q, smem, osg(bid), nblk, 0);
      xcd_barrier(xb);
      hgrn_combine_phase(q, osg(bid), nblk);
      xcd_barrier(xb);
      hgrn_scan_phase(q, smem, osg(bid), nblk, 1);
      xcd_barrier(xb);
      hgrn_gate_phase(q, q.in[21], osg(bid), nblk);
      xcd_barrier(xb);
      gemm_phase(H, DM, WB + WB_OUT, 1024, 1024, 1024, EpiResid{X, modl + 2048, nullptr, 0}, smem, osg(bid), nblk);
      xcd_barrier(xb);
    }

    norm_phase(X, q.in[7] + (layer * 2 + 1) * DM, modl, 3072, 4096, H, osg(bid), nblk);
    xcd_barrier(xb);
    bfr* ACT = BIG;
    float* EDGE = (float*)(q.ws + OFF_BIG + 115343360ull);
    const float* wdw = q.in[24] + (size_t)layer * 3 * 2 * DFF;
    gemm256_phase(H, DM, WB + WB_UP, 1024, 2 * DFF, 1024, EpiFfnUp{ACT, EDGE, wdw}, smem, osg(bid), nblk);
    xcd_barrier(xb);
    ffn_edge_phase(EDGE, wdw, ACT, osg(bid), nblk);
    xcd_barrier(xb);
    gemm_phase(ACT, DFF, WB + WB_DOWN, DFF, 1024, DFF, EpiResid{X, modl + 5120, nullptr, 0}, smem, osg(bid), nblk);
    xcd_barrier(xb);
  }
  final_norm_phase(p.out, p.in[8], osg(bid), nblk);
}

extern "C" void kernel_launch(void* const* d_in, const int* in_sizes, int n_in, void* d_out, int out_size,
                              void* d_ws, size_t ws_size, hipStream_t stream) {
  static int grid_blocks = 0;
  if (!grid_blocks) {
    int dev = 0, cus = 0, per_cu = 0;
    hipGetDevice(&dev);
    hipDeviceGetAttribute(&cus, hipDeviceAttributeMultiprocessorCount, dev);
    hipOccupancyMaxActiveBlocksPerMultiprocessor(&per_cu, mega_kernel, 256, 0);
    if (per_cu > 2) per_cu = 2;
    if (per_cu < 1) per_cu = 1;
    grid_blocks = cus * per_cu;
  }
  if (ws_size < WS_NEED) { fprintf(stderr, "workspace too small: %zu < %zu\n", ws_size, (size_t)WS_NEED); return; }
  Params p{};
  for (int i = 0; i < 26; ++i) p.in[i] = (const float*)d_in[i];
  p.out = (float*)d_out;
  p.ws = (char*)d_ws;
  hipMemsetAsync((char*)d_ws + OFF_BAR, 0, XCD_BAR_WORDS * 4, stream);
  void* args[] = {&p};
  hipError_t e = hipLaunchCooperativeKernel((void*)mega_kernel, dim3(grid_blocks), dim3(256), args, 0, stream);
  if (e != hipSuccess) fprintf(stderr, "cooperative launch failed: %s (grid %d)\n", hipGetErrorString(e), grid_blocks);
}
```

```cpp
#include <hip/hip_runtime.h>
#include <hip/hip_cooperative_groups.h>
#include <stdint.h>
#include <stdio.h>
namespace cg = cooperative_groups;

#define DEVINL __device__ __forceinline__
typedef unsigned short bfr;
using bf16x8 = __attribute__((ext_vector_type(8))) short;
using f32x4 = __attribute__((ext_vector_type(4))) float;
using u32x4 = __attribute__((ext_vector_type(4))) unsigned int;

constexpr int DM = 1024;
constexpr int MTOK = 20480;
constexpr int NPROMPT = 4096;
constexpr int DFF = 2816;
constexpr int HALF_FF = 1408;
constexpr float EPS = 1e-6f;

constexpr size_t OFF_MODP = 0;
constexpr size_t OFF_MOD = 7864320;
constexpr size_t OFF_LBS = OFF_MOD + 491520;
constexpr size_t OFF_BAR = OFF_LBS + 8192;
constexpr size_t OFF_WB = 8388608;
constexpr size_t OFF_H = 41943040;
constexpr size_t OFF_BIG = 83886080;
constexpr size_t WS_NEED = OFF_BIG + 251658240ull + 33554432ull + 262144ull;
constexpr size_t WB_IN = 0, WB_OUT = 5242880, WB_UP = 6291456, WB_DOWN = 12058624;

struct Params {
  const float* in[26];
  float* out;
  char* ws;
};

DEVINL int otid() { int t = threadIdx.x; asm volatile("" : "+v"(t)); return t; }
DEVINL int osg(int x) { asm volatile("" : "+s"(x)); return x; }
typedef __bf16 hbf16x2 __attribute__((ext_vector_type(2)));
typedef float hf32x2 __attribute__((ext_vector_type(2)));
DEVINL uint32_t pk2(float a, float b) {
  hf32x2 v = {a, b};
  hbf16x2 r = __builtin_convertvector(v, hbf16x2);
  return __builtin_bit_cast(uint32_t, r);
}
DEVINL bfr f2bf(float f) { return (bfr)(pk2(f, 0.f) & 0xffffu); }
DEVINL float bf2f(bfr h) { return __uint_as_float(((uint32_t)h) << 16); }
DEVINL float frcp(float x) { return __builtin_amdgcn_rcpf(x); }
DEVINL float bflo(uint32_t u) { return __uint_as_float(u << 16); }
DEVINL float bfhi(uint32_t u) { return __uint_as_float(u & 0xffff0000u); }
DEVINL int cond_of(int m) { return m < NPROMPT ? 0 : 1 + ((m - NPROMPT) >> 12); }
DEVINL float silu_f(float x) { return x * frcp(1.f + __expf(-x)); }
DEVINL float gelu_tanh_f(float x) {
  float y = 0.7978845608028654f * (x + 0.044715f * x * x * x);
  float t = 1.f - 2.f * frcp(__expf(2.f * y) + 1.f);
  return 0.5f * x * (1.f + t);
}
DEVINL float shx(float v, int o, int lane) {
  return __int_as_float(__builtin_amdgcn_ds_bpermute((lane ^ o) << 2, __float_as_int(v)));
}
DEVINL float wave_sum(float v, int lane) {
#pragma unroll
  for (int o = 32; o > 0; o >>= 1) v += shx(v, o, lane);
  return v;
}

DEVINL void tok_pos(int m, int& tl, int& T) {
  if (m < NPROMPT) { tl = m & 255; T = 256; } else { tl = (m - NPROMPT) & 4095; T = 4096; }
}

struct EpiNoPre {};
#define EPI_ELEMENTWISE_TILE                                                                       \
  typedef EpiNoPre Pre;                                                                             \
  DEVINL Pre pre(int tn, int tid) const { return Pre{}; }                                           \
  DEVINL void tile(const f32x4 (&acc)[4][4], const Pre& pre_, int m0, int n0, int tn, int wm, int wn, int l15, \
                   int quad, int tid, char* smem) const {                                           \
    _Pragma("unroll") for (int mt = 0; mt < 4; ++mt)                                                \
      _Pragma("unroll") for (int nt = 0; nt < 4; ++nt)                                              \
        (*this)(m0 + wm * 64 + mt * 16 + l15, n0 + wn * 64 + nt * 16 + quad * 4, acc[mt][nt]);      \
  }
struct EpiStore {
  bfr* C; int ldc;
  DEVINL void tile256(const f32x4 (&acc)[8][4], const EpiNoPre& pre_, int m0, int n0, int tn, int wm, int wn, int l15,
                      int quad, int tid, char* smem) const {
#pragma unroll
    for (int mt = 0; mt < 8; ++mt)
#pragma unroll
      for (int nt = 0; nt < 4; ++nt)
        (*this)(m0 + wm * 128 + mt * 16 + l15, n0 + wn * 64 + nt * 16 + quad * 4, acc[mt][nt]);
  }
  DEVINL void operator()(int m, int n, f32x4 v) const {
    uint2 o; o.x = pk2(v[0], v[1]); o.y = pk2(v[2], v[3]);
    *(uint2*)(C + (size_t)m * ldc + n) = o;
  }
  EPI_ELEMENTWISE_TILE
};
struct EpiGelu {
  bfr* C; int ldc;
  DEVINL void operator()(int m, int n, f32x4 v) const {
    uint2 o; o.x = pk2(gelu_tanh_f(v[0]), gelu_tanh_f(v[1])); o.y = pk2(gelu_tanh_f(v[2]), gelu_tanh_f(v[3]));
    *(uint2*)(C + (size_t)m * ldc + n) = o;
  }
  EPI_ELEMENTWISE_TILE
};
struct EpiResid {
  float* X; const float* gate; const float* cscale; int coff;
  DEVINL void operator()(int m, int n, f32x4 v) const {
    const int cond = cond_of(m);
    const float4 g = *(const float4*)(gate + cond * 6144 + n);
    float4* xp = (float4*)(X + (size_t)m * DM + coff + n);
    float4 x = *xp;
    float s0 = 1.f, s1 = 1.f, s2 = 1.f, s3 = 1.f;
    if (cscale) { const float4 s = *(const float4*)(cscale + n); s0 = s.x; s1 = s.y; s2 = s.z; s3 = s.w; }
    x.x += g.x * v[0] * s0; x.y += g.y * v[1] * s1; x.z += g.z * v[2] * s2; x.w += g.w * v[3] * s3;
    *xp = x;
  }
  EPI_ELEMENTWISE_TILE
};

#define LDS3 __attribute__((address_space(3)))
DEVINL void lds_barrier() { asm volatile("s_waitcnt lgkmcnt(0)\n\ts_barrier" ::: "memory"); }
template <class Epi>
DEVINL void gemm_phase(const bfr* __restrict__ A, int lda, const bfr* __restrict__ Bt, int ldb, int N, int K,
                       const Epi& epi, char* smem, int bid, int nblk) {
  const int tid = otid(), lane = tid & 63, wave = tid >> 6;
  const int wm = wave >> 1, wn = wave & 1, l15 = lane & 15, quad = lane >> 4;
  const int tilesN = N >> 7;
  const int ntiles = (MTOK >> 7) * tilesN;
  const int nk = K >> 6;
  const int srow0 = wave * 8 + (lane >> 3);
  const int lc = (lane & 7) ^ ((srow0 >> 1) & 7);
  const int fsw = (l15 >> 1) & 7;
  char* const dst0 = smem + wave * 1024 + lane * 16;
#define TILE_DECODE(t_, tm_, tn_) { const int xcd_ = (t_) & 7, u_ = (t_) >> 3; const int ur_ = u_ / tilesN; tn_ = u_ - ur_ * tilesN; tm_ = ur_ * 8 + xcd_; }
#define GLDS_STAGE(pa_, pb_, st_, kt_)                                                                    \
  {                                                                                                       \
    _Pragma("unroll") for (int i = 0; i < 4; ++i) {                                                       \
      __builtin_amdgcn_global_load_lds((const unsigned*)((pa_) + (size_t)(i * 32) * lda + (kt_) * 64),    \
                                       (LDS3 unsigned*)(dst0 + (st_) * 32768 + i * 4096), 16, 0, 0);      \
      __builtin_amdgcn_global_load_lds((const unsigned*)((pb_) + (size_t)(i * 32) * ldb + (kt_) * 64),    \
                                       (LDS3 unsigned*)(dst0 + (st_) * 32768 + 16384 + i * 4096), 16, 0, 0); \
    }                                                                                                     \
  }
  int tile = bid;
  if (tile >= ntiles) return;
  int tm, tn;
  TILE_DECODE(tile, tm, tn)
  const bfr* gA = A + (size_t)((tm << 7) + srow0) * lda + lc * 8;
  const bfr* gB = Bt + (size_t)((tn << 7) + srow0) * ldb + lc * 8;
  __syncthreads();
  GLDS_STAGE(gA, gB, 0, 0)
  for (; tile < ntiles; tile += nblk) {
    const int m0 = tm << 7, n0 = tn << 7, tn_cur = tn;
    const bool has_next = (tile + nblk < ntiles);
    const bfr* gAn = gA; const bfr* gBn = gB;
    if (has_next) {
      TILE_DECODE(tile + nblk, tm, tn)
      gAn = A + (size_t)((tm << 7) + srow0) * lda + lc * 8;
      gBn = Bt + (size_t)((tn << 7) + srow0) * ldb + lc * 8;
    }
    typename Epi::Pre pre = epi.pre(tn_cur, tid);
    f32x4 acc[4][4];
#pragma unroll
    for (int i = 0; i < 4; ++i)
#pragma unroll
      for (int j = 0; j < 4; ++j) acc[i][j] = f32x4{0.f, 0.f, 0.f, 0.f};
    __syncthreads();
    for (int kt = 0; kt < nk; ++kt) {
      const int st = kt & 1;
      const bool cur = (kt + 1 < nk);
      const bool any = cur || has_next;
      const bfr* sa = cur ? gA + (kt + 1) * 64 : gAn;
      const bfr* sb = cur ? gB + (kt + 1) * 64 : gBn;
      char* sd = dst0 + (cur ? (st ^ 1) : 0) * 32768;
      const char* cA = smem + st * 32768 + (wm * 64 + l15) * 128;
      const char* cB = smem + st * 32768 + 16384 + (wn * 64 + l15) * 128;
      {
        const int co0 = (quad ^ fsw) * 16, co1 = ((4 + quad) ^ fsw) * 16;
        bf16x8 af0[4], bf0[4], af1[4], bf1[4];
#pragma unroll
        for (int i = 0; i < 4; ++i) {
          af0[i] = *(const bf16x8*)(cA + i * 2048 + co0);
          bf0[i] = *(const bf16x8*)(cB + i * 2048 + co0);
        }
#pragma unroll
        for (int i = 0; i < 4; ++i) {
          af1[i] = *(const bf16x8*)(cA + i * 2048 + co1);
          bf1[i] = *(const bf16x8*)(cB + i * 2048 + co1);
        }
        __builtin_amdgcn_sched_barrier(0);
#pragma unroll
        for (int mt = 0; mt < 4; ++mt) {
#pragma unroll
          for (int nt = 0; nt < 4; ++nt)
            acc[mt][nt] = __builtin_amdgcn_mfma_f32_16x16x32_bf16(bf0[nt], af0[mt], acc[mt][nt], 0, 0, 0);
          if (any) {
            __builtin_amdgcn_global_load_lds((const unsigned*)(sa + (size_t)(mt * 32) * lda), (LDS3 unsigned*)(sd + mt * 4096), 16, 0, 0);
            __builtin_amdgcn_global_load_lds((const unsigned*)(sb + (size_t)(mt * 32) * ldb), (LDS3 unsigned*)(sd + 16384 + mt * 4096), 16, 0, 0);
          }
          __builtin_amdgcn_sched_barrier(0);
        }
#pragma unroll
        for (int mt = 0; mt < 4; ++mt)
#pragma unroll
          for (int nt = 0; nt < 4; ++nt)
            acc[mt][nt] = __builtin_amdgcn_mfma_f32_16x16x32_bf16(bf1[nt], af1[mt], acc[mt][nt], 0, 0, 0);
        __builtin_amdgcn_sched_barrier(0);
      }
      if (kt + 1 < nk) __syncthreads();
    }
    epi.tile(acc, pre, m0, n0, tn_cur, wm, wn, l15, quad, tid, smem);
    gA = gAn; gB = gBn;
  }
}

constexpr int EDGE_LD = 2 * DFF;
struct FfnPre { f32x4 wa[3], wb[3]; };
DEVINL void ffn_conv_rows(const bfr* T, const FfnPre& pre_, bfr* ACT, float* EDGE, int m0, int n0, int tn, int tid) {
  const int c4 = (tid & 15) * 4, r0 = (tid >> 4) * 8;
  const int ja = tn * 64 + c4;
  int tl, Tlen; tok_pos(m0, tl, Tlen);
  const bool top_ok = (tl == 0), bot_ok = (tl + 128 == Tlen);
  if (tid < 128) {
    const int e = tid >> 5, c = (tid & 31) * 4;
    const int r = (e < 2) ? e : 124 + e;
    const uint2 v = *(const uint2*)(T + r * 136 + c);
    *(f32x4*)(EDGE + ((size_t)(m0 >> 7) * 4 + e) * EDGE_LD + n0 + c) = f32x4{bflo(v.x), bfhi(v.x), bflo(v.y), bfhi(v.y)};
  }
  const f32x4 zero = f32x4{0.f, 0.f, 0.f, 0.f};
#define LDT(dst, row, col) { const uint2 v_ = *(const uint2*)(T + (row) * 136 + (col)); dst = f32x4{bflo(v_.x), bfhi(v_.x), bflo(v_.y), bfhi(v_.y)}; }
  f32x4 pa = zero, pb = zero, ca, cb, na, nb;
  if (r0 > 0) { LDT(pa, r0 - 1, c4) LDT(pb, r0 - 1, 64 + c4) }
  LDT(ca, r0, c4) LDT(cb, r0, 64 + c4)
#pragma unroll
  for (int i = 0; i < 8; ++i) {
    const int r = r0 + i;
    if (r < 127) { LDT(na, r + 1, c4) LDT(nb, r + 1, 64 + c4) }
    else { na = zero; nb = zero; }
    const bool ok = (r > 0 || top_ok) && (r < 127 || bot_ok);
    if (ok) {
      const f32x4 a = pre_.wa[0] * pa + pre_.wa[1] * ca + pre_.wa[2] * na;
      const f32x4 b = pre_.wb[0] * pb + pre_.wb[1] * cb + pre_.wb[2] * nb;
      uint2 o;
      o.x = pk2(silu_f(a[0]) * b[0], silu_f(a[1]) * b[1]);
      o.y = pk2(silu_f(a[2]) * b[2], silu_f(a[3]) * b[3]);
      *(uint2*)(ACT + (size_t)(m0 + r) * DFF + ja) = o;
    }
    pa = ca; pb = cb; ca = na; cb = nb;
  }
#undef LDT
}
struct EpiFfnUp {
  bfr* ACT; float* EDGE; const float* wdw;
  typedef FfnPre Pre;
  DEVINL Pre pre(int tn, int tid) const {
    Pre q;
    const int ja = tn * 64 + (tid & 15) * 4;
#pragma unroll
    for (int t = 0; t < 3; ++t) {
      q.wa[t] = *(const f32x4*)(wdw + t * (2 * DFF) + ja);
      q.wb[t] = *(const f32x4*)(wdw + t * (2 * DFF) + DFF + ja);
    }
    return q;
  }
  DEVINL void tile(const f32x4 (&acc)[4][4], const Pre& pre_, int m0, int n0, int tn, int wm, int wn, int l15, int quad,
                   int tid, char* smem) const {
    bfr* T = (bfr*)(smem + 32768);
    lds_barrier();
#pragma unroll
    for (int mt = 0; mt < 4; ++mt)
#pragma unroll
      for (int nt = 0; nt < 4; ++nt) {
        uint2 o; o.x = pk2(acc[mt][nt][0], acc[mt][nt][1]); o.y = pk2(acc[mt][nt][2], acc[mt][nt][3]);
        *(uint2*)(T + (wm * 64 + mt * 16 + l15) * 136 + wn * 64 + nt * 16 + quad * 4) = o;
      }
    lds_barrier();
    ffn_conv_rows(T, pre_, ACT, EDGE, m0, n0, tn, tid);
  }
  DEVINL void tile256(const f32x4 (&acc)[8][4], const Pre& pre_, int m0, int n0, int tn, int wm, int wn, int l15, int quad,
                      int tid, char* smem) const {
    bfr* T = (bfr*)(smem + 24576);
#pragma unroll
    for (int hh = 0; hh < 2; ++hh) {
      lds_barrier();
      if (wm == hh) {
#pragma unroll
        for (int mt = 0; mt < 8; ++mt)
#pragma unroll
          for (int nt = 0; nt < 4; ++nt) {
            uint2 o; o.x = pk2(acc[mt][nt][0], acc[mt][nt][1]); o.y = pk2(acc[mt][nt][2], acc[mt][nt][3]);
            *(uint2*)(T + (mt * 16 + l15) * 136 + wn * 64 + nt * 16 + quad * 4) = o;
          }
      }
      lds_barrier();
      ffn_conv_rows(T, pre_, ACT, EDGE, m0 + hh * 128, n0, tn, tid);
    }
  }
};


template <class Epi>
DEVINL void gemm256_phase(const bfr* __restrict__ A, int lda, const bfr* __restrict__ Bt, int ldb, int N, int K,
                          const Epi& epi, char* smem, int bid, int nblk) {
  const int tid = otid(), lane = tid & 63, wave = tid >> 6;
  const int wm = wave >> 1, wn = wave & 1, l15 = lane & 15, quad = lane >> 4;
  const int tilesN = N >> 7;
  const int ntiles = (MTOK >> 8) * tilesN;
  const int nk = K >> 5;
  const int srow0 = wave * 16 + (lane >> 2);
  const int lc = (lane & 3) ^ ((0 - (lane >> 4)) & 3);
  const int fsw = (0 - (l15 >> 2)) & 3;
  char* const dst0 = smem + wave * 1024 + lane * 16;
#define TILE_DECODE2(t_, tm_, tn_) { const int xcd_ = (t_) & 7, u_ = (t_) >> 3; const int ur_ = u_ / tilesN; tn_ = u_ - ur_ * tilesN; tm_ = ur_ * 8 + xcd_; }
#define GLDS_STAGE2(pa_, pb_, st_, kt_)                                                                   \
  {                                                                                                       \
    _Pragma("unroll") for (int i = 0; i < 4; ++i)                                                         \
      __builtin_amdgcn_global_load_lds((const unsigned*)((pa_) + (size_t)(i * 64) * lda + (kt_) * 32),    \
                                       (LDS3 unsigned*)(dst0 + (st_) * 24576 + i * 4096), 16, 0, 0);      \
    _Pragma("unroll") for (int i = 0; i < 2; ++i)                                                         \
      __builtin_amdgcn_global_load_lds((const unsigned*)((pb_) + (size_t)(i * 64) * ldb + (kt_) * 32),    \
                                       (LDS3 unsigned*)(dst0 + (st_) * 24576 + 16384 + i * 4096), 16, 0, 0); \
  }
  int tile = bid;
  if (tile >= ntiles) return;
  int tm, tn;
  TILE_DECODE2(tile, tm, tn)
  const bfr* gA = A + (size_t)((tm << 8) + srow0) * lda + lc * 8;
  const bfr* gB = Bt + (size_t)((tn << 7) + srow0) * ldb + lc * 8;
  __syncthreads();
  GLDS_STAGE2(gA, gB, 0, 0)
  for (; tile < ntiles; tile += nblk) {
    const int m0 = tm << 8, n0 = tn << 7, tn_cur = tn;
    const bool has_next = (tile + nblk < ntiles);
    const bfr* gAn = gA; const bfr* gBn = gB;
    if (has_next) {
      TILE_DECODE2(tile + nblk, tm, tn)
      gAn = A + (size_t)((tm << 8) + srow0) * lda + lc * 8;
      gBn = Bt + (size_t)((tn << 7) + srow0) * ldb + lc * 8;
    }
    f32x4 acc[8][4];
#pragma unroll
    for (int i = 0; i < 8; ++i)
#pragma unroll
      for (int j = 0; j < 4; ++j) acc[i][j] = f32x4{0.f, 0.f, 0.f, 0.f};
    __syncthreads();
    for (int kt = 0; kt < nk; ++kt) {
      const int st = kt & 1;
      const bool cur = (kt + 1 < nk);
      const bool any = cur || has_next;
      const bfr* sa = cur ? gA + (kt + 1) * 32 : gAn;
      const bfr* sb = cur ? gB + (kt + 1) * 32 : gBn;
      char* sd = dst0 + (cur ? (st ^ 1) : 0) * 24576;
      const char* cA = smem + st * 24576 + (wm * 128 + l15) * 64 + ((quad ^ fsw) * 16);
      const char* cB = smem + st * 24576 + 16384 + (wn * 64 + l15) * 64 + ((quad ^ fsw) * 16);
      bf16x8 bfg[4];
#pragma unroll
      for (int i = 0; i < 4; ++i) bfg[i] = *(const bf16x8*)(cB + i * 1024);
#pragma unroll
      for (int hm = 0; hm < 2; ++hm) {
        bf16x8 af[4];
#pragma unroll
        for (int i = 0; i < 4; ++i) af[i] = *(const bf16x8*)(cA + (hm * 4 + i) * 1024);
        __builtin_amdgcn_sched_barrier(0);
#pragma unroll
        for (int mt = 0; mt < 4; ++mt) {
#pragma unroll
          for (int nt = 0; nt < 4; ++nt)
            acc[hm * 4 + mt][nt] = __builtin_amdgcn_mfma_f32_16x16x32_bf16(bfg[nt], af[mt], acc[hm * 4 + mt][nt], 0, 0, 0);
          const int g = hm * 4 + mt;
          if (any && g < 4)
            __builtin_amdgcn_global_load_lds((const unsigned*)(sa + (size_t)(g * 64) * lda), (LDS3 unsigned*)(sd + g * 4096), 16, 0, 0);
          else if (any && g < 6)
            __builtin_amdgcn_global_load_lds((const unsigned*)(sb + (size_t)((g - 4) * 64) * ldb), (LDS3 unsigned*)(sd + 16384 + (g - 4) * 4096), 16, 0, 0);
          __builtin_amdgcn_sched_barrier(0);
        }
      }
      if (kt + 1 < nk) __syncthreads();
    }
    {
      typename Epi::Pre pre = epi.pre(tn_cur, tid);
      epi.tile256(acc, pre, m0, n0, tn_cur, wm, wn, l15, quad, tid, smem);
    }
    gA = gAn; gB = gBn;
  }
}

DEVINL void ffn_edge_phase(const float* __restrict__ EDGE, const float* __restrict__ wdw, bfr* __restrict__ ACT, int bid, int nblk) {
  const int gt = bid * 256 + otid(), nt = nblk * 256;
  for (int i = gt; i < 160 * 2 * 704; i += nt) {
    const int cg4 = i % 704, r2 = i / 704, side = r2 & 1, tm = r2 >> 1;
    const int m0 = tm << 7;
    int tl, Tlen; tok_pos(m0, tl, Tlen);
    if (side == 0 ? (tl == 0) : (tl + 128 == Tlen)) continue;
    const int ja = cg4 * 4;
    const int nb_ = ja >> 6, cc = ja & 63;
    const int ea = nb_ * 128 + cc, eb = ea + 64;
    const float* prev; const float* cur; const float* next;
    if (side == 0) {
      prev = EDGE + ((size_t)(tm - 1) * 4 + 3) * EDGE_LD; cur = EDGE + ((size_t)tm * 4 + 0) * EDGE_LD; next = EDGE + ((size_t)tm * 4 + 1) * EDGE_LD;
    } else {
      prev = EDGE + ((size_t)tm * 4 + 2) * EDGE_LD; cur = EDGE + ((size_t)tm * 4 + 3) * EDGE_LD; next = EDGE + ((size_t)(tm + 1) * 4 + 0) * EDGE_LD;
    }
    const f32x4 a = *(const f32x4*)(wdw + ja) * *(const f32x4*)(prev + ea) + *(const f32x4*)(wdw + 2 * DFF + ja) * *(const f32x4*)(cur + ea) +
                    *(const f32x4*)(wdw + 4 * DFF + ja) * *(const f32x4*)(next + ea);
    const f32x4 b = *(const f32x4*)(wdw + DFF + ja) * *(const f32x4*)(prev + eb) + *(const f32x4*)(wdw + 3 * DFF + ja) * *(const f32x4*)(cur + eb) +
                    *(const f32x4*)(wdw + 5 * DFF + ja) * *(const f32x4*)(next + eb);
    uint2 o;
    o.x = pk2(silu_f(a[0]) * b[0], silu_f(a[1]) * b[1]);
    o.y = pk2(silu_f(a[2]) * b[2], silu_f(a[3]) * b[3]);
    const int m = m0 + (side ? 127 : 0);
    *(uint2*)(ACT + (size_t)m * DFF + ja) = o;
  }
}

DEVINL int up_perm(int n0) {
  if (n0 < DFF) return (n0 >> 6) * 128;
  return ((n0 - DFF) >> 6) * 128 + 64;
}
DEVINL void conv_matrix(const float* __restrict__ src, int K, int N, bfr* __restrict__ dst, int perm,
                        char* smem, int bid, int nblk) {
  float* sT = (float*)smem;
  const int tid = otid();
  const int tilesN = N >> 6;
  const int ntiles = (K >> 6) * tilesN;
  for (int t = bid; t < ntiles; t += nblk) {
    const int tk = t / tilesN, tn = t - tk * tilesN;
    const int k0 = tk << 6, n0 = tn << 6;
    const int r = tid >> 4, c4 = tid & 15;
    __syncthreads();
#pragma unroll
    for (int i = 0; i < 4; ++i) {
      const float4 v = *(const float4*)(src + (size_t)(k0 + r + i * 16) * N + n0 + c4 * 4);
      float* d = sT + (r + i * 16) * 65 + c4 * 4;
      d[0] = v.x; d[1] = v.y; d[2] = v.z; d[3] = v.w;
    }
    __syncthreads();
    const int n = tid >> 2, kc = tid & 3;
    uint32_t w[8];
#pragma unroll
    for (int j = 0; j < 8; ++j)
      w[j] = pk2(sT[(kc * 16 + 2 * j) * 65 + n], sT[(kc * 16 + 2 * j + 1) * 65 + n]);
    const int nd = (perm ? up_perm(n0) : n0) + n;
    bfr* dp = dst + (size_t)nd * K + k0 + kc * 16;
    *(uint4*)dp = make_uint4(w[0], w[1], w[2], w[3]);
    *(uint4*)(dp + 8) = make_uint4(w[4], w[5], w[6], w[7]);
  }
}

DEVINL void phase0a(const Params& p, char* smem, int bid, int nblk) {
  const int tid = otid();
  float* sc = (float*)smem;
  float* modp = (float*)(p.ws + OFF_MODP);
  const float* cvec = p.in[3];
  const float* cctx = p.in[4];
  const float* ada_w = p.in[5];
  for (int job = bid; job < 384; job += nblk) {
    const int l = job / 96, r = job - l * 96, ks = r / 6, cgp = r - ks * 6;
    __syncthreads();
    for (int i = tid; i < 320; i += 256) {
      const int cond = i >> 6, kk = i & 63;
      const float v = cond == 0 ? cctx[ks * 64 + kk] : cvec[(cond - 1) * DM + ks * 64 + kk];
      sc[i] = silu_f(v);
    }
    __syncthreads();
    const int col = cgp * 1024 + tid * 4;
    const float* wp = ada_w + ((size_t)l * DM + ks * 64) * 6144 + col;
    float a[5][4];
#pragma unroll
    for (int c = 0; c < 5; ++c)
#pragma unroll
      for (int j = 0; j < 4; ++j) a[c][j] = 0.f;
#pragma unroll 8
    for (int kk = 0; kk < 64; ++kk) {
      const float4 w = *(const float4*)(wp + (size_t)kk * 6144);
#pragma unroll
      for (int c = 0; c < 5; ++c) {
        const float s = sc[c * 64 + kk];
        a[c][0] += s * w.x; a[c][1] += s * w.y; a[c][2] += s * w.z; a[c][3] += s * w.w;
      }
    }
#pragma unroll
    for (int c = 0; c < 5; ++c)
      *(float4*)(modp + ((size_t)(ks * 4 + l) * 5 + c) * 6144 + col) = make_float4(a[c][0], a[c][1], a[c][2], a[c][3]);
  }
  const int gt = bid * 256 + tid, nt = nblk * 256;
  {
    const float* lb = p.in[20];
    float* lbs = (float*)(p.ws + OFF_LBS);
    for (int i = gt; i < 2048; i += nt) {
      const float v0 = lb[i], v1 = lb[2048 + i], v2 = lb[4096 + i], v3 = lb[6144 + i];
      const float mx = fmaxf(fmaxf(v0, v1), fmaxf(v2, v3));
      const float e0 = expf(v0 - mx), e1 = expf(v1 - mx), e2 = expf(v2 - mx), e3 = expf(v3 - mx);
      lbs[i] = (e1 + e2 + e3) / (e0 + e1 + e2 + e3);
    }
  }
  float* X = p.out;
  {
    const float4* xp = (const float4*)p.in[0];
    float4* xo = (float4*)X;
    for (int i = gt; i < NPROMPT * DM / 4; i += nt) xo[i] = xp[i];
    const float* xs = p.in[1];
    for (int i = gt; i < 4096 * 256; i += nt) {
      const int t = i >> 8, c = (i & 255) * 4;
      const int part = c >> 8;
      const float pos = (float)((part < 2) ? (t >> 6) : (t & 63));
      float pe[4];
#pragma unroll
      for (int j = 0; j < 4; ++j) {
        const int jj = (c + j) & 255;
        const float freq = expf((-9.210340371976184f * (float)jj) / 256.0f);
        const float arg = pos * freq;
        pe[j] = (part & 1) ? cosf(arg) : sinf(arg);
      }
#pragma unroll
      for (int b = 0; b < 4; ++b) {
        const size_t off = ((size_t)b * 4096 + t) * DM + c;
        float4 v = *(const float4*)(xs + off);
        v.x += pe[0]; v.y += pe[1]; v.z += pe[2]; v.w += pe[3];
        *(float4*)(X + (size_t)NPROMPT * DM + off) = v;
      }
    }
  }
}

DEVINL void phase0b(const Params& p, int bid, int nblk) {
  const int gt = bid * 256 + otid(), nt = nblk * 256;
  const float* modp = (const float*)(p.ws + OFF_MODP);
  float* mod = (float*)(p.ws + OFF_MOD);
  const float* ada_b = p.in[6];
  for (int i = gt; i < 4 * 5 * 6144; i += nt) {
    const int l = i / 30720, col = i % 6144;
    float s = ada_b[l * 6144 + col];
#pragma unroll
    for (int ks = 0; ks < 16; ++ks) s += modp[(size_t)ks * 122880 + i];
    mod[i] = s;
  }
}

DEVINL void norm_phase(const float* __restrict__ X, const float* __restrict__ g, const float* __restrict__ modl,
                       int shift_off, int scale_off, bfr* __restrict__ H, int bid, int nblk) {
  const int tid = otid(); const int lane = tid & 63;
  const int gw = bid * 4 + (tid >> 6), nw = nblk * 4;
  for (int row = gw; row < MTOK; row += nw) {
    const float* xr = X + (size_t)row * DM;
    float4 x[4];
    float ss = 0.f;
#pragma unroll
    for (int i = 0; i < 4; ++i) {
      x[i] = *(const float4*)(xr + i * 256 + lane * 4);
      ss += x[i].x * x[i].x + x[i].y * x[i].y + x[i].z * x[i].z + x[i].w * x[i].w;
    }
    ss = wave_sum(ss, lane);
    const float rstd = rsqrtf(ss * (1.f / DM) + EPS);
    const float* mc = modl + cond_of(row) * 6144;
#pragma unroll
    for (int i = 0; i < 4; ++i) {
      const int c = i * 256 + lane * 4;
      const float4 gg = *(const float4*)(g + c);
      const float4 sh = *(const float4*)(mc + shift_off + c);
      const float4 sc = *(const float4*)(mc + scale_off + c);
      const float h0 = x[i].x * rstd * gg.x * (1.f + sc.x) + sh.x;
      const float h1 = x[i].y * rstd * gg.y * (1.f + sc.y) + sh.y;
      const float h2 = x[i].z * rstd * gg.z * (1.f + sc.z) + sh.z;
      const float h3 = x[i].w * rstd * gg.w * (1.f + sc.w) + sh.w;
      uint2 o; o.x = pk2(h0, h1); o.y = pk2(h2, h3);
      *(uint2*)(H + (size_t)row * DM + c) = o;
    }
  }
}

DEVINL void final_norm_phase(float* X, const float* __restrict__ g, int bid, int nblk) {
  const int tid = otid(); const int lane = tid & 63;
  const int gw = bid * 4 + (tid >> 6), nw = nblk * 4;
  for (int row = gw; row < MTOK; row += nw) {
    float* xr = X + (size_t)row * DM;
    float4 x[4];
    float ss = 0.f;
#pragma unroll
    for (int i = 0; i < 4; ++i) {
      x[i] = *(const float4*)(xr + i * 256 + lane * 4);
      ss += x[i].x * x[i].x + x[i].y * x[i].y + x[i].z * x[i].z + x[i].w * x[i].w;
    }
    ss = wave_sum(ss, lane);
    const float rstd = rsqrtf(ss * (1.f / DM) + EPS);
#pragma unroll
    for (int i = 0; i < 4; ++i) {
      const int c = i * 256 + lane * 4;
      const float4 gg = *(const float4*)(g + c);
      float4 o;
      o.x = x[i].x * rstd * gg.x; o.y = x[i].y * rstd * gg.y; o.z = x[i].z * rstd * gg.z; o.w = x[i].w * rstd * gg.w;
      *(float4*)(xr + c) = o;
    }
  }
}

DEVINL void shortconv_ew_phase(const bfr* __restrict__ G, const float* __restrict__ wdw, bfr* __restrict__ U, int bid, int nblk) {
  const int gt = bid * 256 + otid(), nt = nblk * 256;
  for (int i = gt; i < MTOK * 128; i += nt) {
    const int m = i >> 7, c = (i & 127) * 8;
    int tl, T; tok_pos(m, tl, T);
    const bfr* gr = G + (size_t)m * 3072;
    const uint4 bg = *(const uint4*)(gr + c);
    float accv[8];
#pragma unroll
    for (int j = 0; j < 8; ++j) accv[j] = 0.f;
#pragma unroll
    for (int tap = 0; tap < 3; ++tap) {
      const int d = tap - 1;
      if ((d < 0 && tl == 0) || (d > 0 && tl == T - 1)) continue;
      const bfr* nr = gr + (ptrdiff_t)d * 3072;
      const uint4 cgv = *(const uint4*)(nr + 1024 + c);
      const uint4 xhv = *(const uint4*)(nr + 2048 + c);
      const float4 w0 = *(const float4*)(wdw + tap * DM + c);
      const float4 w1 = *(const float4*)(wdw + tap * DM + c + 4);
      accv[0] += w0.x * bflo(cgv.x) * bflo(xhv.x); accv[1] += w0.y * bfhi(cgv.x) * bfhi(xhv.x);
      accv[2] += w0.z * bflo(cgv.y) * bflo(xhv.y); accv[3] += w0.w * bfhi(cgv.y) * bfhi(xhv.y);
      accv[4] += w1.x * bflo(cgv.z) * bflo(xhv.z); accv[5] += w1.y * bfhi(cgv.z) * bfhi(xhv.z);
      accv[6] += w1.z * bflo(cgv.w) * bflo(xhv.w); accv[7] += w1.w * bfhi(cgv.w) * bfhi(xhv.w);
    }
    uint4 o;
    o.x = pk2(bflo(bg.x) * accv[0], bfhi(bg.x) * accv[1]);
    o.y = pk2(bflo(bg.y) * accv[2], bfhi(bg.y) * accv[3]);
    o.z = pk2(bflo(bg.z) * accv[4], bfhi(bg.z) * accv[5]);
    o.w = pk2(bflo(bg.w) * accv[6], bfhi(bg.w) * accv[7]);
    *(uint4*)(U + (size_t)m * DM + c) = o;
  }
}

DEVINL void pool_ew_phase(const bfr* __restrict__ H, bfr* __restrict__ P, int bid, int nblk) {
  const int gt = bid * 256 + otid(), nt = nblk * 256;
  for (int i = gt; i < MTOK * 128; i += nt) {
    const int m = i >> 7, ch = i & 127, c = ch * 8;
    int tl, T; tok_pos(m, tl, T);
    const int hw = 1 << (ch >> 5);
    const int lo = max(tl - hw, 0), hi = min(tl + hw, T);
    float s[8];
#pragma unroll
    for (int j = 0; j < 8; ++j) s[j] = 0.f;
    const bfr* base = H + (size_t)(m - tl) * DM + c;
    for (int q = lo; q < hi; ++q) {
      const uint4 v = *(const uint4*)(base + (size_t)q * DM);
      s[0] += bflo(v.x); s[1] += bfhi(v.x); s[2] += bflo(v.y); s[3] += bfhi(v.y);
      s[4] += bflo(v.z); s[5] += bfhi(v.z); s[6] += bflo(v.w); s[7] += bfhi(v.w);
    }
    const float inv = 1.f / (float)(hi - lo);
    const uint4 v = *(const uint4*)(base + (size_t)tl * DM);
    uint4 o;
    o.x = pk2(s[0] * inv - bflo(v.x), s[1] * inv - bfhi(v.x));
    o.y = pk2(s[2] * inv - bflo(v.y), s[3] * inv - bfhi(v.y));
    o.z = pk2(s[4] * inv - bflo(v.z), s[5] * inv - bfhi(v.z));
    o.w = pk2(s[6] * inv - bflo(v.w), s[7] * inv - bfhi(v.w));
    *(uint4*)(P + (size_t)m * DM + c) = o;
  }
}

DEVINL void sgu_norm_phase(bfr* UV, const float* __restrict__ g, int bid, int nblk) {
  const int tid = otid(); const int lane = tid & 63;
  const int gw = bid * 4 + (tid >> 6), nw = nblk * 4;
  for (int row = gw; row < MTOK; row += nw) {
    bfr* vr = UV + (size_t)row * 2048 + 1024;
    float x[4][4];
    float ss = 0.f;
#pragma unroll
    for (int i = 0; i < 4; ++i) {
      const uint2 v = *(const uint2*)(vr + i * 256 + lane * 4);
      x[i][0] = bflo(v.x); x[i][1] = bfhi(v.x); x[i][2] = bflo(v.y); x[i][3] = bfhi(v.y);
      ss += x[i][0] * x[i][0] + x[i][1] * x[i][1] + x[i][2] * x[i][2] + x[i][3] * x[i][3];
    }
    ss = wave_sum(ss, lane);
    const float rstd = rsqrtf(ss * (1.f / DM) + EPS);
#pragma unroll
    for (int i = 0; i < 4; ++i) {
      const int c = i * 256 + lane * 4;
      const float4 gg = *(const float4*)(g + c);
      uint2 o;
      o.x = pk2(x[i][0] * rstd * gg.x, x[i][1] * rstd * gg.y);
      o.y = pk2(x[i][2] * rstd * gg.z, x[i][3] * rstd * gg.w);
      *(uint2*)(vr + c) = o;
    }
  }
}

DEVINL void sgu_spatial_phase(bfr* UV, const float* __restrict__ ws_, const float* __restrict__ bs_, char* smem, int bid, int nblk) {
  bfr* sV = (bfr*)smem;
  bfr* sW = sV + 128 * 136;
  const int tid = otid(), lane = tid & 63, wave = tid >> 6, l15 = lane & 15, quad = lane >> 4;
  for (int item = bid; item < 160 * 8; item += nblk) {
    const int chunk = item >> 3, g = item & 7;
    __syncthreads();
    const float* wg = ws_ + (size_t)g * 16384;
#pragma unroll 4
    for (int i = 0; i < 16; ++i) {
      const int idx = tid + 256 * i;
      const int row = idx >> 5, chn = idx & 31;
      const float4 v = *(const float4*)(wg + row * 128 + chn * 4);
      uint2 o; o.x = pk2(v.x, v.y); o.y = pk2(v.z, v.w);
      *(uint2*)(sW + row * 136 + chn * 4) = o;
    }
#pragma unroll 2
    for (int i = 0; i < 8; ++i) {
      const int idx = tid + 256 * i;
      const int q = idx >> 4, chn = idx & 15;
      const uint4 v = *(const uint4*)(UV + (size_t)(chunk * 128 + q) * 2048 + 1024 + g * 128 + chn * 8);
      bfr* d = sV + (chn * 8) * 136 + q;
      d[0 * 136] = (bfr)(v.x & 0xffff); d[1 * 136] = (bfr)(v.x >> 16);
      d[2 * 136] = (bfr)(v.y & 0xffff); d[3 * 136] = (bfr)(v.y >> 16);
      d[4 * 136] = (bfr)(v.z & 0xffff); d[5 * 136] = (bfr)(v.z >> 16);
      d[6 * 136] = (bfr)(v.w & 0xffff); d[7 * 136] = (bfr)(v.w >> 16);
    }
    __syncthreads();
    f32x4 acc[8][2];
#pragma unroll
    for (int i = 0; i < 8; ++i) { acc[i][0] = f32x4{0.f, 0.f, 0.f, 0.f}; acc[i][1] = f32x4{0.f, 0.f, 0.f, 0.f}; }
#pragma unroll
    for (int kk = 0; kk < 4; ++kk) {
      bf16x8 bw[2];
#pragma unroll
      for (int pt = 0; pt < 2; ++pt) bw[pt] = *(const bf16x8*)(sW + (wave * 32 + pt * 16 + l15) * 136 + kk * 32 + quad * 8);
#pragma unroll
      for (int ct = 0; ct < 8; ++ct) {
        const bf16x8 av = *(const bf16x8*)(sV + (ct * 16 + l15) * 136 + kk * 32 + quad * 8);
#pragma unroll
        for (int pt = 0; pt < 2; ++pt)
          acc[ct][pt] = __builtin_amdgcn_mfma_f32_16x16x32_bf16(av, bw[pt], acc[ct][pt], 0, 0, 0);
      }
    }
#pragma unroll
    for (int pt = 0; pt < 2; ++pt) {
      const int pp = wave * 32 + pt * 16 + l15;
      const float bias = bs_[g * 128 + pp];
      bfr* ur = UV + (size_t)(chunk * 128 + pp) * 2048 + g * 128 + quad * 4;
#pragma unroll
      for (int ct = 0; ct < 8; ++ct) {
        const uint2 u = *(const uint2*)(ur + ct * 16);
        uint2 o;
        o.x = pk2(bflo(u.x) * (acc[ct][pt][0] + bias), bfhi(u.x) * (acc[ct][pt][1] + bias));
        o.y = pk2(bflo(u.y) * (acc[ct][pt][2] + bias), bfhi(u.y) * (acc[ct][pt][3] + bias));
        *(uint2*)(ur + ct * 16) = o;
      }
    }
  }
}

DEVINL void hgrn_scan_phase(const Params& p, char* smem, int bid, int nblk, const int mode) {
  bfr* sQe = (bfr*)smem;
  bfr* sKe = sQe + 32 * 136;
  bfr* sKeT = sKe + 32 * 136;
  bfr* sVT = sKeT + 128 * 40;
  bfr* sP = sVT + 64 * 40;
  bfr* sST = sP + 32 * 40;
  float* sLast = (float*)(sST + 64 * 136);
  float* sTot = sLast + 128;
  const int tid = otid(), lane = tid & 63, wave = tid >> 6, l15 = lane & 15, quad = lane >> 4;
  const int cp = lane, qt = wave, i0 = qt * 8;
  const bfr* QZ = (const bfr*)(p.ws + OFF_BIG);
  bfr* Of = (bfr*)(p.ws + OFF_H);
  bfr* Ob = (bfr*)(p.ws + OFF_BIG + 209715200ull);
  const float* lbs = (const float*)(p.ws + OFF_LBS);
  const float* state_rec = p.in[2];
  float* out_state = p.out + (size_t)MTOK * DM;

  float* SLOC = (float*)(p.ws + OFF_BIG + 251658240ull);
  float* DLOC = (float*)(p.ws + OFF_BIG + 251658240ull + 33554432ull);
  const int nitems = mode ? 1536 : 896;
  for (int item = bid; item < nitems; item += nblk) {
    const int eh = item & 1, dir = (item >> 1) & 1, h = (item >> 2) & 7;
    int base, T, nchunks, pos0, slot, seq;
    bool is_prompt = false;
    if (!mode) {
      const int r = item >> 5, seqb = r / 7, j = r - seqb * 7;
      seq = 16 + seqb; base = NPROMPT + seqb * 4096; T = 4096; nchunks = 16; pos0 = j * 512;
      slot = ((seqb * 8 + j) * 8 + h) * 2 + dir;
    } else if (item < 1024) {
      const int r = item >> 5, seqb = r >> 3, j = r & 7;
      seq = 16 + seqb; base = NPROMPT + seqb * 4096; T = 4096; nchunks = 16; pos0 = j * 512;
      slot = ((seqb * 8 + j) * 8 + h) * 2 + dir;
    } else {
      seq = (item - 1024) >> 5; base = seq * 256; T = 256; nchunks = 8; pos0 = 0; slot = 0;
      is_prompt = true;
    }
    bfr* Od = dir ? Ob : Of;
    const float lbv0 = lbs[dir * 1024 + h * 128 + 2 * cp], lbv1 = lbs[dir * 1024 + h * 128 + 2 * cp + 1];
    const int eloc = wave * 16 + l15;
    const int eglob = eh * 64 + eloc;

    f32x4 S[8];
    if (is_prompt || !mode) {
#pragma unroll
      for (int dt = 0; dt < 8; ++dt) S[dt] = f32x4{0.f, 0.f, 0.f, 0.f};
    } else {
      const float* s0 = SLOC + (size_t)slot * 16384;
#pragma unroll
      for (int dt = 0; dt < 8; ++dt)
#pragma unroll
        for (int j = 0; j < 4; ++j) S[dt][j] = s0[(dt * 16 + quad * 4 + j) * 128 + eglob];
    }
    float cum0 = 1.f, cum1 = 1.f;
    __syncthreads();
#pragma unroll
    for (int dt = 0; dt < 8; ++dt) {
      uint2 o; o.x = pk2(S[dt][0], S[dt][1]); o.y = pk2(S[dt][2], S[dt][3]);
      *(uint2*)(sST + eloc * 136 + dt * 16 + quad * 4) = o;
    }

    const unsigned qoff2 = h * 64 + cp, zoff2 = (1 + dir) * 512 + h * 64 + cp;
    const unsigned voff2 = 1536 + h * 64 + eh * 32 + (cp & 31);
    const uint32_t* __restrict__ QZ32 = (const uint32_t*)QZ;
    uint32_t rq[8], rz[8], rv[8];
#pragma unroll
    for (int ii = 0; ii < 8; ++ii) {
      const int pos = pos0 + i0 + ii;
      const unsigned tok = dir ? base + T - 1 - pos : base + pos;
      const unsigned ri = tok * 2560u;
      rq[ii] = QZ32[ri + qoff2]; rz[ii] = QZ32[ri + zoff2]; rv[ii] = QZ32[ri + voff2];
    }

    for (int c = 0; c < nchunks; ++c) {
      float pc0[8], pc1[8], kv0[8], kv1[8];
      float run0 = 1.f, run1 = 1.f;
#pragma unroll
      for (int ii = 0; ii < 8; ++ii) {
        const float z0 = bflo(rz[ii]), z1 = bfhi(rz[ii]);
        const float f0 = lbv0 + (1.f - lbv0) * frcp(1.f + __expf(-z0));
        const float f1 = lbv1 + (1.f - lbv1) * frcp(1.f + __expf(-z1));
        run0 *= f0; run1 *= f1;
        pc0[ii] = run0; pc1[ii] = run1;
        kv0[ii] = 1.f - f0; kv1[ii] = 1.f - f1;
      }
      *(float2*)(sTot + qt * 128 + 2 * cp) = make_float2(run0, run1);
      __syncthreads();
      {
        float off0 = 1.f, off1 = 1.f, tot0 = 1.f, tot1 = 1.f;
#pragma unroll
        for (int q = 0; q < 4; ++q) {
          const float2 t = *(const float2*)(sTot + q * 128 + 2 * cp);
          if (q < qt) { off0 *= t.x; off1 *= t.y; }
          tot0 *= t.x; tot1 *= t.y;
        }
        uint32_t wk0[4], wk1[4], wv0[4], wv1[4];
#pragma unroll
        for (int ii = 0; ii < 8; ii += 2) {
          uint32_t kp[2];
#pragma unroll
          for (int u = 0; u < 2; ++u) {
            const float e0 = pc0[ii + u] * off0, e1 = pc1[ii + u] * off1;
            kp[u] = pk2(kv0[ii + u] * frcp(e0), kv1[ii + u] * frcp(e1));
            *(uint32_t*)(sKe + (i0 + ii + u) * 136 + 2 * cp) = kp[u];
            if (mode) *(uint32_t*)(sQe + (i0 + ii + u) * 136 + 2 * cp) = pk2(bflo(rq[ii + u]) * e0, bfhi(rq[ii + u]) * e1);
          }
          wk0[ii >> 1] = (kp[0] & 0xffffu) | (kp[1] << 16);
          wk1[ii >> 1] = (kp[0] >> 16) | (kp[1] & 0xffff0000u);
          wv0[ii >> 1] = (rv[ii] & 0xffffu) | (rv[ii + 1] << 16);
          wv1[ii >> 1] = (rv[ii] >> 16) | (rv[ii + 1] & 0xffff0000u);
        }
        *(u32x4*)(sKeT + (2 * cp) * 40 + i0) = u32x4{wk0[0], wk0[1], wk0[2], wk0[3]};
        *(u32x4*)(sKeT + (2 * cp + 1) * 40 + i0) = u32x4{wk1[0], wk1[1], wk1[2], wk1[3]};
        if (cp < 32) {
          *(u32x4*)(sVT + (2 * cp) * 40 + i0) = u32x4{wv0[0], wv0[1], wv0[2], wv0[3]};
          *(u32x4*)(sVT + (2 * cp + 1) * 40 + i0) = u32x4{wv1[0], wv1[1], wv1[2], wv1[3]};
        }
        if (qt == 0) *(float2*)(sLast + 2 * cp) = make_float2(tot0, tot1);
        cum0 *= tot0; cum1 *= tot1;
      }
      if (c + 1 < nchunks) {
#pragma unroll
        for (int ii = 0; ii < 8; ++ii) {
          const int pos = pos0 + (c + 1) * 32 + i0 + ii;
          const unsigned tok = dir ? base + T - 1 - pos : base + pos;
          const unsigned ri = tok * 2560u;
          rq[ii] = QZ32[ri + qoff2]; rz[ii] = QZ32[ri + zoff2]; rv[ii] = QZ32[ri + voff2];
        }
      }
      __syncthreads();
      if (mode) {
        const int ti = wave >> 1, si = wave & 1;
        f32x4 sc = f32x4{0.f, 0.f, 0.f, 0.f};
        if (si <= ti) {
#pragma unroll
          for (int kk = 0; kk < 4; ++kk) {
            const bf16x8 a = *(const bf16x8*)(sQe + (ti * 16 + l15) * 136 + kk * 32 + quad * 8);
            const bf16x8 b = *(const bf16x8*)(sKe + (si * 16 + l15) * 136 + kk * 32 + quad * 8);
            sc = __builtin_amdgcn_mfma_f32_16x16x32_bf16(a, b, sc, 0, 0, 0);
          }
        }
#pragma unroll
        for (int j = 0; j < 4; ++j) {
          const int t = ti * 16 + quad * 4 + j, s2 = si * 16 + l15;
          sP[t * 40 + s2] = (s2 <= t) ? f2bf(sc[j]) : (bfr)0;
        }
      }
      f32x4 oacc[2];
      oacc[0] = f32x4{0.f, 0.f, 0.f, 0.f}; oacc[1] = f32x4{0.f, 0.f, 0.f, 0.f};
      if (mode) {
#pragma unroll
      for (int kk = 0; kk < 4; ++kk) {
        const bf16x8 sb = *(const bf16x8*)(sST + eloc * 136 + kk * 32 + quad * 8);
#pragma unroll
        for (int tt = 0; tt < 2; ++tt) {
          const bf16x8 qa = *(const bf16x8*)(sQe + (tt * 16 + l15) * 136 + kk * 32 + quad * 8);
          oacc[tt] = __builtin_amdgcn_mfma_f32_16x16x32_bf16(sb, qa, oacc[tt], 0, 0, 0);
        }
      }
      }
      __syncthreads();
      {
        const bf16x8 vb = *(const bf16x8*)(sVT + eloc * 40 + quad * 8);
        if (mode) {
#pragma unroll
        for (int tt = 0; tt < 2; ++tt) {
          const bf16x8 pb = *(const bf16x8*)(sP + (tt * 16 + l15) * 40 + quad * 8);
          oacc[tt] = __builtin_amdgcn_mfma_f32_16x16x32_bf16(vb, pb, oacc[tt], 0, 0, 0);
          const int pos = pos0 + c * 32 + tt * 16 + l15;
          const int tok = dir ? base + T - 1 - pos : base + pos;
          uint2 o; o.x = pk2(oacc[tt][0], oacc[tt][1]); o.y = pk2(oacc[tt][2], oacc[tt][3]);
          *(uint2*)(Od + (size_t)tok * DM + h * 128 + eh * 64 + wave * 16 + quad * 4) = o;
        }
        }
#pragma unroll
        for (int dt = 0; dt < 8; ++dt) {
          const bf16x8 ka = *(const bf16x8*)(sKeT + (dt * 16 + l15) * 40 + quad * 8);
          const float4 dl = *(const float4*)(sLast + dt * 16 + quad * 4);
          f32x4 sn = __builtin_amdgcn_mfma_f32_16x16x32_bf16(ka, vb, S[dt], 0, 0, 0);
          sn[0] *= dl.x; sn[1] *= dl.y; sn[2] *= dl.z; sn[3] *= dl.w;
          S[dt] = sn;
          uint2 o; o.x = pk2(sn[0], sn[1]); o.y = pk2(sn[2], sn[3]);
          *(uint2*)(sST + eloc * 136 + dt * 16 + quad * 4) = o;
        }
      }
    }
    if (is_prompt || !mode) {
      float* so = is_prompt ? out_state + ((size_t)(seq * 2 + dir) * 8 + h) * 16384 : SLOC + (size_t)slot * 16384;
#pragma unroll
      for (int dt = 0; dt < 8; ++dt)
#pragma unroll
        for (int j = 0; j < 4; ++j) so[(dt * 16 + quad * 4 + j) * 128 + eglob] = S[dt][j];
      if (!mode && eh == 0 && qt == 0) *(float2*)(DLOC + slot * 128 + 2 * cp) = make_float2(cum0, cum1);
    }
  }
}

DEVINL void hgrn_combine_phase(const Params& p, int bid, int nblk) {
  const int gt = bid * 256 + otid(), nt = nblk * 256;
  float* SLOC = (float*)(p.ws + OFF_BIG + 251658240ull);
  const float* DLOC = (const float*)(p.ws + OFF_BIG + 251658240ull + 33554432ull);
  const float* state_rec = p.in[2];
  for (int idx = gt; idx < 4 * 8 * 2 * 16384; idx += nt) {
    const int de = idx & 16383, r = idx >> 14;
    const int dir = r & 1, h = (r >> 1) & 7, seqb = r >> 4;
    const int d = de >> 7;
    float prev = state_rec[((size_t)(seqb * 2 + dir) * 8 + h) * 16384 + de];
#pragma unroll
    for (int j = 0; j < 8; ++j) {
      const int slot = ((seqb * 8 + j) * 8 + h) * 2 + dir;
      float* ptr = SLOC + (size_t)slot * 16384 + de;
      const float a = (j < 7) ? *ptr : 0.f;
      *ptr = prev;
      if (j < 7) prev = DLOC[slot * 128 + d] * prev + a;
    }
  }
}

DEVINL void hgrn_gate_phase(const Params& p, const float* __restrict__ ng, int bid, int nblk) {
  const int tid = otid(); const int lane = tid & 63;
  const int gw = bid * 4 + (tid >> 6), nw = nblk * 4;
  bfr* Of = (bfr*)(p.ws + OFF_H);
  const bfr* Ob = (const bfr*)(p.ws + OFF_BIG + 209715200ull);
  const bfr* QZ = (const bfr*)(p.ws + OFF_BIG);
  for (int row = gw; row < MTOK; row += nw) {
#pragma unroll
    for (int seg = 0; seg < 4; ++seg) {
      const int c = seg * 256 + lane * 4;
      const uint2 a = *(const uint2*)(Of + (size_t)row * DM + c);
      const uint2 b = *(const uint2*)(Ob + (size_t)row * DM + c);
      const uint2 gq = *(const uint2*)(QZ + (size_t)row * 5120 + 4096 + c);
      const float o0 = bflo(a.x) + bflo(b.x), o1 = bfhi(a.x) + bfhi(b.x), o2 = bflo(a.y) + bflo(b.y), o3 = bfhi(a.y) + bfhi(b.y);
      float ss = o0 * o0 + o1 * o1 + o2 * o2 + o3 * o3;
#pragma unroll
      for (int o = 16; o > 0; o >>= 1) ss += shx(ss, o, lane);
      const float rstd = rsqrtf(ss * (1.f / 128.f) + EPS);
      const float4 gg = *(const float4*)(ng + c);
      uint2 o;
      o.x = pk2(o0 * rstd * gg.x * silu_f(bflo(gq.x)), o1 * rstd * gg.y * silu_f(bfhi(gq.x)));
      o.y = pk2(o2 * rstd * gg.z * silu_f(bflo(gq.y)), o3 * rstd * gg.w * silu_f(bfhi(gq.y)));
      *(uint2*)(Of + (size_t)row * DM + c) = o;
    }
  }
}

DEVINL void ffn_act_phase(const bfr* __restrict__ UP, const float* __restrict__ wdw, int hf, bfr* __restrict__ ACT, int bid, int nblk) {
  const int gt = bid * 256 + otid(), nt = nblk * 256;
  for (int i = gt; i < MTOK * 176; i += nt) {
    const int m = i / 176, j = (i - m * 176) * 8;
    int tl, T; tok_pos(m, tl, T);
    const bfr* ur = UP + (size_t)m * DFF;
    float a[8], b[8];
#pragma unroll
    for (int q = 0; q < 8; ++q) { a[q] = 0.f; b[q] = 0.f; }
#pragma unroll
    for (int tap = 0; tap < 3; ++tap) {
      const int d = tap - 1;
      if ((d < 0 && tl == 0) || (d > 0 && tl == T - 1)) continue;
      const bfr* nr = ur + (ptrdiff_t)d * DFF;
      const uint4 av = *(const uint4*)(nr + j);
      const uint4 bv = *(const uint4*)(nr + HALF_FF + j);
      const float* wa = wdw + tap * (2 * DFF) + hf * HALF_FF + j;
      const float* wb = wdw + tap * (2 * DFF) + DFF + hf * HALF_FF + j;
      const float4 wa0 = *(const float4*)wa, wa1 = *(const float4*)(wa + 4);
      const float4 wb0 = *(const float4*)wb, wb1 = *(const float4*)(wb + 4);
      a[0] += wa0.x * bflo(av.x); a[1] += wa0.y * bfhi(av.x); a[2] += wa0.z * bflo(av.y); a[3] += wa0.w * bfhi(av.y);
      a[4] += wa1.x * bflo(av.z); a[5] += wa1.y * bfhi(av.z); a[6] += wa1.z * bflo(av.w); a[7] += wa1.w * bfhi(av.w);
      b[0] += wb0.x * bflo(bv.x); b[1] += wb0.y * bfhi(bv.x); b[2] += wb0.z * bflo(bv.y); b[3] += wb0.w * bfhi(bv.y);
      b[4] += wb1.x * bflo(bv.z); b[5] += wb1.y * bfhi(bv.z); b[6] += wb1.z * bflo(bv.w); b[7] += wb1.w * bfhi(bv.w);
    }
    uint4 o;
    o.x = pk2(silu_f(a[0]) * b[0], silu_f(a[1]) * b[1]);
    o.y = pk2(silu_f(a[2]) * b[2], silu_f(a[3]) * b[3]);
    o.z = pk2(silu_f(a[4]) * b[4], silu_f(a[5]) * b[5]);
    o.w = pk2(silu_f(a[6]) * b[6], silu_f(a[7]) * b[7]);
    *(uint4*)(ACT + (size_t)m * DFF + hf * HALF_FF + j) = o;
  }
}


#define XB_TMO      128
#define XB_XCNT(j)  (256  + 64 * (j))
#define XB_XSUB(j)  (1280 + 64 * (j))
#define XB_XGEN(j)  (2304 + 64 * (j))
#define XB_TOP      3328
#define XB_TOPGEN   3392
#define XCD_BAR_WORDS 3456
#define XB_SPIN_CAP (1u << 22)
#define LAS __attribute__((address_space(3)))
DEVINL unsigned xb_ld(unsigned* p) { return __hip_atomic_load(p, __ATOMIC_RELAXED, __HIP_MEMORY_SCOPE_AGENT); }
DEVINL unsigned xb_add(unsigned* p, unsigned v) { return __hip_atomic_fetch_add(p, v, __ATOMIC_RELAXED, __HIP_MEMORY_SCOPE_AGENT); }
DEVINL unsigned xb_xcc_id() { return (unsigned)__builtin_amdgcn_s_getreg((3 << 11) | 20) & 0xFu; }
#define XB_SPIN(cond, bar) do { unsigned _sp = 0; while (cond) { __builtin_amdgcn_s_sleep(1); \
    if ((++_sp & 255u) == 0u) { if (xb_ld(&(bar)[XB_TMO])) break; if (_sp > XB_SPIN_CAP) { atomicAdd(&(bar)[XB_TMO], 1u); break; } } } } while (0)
struct XcdBarrier { unsigned* bar; unsigned x; volatile LAS unsigned* st; };
DEVINL XcdBarrier xcd_barrier_post(unsigned* bar, volatile LAS unsigned* st) {
  XcdBarrier b; b.bar = bar; b.x = xb_xcc_id(); b.st = st;
  if (threadIdx.x == 0) (void)xb_add(&bar[XB_XCNT(b.x)], 1u);
  return b;
}
DEVINL void xcd_barrier_complete(unsigned* bar, unsigned x, unsigned& nloc, unsigned& nx) {
  const unsigned G = gridDim.x * gridDim.y * gridDim.z;
  unsigned sum, cnt, mine, sp = 0u;
  for (;;) {
    sum = 0u; cnt = 0u; mine = 0u;
#pragma unroll
    for (unsigned j = 0; j < 16; ++j) { const unsigned c = xb_ld(&bar[XB_XCNT(j)]); sum += c; cnt += (c > 0u) ? 1u : 0u; mine = (j == x) ? c : mine; }
    if (sum == G) break;
    __builtin_amdgcn_s_sleep(1);
    if ((++sp & 255u) == 0u) { if (xb_ld(&bar[XB_TMO])) break; if (sp > XB_SPIN_CAP) { atomicAdd(&bar[XB_TMO], 1u); break; } }
  }
  nloc = mine > 0u ? mine : 1u; nx = cnt > 0u ? cnt : 1u;
}
DEVINL void xcd_barrier(const XcdBarrier& b) {
  asm volatile("s_waitcnt vmcnt(0)" ::: "memory");
  __syncthreads();
  if (threadIdx.x == 0) {
    unsigned* bar = b.bar;
    unsigned bx = b.x;
    asm volatile("" : "+s"(bar), "+s"(bx));
    __builtin_amdgcn_s_waitcnt(0);
    unsigned nloc = b.st[0], nx = b.st[1];
    if (nloc == 0u) { xcd_barrier_complete(bar, bx, nloc, nx); b.st[0] = nloc; b.st[1] = nx; }
    const unsigned old = xb_add(&bar[XB_XSUB(bx)], 1u);
    const unsigned gen = old / nloc;
    if (old + 1u == (gen + 1u) * nloc) {
      __builtin_amdgcn_fence(__ATOMIC_RELEASE, "agent");
      asm volatile("s_waitcnt vmcnt(0)" ::: "memory");
      const unsigned og = xb_add(&bar[XB_TOP], 1u);
      const unsigned tg = og / nx;
      if (og + 1u == (tg + 1u) * nx) xb_add(&bar[XB_TOPGEN], 1u);
      else XB_SPIN(xb_ld(&bar[XB_TOPGEN]) == tg, bar);
      __builtin_amdgcn_fence(__ATOMIC_ACQUIRE, "agent");
      xb_add(&bar[XB_XGEN(bx)], 1u);
      asm volatile("s_waitcnt vmcnt(0)" ::: "memory");
    } else {
      XB_SPIN(xb_ld(&bar[XB_XGEN(bx)]) == gen, bar);
      __builtin_amdgcn_fence(__ATOMIC_ACQUIRE, "agent");
      asm volatile("s_waitcnt vmcnt(0)" ::: "memory");
    }
  }
  __syncthreads();
}

constexpr int SMEM_BYTES = 77824;

__global__ void __launch_bounds__(256, 2) mega_kernel(Params p) {
  __shared__ __attribute__((aligned(16))) char smem[SMEM_BYTES];
  cg::grid_group grid = cg::this_grid();
  __shared__ uint4 xb_words;
  if (threadIdx.x == 0) xb_words = make_uint4(0u, 0u, 0u, 0u);
  __syncthreads();
  XcdBarrier xb = xcd_barrier_post((unsigned*)(p.ws + OFF_BAR), (volatile LAS unsigned*)&xb_words);
  const int bid = blockIdx.x, nblk = gridDim.x;

  phase0a(p, smem, osg(bid), nblk);
  grid.sync();
  phase0b(p, osg(bid), nblk);
  xcd_barrier(xb);

  for (int layer = 0; layer < 4; ++layer) {
    Params q = p;
    {
      size_t oz = 0;
      asm volatile("" : "+s"(oz));
      q.ws = p.ws + oz;
      q.out = p.out + oz;
    }
    float* X = q.out;
    bfr* WB = (bfr*)(q.ws + OFF_WB);
    bfr* H = (bfr*)(q.ws + OFF_H);
    bfr* BIG = (bfr*)(q.ws + OFF_BIG);
    const float* MOD = (const float*)(q.ws + OFF_MOD);
    const float* modl = MOD + layer * 30720;
    if (layer == 0) {
      conv_matrix(q.in[9], 1024, 3072, WB + WB_IN, 0, smem, osg(bid), nblk);
      conv_matrix(q.in[11], 1024, 1024, WB + WB_OUT, 0, smem, osg(bid), nblk);
    } else if (layer == 1) {
      for (int g = 0; g < 4; ++g) conv_matrix(q.in[12] + g * 65536, 256, 256, WB + WB_IN + g * 65536, 0, smem, osg(bid), nblk);
    } else if (layer == 2) {
      conv_matrix(q.in[14], 1024, 2048, WB + WB_IN, 0, smem, osg(bid), nblk);
      conv_matrix(q.in[18], 1024, 1024, WB + WB_OUT, 0, smem, osg(bid), nblk);
    } else {
      conv_matrix(q.in[19], 1024, 5120, WB + WB_IN, 0, smem, osg(bid), nblk);
      conv_matrix(q.in[22], 1024, 1024, WB + WB_OUT, 0, smem, osg(bid), nblk);
    }
    conv_matrix(q.in[23] + (size_t)layer * 1024 * 5632, 1024, 5632, WB + WB_UP, 1, smem, osg(bid), nblk);
    conv_matrix(q.in[25] + (size_t)layer * DFF * 1024, DFF, 1024, WB + WB_DOWN, 0, smem, osg(bid), nblk);
    norm_phase(X, q.in[7] + (layer * 2 + 0) * DM, modl, 0, 1024, H, osg(bid), nblk);
    xcd_barrier(xb);

    if (layer == 0) {
      bfr* G = BIG;
      bfr* U = BIG + (size_t)MTOK * 3072;
      gemm256_phase(H, DM, WB + WB_IN, 1024, 3072, 1024, EpiStore{G, 3072}, smem, osg(bid), nblk);
      xcd_barrier(xb);
      shortconv_ew_phase(G, q.in[10], U, osg(bid), nblk);
      xcd_barrier(xb);
      gemm_phase(U, DM, WB + WB_OUT, 1024, 1024, 1024, EpiResid{X, modl + 2048, nullptr, 0}, smem, osg(bid), nblk);
      xcd_barrier(xb);
    } else if (layer == 1) {
      bfr* P = BIG;
      pool_ew_phase(H, P, osg(bid), nblk);
      xcd_barrier(xb);
      for (int g = 0; g < 4; ++g)
        gemm_phase(P + g * 256, DM, WB + WB_IN + g * 65536, 256, 256, 256,
                   EpiResid{X, modl + 2048 + g * 256, q.in[13] + g * 256, g * 256}, smem, osg(bid), nblk);
      xcd_barrier(xb);
    } else if (layer == 2) {
      bfr* UV = BIG;
      gemm_phase(H, DM, WB + WB_IN, 1024, 2048, 1024, EpiGelu{UV, 2048}, smem, osg(bid), nblk);
      xcd_barrier(xb);
      sgu_norm_phase(UV, q.in[15], osg(bid), nblk);
      xcd_barrier(xb);
      sgu_spatial_phase(UV, q.in[16], q.in[17], smem, osg(bid), nblk);
      xcd_barrier(xb);
      gemm_phase(UV, 2048, WB + WB_OUT, 1024, 1024, 1024, EpiResid{X, modl + 2048, nullptr, 0}, smem, osg(bid), nblk);
      xcd_barrier(xb);
    } else {
      bfr* QZ = BIG;
      gemm256_phase(H, DM, WB + WB_IN, 1024, 5120, 1024, EpiStore{QZ, 5120}, smem, osg(bid), nblk);
      xcd_barrier(xb);
      hgrn_scan_phase(q, smem, osg(bid), nblk, 0);
      xcd_barrier(xb);
      hgrn_combine_phase(q, osg(bid), nblk);
      xcd_barrier(xb);
      hgrn_scan_phase(q, smem, osg(bid), nblk, 1);
      xcd_barrier(xb);
      hgrn_gate_phase(q, q.in[21], osg(bid), nblk);
      xcd_barrier(xb);
      gemm_phase(H, DM, WB + WB_OUT, 1024, 1024, 1024, EpiResid{X, modl + 2048, nullptr, 0}, smem, osg(bid), nblk);
      xcd_barrier(xb);
    }

    norm_phase(X, q.in[7] + (layer * 2 + 1) * DM, modl, 3072, 4096, H, osg(bid), nblk);
    xcd_barrier(xb);
    bfr* ACT = BIG;
    float* EDGE = (float*)(q.ws + OFF_BIG + 115343360ull);
    const float* wdw = q.in[24] + (size_t)layer * 3 * 2 * DFF;
    gemm256_phase(H, DM, WB + WB_UP, 1024, 2 * DFF, 1024, EpiFfnUp{ACT, EDGE, wdw}, smem, osg(bid), nblk);
    xcd_barrier(xb);
    ffn_edge_phase(EDGE, wdw, ACT, osg(bid), nblk);
    xcd_barrier(xb);
    gemm_phase(ACT, DFF, WB + WB_DOWN, DFF, 1024, DFF, EpiResid{X, modl + 5120, nullptr, 0}, smem, osg(bid), nblk);
    xcd_barrier(xb);
  }
  final_norm_phase(p.out, p.in[8], osg(bid), nblk);
}

extern "C" void kernel_launch(void* const* d_in, const int* in_sizes, int n_in, void* d_out, int out_size,
                              void* d_ws, size_t ws_size, hipStream_t stream) {
  static int grid_blocks = 0;
  if (!grid_blocks) {
    int dev = 0, cus = 0, per_cu = 0;
    hipGetDevice(&dev);
    hipDeviceGetAttribute(&cus, hipDeviceAttributeMultiprocessorCount, dev);
    hipOccupancyMaxActiveBlocksPerMultiprocessor(&per_cu, mega_kernel, 256, 0);
    if (per_cu > 2) per_cu = 2;
    if (per_cu < 1) per_cu = 1;
    grid_blocks = cus * per_cu;
  }
  if (ws_size < WS_NEED) { fprintf(stderr, "workspace too small: %zu < %zu\n", ws_size, (size_t)WS_NEED); return; }
  Params p{};
  for (int i = 0; i < 26; ++i) p.in[i] = (const float*)d_in[i];
  p.out = (float*)d_out;
  p.ws = (char*)d_ws;
  hipMemsetAsync((char*)d_ws + OFF_BAR, 0, XCD_BAR_WORDS * 4, stream);
  void* args[] = {&p};
  hipError_t e = hipLaunchCooperativeKernel((void*)mega_kernel, dim3(grid_blocks), dim3(256), args, 0, stream);
  if (e != hipSuccess) fprintf(stderr, "cooperative launch failed: %s (grid %d)\n", hipGetErrorString(e), grid_blocks);
}
```

```cpp
#include <hip/hip_runtime.h>
#include <hip/hip_cooperative_groups.h>
#include <stdint.h>
#include <stdio.h>
namespace cg = cooperative_groups;

#define DEVINL __device__ __forceinline__
typedef unsigned short bfr;
using bf16x8 = __attribute__((ext_vector_type(8))) short;
using f32x4 = __attribute__((ext_vector_type(4))) float;
using u32x4 = __attribute__((ext_vector_type(4))) unsigned int;

constexpr int DM = 1024;
constexpr int MTOK = 20480;
constexpr int NPROMPT = 4096;
constexpr int DFF = 2816;
constexpr int HALF_FF = 1408;
constexpr float EPS = 1e-6f;

constexpr size_t OFF_MODP = 0;
constexpr size_t OFF_MOD = 7864320;
constexpr size_t OFF_LBS = OFF_MOD + 491520;
constexpr size_t OFF_BAR = OFF_LBS + 8192;
constexpr size_t OFF_WB = 8388608;
constexpr size_t OFF_H = 41943040;
constexpr size_t OFF_BIG = 83886080;
constexpr size_t WS_NEED = OFF_BIG + 251658240ull + 33554432ull + 262144ull;
constexpr size_t WB_IN = 0, WB_OUT = 5242880, WB_UP = 6291456, WB_DOWN = 12058624;

struct Params {
  const float* in[26];
  float* out;
  char* ws;
};

DEVINL int otid() { int t = threadIdx.x; asm volatile("" : "+v"(t)); return t; }
DEVINL int osg(int x) { asm volatile("" : "+s"(x)); return x; }
typedef __bf16 hbf16x2 __attribute__((ext_vector_type(2)));
typedef float hf32x2 __attribute__((ext_vector_type(2)));
DEVINL uint32_t pk2(float a, float b) {
  hf32x2 v = {a, b};
  hbf16x2 r = __builtin_convertvector(v, hbf16x2);
  return __builtin_bit_cast(uint32_t, r);
}
DEVINL bfr f2bf(float f) { return (bfr)(pk2(f, 0.f) & 0xffffu); }
DEVINL float bf2f(bfr h) { return __uint_as_float(((uint32_t)h) << 16); }
DEVINL float frcp(float x) { return __builtin_amdgcn_rcpf(x); }
DEVINL float bflo(uint32_t u) { return __uint_as_float(u << 16); }
DEVINL float bfhi(uint32_t u) { return __uint_as_float(u & 0xffff0000u); }
DEVINL int cond_of(int m) { return m < NPROMPT ? 0 : 1 + ((m - NPROMPT) >> 12); }
DEVINL float silu_f(float x) { return x * frcp(1.f + __expf(-x)); }
DEVINL float gelu_tanh_f(float x) {
  float y = 0.7978845608028654f * (x + 0.044715f * x * x * x);
  float t = 1.f - 2.f * frcp(__expf(2.f * y) + 1.f);
  return 0.5f * x * (1.f + t);
}
DEVINL float shx(float v, int o, int lane) {
  return __int_as_float(__builtin_amdgcn_ds_bpermute((lane ^ o) << 2, __float_as_int(v)));
}
DEVINL float wave_sum(float v, int lane) {
#pragma unroll
  for (int o = 32; o > 0; o >>= 1) v += shx(v, o, lane);
  return v;
}

DEVINL void tok_pos(int m, int& tl, int& T) {
  if (m < NPROMPT) { tl = m & 255; T = 256; } else { tl = (m - NPROMPT) & 4095; T = 4096; }
}

struct EpiNoPre {};
#define EPI_ELEMENTWISE_TILE                                                                       \
  typedef EpiNoPre Pre;                                                                             \
  DEVINL Pre pre(int tn, int tid) const { return Pre{}; }                                           \
  DEVINL void tile(const f32x4 (&acc)[4][4], const Pre& pre_, int m0, int n0, int tn, int wm, int wn, int l15, \
                   int quad, int tid, char* smem) const {                                           \
    _Pragma("unroll") for (int mt = 0; mt < 4; ++mt)                                                \
      _Pragma("unroll") for (int nt = 0; nt < 4; ++nt)                                              \
        (*this)(m0 + wm * 64 + mt * 16 + l15, n0 + wn * 64 + nt * 16 + quad * 4, acc[mt][nt]);      \
  }
struct EpiStore {
  bfr* C; int ldc;
  DEVINL void tile256(const f32x4 (&acc)[8][4], const EpiNoPre& pre_, int m0, int n0, int tn, int wm, int wn, int l15,
                      int quad, int tid, char* smem) const {
#pragma unroll
    for (int mt = 0; mt < 8; ++mt)
#pragma unroll
      for (int nt = 0; nt < 4; ++nt)
        (*this)(m0 + wm * 128 + mt * 16 + l15, n0 + wn * 64 + nt * 16 + quad * 4, acc[mt][nt]);
  }
  DEVINL void operator()(int m, int n, f32x4 v) const {
    uint2 o; o.x = pk2(v[0], v[1]); o.y = pk2(v[2], v[3]);
    *(uint2*)(C + (size_t)m * ldc + n) = o;
  }
  EPI_ELEMENTWISE_TILE
};
struct EpiGelu {
  bfr* C; int ldc;
  DEVINL void operator()(int m, int n, f32x4 v) const {
    uint2 o; o.x = pk2(gelu_tanh_f(v[0]), gelu_tanh_f(v[1])); o.y = pk2(gelu_tanh_f(v[2]), gelu_tanh_f(v[3]));
    *(uint2*)(C + (size_t)m * ldc + n) = o;
  }
  EPI_ELEMENTWISE_TILE
};
struct EpiResid {
  float* X; const float* gate; const float* cscale; int coff;
  DEVINL void operator()(int m, int n, f32x4 v) const {
    const int cond = cond_of(m);
    const float4 g = *(const float4*)(gate + cond * 6144 + n);
    float4* xp = (float4*)(X + (size_t)m * DM + coff + n);
    float4 x = *xp;
    float s0 = 1.f, s1 = 1.f, s2 = 1.f, s3 = 1.f;
    if (cscale) { const float4 s = *(const float4*)(cscale + n); s0 = s.x; s1 = s.y; s2 = s.z; s3 = s.w; }
    x.x += g.x * v[0] * s0; x.y += g.y * v[1] * s1; x.z += g.z * v[2] * s2; x.w += g.w * v[3] * s3;
    *xp = x;
  }
  EPI_ELEMENTWISE_TILE
};

#define LDS3 __attribute__((address_space(3)))
DEVINL void lds_barrier() { asm volatile("s_waitcnt lgkmcnt(0)\n\ts_barrier" ::: "memory"); }
template <class Epi>
DEVINL void gemm_phase(const bfr* __restrict__ A, int lda, const bfr* __restrict__ Bt, int ldb, int N, int K,
                       const Epi& epi, char* smem, int bid, int nblk) {
  const int tid = otid(), lane = tid & 63, wave = tid >> 6;
  const int wm = wave >> 1, wn = wave & 1, l15 = lane & 15, quad = lane >> 4;
  const int tilesN = N >> 7;
  const int ntiles = (MTOK >> 7) * tilesN;
  const int nk = K >> 6;
  const int srow0 = wave * 8 + (lane >> 3);
  const int lc = (lane & 7) ^ ((srow0 >> 1) & 7);
  const int fsw = (l15 >> 1) & 7;
  char* const dst0 = smem + wave * 1024 + lane * 16;
#define TILE_DECODE(t_, tm_, tn_) { const int xcd_ = (t_) & 7, u_ = (t_) >> 3; const int ur_ = u_ / tilesN; tn_ = u_ - ur_ * tilesN; tm_ = ur_ * 8 + xcd_; }
#define GLDS_STAGE(pa_, pb_, st_, kt_)                                                                    \
  {                                                                                                       \
    _Pragma("unroll") for (int i = 0; i < 4; ++i) {                                                       \
      __builtin_amdgcn_global_load_lds((const unsigned*)((pa_) + (size_t)(i * 32) * lda + (kt_) * 64),    \
                                       (LDS3 unsigned*)(dst0 + (st_) * 32768 + i * 4096), 16, 0, 0);      \
      __builtin_amdgcn_global_load_lds((const unsigned*)((pb_) + (size_t)(i * 32) * ldb + (kt_) * 64),    \
                                       (LDS3 unsigned*)(dst0 + (st_) * 32768 + 16384 + i * 4096), 16, 0, 0); \
    }                                                                                                     \
  }
  int tile = bid;
  if (tile >= ntiles) return;
  int tm, tn;
  TILE_DECODE(tile, tm, tn)
  const bfr* gA = A + (size_t)((tm << 7) + srow0) * lda + lc * 8;
  const bfr* gB = Bt + (size_t)((tn << 7) + srow0) * ldb + lc * 8;
  __syncthreads();
  GLDS_STAGE(gA, gB, 0, 0)
  for (; tile < ntiles; tile += nblk) {
    const int m0 = tm << 7, n0 = tn << 7, tn_cur = tn;
    const bool has_next = (tile + nblk < ntiles);
    const bfr* gAn = gA; const bfr* gBn = gB;
    if (has_next) {
      TILE_DECODE(tile + nblk, tm, tn)
      gAn = A + (size_t)((tm << 7) + srow0) * lda + lc * 8;
      gBn = Bt + (size_t)((tn << 7) + srow0) * ldb + lc * 8;
    }
    typename Epi::Pre pre = epi.pre(tn_cur, tid);
    f32x4 acc[4][4];
#pragma unroll
    for (int i = 0; i < 4; ++i)
#pragma unroll
      for (int j = 0; j < 4; ++j) acc[i][j] = f32x4{0.f, 0.f, 0.f, 0.f};
    __syncthreads();
    for (int kt = 0; kt < nk; ++kt) {
      const int st = kt & 1;
      const bool cur = (kt + 1 < nk);
      const bool any = cur || has_next;
      const bfr* sa = cur ? gA + (kt + 1) * 64 : gAn;
      const bfr* sb = cur ? gB + (kt + 1) * 64 : gBn;
      char* sd = dst0 + (cur ? (st ^ 1) : 0) * 32768;
      const char* cA = smem + st * 32768 + (wm * 64 + l15) * 128;
      const char* cB = smem + st * 32768 + 16384 + (wn * 64 + l15) * 128;
      {
        const int co0 = (quad ^ fsw) * 16, co1 = ((4 + quad) ^ fsw) * 16;
        bf16x8 af0[4], bf0[4], af1[4], bf1[4];
#pragma unroll
        for (int i = 0; i < 4; ++i) {
          af0[i] = *(const bf16x8*)(cA + i * 2048 + co0);
          bf0[i] = *(const bf16x8*)(cB + i * 2048 + co0);
        }
#pragma unroll
        for (int i = 0; i < 4; ++i) {
          af1[i] = *(const bf16x8*)(cA + i * 2048 + co1);
          bf1[i] = *(const bf16x8*)(cB + i * 2048 + co1);
        }
        __builtin_amdgcn_sched_barrier(0);
#pragma unroll
        for (int mt = 0; mt < 4; ++mt) {
#pragma unroll
          for (int nt = 0; nt < 4; ++nt)
            acc[mt][nt] = __builtin_amdgcn_mfma_f32_16x16x32_bf16(bf0[nt], af0[mt], acc[mt][nt], 0, 0, 0);
          if (any) {
            __builtin_amdgcn_global_load_lds((const unsigned*)(sa + (size_t)(mt * 32) * lda), (LDS3 unsigned*)(sd + mt * 4096), 16, 0, 0);
            __builtin_amdgcn_global_load_lds((const unsigned*)(sb + (size_t)(mt * 32) * ldb), (LDS3 unsigned*)(sd + 16384 + mt * 4096), 16, 0, 0);
          }
          __builtin_amdgcn_sched_barrier(0);
        }
#pragma unroll
        for (int mt = 0; mt < 4; ++mt)
#pragma unroll
          for (int nt = 0; nt < 4; ++nt)
            acc[mt][nt] = __builtin_amdgcn_mfma_f32_16x16x32_bf16(bf1[nt], af1[mt], acc[mt][nt], 0, 0, 0);
        __builtin_amdgcn_sched_barrier(0);
      }
      if (kt + 1 < nk) __syncthreads();
    }
    epi.tile(acc, pre, m0, n0, tn_cur, wm, wn, l15, quad, tid, smem);
    gA = gAn; gB = gBn;
  }
}

constexpr int EDGE_LD = 2 * DFF;
struct FfnPre { f32x4 wa[3], wb[3]; };
DEVINL void ffn_conv_rows(const bfr* T, const FfnPre& pre_, bfr* ACT, float* EDGE, int m0, int n0, int tn, int tid) {
  const int c4 = (tid & 15) * 4, r0 = (tid >> 4) * 8;
  const int ja = tn * 64 + c4;
  int tl, Tlen; tok_pos(m0, tl, Tlen);
  const bool top_ok = (tl == 0), bot_ok = (tl + 128 == Tlen);
  if (tid < 128) {
    const int e = tid >> 5, c = (tid & 31) * 4;
    const int r = (e < 2) ? e : 124 + e;
    const uint2 v = *(const uint2*)(T + r * 136 + c);
    *(f32x4*)(EDGE + ((size_t)(m0 >> 7) * 4 + e) * EDGE_LD + n0 + c) = f32x4{bflo(v.x), bfhi(v.x), bflo(v.y), bfhi(v.y)};
  }
  const f32x4 zero = f32x4{0.f, 0.f, 0.f, 0.f};
#define LDT(dst, row, col) { const uint2 v_ = *(const uint2*)(T + (row) * 136 + (col)); dst = f32x4{bflo(v_.x), bfhi(v_.x), bflo(v_.y), bfhi(v_.y)}; }
  f32x4 pa = zero, pb = zero, ca, cb, na, nb;
  if (r0 > 0) { LDT(pa, r0 - 1, c4) LDT(pb, r0 - 1, 64 + c4) }
  LDT(ca, r0, c4) LDT(cb, r0, 64 + c4)
#pragma unroll
  for (int i = 0; i < 8; ++i) {
    const int r = r0 + i;
    if (r < 127) { LDT(na, r + 1, c4) LDT(nb, r + 1, 64 + c4) }
    else { na = zero; nb = zero; }
    const bool ok = (r > 0 || top_ok) && (r < 127 || bot_ok);
    if (ok) {
      const f32x4 a = pre_.wa[0] * pa + pre_.wa[1] * ca + pre_.wa[2] * na;
      const f32x4 b = pre_.wb[0] * pb + pre_.wb[1] * cb + pre_.wb[2] * nb;
      uint2 o;
      o.x = pk2(silu_f(a[0]) * b[0], silu_f(a[1]) * b[1]);
      o.y = pk2(silu_f(a[2]) * b[2], silu_f(a[3]) * b[3]);
      *(uint2*)(ACT + (size_t)(m0 + r) * DFF + ja) = o;
    }
    pa = ca; pb = cb; ca = na; cb = nb;
  }
#undef LDT
}
struct EpiFfnUp {
  bfr* ACT; float* EDGE; const float* wdw;
  typedef FfnPre Pre;
  DEVINL Pre pre(int tn, int tid) const {
    Pre q;
    const int ja = tn * 64 + (tid & 15) * 4;
#pragma unroll
    for (int t = 0; t < 3; ++t) {
      q.wa[t] = *(const f32x4*)(wdw + t * (2 * DFF) + ja);
      q.wb[t] = *(const f32x4*)(wdw + t * (2 * DFF) + DFF + ja);
    }
    return q;
  }
  DEVINL void tile(const f32x4 (&acc)[4][4], const Pre& pre_, int m0, int n0, int tn, int wm, int wn, int l15, int quad,
                   int tid, char* smem) const {
    bfr* T = (bfr*)(smem + 32768);
    lds_barrier();
#pragma unroll
    for (int mt = 0; mt < 4; ++mt)
#pragma unroll
      for (int nt = 0; nt < 4; ++nt) {
        uint2 o; o.x = pk2(acc[mt][nt][0], acc[mt][nt][1]); o.y = pk2(acc[mt][nt][2], acc[mt][nt][3]);
        *(uint2*)(T + (wm * 64 + mt * 16 + l15) * 136 + wn * 64 + nt * 16 + quad * 4) = o;
      }
    lds_barrier();
    ffn_conv_rows(T, pre_, ACT, EDGE, m0, n0, tn, tid);
  }
  DEVINL void tile256(const f32x4 (&acc)[8][4], const Pre& pre_, int m0, int n0, int tn, int wm, int wn, int l15, int quad,
                      int tid, char* smem) const {
    bfr* T = (bfr*)(smem + 24576);
#pragma unroll
    for (int hh = 0; hh < 2; ++hh) {
      lds_barrier();
      if (wm == hh) {
#pragma unroll
        for (int mt = 0; mt < 8; ++mt)
#pragma unroll
          for (int nt = 0; nt < 4; ++nt) {
            uint2 o; o.x = pk2(acc[mt][nt][0], acc[mt][nt][1]); o.y = pk2(acc[mt][nt][2], acc[mt][nt][3]);
            *(uint2*)(T + (mt * 16 + l15) * 136 + wn * 64 + nt * 16 + quad * 4) = o;
          }
      }
      lds_barrier();
      ffn_conv_rows(T, pre_, ACT, EDGE, m0 + hh * 128, n0, tn, tid);
    }
  }
};


template <class Epi>
DEVINL void gemm256_phase(const bfr* __restrict__ A, int lda, const bfr* __restrict__ Bt, int ldb, int N, int K,
                          const Epi& epi, char* smem, int bid, int nblk) {
  const int tid = otid(), lane = tid & 63, wave = tid >> 6;
  const int wm = wave >> 1, wn = wave & 1, l15 = lane & 15, quad = lane >> 4;
  const int tilesN = N >> 7;
  const int ntiles = (MTOK >> 8) * tilesN;
  const int nk = K >> 5;
  const int srow0 = wave * 16 + (lane >> 2);
  const int lc = (lane & 3) ^ ((0 - (lane >> 4)) & 3);
  const int fsw = (0 - (l15 >> 2)) & 3;
  char* const dst0 = smem + wave * 1024 + lane * 16;
#define TILE_DECODE2(t_, tm_, tn_) { const int xcd_ = (t_) & 7, u_ = (t_) >> 3; const int ur_ = u_ / tilesN; tn_ = u_ - ur_ * tilesN; tm_ = ur_ * 8 + xcd_; }
#define GLDS_STAGE2(pa_, pb_, st_, kt_)                                                                   \
  {                                                                                                       \
    _Pragma("unroll") for (int i = 0; i < 4; ++i)                                                         \
      __builtin_amdgcn_global_load_lds((const unsigned*)((pa_) + (size_t)(i * 64) * lda + (kt_) * 32),    \
                                       (LDS3 unsigned*)(dst0 + (st_) * 24576 + i * 4096), 16, 0, 0);      \
    _Pragma("unroll") for (int i = 0; i < 2; ++i)                                                         \
      __builtin_amdgcn_global_load_lds((const unsigned*)((pb_) + (size_t)(i * 64) * ldb + (kt_) * 32),    \
                                       (LDS3 unsigned*)(dst0 + (st_) * 24576 + 16384 + i * 4096), 16, 0, 0); \
  }
  int tile = bid;
  if (tile >= ntiles) return;
  int tm, tn;
  TILE_DECODE2(tile, tm, tn)
  const bfr* gA = A + (size_t)((tm << 8) + srow0) * lda + lc * 8;
  const bfr* gB = Bt + (size_t)((tn << 7) + srow0) * ldb + lc * 8;
  __syncthreads();
  GLDS_STAGE2(gA, gB, 0, 0)
  for (; tile < ntiles; tile += nblk) {
    const int m0 = tm << 8, n0 = tn << 7, tn_cur = tn;
    const bool has_next = (tile + nblk < ntiles);
    const bfr* gAn = gA; const bfr* gBn = gB;
    if (has_next) {
      TILE_DECODE2(tile + nblk, tm, tn)
      gAn = A + (size_t)((tm << 8) + srow0) * lda + lc * 8;
      gBn = Bt + (size_t)((tn << 7) + srow0) * ldb + lc * 8;
    }
    f32x4 acc[8][4];
#pragma unroll
    for (int i = 0; i < 8; ++i)
#pragma unroll
      for (int j = 0; j < 4; ++j) acc[i][j] = f32x4{0.f, 0.f, 0.f, 0.f};
    __syncthreads();
    for (int kt = 0; kt < nk; ++kt) {
      const int st = kt & 1;
      const bool cur = (kt + 1 < nk);
      const bool any = cur || has_next;
      const bfr* sa = cur ? gA + (kt + 1) * 32 : gAn;
      const bfr* sb = cur ? gB + (kt + 1) * 32 : gBn;
      char* sd = dst0 + (cur ? (st ^ 1) : 0) * 24576;
      const char* cA = smem + st * 24576 + (wm * 128 + l15) * 64 + ((quad ^ fsw) * 16);
      const char* cB = smem + st * 24576 + 16384 + (wn * 64 + l15) * 64 + ((quad ^ fsw) * 16);
      bf16x8 bfg[4];
#pragma unroll
      for (int i = 0; i < 4; ++i) bfg[i] = *(const bf16x8*)(cB + i * 1024);
#pragma unroll
      for (int hm = 0; hm < 2; ++hm) {
        bf16x8 af[4];
#pragma unroll
        for (int i = 0; i < 4; ++i) af[i] = *(const bf16x8*)(cA + (hm * 4 + i) * 1024);
        __builtin_amdgcn_sched_barrier(0);
#pragma unroll
        for (int mt = 0; mt < 4; ++mt) {
#pragma unroll
          for (int nt = 0; nt < 4; ++nt)
            acc[hm * 4 + mt][nt] = __builtin_amdgcn_mfma_f32_16x16x32_bf16(bfg[nt], af[mt], acc[hm * 4 + mt][nt], 0, 0, 0);
          const int g = hm * 4 + mt;
          if (any && g < 4)
            __builtin_amdgcn_global_load_lds((const unsigned*)(sa + (size_t)(g * 64) * lda), (LDS3 unsigned*)(sd + g * 4096), 16, 0, 0);
          else if (any && g < 6)
            __builtin_amdgcn_global_load_lds((const unsigned*)(sb + (size_t)((g - 4) * 64) * ldb), (LDS3 unsigned*)(sd + 16384 + (g - 4) * 4096), 16, 0, 0);
          __builtin_amdgcn_sched_barrier(0);
        }
      }
      if (kt + 1 < nk) __syncthreads();
    }
    {
      typename Epi::Pre pre = epi.pre(tn_cur, tid);
      epi.tile256(acc, pre, m0, n0, tn_cur, wm, wn, l15, quad, tid, smem);
    }
    gA = gAn; gB = gBn;
  }
}

DEVINL void ffn_edge_phase(const float* __restrict__ EDGE, const float* __restrict__ wdw, bfr* __restrict__ ACT, int bid, int nblk) {
  const int gt = bid * 256 + otid(), nt = nblk * 256;
  for (int i = gt; i < 160 * 2 * 704; i += nt) {
    const int cg4 = i % 704, r2 = i / 704, side = r2 & 1, tm = r2 >> 1;
    const int m0 = tm << 7;
    int tl, Tlen; tok_pos(m0, tl, Tlen);
    if (side == 0 ? (tl == 0) : (tl + 128 == Tlen)) continue;
    const int ja = cg4 * 4;
    const int nb_ = ja >> 6, cc = ja & 63;
    const int ea = nb_ * 128 + cc, eb = ea + 64;
    const float* prev; const float* cur; const float* next;
    if (side == 0) {
      prev = EDGE + ((size_t)(tm - 1) * 4 + 3) * EDGE_LD; cur = EDGE + ((size_t)tm * 4 + 0) * EDGE_LD; next = EDGE + ((size_t)tm * 4 + 1) * EDGE_LD;
    } else {
      prev = EDGE + ((size_t)tm * 4 + 2) * EDGE_LD; cur = EDGE + ((size_t)tm * 4 + 3) * EDGE_LD; next = EDGE + ((size_t)(tm + 1) * 4 + 0) * EDGE_LD;
    }
    const f32x4 a = *(const f32x4*)(wdw + ja) * *(const f32x4*)(prev + ea) + *(const f32x4*)(wdw + 2 * DFF + ja) * *(const f32x4*)(cur + ea) +
                    *(const f32x4*)(wdw + 4 * DFF + ja) * *(const f32x4*)(next + ea);
    const f32x4 b = *(const f32x4*)(wdw + DFF + ja) * *(const f32x4*)(prev + eb) + *(const f32x4*)(wdw + 3 * DFF + ja) * *(const f32x4*)(cur + eb) +
                    *(const f32x4*)(wdw + 5 * DFF + ja) * *(const f32x4*)(next + eb);
    uint2 o;
    o.x = pk2(silu_f(a[0]) * b[0], silu_f(a[1]) * b[1]);
    o.y = pk2(silu_f(a[2]) * b[2], silu_f(a[3]) * b[3]);
    const int m = m0 + (side ? 127 : 0);
    *(uint2*)(ACT + (size_t)m * DFF + ja) = o;
  }
}

DEVINL int up_perm(int n0) {
  if (n0 < DFF) return (n0 >> 6) * 128;
  return ((n0 - DFF) >> 6) * 128 + 64;
}
DEVINL void conv_matrix(const float* __restrict__ src, int K, int N, bfr* __restrict__ dst, int perm,
                        char* smem, int bid, int nblk) {
  float* sT = (float*)smem;
  const int tid = otid();
  const int tilesN = N >> 6;
  const int ntiles = (K >> 6) * tilesN;
  for (int t = bid; t < ntiles; t += nblk) {
    const int tk = t / tilesN, tn = t - tk * tilesN;
    const int k0 = tk << 6, n0 = tn << 6;
    const int r = tid >> 4, c4 = tid & 15;
    __syncthreads();
#pragma unroll
    for (int i = 0; i < 4; ++i) {
      const float4 v = *(const float4*)(src + (size_t)(k0 + r + i * 16) * N + n0 + c4 * 4);
      float* d = sT + (r + i * 16) * 65 + c4 * 4;
      d[0] = v.x; d[1] = v.y; d[2] = v.z; d[3] = v.w;
    }
    __syncthreads();
    const int n = tid >> 2, kc = tid & 3;
    uint32_t w[8];
#pragma unroll
    for (int j = 0; j < 8; ++j)
      w[j] = pk2(sT[(kc * 16 + 2 * j) * 65 + n], sT[(kc * 16 + 2 * j + 1) * 65 + n]);
    const int nd = (perm ? up_perm(n0) : n0) + n;
    bfr* dp = dst + (size_t)nd * K + k0 + kc * 16;
    *(uint4*)dp = make_uint4(w[0], w[1], w[2], w[3]);
    *(uint4*)(dp + 8) = make_uint4(w[4], w[5], w[6], w[7]);
  }
}

DEVINL void phase0a(const Params& p, char* smem, int bid, int nblk) {
  const int tid = otid();
  float* sc = (float*)smem;
  float* modp = (float*)(p.ws + OFF_MODP);
  const float* cvec = p.in[3];
  const float* cctx = p.in[4];
  const float* ada_w = p.in[5];
  for (int job = bid; job < 384; job += nblk) {
    const int l = job / 96, r = job - l * 96, ks = r / 6, cgp = r - ks * 6;
    __syncthreads();
    for (int i = tid; i < 320; i += 256) {
      const int cond = i >> 6, kk = i & 63;
      const float v = cond == 0 ? cctx[ks * 64 + kk] : cvec[(cond - 1) * DM + ks * 64 + kk];
      sc[i] = silu_f(v);
    }
    __syncthreads();
    const int col = cgp * 1024 + tid * 4;
    const float* wp = ada_w + ((size_t)l * DM + ks * 64) * 6144 + col;
    float a[5][4];
#pragma unroll
    for (int c = 0; c < 5; ++c)
#pragma unroll
      for (int j = 0; j < 4; ++j) a[c][j] = 0.f;
#pragma unroll 8
    for (int kk = 0; kk < 64; ++kk) {
      const float4 w = *(const float4*)(wp + (size_t)kk * 6144);
#pragma unroll
      for (int c = 0; c < 5; ++c) {
        const float s = sc[c * 64 + kk];
        a[c][0] += s * w.x; a[c][1] += s * w.y; a[c][2] += s * w.z; a[c][3] += s * w.w;
      }
    }
#pragma unroll
    for (int c = 0; c < 5; ++c)
      *(float4*)(modp + ((size_t)(ks * 4 + l) * 5 + c) * 6144 + col) = make_float4(a[c][0], a[c][1], a[c][2], a[c][3]);
  }
  const int gt = bid * 256 + tid, nt = nblk * 256;
  {
    const float* lb = p.in[20];
    float* lbs = (float*)(p.ws + OFF_LBS);
    for (int i = gt; i < 2048; i += nt) {
      const float v0 = lb[i], v1 = lb[2048 + i], v2 = lb[4096 + i], v3 = lb[6144 + i];
      const float mx = fmaxf(fmaxf(v0, v1), fmaxf(v2, v3));
      const float e0 = expf(v0 - mx), e1 = expf(v1 - mx), e2 = expf(v2 - mx), e3 = expf(v3 - mx);
      lbs[i] = (e1 + e2 + e3) / (e0 + e1 + e2 + e3);
    }
  }
  float* X = p.out;
  {
    const float4* xp = (const float4*)p.in[0];
    float4* xo = (float4*)X;
    for (int i = gt; i < NPROMPT * DM / 4; i += nt) xo[i] = xp[i];
    const float* xs = p.in[1];
    for (int i = gt; i < 4096 * 256; i += nt) {
      const int t = i >> 8, c = (i & 255) * 4;
      const int part = c >> 8;
      const float pos = (float)((part < 2) ? (t >> 6) : (t & 63));
      float pe[4];
#pragma unroll
      for (int j = 0; j < 4; ++j) {
        const int jj = (c + j) & 255;
        const float freq = expf((-9.210340371976184f * (float)jj) / 256.0f);
        const float arg = pos * freq;
        pe[j] = (part & 1) ? cosf(arg) : sinf(arg);
      }
#pragma unroll
      for (int b = 0; b < 4; ++b) {
        const size_t off = ((size_t)b * 4096 + t) * DM + c;
        float4 v = *(const float4*)(xs + off);
        v.x += pe[0]; v.y += pe[1]; v.z += pe[2]; v.w += pe[3];
        *(float4*)(X + (size_t)NPROMPT * DM + off) = v;
      }
    }
  }
}

DEVINL void phase0b(const Params& p, int bid, int nblk) {
  const int gt = bid * 256 + otid(), nt = nblk * 256;
  const float* modp = (const float*)(p.ws + OFF_MODP);
  float* mod = (float*)(p.ws + OFF_MOD);
  const float* ada_b = p.in[6];
  for (int i = gt; i < 4 * 5 * 6144; i += nt) {
    const int l = i / 30720, col = i % 6144;
    float s = ada_b[l * 6144 + col];
#pragma unroll
    for (int ks = 0; ks < 16; ++ks) s += modp[(size_t)ks * 122880 + i];
    mod[i] = s;
  }
}

DEVINL void norm_phase(const float* __restrict__ X, const float* __restrict__ g, const float* __restrict__ modl,
                       int shift_off, int scale_off, bfr* __restrict__ H, int bid, int nblk) {
  const int tid = otid(); const int lane = tid & 63;
  const int gw = bid * 4 + (tid >> 6), nw = nblk * 4;
  for (int row = gw; row < MTOK; row += nw) {
    const float* xr = X + (size_t)row * DM;
    float4 x[4];
    float ss = 0.f;
#pragma unroll
    for (int i = 0; i < 4; ++i) {
      x[i] = *(const float4*)(xr + i * 256 + lane * 4);
      ss += x[i].x * x[i].x + x[i].y * x[i].y + x[i].z * x[i].z + x[i].w * x[i].w;
    }
    ss = wave_sum(ss, lane);
    const float rstd = rsqrtf(ss * (1.f / DM) + EPS);
    const float* mc = modl + cond_of(row) * 6144;
#pragma unroll
    for (int i = 0; i < 4; ++i) {
      const int c = i * 256 + lane * 4;
      const float4 gg = *(const float4*)(g + c);
      const float4 sh = *(const float4*)(mc + shift_off + c);
      const float4 sc = *(const float4*)(mc + scale_off + c);
      const float h0 = x[i].x * rstd * gg.x * (1.f + sc.x) + sh.x;
      const float h1 = x[i].y * rstd * gg.y * (1.f + sc.y) + sh.y;
      const float h2 = x[i].z * rstd * gg.z * (1.f + sc.z) + sh.z;
      const float h3 = x[i].w * rstd * gg.w * (1.f + sc.w) + sh.w;
      uint2 o; o.x = pk2(h0, h1); o.y = pk2(h2, h3);
      *(uint2*)(H + (size_t)row * DM + c) = o;
    }
  }
}

DEVINL void final_norm_phase(float* X, const float* __restrict__ g, int bid, int nblk) {
  const int tid = otid(); const int lane = tid & 63;
  const int gw = bid * 4 + (tid >> 6), nw = nblk * 4;
  for (int row = gw; row < MTOK; row += nw) {
    float* xr = X + (size_t)row * DM;
    float4 x[4];
    float ss = 0.f;
#pragma unroll
    for (int i = 0; i < 4; ++i) {
      x[i] = *(const float4*)(xr + i * 256 + lane * 4);
      ss += x[i].x * x[i].x + x[i].y * x[i].y + x[i].z * x[i].z + x[i].w * x[i].w;
    }
    ss = wave_sum(ss, lane);
    const float rstd = rsqrtf(ss * (1.f / DM) + EPS);
#pragma unroll
    for (int i = 0; i < 4; ++i) {
      const int c = i * 256 + lane * 4;
      const float4 gg = *(const float4*)(g + c);
      float4 o;
      o.x = x[i].x * rstd * gg.x; o.y = x[i].y * rstd * gg.y; o.z = x[i].z * rstd * gg.z; o.w = x[i].w * rstd * gg.w;
      *(float4*)(xr + c) = o;
    }
  }
}

DEVINL void shortconv_ew_phase(const bfr* __restrict__ G, const float* __restrict__ wdw, bfr* __restrict__ U, int bid, int nblk) {
  const int gt = bid * 256 + otid(), nt = nblk * 256;
  for (int i = gt; i < MTOK * 128; i += nt) {
    const int m = i >> 7, c = (i & 127) * 8;
    int tl, T; tok_pos(m, tl, T);
    const bfr* gr = G + (size_t)m * 3072;
    const uint4 bg = *(const uint4*)(gr + c);
    float accv[8];
#pragma unroll
    for (int j = 0; j < 8; ++j) accv[j] = 0.f;
#pragma unroll
    for (int tap = 0; tap < 3; ++tap) {
      const int d = tap - 1;
      if ((d < 0 && tl == 0) || (d > 0 && tl == T - 1)) continue;
      const bfr* nr = gr + (ptrdiff_t)d * 3072;
      const uint4 cgv = *(const uint4*)(nr + 1024 + c);
      const uint4 xhv = *(const uint4*)(nr + 2048 + c);
      const float4 w0 = *(const float4*)(wdw + tap * DM + c);
      const float4 w1 = *(const float4*)(wdw + tap * DM + c + 4);
      accv[0] += w0.x * bflo(cgv.x) * bflo(xhv.x); accv[1] += w0.y * bfhi(cgv.x) * bfhi(xhv.x);
      accv[2] += w0.z * bflo(cgv.y) * bflo(xhv.y); accv[3] += w0.w * bfhi(cgv.y) * bfhi(xhv.y);
      accv[4] += w1.x * bflo(cgv.z) * bflo(xhv.z); accv[5] += w1.y * bfhi(cgv.z) * bfhi(xhv.z);
      accv[6] += w1.z * bflo(cgv.w) * bflo(xhv.w); accv[7] += w1.w * bfhi(cgv.w) * bfhi(xhv.w);
    }
    uint4 o;
    o.x = pk2(bflo(bg.x) * accv[0], bfhi(bg.x) * accv[1]);
    o.y = pk2(bflo(bg.y) * accv[2], bfhi(bg.y) * accv[3]);
    o.z = pk2(bflo(bg.z) * accv[4], bfhi(bg.z) * accv[5]);
    o.w = pk2(bflo(bg.w) * accv[6], bfhi(bg.w) * accv[7]);
    *(uint4*)(U + (size_t)m * DM + c) = o;
  }
}

DEVINL void pool_ew_phase(const bfr* __restrict__ H, bfr* __restrict__ P, int bid, int nblk) {
  const int gt = bid * 256 + otid(), nt = nblk * 256;
  for (int i = gt; i < MTOK * 128; i += nt) {
    const int m = i >> 7, ch = i & 127, c = ch * 8;
    int tl, T; tok_pos(m, tl, T);
    const int hw = 1 << (ch >> 5);
    const int lo = max(tl - hw, 0), hi = min(tl + hw, T);
    float s[8];
#pragma unroll
    for (int j = 0; j < 8; ++j) s[j] = 0.f;
    const bfr* base = H + (size_t)(m - tl) * DM + c;
    for (int q = lo; q < hi; ++q) {
      const uint4 v = *(const uint4*)(base + (size_t)q * DM);
      s[0] += bflo(v.x); s[1] += bfhi(v.x); s[2] += bflo(v.y); s[3] += bfhi(v.y);
      s[4] += bflo(v.z); s[5] += bfhi(v.z); s[6] += bflo(v.w); s[7] += bfhi(v.w);
    }
    const float inv = 1.f / (float)(hi - lo);
    const uint4 v = *(const uint4*)(base + (size_t)tl * DM);
    uint4 o;
    o.x = pk2(s[0] * inv - bflo(v.x), s[1] * inv - bfhi(v.x));
    o.y = pk2(s[2] * inv - bflo(v.y), s[3] * inv - bfhi(v.y));
    o.z = pk2(s[4] * inv - bflo(v.z), s[5] * inv - bfhi(v.z));
    o.w = pk2(s[6] * inv - bflo(v.w), s[7] * inv - bfhi(v.w));
    *(uint4*)(P + (size_t)m * DM + c) = o;
  }
}

DEVINL void sgu_norm_phase(bfr* UV, const float* __restrict__ g, int bid, int nblk) {
  const int tid = otid(); const int lane = tid & 63;
  const int gw = bid * 4 + (tid >> 6), nw = nblk * 4;
  for (int row = gw; row < MTOK; row += nw) {
    bfr* vr = UV + (size_t)row * 2048 + 1024;
    float x[4][4];
    float ss = 0.f;
#pragma unroll
    for (int i = 0; i < 4; ++i) {
      const uint2 v = *(const uint2*)(vr + i * 256 + lane * 4);
      x[i][0] = bflo(v.x); x[i][1] = bfhi(v.x); x[i][2] = bflo(v.y); x[i][3] = bfhi(v.y);
      ss += x[i][0] * x[i][0] + x[i][1] * x[i][1] + x[i][2] * x[i][2] + x[i][3] * x[i][3];
    }
    ss = wave_sum(ss, lane);
    const float rstd = rsqrtf(ss * (1.f / DM) + EPS);
#pragma unroll
    for (int i = 0; i < 4; ++i) {
      const int c = i * 256 + lane * 4;
      const float4 gg = *(const float4*)(g + c);
      uint2 o;
      o.x = pk2(x[i][0] * rstd * gg.x, x[i][1] * rstd * gg.y);
      o.y = pk2(x[i][2] * rstd * gg.z, x[i][3] * rstd * gg.w);
      *(uint2*)(vr + c) = o;
    }
  }
}

DEVINL void sgu_spatial_phase(bfr* UV, const float* __restrict__ ws_, const float* __restrict__ bs_, char* smem, int bid, int nblk) {
  bfr* sV = (bfr*)smem;
  bfr* sW = sV + 128 * 136;
  const int tid = otid(), lane = tid & 63, wave = tid >> 6, l15 = lane & 15, quad = lane >> 4;
  for (int item = bid; item < 160 * 8; item += nblk) {
    const int chunk = item >> 3, g = item & 7;
    __syncthreads();
    const float* wg = ws_ + (size_t)g * 16384;
#pragma unroll 4
    for (int i = 0; i < 16; ++i) {
      const int idx = tid + 256 * i;
      const int row = idx >> 5, chn = idx & 31;
      const float4 v = *(const float4*)(wg + row * 128 + chn * 4);
      uint2 o; o.x = pk2(v.x, v.y); o.y = pk2(v.z, v.w);
      *(uint2*)(sW + row * 136 + chn * 4) = o;
    }
#pragma unroll 2
    for (int i = 0; i < 8; ++i) {
      const int idx = tid + 256 * i;
      const int q = idx >> 4, chn = idx & 15;
      const uint4 v = *(const uint4*)(UV + (size_t)(chunk * 128 + q) * 2048 + 1024 + g * 128 + chn * 8);
      bfr* d = sV + (chn * 8) * 136 + q;
      d[0 * 136] = (bfr)(v.x & 0xffff); d[1 * 136] = (bfr)(v.x >> 16);
      d[2 * 136] = (bfr)(v.y & 0xffff); d[3 * 136] = (bfr)(v.y >> 16);
      d[4 * 136] = (bfr)(v.z & 0xffff); d[5 * 136] = (bfr)(v.z >> 16);
      d[6 * 136] = (bfr)(v.w & 0xffff); d[7 * 136] = (bfr)(v.w >> 16);
    }
    __syncthreads();
    f32x4 acc[8][2];
#pragma unroll
    for (int i = 0; i < 8; ++i) { acc[i][0] = f32x4{0.f, 0.f, 0.f, 0.f}; acc[i][1] = f32x4{0.f, 0.f, 0.f, 0.f}; }
#pragma unroll
    for (int kk = 0; kk < 4; ++kk) {
      bf16x8 bw[2];
#pragma unroll
      for (int pt = 0; pt < 2; ++pt) bw[pt] = *(const bf16x8*)(sW + (wave * 32 + pt * 16 + l15) * 136 + kk * 32 + quad * 8);
#pragma unroll
      for (int ct = 0; ct < 8; ++ct) {
        const bf16x8 av = *(const bf16x8*)(sV + (ct * 16 + l15) * 136 + kk * 32 + quad * 8);
#pragma unroll
        for (int pt = 0; pt < 2; ++pt)
          acc[ct][pt] = __builtin_amdgcn_mfma_f32_16x16x32_bf16(av, bw[pt], acc[ct][pt], 0, 0, 0);
      }
    }
#pragma unroll
    for (int pt = 0; pt < 2; ++pt) {
      const int pp = wave * 32 + pt * 16 + l15;
      const float bias = bs_[g * 128 + pp];
      bfr* ur = UV + (size_t)(chunk * 128 + pp) * 2048 + g * 128 + quad * 4;
#pragma unroll
      for (int ct = 0; ct < 8; ++ct) {
        const uint2 u = *(const uint2*)(ur + ct * 16);
        uint2 o;
        o.x = pk2(bflo(u.x) * (acc[ct][pt][0] + bias), bfhi(u.x) * (acc[ct][pt][1] + bias));
        o.y = pk2(bflo(u.y) * (acc[ct][pt][2] + bias), bfhi(u.y) * (acc[ct][pt][3] + bias));
        *(uint2*)(ur + ct * 16) = o;
      }
    }
  }
}

DEVINL void hgrn_scan_phase(const Params& p, char* smem, int bid, int nblk, const int mode) {
  bfr* sQe = (bfr*)smem;
  bfr* sKe = sQe + 32 * 136;
  bfr* sKeT = sKe + 32 * 136;
  bfr* sVT = sKeT + 128 * 40;
  bfr* sP = sVT + 64 * 40;
  bfr* sST = sP + 32 * 40;
  float* sLast = (float*)(sST + 64 * 136);
  float* sTot = sLast + 128;
  const int tid = otid(), lane = tid & 63, wave = tid >> 6, l15 = lane & 15, quad = lane >> 4;
  const int cp = lane, qt = wave, i0 = qt * 8;
  const bfr* QZ = (const bfr*)(p.ws + OFF_BIG);
  bfr* Of = (bfr*)(p.ws + OFF_H);
  bfr* Ob = (bfr*)(p.ws + OFF_BIG + 209715200ull);
  const float* lbs = (const float*)(p.ws + OFF_LBS);
  const float* state_rec = p.in[2];
  float* out_state = p.out + (size_t)MTOK * DM;

  float* SLOC = (float*)(p.ws + OFF_BIG + 251658240ull);
  float* DLOC = (float*)(p.ws + OFF_BIG + 251658240ull + 33554432ull);
  const int nitems = mode ? 1536 : 896;
  for (int item = bid; item < nitems; item += nblk) {
    const int eh = item & 1, dir = (item >> 1) & 1, h = (item >> 2) & 7;
    int base, T, nchunks, pos0, slot, seq;
    bool is_prompt = false;
    if (!mode) {
      const int r = item >> 5, seqb = r / 7, j = r - seqb * 7;
      seq = 16 + seqb; base = NPROMPT + seqb * 4096; T = 4096; nchunks = 16; pos0 = j * 512;
      slot = ((seqb * 8 + j) * 8 + h) * 2 + dir;
    } else if (item < 1024) {
      const int r = item >> 5, seqb = r >> 3, j = r & 7;
      seq = 16 + seqb; base = NPROMPT + seqb * 4096; T = 4096; nchunks = 16; pos0 = j * 512;
      slot = ((seqb * 8 + j) * 8 + h) * 2 + dir;
    } else {
      seq = (item - 1024) >> 5; base = seq * 256; T = 256; nchunks = 8; pos0 = 0; slot = 0;
      is_prompt = true;
    }
    bfr* Od = dir ? Ob : Of;
    const float lbv0 = lbs[dir * 1024 + h * 128 + 2 * cp], lbv1 = lbs[dir * 1024 + h * 128 + 2 * cp + 1];
    const int eloc = wave * 16 + l15;
    const int eglob = eh * 64 + eloc;

    f32x4 S[8];
    if (is_prompt || !mode) {
#pragma unroll
      for (int dt = 0; dt < 8; ++dt) S[dt] = f32x4{0.f, 0.f, 0.f, 0.f};
    } else {
      const float* s0 = SLOC + (size_t)slot * 16384;
#pragma unroll
      for (int dt = 0; dt < 8; ++dt)
#pragma unroll
        for (int j = 0; j < 4; ++j) S[dt][j] = s0[(dt * 16 + quad * 4 + j) * 128 + eglob];
    }
    float cum0 = 1.f, cum1 = 1.f;
    __syncthreads();
#pragma unroll
    for (int dt = 0; dt < 8; ++dt) {
      uint2 o; o.x = pk2(S[dt][0], S[dt][1]); o.y = pk2(S[dt][2], S[dt][3]);
      *(uint2*)(sST + eloc * 136 + dt * 16 + quad * 4) = o;
    }

    const unsigned qoff2 = h * 64 + cp, zoff2 = (1 + dir) * 512 + h * 64 + cp;
    const unsigned voff2 = 1536 + h * 64 + eh * 32 + (cp & 31);
    const uint32_t* __restrict__ QZ32 = (const uint32_t*)QZ;
    uint32_t rq[8], rz[8], rv[8];
#pragma unroll
    for (int ii = 0; ii < 8; ++ii) {
      const int pos = pos0 + i0 + ii;
      const unsigned tok = dir ? base + T - 1 - pos : base + pos;
      const unsigned ri = tok * 2560u;
      rq[ii] = QZ32[ri + qoff2]; rz[ii] = QZ32[ri + zoff2]; rv[ii] = QZ32[ri + voff2];
    }

    for (int c = 0; c < nchunks; ++c) {
      float pc0[8], pc1[8], kv0[8], kv1[8];
      float run0 = 1.f, run1 = 1.f;
#pragma unroll
      for (int ii = 0; ii < 8; ++ii) {
        const float z0 = bflo(rz[ii]), z1 = bfhi(rz[ii]);
        const float f0 = lbv0 + (1.f - lbv0) * frcp(1.f + __expf(-z0));
        const float f1 = lbv1 + (1.f - lbv1) * frcp(1.f + __expf(-z1));
        run0 *= f0; run1 *= f1;
        pc0[ii] = run0; pc1[ii] = run1;
        kv0[ii] = 1.f - f0; kv1[ii] = 1.f - f1;
      }
      *(float2*)(sTot + qt * 128 + 2 * cp) = make_float2(run0, run1);
      __syncthreads();
      {
        float off0 = 1.f, off1 = 1.f, tot0 = 1.f, tot1 = 1.f;
#pragma unroll
        for (int q = 0; q < 4; ++q) {
          const float2 t = *(const float2*)(sTot + q * 128 + 2 * cp);
          if (q < qt) { off0 *= t.x; off1 *= t.y; }
          tot0 *= t.x; tot1 *= t.y;
        }
        uint32_t wk0[4], wk1[4], wv0[4], wv1[4];
#pragma unroll
        for (int ii = 0; ii < 8; ii += 2) {
          uint32_t kp[2];
#pragma unroll
          for (int u = 0; u < 2; ++u) {
            const float e0 = pc0[ii + u] * off0, e1 = pc1[ii + u] * off1;
            kp[u] = pk2(kv0[ii + u] * frcp(e0), kv1[ii + u] * frcp(e1));
            *(uint32_t*)(sKe + (i0 + ii + u) * 136 + 2 * cp) = kp[u];
            if (mode) *(uint32_t*)(sQe + (i0 + ii + u) * 136 + 2 * cp) = pk2(bflo(rq[ii + u]) * e0, bfhi(rq[ii + u]) * e1);
          }
          wk0[ii >> 1] = (kp[0] & 0xffffu) | (kp[1] << 16);
          wk1[ii >> 1] = (kp[0] >> 16) | (kp[1] & 0xffff0000u);
          wv0[ii >> 1] = (rv[ii] & 0xffffu) | (rv[ii + 1] << 16);
          wv1[ii >> 1] = (rv[ii] >> 16) | (rv[ii + 1] & 0xffff0000u);
        }
        *(u32x4*)(sKeT + (2 * cp) * 40 + i0) = u32x4{wk0[0], wk0[1], wk0[2], wk0[3]};
        *(u32x4*)(sKeT + (2 * cp + 1) * 40 + i0) = u32x4{wk1[0], wk1[1], wk1[2], wk1[3]};
        if (cp < 32) {
          *(u32x4*)(sVT + (2 * cp) * 40 + i0) = u32x4{wv0[0], wv0[1], wv0[2], wv0[3]};
          *(u32x4*)(sVT + (2 * cp + 1) * 40 + i0) = u32x4{wv1[0], wv1[1], wv1[2], wv1[3]};
        }
        if (qt == 0) *(float2*)(sLast + 2 * cp) = make_float2(tot0, tot1);
        cum0 *= tot0; cum1 *= tot1;
      }
      if (c + 1 < nchunks) {
#pragma unroll
        for (int ii = 0; ii < 8; ++ii) {
          const int pos = pos0 + (c + 1) * 32 + i0 + ii;
          const unsigned tok = dir ? base + T - 1 - pos : base + pos;
          const unsigned ri = tok * 2560u;
          rq[ii] = QZ32[ri + qoff2]; rz[ii] = QZ32[ri + zoff2]; rv[ii] = QZ32[ri + voff2];
        }
      }
      __syncthreads();
      if (mode) {
        const int ti = wave >> 1, si = wave & 1;
        f32x4 sc = f32x4{0.f, 0.f, 0.f, 0.f};
        if (si <= ti) {
#pragma unroll
          for (int kk = 0; kk < 4; ++kk) {
            const bf16x8 a = *(const bf16x8*)(sQe + (ti * 16 + l15) * 136 + kk * 32 + quad * 8);
            const bf16x8 b = *(const bf16x8*)(sKe + (si * 16 + l15) * 136 + kk * 32 + quad * 8);
            sc = __builtin_amdgcn_mfma_f32_16x16x32_bf16(a, b, sc, 0, 0, 0);
          }
        }
#pragma unroll
        for (int j = 0; j < 4; ++j) {
          const int t = ti * 16 + quad * 4 + j, s2 = si * 16 + l15;
          sP[t * 40 + s2] = (s2 <= t) ? f2bf(sc[j]) : (bfr)0;
        }
      }
      f32x4 oacc[2];
      oacc[0] = f32x4{0.f, 0.f, 0.f, 0.f}; oacc[1] = f32x4{0.f, 0.f, 0.f, 0.f};
      if (mode) {
#pragma unroll
      for (int kk = 0; kk < 4; ++kk) {
        const bf16x8 sb = *(const bf16x8*)(sST + eloc * 136 + kk * 32 + quad * 8);
#pragma unroll
        for (int tt = 0; tt < 2; ++tt) {
          const bf16x8 qa = *(const bf16x8*)(sQe + (tt * 16 + l15) * 136 + kk * 32 + quad * 8);
          oacc[tt] = __builtin_amdgcn_mfma_f32_16x16x32_bf16(sb, qa, oacc[tt], 0, 0, 0);
        }
      }
      }
      __syncthreads();
      {
        const bf16x8 vb = *(const bf16x8*)(sVT + eloc * 40 + quad * 8);
        if (mode) {
#pragma unroll
        for (int tt = 0; tt < 2; ++tt) {
          const bf16x8 pb = *(const bf16x8*)(sP + (tt * 16 + l15) * 40 + quad * 8);
          oacc[tt] = __builtin_amdgcn_mfma_f32_16x16x32_bf16(vb, pb, oacc[tt], 0, 0, 0);
          const int pos = pos0 + c * 32 + tt * 16 + l15;
          const int tok = dir ? base + T - 1 - pos : base + pos;
          uint2 o; o.x = pk2(oacc[tt][0], oacc[tt][1]); o.y = pk2(oacc[tt][2], oacc[tt][3]);
          *(uint2*)(Od + (size_t)tok * DM + h * 128 + eh * 64 + wave * 16 + quad * 4) = o;
        }
        }
#pragma unroll
        for (int dt = 0; dt < 8; ++dt) {
          const bf16x8 ka = *(const bf16x8*)(sKeT + (dt * 16 + l15) * 40 + quad * 8);
          const float4 dl = *(const float4*)(sLast + dt * 16 + quad * 4);
          f32x4 sn = __builtin_amdgcn_mfma_f32_16x16x32_bf16(ka, vb, S[dt], 0, 0, 0);
          sn[0] *= dl.x; sn[1] *= dl.y; sn[2] *= dl.z; sn[3] *= dl.w;
          S[dt] = sn;
          uint2 o; o.x = pk2(sn[0], sn[1]); o.y = pk2(sn[2], sn[3]);
          *(uint2*)(sST + eloc * 136 + dt * 16 + quad * 4) = o;
        }
      }
    }
    if (is_prompt || !mode) {
      float* so = is_prompt ? out_state + ((size_t)(seq * 2 + dir) * 8 + h) * 16384 : SLOC + (size_t)slot * 16384;
#pragma unroll
      for (int dt = 0; dt < 8; ++dt)
#pragma unroll
        for (int j = 0; j < 4; ++j) so[(dt * 16 + quad * 4 + j) * 128 + eglob] = S[dt][j];
      if (!mode && eh == 0 && qt == 0) *(float2*)(DLOC + slot * 128 + 2 * cp) = make_float2(cum0, cum1);
    }
  }
}

DEVINL void hgrn_combine_phase(const Params& p, int bid, int nblk) {
  const int gt = bid * 256 + otid(), nt = nblk * 256;
  float* SLOC = (float*)(p.ws + OFF_BIG + 251658240ull);
  const float* DLOC = (const float*)(p.ws + OFF_BIG + 251658240ull + 33554432ull);
  const float* state_rec = p.in[2];
  for (int idx = gt; idx < 4 * 8 * 2 * 16384; idx += nt) {
    const int de = idx & 16383, r = idx >> 14;
    const int dir = r & 1, h = (r >> 1) & 7, seqb = r >> 4;
    const int d = de >> 7;
    float prev = state_rec[((size_t)(seqb * 2 + dir) * 8 + h) * 16384 + de];
#pragma unroll
    for (int j = 0; j < 8; ++j) {
      const int slot = ((seqb * 8 + j) * 8 + h) * 2 + dir;
      float* ptr = SLOC + (size_t)slot * 16384 + de;
      const float a = (j < 7) ? *ptr : 0.f;
      *ptr = prev;
      if (j < 7) prev = DLOC[slot * 128 + d] * prev + a;
    }
  }
}

DEVINL void hgrn_gate_phase(const Params& p, const float* __restrict__ ng, int bid, int nblk) {
  const int tid = otid(); const int lane = tid & 63;
  const int gw = bid * 4 + (tid >> 6), nw = nblk * 4;
  bfr* Of = (bfr*)(p.ws + OFF_H);
  const bfr* Ob = (const bfr*)(p.ws + OFF_BIG + 209715200ull);
  const bfr* QZ = (const bfr*)(p.ws + OFF_BIG);
  for (int row = gw; row < MTOK; row += nw) {
#pragma unroll
    for (int seg = 0; seg < 4; ++seg) {
      const int c = seg * 256 + lane * 4;
      const uint2 a = *(const uint2*)(Of + (size_t)row * DM + c);
      const uint2 b = *(const uint2*)(Ob + (size_t)row * DM + c);
      const uint2 gq = *(const uint2*)(QZ + (size_t)row * 5120 + 4096 + c);
      const float o0 = bflo(a.x) + bflo(b.x), o1 = bfhi(a.x) + bfhi(b.x), o2 = bflo(a.y) + bflo(b.y), o3 = bfhi(a.y) + bfhi(b.y);
      float ss = o0 * o0 + o1 * o1 + o2 * o2 + o3 * o3;
#pragma unroll
      for (int o = 16; o > 0; o >>= 1) ss += shx(ss, o, lane);
      const float rstd = rsqrtf(ss * (1.f / 128.f) + EPS);
      const float4 gg = *(const float4*)(ng + c);
      uint2 o;
      o.x = pk2(o0 * rstd * gg.x * silu_f(bflo(gq.x)), o1 * rstd * gg.y * silu_f(bfhi(gq.x)));
      o.y = pk2(o2 * rstd * gg.z * silu_f(bflo(gq.y)), o3 * rstd * gg.w * silu_f(bfhi(gq.y)));
      *(uint2*)(Of + (size_t)row * DM + c) = o;
    }
  }
}

DEVINL void ffn_act_phase(const bfr* __restrict__ UP, const float* __restrict__ wdw, int hf, bfr* __restrict__ ACT, int bid, int nblk) {
  const int gt = bid * 256 + otid(), nt = nblk * 256;
  for (int i = gt; i < MTOK * 176; i += nt) {
    const int m = i / 176, j = (i - m * 176) * 8;
    int tl, T; tok_pos(m, tl, T);
    const bfr* ur = UP + (size_t)m * DFF;
    float a[8], b[8];
#pragma unroll
    for (int q = 0; q < 8; ++q) { a[q] = 0.f; b[q] = 0.f; }
#pragma unroll
    for (int tap = 0; tap < 3; ++tap) {
      const int d = tap - 1;
      if ((d < 0 && tl == 0) || (d > 0 && tl == T - 1)) continue;
      const bfr* nr = ur + (ptrdiff_t)d * DFF;
      const uint4 av = *(const uint4*)(nr + j);
      const uint4 bv = *(const uint4*)(nr + HALF_FF + j);
      const float* wa = wdw + tap * (2 * DFF) + hf * HALF_FF + j;
      const float* wb = wdw + tap * (2 * DFF) + DFF + hf * HALF_FF + j;
      const float4 wa0 = *(const float4*)wa, wa1 = *(const float4*)(wa + 4);
      const float4 wb0 = *(const float4*)wb, wb1 = *(const float4*)(wb + 4);
      a[0] += wa0.x * bflo(av.x); a[1] += wa0.y * bfhi(av.x); a[2] += wa0.z * bflo(av.y); a[3] += wa0.w * bfhi(av.y);
      a[4] += wa1.x * bflo(av.z); a[5] += wa1.y * bfhi(av.z); a[6] += wa1.z * bflo(av.w); a[7] += wa1.w * bfhi(av.w);
      b[0] += wb0.x * bflo(bv.x); b[1] += wb0.y * bfhi(bv.x); b[2] += wb0.z * bflo(bv.y); b[3] += wb0.w * bfhi(bv.y);
      b[4] += wb1.x * bflo(bv.z); b[5] += wb1.y * bfhi(bv.z); b[6] += wb1.z * bflo(bv.w); b[7] += wb1.w * bfhi(bv.w);
    }
    uint4 o;
    o.x = pk2(silu_f(a[0]) * b[0], silu_f(a[1]) * b[1]);
    o.y = pk2(silu_f(a[2]) * b[2], silu_f(a[3]) * b[3]);
    o.z = pk2(silu_f(a[4]) * b[4], silu_f(a[5]) * b[5]);
    o.w = pk2(silu_f(a[6]) * b[6], silu_f(a[7]) * b[7]);
    *(uint4*)(ACT + (size_t)m * DFF + hf * HALF_FF + j) = o;
  }
}


#define XB_TMO      128
#define XB_XCNT(j)  (256  + 64 * (j))
#define XB_XSUB(j)  (1280 + 64 * (j))
#define XB_XGEN(j)  (2304 + 64 * (j))
#define XB_TOP      3328
#define XB_TOPGEN   3392
#define XCD_BAR_WORDS 3456
#define XB_SPIN_CAP (1u << 22)
#define LAS __attribute__((address_space(3)))
DEVINL unsigned xb_ld(unsigned* p) { return __hip_atomic_load(p, __ATOMIC_RELAXED, __HIP_MEMORY_SCOPE_AGENT); }
DEVINL unsigned xb_add(unsigned* p, unsigned v) { return __hip_atomic_fetch_add(p, v, __ATOMIC_RELAXED, __HIP_MEMORY_SCOPE_AGENT); }
DEVINL unsigned xb_xcc_id() { return (unsigned)__builtin_amdgcn_s_getreg((3 << 11) | 20) & 0xFu; }
#define XB_SPIN(cond, bar) do { unsigned _sp = 0; while (cond) { __builtin_amdgcn_s_sleep(1); \
    if ((++_sp & 255u) == 0u) { if (xb_ld(&(bar)[XB_TMO])) break; if (_sp > XB_SPIN_CAP) { atomicAdd(&(bar)[XB_TMO], 1u); break; } } } } while (0)
struct XcdBarrier { unsigned* bar; unsigned x; volatile LAS unsigned* st; };
DEVINL XcdBarrier xcd_barrier_post(unsigned* bar, volatile LAS unsigned* st) {
  XcdBarrier b; b.bar = bar; b.x = xb_xcc_id(); b.st = st;
  if (threadIdx.x == 0) (void)xb_add(&bar[XB_XCNT(b.x)], 1u);
  return b;
}
DEVINL void xcd_barrier_complete(unsigned* bar, unsigned x, unsigned& nloc, unsigned& nx) {
  const unsigned G = gridDim.x * gridDim.y * gridDim.z;
  unsigned sum, cnt, mine, sp = 0u;
  for (;;) {
    sum = 0u; cnt = 0u; mine = 0u;
#pragma unroll
    for (unsigned j = 0; j < 16; ++j) { const unsigned c = xb_ld(&bar[XB_XCNT(j)]); sum += c; cnt += (c > 0u) ? 1u : 0u; mine = (j == x) ? c : mine; }
    if (sum == G) break;
    __builtin_amdgcn_s_sleep(1);
    if ((++sp & 255u) == 0u) { if (xb_ld(&bar[XB_TMO])) break; if (sp > XB_SPIN_CAP) { atomicAdd(&bar[XB_TMO], 1u); break; } }
  }
  nloc = mine > 0u ? mine : 1u; nx = cnt > 0u ? cnt : 1u;
}
DEVINL void xcd_barrier(const XcdBarrier& b) {
  asm volatile("s_waitcnt vmcnt(0)" ::: "memory");
  __syncthreads();
  if (threadIdx.x == 0) {
    unsigned* bar = b.bar;
    unsigned bx = b.x;
    asm volatile("" : "+s"(bar), "+s"(bx));
    __builtin_amdgcn_s_waitcnt(0);
    unsigned nloc = b.st[0], nx = b.st[1];
    if (nloc == 0u) { xcd_barrier_complete(bar, bx, nloc, nx); b.st[0] = nloc; b.st[1] = nx; }
    const unsigned old = xb_add(&bar[XB_XSUB(bx)], 1u);
    const unsigned gen = old / nloc;
    if (old + 1u == (gen + 1u) * nloc) {
      __builtin_amdgcn_fence(__ATOMIC_RELEASE, "agent");
      asm volatile("s_waitcnt vmcnt(0)" ::: "memory");
      const unsigned og = xb_add(&bar[XB_TOP], 1u);
      const unsigned tg = og / nx;
      if (og + 1u == (tg + 1u) * nx) xb_add(&bar[XB_TOPGEN], 1u);
      else XB_SPIN(xb_ld(&bar[XB_TOPGEN]) == tg, bar);
      __builtin_amdgcn_fence(__ATOMIC_ACQUIRE, "agent");
      xb_add(&bar[XB_XGEN(bx)], 1u);
      asm volatile("s_waitcnt vmcnt(0)" ::: "memory");
    } else {
      XB_SPIN(xb_ld(&bar[XB_XGEN(bx)]) == gen, bar);
      __builtin_amdgcn_fence(__ATOMIC_ACQUIRE, "agent");
      asm volatile("s_waitcnt vmcnt(0)" ::: "memory");
    }
  }
  __syncthreads();
}

constexpr int SMEM_BYTES = 77824;

__global__ void __launch_bounds__(256, 2) mega_kernel(Params p) {
  __shared__ __attribute__((aligned(16))) char smem[SMEM_BYTES];
  cg::grid_group grid = cg::this_grid();
  __shared__ uint4 xb_words;
  if (threadIdx.x == 0) xb_words = make_uint4(0u, 0u, 0u, 0u);
  __syncthreads();
  XcdBarrier xb = xcd_barrier_post((unsigned*)(p.ws + OFF_BAR), (volatile LAS unsigned*)&xb_words);
  const int bid = blockIdx.x, nblk = gridDim.x;

  phase0a(p, smem, osg(bid), nblk);
  grid.sync();
  phase0b(p, osg(bid), nblk);
  xcd_barrier(xb);

  for (int layer = 0; layer < 4; ++layer) {
    Params q = p;
    {
      size_t oz = 0;
      asm volatile("" : "+s"(oz));
      q.ws = p.ws + oz;
      q.out = p.out + oz;
    }
    float* X = q.out;
    bfr* WB = (bfr*)(q.ws + OFF_WB);
    bfr* H = (bfr*)(q.ws + OFF_H);
    bfr* BIG = (bfr*)(q.ws + OFF_BIG);
    const float* MOD = (const float*)(q.ws + OFF_MOD);
    const float* modl = MOD + layer * 30720;
    if (layer == 0) {
      conv_matrix(q.in[9], 1024, 3072, WB + WB_IN, 0, smem, osg(bid), nblk);
      conv_matrix(q.in[11], 1024, 1024, WB + WB_OUT, 0, smem, osg(bid), nblk);
    } else if (layer == 1) {
      for (int g = 0; g < 4; ++g) conv_matrix(q.in[12] + g * 65536, 256, 256, WB + WB_IN + g * 65536, 0, smem, osg(bid), nblk);
    } else if (layer == 2) {
      conv_matrix(q.in[14], 1024, 2048, WB + WB_IN, 0, smem, osg(bid), nblk);
      conv_matrix(q.in[18], 1024, 1024, WB + WB_OUT, 0, smem, osg(bid), nblk);
    } else {
      conv_matrix(q.in[19], 1024, 5120, WB + WB_IN, 0, smem, osg(bid), nblk);
      conv_matrix(q.in[22], 1024, 1024, WB + WB_OUT, 0, smem, osg(bid), nblk);
    }
    conv_matrix(q.in[23] + (size_t)layer * 1024 * 5632, 1024, 5632, WB + WB_UP, 1, smem, osg(bid), nblk);
    conv_matrix(q.in[25] + (size_t)layer * DFF * 1024, DFF, 1024, WB + WB_DOWN, 0, smem, osg(bid), nblk);
    norm_phase(X, q.in[7] + (layer * 2 + 0) * DM, modl, 0, 1024, H, osg(bid), nblk);
    xcd_barrier(xb);

    if (layer == 0) {
      bfr* G = BIG;
      bfr* U = BIG + (size_t)MTOK * 3072;
      gemm_phase(H, DM, WB + WB_IN, 1024, 3072, 1024, EpiStore{G, 3072}, smem, osg(bid), nblk);
      xcd_barrier(xb);
      shortconv_ew_phase(G, q.in[10], U, osg(bid), nblk);
      xcd_barrier(xb);
      gemm_phase(U, DM, WB + WB_OUT, 1024, 1024, 1024, EpiResid{X, modl + 2048, nullptr, 0}, smem, osg(bid), nblk);
      xcd_barrier(xb);
    } else if (layer == 1) {
      bfr* P = BIG;
      pool_ew_phase(H, P, osg(bid), nblk);
      xcd_barrier(xb);
      for (int g = 0; g < 4; ++g)
        gemm_phase(P + g * 256, DM, WB + WB_IN + g * 65536, 256, 256, 256,
                   EpiResid{X, modl + 2048 + g * 256, q.in[13] + g * 256, g * 256}, smem, osg(bid), nblk);
      xcd_barrier(xb);
    } else if (layer == 2) {
      bfr* UV = BIG;
      gemm_phase(H, DM, WB + WB_IN, 1024, 2048, 1024, EpiGelu{UV, 2048}, smem, osg(bid), nblk);
      xcd_barrier(xb);
      sgu_norm_phase(UV, q.in[15], osg(bid), nblk);
      xcd_barrier(xb);
      sgu_spatial_phase(UV, q.in[16], q.in[17], smem, osg(bid), nblk);
      xcd_barrier(xb);
      gemm_phase(UV, 2048, WB + WB_OUT, 1024, 1024, 1024, EpiResid{X, modl + 2048, nullptr, 0}, smem, osg(bid), nblk);
      xcd_barrier(xb);
    } else {
      bfr* QZ = BIG;
      gemm_phase(H, DM, WB + WB_IN, 1024, 5120, 1024, EpiStore{QZ, 5120}, smem, osg(bid), nblk);
      xcd_barrier(xb);
      hgrn_scan_phase(q, smem, osg(bid), nblk, 0);
      xcd_barrier(xb);
      hgrn_combine_phase(q, osg(bid), nblk);
      xcd_barrier(xb);
      hgrn_scan_phase(q, smem, osg(bid), nblk, 1);
      xcd_barrier(xb);
      hgrn_gate_phase(q, q.in[21], osg(bid), nblk);
      xcd_barrier(xb);
      gemm_phase(H, DM, WB + WB_OUT, 1024, 1024, 1024, EpiResid{X, modl + 2048, nullptr, 0}, smem, osg(bid), nblk);
      xcd_barrier(xb);
    }

    norm_phase(X, q.in[7] + (layer * 2 + 1) * DM, modl, 3072, 4096, H, osg(bid), nblk);
    xcd_barrier(xb);
    bfr* ACT = BIG;
    float* EDGE = (float*)(q.ws + OFF_BIG + 115343360ull);
    const float* wdw = q.in[24] + (size_t)layer * 3 * 2 * DFF;
    gemm_phase(H, DM, WB + WB_UP, 1024, 2 * DFF, 1024, EpiFfnUp{ACT, EDGE, wdw}, smem, osg(bid), nblk);
    xcd_barrier(xb);
    ffn_edge_phase(EDGE, wdw, ACT, osg(bid), nblk);
    xcd_barrier(xb);
    gemm_phase(ACT, DFF, WB + WB_DOWN, DFF, 1024, DFF, EpiResid{X, modl + 5120, nullptr, 0}, smem, osg(bid), nblk);
    xcd_barrier(xb);
  }
  final_norm_phase(p.out, p.in[8], osg(bid), nblk);
}

extern "C" void kernel_launch(void* const* d_in, const int* in_sizes, int n_in, void* d_out, int out_size,
                              void* d_ws, size_t ws_size, hipStream_t stream) {
  static int grid_blocks = 0;
  if (!grid_blocks) {
    int dev = 0, cus = 0, per_cu = 0;
    hipGetDevice(&dev);
    hipDeviceGetAttribute(&cus, hipDeviceAttributeMultiprocessorCount, dev);
    hipOccupancyMaxActiveBlocksPerMultiprocessor(&per_cu, mega_kernel, 256, 0);
    if (per_cu > 2) per_cu = 2;
    if (per_cu < 1) per_cu = 1;
    grid_blocks = cus * per_cu;
  }
  if (ws_size < WS_NEED) { fprintf(stderr, "workspace too small: %zu < %zu\n", ws_size, (size_t)WS_NEED); return; }
  Params p{};
  for (int i = 0; i < 26; ++i) p.in[i] = (const float*)d_in[i];
  p.out = (float*)d_out;
  p.ws = (char*)d_ws;
  hipMemsetAsync((char*)d_ws + OFF_BAR, 0, XCD_BAR_WORDS * 4, stream);
  void* args[] = {&p};
  hipError_t e = hipLaunchCooperativeKernel((void*)mega_kernel, dim3(grid_blocks), dim3(256), args, 0, stream);
  if (e != hipSuccess) fprintf(stderr, "cooperative launch failed: %s (grid %d)\n", hipGetErrorString(e), grid_blocks);
}
```

```cpp
#include <hip/hip_runtime.h>
#include <hip/hip_cooperative_groups.h>
#include <stdint.h>
#include <stdio.h>
namespace cg = cooperative_groups;

#define DEVINL __device__ __forceinline__
typedef unsigned short bfr;
using bf16x8 = __attribute__((ext_vector_type(8))) short;
using f32x4 = __attribute__((ext_vector_type(4))) float;
using u32x4 = __attribute__((ext_vector_type(4))) unsigned int;

constexpr int DM = 1024;
constexpr int MTOK = 20480;
constexpr int NPROMPT = 4096;
constexpr int DFF = 2816;
constexpr int HALF_FF = 1408;
constexpr float EPS = 1e-6f;

constexpr size_t OFF_MODP = 0;
constexpr size_t OFF_MOD = 7864320;
constexpr size_t OFF_LBS = OFF_MOD + 491520;
constexpr size_t OFF_BAR = OFF_LBS + 8192;
constexpr size_t OFF_WB = 8388608;
constexpr size_t OFF_H = 41943040;
constexpr size_t OFF_BIG = 83886080;
constexpr size_t WS_NEED = OFF_BIG + 251658240ull + 33554432ull + 262144ull;
constexpr size_t WB_IN = 0, WB_OUT = 5242880, WB_UP = 6291456, WB_DOWN = 12058624;

struct Params {
  const float* in[26];
  float* out;
  char* ws;
};

DEVINL int otid() { int t = threadIdx.x; asm volatile("" : "+v"(t)); return t; }
DEVINL int osg(int x) { asm volatile("" : "+s"(x)); return x; }
typedef __bf16 hbf16x2 __attribute__((ext_vector_type(2)));
typedef float hf32x2 __attribute__((ext_vector_type(2)));
DEVINL uint32_t pk2(float a, float b) {
  hf32x2 v = {a, b};
  hbf16x2 r = __builtin_convertvector(v, hbf16x2);
  return __builtin_bit_cast(uint32_t, r);
}
DEVINL bfr f2bf(float f) { return (bfr)(pk2(f, 0.f) & 0xffffu); }
DEVINL float bf2f(bfr h) { return __uint_as_float(((uint32_t)h) << 16); }
DEVINL float frcp(float x) { return __builtin_amdgcn_rcpf(x); }
DEVINL float bflo(uint32_t u) { return __uint_as_float(u << 16); }
DEVINL float bfhi(uint32_t u) { return __uint_as_float(u & 0xffff0000u); }
DEVINL int cond_of(int m) { return m < NPROMPT ? 0 : 1 + ((m - NPROMPT) >> 12); }
DEVINL float silu_f(float x) { return x * frcp(1.f + __expf(-x)); }
DEVINL float gelu_tanh_f(float x) {
  float y = 0.7978845608028654f * (x + 0.044715f * x * x * x);
  float t = 1.f - 2.f * frcp(__expf(2.f * y) + 1.f);
  return 0.5f * x * (1.f + t);
}
DEVINL float shx(float v, int o, int lane) {
  return __int_as_float(__builtin_amdgcn_ds_bpermute((lane ^ o) << 2, __float_as_int(v)));
}
DEVINL float wave_sum(float v, int lane) {
#pragma unroll
  for (int o = 32; o > 0; o >>= 1) v += shx(v, o, lane);
  return v;
}

DEVINL void tok_pos(int m, int& tl, int& T) {
  if (m < NPROMPT) { tl = m & 255; T = 256; } else { tl = (m - NPROMPT) & 4095; T = 4096; }
}

struct EpiNoPre {};
#define EPI_ELEMENTWISE_TILE                                                                       \
  typedef EpiNoPre Pre;                                                                             \
  DEVINL Pre pre(int tn, int tid) const { return Pre{}; }                                           \
  DEVINL void tile(const f32x4 (&acc)[4][4], const Pre& pre_, int m0, int n0, int tn, int wm, int wn, int l15, \
                   int quad, int tid, char* smem) const {                                           \
    _Pragma("unroll") for (int mt = 0; mt < 4; ++mt)                                                \
      _Pragma("unroll") for (int nt = 0; nt < 4; ++nt)                                              \
        (*this)(m0 + wm * 64 + mt * 16 + l15, n0 + wn * 64 + nt * 16 + quad * 4, acc[mt][nt]);      \
  }
struct EpiStore {
  bfr* C; int ldc;
  DEVINL void tile256(const f32x4 (&acc)[8][4], const EpiNoPre& pre_, int m0, int n0, int tn, int wm, int wn, int l15,
                      int quad, int tid, char* smem) const {
#pragma unroll
    for (int mt = 0; mt < 8; ++mt)
#pragma unroll
      for (int nt = 0; nt < 4; ++nt)
        (*this)(m0 + wm * 128 + mt * 16 + l15, n0 + wn * 64 + nt * 16 + quad * 4, acc[mt][nt]);
  }
  DEVINL void operator()(int m, int n, f32x4 v) const {
    uint2 o; o.x = pk2(v[0], v[1]); o.y = pk2(v[2], v[3]);
    *(uint2*)(C + (size_t)m * ldc + n) = o;
  }
  EPI_ELEMENTWISE_TILE
};
struct EpiGelu {
  bfr* C; int ldc;
  DEVINL void operator()(int m, int n, f32x4 v) const {
    uint2 o; o.x = pk2(gelu_tanh_f(v[0]), gelu_tanh_f(v[1])); o.y = pk2(gelu_tanh_f(v[2]), gelu_tanh_f(v[3]));
    *(uint2*)(C + (size_t)m * ldc + n) = o;
  }
  EPI_ELEMENTWISE_TILE
};
struct EpiResid {
  float* X; const float* gate; const float* cscale; int coff;
  DEVINL void operator()(int m, int n, f32x4 v) const {
    const int cond = cond_of(m);
    const float4 g = *(const float4*)(gate + cond * 6144 + n);
    float4* xp = (float4*)(X + (size_t)m * DM + coff + n);
    float4 x = *xp;
    float s0 = 1.f, s1 = 1.f, s2 = 1.f, s3 = 1.f;
    if (cscale) { const float4 s = *(const float4*)(cscale + n); s0 = s.x; s1 = s.y; s2 = s.z; s3 = s.w; }
    x.x += g.x * v[0] * s0; x.y += g.y * v[1] * s1; x.z += g.z * v[2] * s2; x.w += g.w * v[3] * s3;
    *xp = x;
  }
  EPI_ELEMENTWISE_TILE
};

#define LDS3 __attribute__((address_space(3)))
DEVINL void lds_barrier() { asm volatile("s_waitcnt lgkmcnt(0)\n\ts_barrier" ::: "memory"); }
template <class Epi>
DEVINL void gemm_phase(const bfr* __restrict__ A, int lda, const bfr* __restrict__ Bt, int ldb, int N, int K,
                       const Epi& epi, char* smem, int bid, int nblk) {
  const int tid = otid(), lane = tid & 63, wave = tid >> 6;
  const int wm = wave >> 1, wn = wave & 1, l15 = lane & 15, quad = lane >> 4;
  const int tilesN = N >> 7;
  const int ntiles = (MTOK >> 7) * tilesN;
  const int nk = K >> 6;
  const int srow0 = wave * 8 + (lane >> 3);
  const int lc = (lane & 7) ^ ((srow0 >> 1) & 7);
  const int fsw = (l15 >> 1) & 7;
  char* const dst0 = smem + wave * 1024 + lane * 16;
#define TILE_DECODE(t_, tm_, tn_) {                                                        \
    const int xcd_ = (t_) & 7, u_ = (t_) >> 3, g16_ = 16 * tilesN;                         \
    int ur_;                                                                               \
    if (u_ < g16_) { const int gs_ = 8 * tilesN; const int g_ = u_ / gs_, r_ = u_ - g_ * gs_; tn_ = r_ >> 3; ur_ = g_ * 8 + (r_ & 7); } \
    else { const int r_ = u_ - g16_; tn_ = r_ >> 2; ur_ = 16 + (r_ & 3); }                 \
    tm_ = ur_ * 8 + xcd_; }
#define GLDS_STAGE(pa_, pb_, st_, kt_)                                                                    \
  {                                                                                                       \
    _Pragma("unroll") for (int i = 0; i < 4; ++i) {                                                       \
      __builtin_amdgcn_global_load_lds((const unsigned*)((pa_) + (size_t)(i * 32) * lda + (kt_) * 64),    \
                                       (LDS3 unsigned*)(dst0 + (st_) * 32768 + i * 4096), 16, 0, 0);      \
      __builtin_amdgcn_global_load_lds((const unsigned*)((pb_) + (size_t)(i * 32) * ldb + (kt_) * 64),    \
                                       (LDS3 unsigned*)(dst0 + (st_) * 32768 + 16384 + i * 4096), 16, 0, 0); \
    }                                                                                                     \
  }
  int tile = bid;
  if (tile >= ntiles) return;
  int tm, tn;
  TILE_DECODE(tile, tm, tn)
  const bfr* gA = A + (size_t)((tm << 7) + srow0) * lda + lc * 8;
  const bfr* gB = Bt + (size_t)((tn << 7) + srow0) * ldb + lc * 8;
  __syncthreads();
  GLDS_STAGE(gA, gB, 0, 0)
  for (; tile < ntiles; tile += nblk) {
    const int m0 = tm << 7, n0 = tn << 7, tn_cur = tn;
    const bool has_next = (tile + nblk < ntiles);
    const bfr* gAn = gA; const bfr* gBn = gB;
    if (has_next) {
      TILE_DECODE(tile + nblk, tm, tn)
      gAn = A + (size_t)((tm << 7) + srow0) * lda + lc * 8;
      gBn = Bt + (size_t)((tn << 7) + srow0) * ldb + lc * 8;
    }
    typename Epi::Pre pre = epi.pre(tn_cur, tid);
    f32x4 acc[4][4];
#pragma unroll
    for (int i = 0; i < 4; ++i)
#pragma unroll
      for (int j = 0; j < 4; ++j) acc[i][j] = f32x4{0.f, 0.f, 0.f, 0.f};
    __syncthreads();
    for (int kt = 0; kt < nk; ++kt) {
      const int st = kt & 1;
      const bool cur = (kt + 1 < nk);
      const bool any = cur || has_next;
      const bfr* sa = cur ? gA + (kt + 1) * 64 : gAn;
      const bfr* sb = cur ? gB + (kt + 1) * 64 : gBn;
      char* sd = dst0 + (cur ? (st ^ 1) : 0) * 32768;
      const char* cA = smem + st * 32768 + (wm * 64 + l15) * 128;
      const char* cB = smem + st * 32768 + 16384 + (wn * 64 + l15) * 128;
      {
        const int co0 = (quad ^ fsw) * 16, co1 = ((4 + quad) ^ fsw) * 16;
        bf16x8 af0[4], bf0[4], af1[4], bf1[4];
#pragma unroll
        for (int i = 0; i < 4; ++i) {
          af0[i] = *(const bf16x8*)(cA + i * 2048 + co0);
          bf0[i] = *(const bf16x8*)(cB + i * 2048 + co0);
        }
#pragma unroll
        for (int i = 0; i < 4; ++i) {
          af1[i] = *(const bf16x8*)(cA + i * 2048 + co1);
          bf1[i] = *(const bf16x8*)(cB + i * 2048 + co1);
        }
        __builtin_amdgcn_sched_barrier(0);
#pragma unroll
        for (int mt = 0; mt < 4; ++mt) {
#pragma unroll
          for (int nt = 0; nt < 4; ++nt)
            acc[mt][nt] = __builtin_amdgcn_mfma_f32_16x16x32_bf16(bf0[nt], af0[mt], acc[mt][nt], 0, 0, 0);
          if (any) {
            __builtin_amdgcn_global_load_lds((const unsigned*)(sa + (size_t)(mt * 32) * lda), (LDS3 unsigned*)(sd + mt * 4096), 16, 0, 0);
            __builtin_amdgcn_global_load_lds((const unsigned*)(sb + (size_t)(mt * 32) * ldb), (LDS3 unsigned*)(sd + 16384 + mt * 4096), 16, 0, 0);
          }
          __builtin_amdgcn_sched_barrier(0);
        }
#pragma unroll
        for (int mt = 0; mt < 4; ++mt)
#pragma unroll
          for (int nt = 0; nt < 4; ++nt)
            acc[mt][nt] = __builtin_amdgcn_mfma_f32_16x16x32_bf16(bf1[nt], af1[mt], acc[mt][nt], 0, 0, 0);
        __builtin_amdgcn_sched_barrier(0);
      }
      if (kt + 1 < nk) __syncthreads();
    }
    epi.tile(acc, pre, m0, n0, tn_cur, wm, wn, l15, quad, tid, smem);
    gA = gAn; gB = gBn;
  }
}

constexpr int EDGE_LD = 2 * DFF;
struct FfnPre { f32x4 wa[3], wb[3]; };
DEVINL void ffn_conv_rows(const bfr* T, const FfnPre& pre_, bfr* ACT, float* EDGE, int m0, int n0, int tn, int tid) {
  const int c4 = (tid & 15) * 4, r0 = (tid >> 4) * 8;
  const int ja = tn * 64 + c4;
  int tl, Tlen; tok_pos(m0, tl, Tlen);
  const bool top_ok = (tl == 0), bot_ok = (tl + 128 == Tlen);
  if (tid < 128) {
    const int e = tid >> 5, c = (tid & 31) * 4;
    const int r = (e < 2) ? e : 124 + e;
    const uint2 v = *(const uint2*)(T + r * 136 + c);
    *(f32x4*)(EDGE + ((size_t)(m0 >> 7) * 4 + e) * EDGE_LD + n0 + c) = f32x4{bflo(v.x), bfhi(v.x), bflo(v.y), bfhi(v.y)};
  }
  const f32x4 zero = f32x4{0.f, 0.f, 0.f, 0.f};
#define LDT(dst, row, col) { const uint2 v_ = *(const uint2*)(T + (row) * 136 + (col)); dst = f32x4{bflo(v_.x), bfhi(v_.x), bflo(v_.y), bfhi(v_.y)}; }
  f32x4 pa = zero, pb = zero, ca, cb, na, nb;
  if (r0 > 0) { LDT(pa, r0 - 1, c4) LDT(pb, r0 - 1, 64 + c4) }
  LDT(ca, r0, c4) LDT(cb, r0, 64 + c4)
#pragma unroll
  for (int i = 0; i < 8; ++i) {
    const int r = r0 + i;
    if (r < 127) { LDT(na, r + 1, c4) LDT(nb, r + 1, 64 + c4) }
    else { na = zero; nb = zero; }
    const bool ok = (r > 0 || top_ok) && (r < 127 || bot_ok);
    if (ok) {
      const f32x4 a = pre_.wa[0] * pa + pre_.wa[1] * ca + pre_.wa[2] * na;
      const f32x4 b = pre_.wb[0] * pb + pre_.wb[1] * cb + pre_.wb[2] * nb;
      uint2 o;
      o.x = pk2(silu_f(a[0]) * b[0], silu_f(a[1]) * b[1]);
      o.y = pk2(silu_f(a[2]) * b[2], silu_f(a[3]) * b[3]);
      *(uint2*)(ACT + (size_t)(m0 + r) * DFF + ja) = o;
    }
    pa = ca; pb = cb; ca = na; cb = nb;
  }
#undef LDT
}
struct EpiFfnUp {
  bfr* ACT; float* EDGE; const float* wdw;
  typedef FfnPre Pre;
  DEVINL Pre pre(int tn, int tid) const {
    Pre q;
    const int ja = tn * 64 + (tid & 15) * 4;
#pragma unroll
    for (int t = 0; t < 3; ++t) {
      q.wa[t] = *(const f32x4*)(wdw + t * (2 * DFF) + ja);
      q.wb[t] = *(const f32x4*)(wdw + t * (2 * DFF) + DFF + ja);
    }
    return q;
  }
  DEVINL void tile(const f32x4 (&acc)[4][4], const Pre& pre_, int m0, int n0, int tn, int wm, int wn, int l15, int quad,
                   int tid, char* smem) const {
    bfr* T = (bfr*)(smem + 32768);
    lds_barrier();
#pragma unroll
    for (int mt = 0; mt < 4; ++mt)
#pragma unroll
      for (int nt = 0; nt < 4; ++nt) {
        uint2 o; o.x = pk2(acc[mt][nt][0], acc[mt][nt][1]); o.y = pk2(acc[mt][nt][2], acc[mt][nt][3]);
        *(uint2*)(T + (wm * 64 + mt * 16 + l15) * 136 + wn * 64 + nt * 16 + quad * 4) = o;
      }
    lds_barrier();
    ffn_conv_rows(T, pre_, ACT, EDGE, m0, n0, tn, tid);
  }
  DEVINL void tile256(const f32x4 (&acc)[8][4], const Pre& pre_, int m0, int n0, int tn, int wm, int wn, int l15, int quad,
                      int tid, char* smem) const {
    bfr* T = (bfr*)(smem + 24576);
#pragma unroll
    for (int hh = 0; hh < 2; ++hh) {
      lds_barrier();
      if (wm == hh) {
#pragma unroll
        for (int mt = 0; mt < 8; ++mt)
#pragma unroll
          for (int nt = 0; nt < 4; ++nt) {
            uint2 o; o.x = pk2(acc[mt][nt][0], acc[mt][nt][1]); o.y = pk2(acc[mt][nt][2], acc[mt][nt][3]);
            *(uint2*)(T + (mt * 16 + l15) * 136 + wn * 64 + nt * 16 + quad * 4) = o;
          }
      }
      lds_barrier();
      ffn_conv_rows(T, pre_, ACT, EDGE, m0 + hh * 128, n0, tn, tid);
    }
  }
};


template <class Epi>
DEVINL void gemm256_phase(const bfr* __restrict__ A, int lda, const bfr* __restrict__ Bt, int ldb, int N, int K,
                          const Epi& epi, char* smem, int bid, int nblk) {
  const int tid = otid(), lane = tid & 63, wave = tid >> 6;
  const int wm = wave >> 1, wn = wave & 1, l15 = lane & 15, quad = lane >> 4;
  const int tilesN = N >> 7;
  const int ntiles = (MTOK >> 8) * tilesN;
  const int nk = K >> 5;
  const int srow0 = wave * 16 + (lane >> 2);
  const int lc = (lane & 3) ^ ((0 - (lane >> 4)) & 3);
  const int fsw = (0 - (l15 >> 2)) & 3;
  char* const dst0 = smem + wave * 1024 + lane * 16;
#define TILE_DECODE2(t_, tm_, tn_) { const int xcd_ = (t_) & 7, u_ = (t_) >> 3; const int ur_ = u_ / tilesN; tn_ = u_ - ur_ * tilesN; tm_ = ur_ * 8 + xcd_; }
#define GLDS_STAGE2(pa_, pb_, st_, kt_)                                                                   \
  {                                                                                                       \
    _Pragma("unroll") for (int i = 0; i < 4; ++i)                                                         \
      __builtin_amdgcn_global_load_lds((const unsigned*)((pa_) + (size_t)(i * 64) * lda + (kt_) * 32),    \
                                       (LDS3 unsigned*)(dst0 + (st_) * 24576 + i * 4096), 16, 0, 0);      \
    _Pragma("unroll") for (int i = 0; i < 2; ++i)                                                         \
      __builtin_amdgcn_global_load_lds((const unsigned*)((pb_) + (size_t)(i * 64) * ldb + (kt_) * 32),    \
                                       (LDS3 unsigned*)(dst0 + (st_) * 24576 + 16384 + i * 4096), 16, 0, 0); \
  }
  int tile = bid;
  if (tile >= ntiles) return;
  int tm, tn;
  TILE_DECODE2(tile, tm, tn)
  const bfr* gA = A + (size_t)((tm << 8) + srow0) * lda + lc * 8;
  const bfr* gB = Bt + (size_t)((tn << 7) + srow0) * ldb + lc * 8;
  __syncthreads();
  GLDS_STAGE2(gA, gB, 0, 0)
  for (; tile < ntiles; tile += nblk) {
    const int m0 = tm << 8, n0 = tn << 7, tn_cur = tn;
    const bool has_next = (tile + nblk < ntiles);
    const bfr* gAn = gA; const bfr* gBn = gB;
    if (has_next) {
      TILE_DECODE2(tile + nblk, tm, tn)
      gAn = A + (size_t)((tm << 8) + srow0) * lda + lc * 8;
      gBn = Bt + (size_t)((tn << 7) + srow0) * ldb + lc * 8;
    }
    f32x4 acc[8][4];
#pragma unroll
    for (int i = 0; i < 8; ++i)
#pragma unroll
      for (int j = 0; j < 4; ++j) acc[i][j] = f32x4{0.f, 0.f, 0.f, 0.f};
    __syncthreads();
    for (int kt = 0; kt < nk; ++kt) {
      const int st = kt & 1;
      const bool cur = (kt + 1 < nk);
      const bool any = cur || has_next;
      const bfr* sa = cur ? gA + (kt + 1) * 32 : gAn;
      const bfr* sb = cur ? gB + (kt + 1) * 32 : gBn;
      char* sd = dst0 + (cur ? (st ^ 1) : 0) * 24576;
      const char* cA = smem + st * 24576 + (wm * 128 + l15) * 64 + ((quad ^ fsw) * 16);
      const char* cB = smem + st * 24576 + 16384 + (wn * 64 + l15) * 64 + ((quad ^ fsw) * 16);
      bf16x8 bfg[4];
#pragma unroll
      for (int i = 0; i < 4; ++i) bfg[i] = *(const bf16x8*)(cB + i * 1024);
#pragma unroll
      for (int hm = 0; hm < 2; ++hm) {
        bf16x8 af[4];
#pragma unroll
        for (int i = 0; i < 4; ++i) af[i] = *(const bf16x8*)(cA + (hm * 4 + i) * 1024);
        __builtin_amdgcn_sched_barrier(0);
#pragma unroll
        for (int mt = 0; mt < 4; ++mt) {
#pragma unroll
          for (int nt = 0; nt < 4; ++nt)
            acc[hm * 4 + mt][nt] = __builtin_amdgcn_mfma_f32_16x16x32_bf16(bfg[nt], af[mt], acc[hm * 4 + mt][nt], 0, 0, 0);
          const int g = hm * 4 + mt;
          if (any && g < 4)
            __builtin_amdgcn_global_load_lds((const unsigned*)(sa + (size_t)(g * 64) * lda), (LDS3 unsigned*)(sd + g * 4096), 16, 0, 0);
          else if (any && g < 6)
            __builtin_amdgcn_global_load_lds((const unsigned*)(sb + (size_t)((g - 4) * 64) * ldb), (LDS3 unsigned*)(sd + 16384 + (g - 4) * 4096), 16, 0, 0);
          __builtin_amdgcn_sched_barrier(0);
        }
      }
      if (kt + 1 < nk) __syncthreads();
    }
    {
      typename Epi::Pre pre = epi.pre(tn_cur, tid);
      epi.tile256(acc, pre, m0, n0, tn_cur, wm, wn, l15, quad, tid, smem);
    }
    gA = gAn; gB = gBn;
  }
}

DEVINL void ffn_edge_phase(const float* __restrict__ EDGE, const float* __restrict__ wdw, bfr* __restrict__ ACT, int bid, int nblk) {
  const int gt = bid * 256 + otid(), nt = nblk * 256;
  for (int i = gt; i < 160 * 2 * 704; i += nt) {
    const int cg4 = i % 704, r2 = i / 704, side = r2 & 1, tm = r2 >> 1;
    const int m0 = tm << 7;
    int tl, Tlen; tok_pos(m0, tl, Tlen);
    if (side == 0 ? (tl == 0) : (tl + 128 == Tlen)) continue;
    const int ja = cg4 * 4;
    const int nb_ = ja >> 6, cc = ja & 63;
    const int ea = nb_ * 128 + cc, eb = ea + 64;
    const float* prev; const float* cur; const float* next;
    if (side == 0) {
      prev = EDGE + ((size_t)(tm - 1) * 4 + 3) * EDGE_LD; cur = EDGE + ((size_t)tm * 4 + 0) * EDGE_LD; next = EDGE + ((size_t)tm * 4 + 1) * EDGE_LD;
    } else {
      prev = EDGE + ((size_t)tm * 4 + 2) * EDGE_LD; cur = EDGE + ((size_t)tm * 4 + 3) * EDGE_LD; next = EDGE + ((size_t)(tm + 1) * 4 + 0) * EDGE_LD;
    }
    const f32x4 a = *(const f32x4*)(wdw + ja) * *(const f32x4*)(prev + ea) + *(const f32x4*)(wdw + 2 * DFF + ja) * *(const f32x4*)(cur + ea) +
                    *(const f32x4*)(wdw + 4 * DFF + ja) * *(const f32x4*)(next + ea);
    const f32x4 b = *(const f32x4*)(wdw + DFF + ja) * *(const f32x4*)(prev + eb) + *(const f32x4*)(wdw + 3 * DFF + ja) * *(const f32x4*)(cur + eb) +
                    *(const f32x4*)(wdw + 5 * DFF + ja) * *(const f32x4*)(next + eb);
    uint2 o;
    o.x = pk2(silu_f(a[0]) * b[0], silu_f(a[1]) * b[1]);
    o.y = pk2(silu_f(a[2]) * b[2], silu_f(a[3]) * b[3]);
    const int m = m0 + (side ? 127 : 0);
    *(uint2*)(ACT + (size_t)m * DFF + ja) = o;
  }
}

DEVINL int up_perm(int n0) {
  if (n0 < DFF) return (n0 >> 6) * 128;
  return ((n0 - DFF) >> 6) * 128 + 64;
}
DEVINL void conv_matrix(const float* __restrict__ src, int K, int N, bfr* __restrict__ dst, int perm,
                        char* smem, int bid, int nblk) {
  float* sT = (float*)smem;
  const int tid = otid();
  const int tilesN = N >> 6;
  const int ntiles = (K >> 6) * tilesN;
  for (int t = bid; t < ntiles; t += nblk) {
    const int tk = t / tilesN, tn = t - tk * tilesN;
    const int k0 = tk << 6, n0 = tn << 6;
    const int r = tid >> 4, c4 = tid & 15;
    __syncthreads();
#pragma unroll
    for (int i = 0; i < 4; ++i) {
      const float4 v = *(const float4*)(src + (size_t)(k0 + r + i * 16) * N + n0 + c4 * 4);
      float* d = sT + (r + i * 16) * 65 + c4 * 4;
      d[0] = v.x; d[1] = v.y; d[2] = v.z; d[3] = v.w;
    }
    __syncthreads();
    const int n = tid >> 2, kc = tid & 3;
    uint32_t w[8];
#pragma unroll
    for (int j = 0; j < 8; ++j)
      w[j] = pk2(sT[(kc * 16 + 2 * j) * 65 + n], sT[(kc * 16 + 2 * j + 1) * 65 + n]);
    const int nd = (perm ? up_perm(n0) : n0) + n;
    bfr* dp = dst + (size_t)nd * K + k0 + kc * 16;
    *(uint4*)dp = make_uint4(w[0], w[1], w[2], w[3]);
    *(uint4*)(dp + 8) = make_uint4(w[4], w[5], w[6], w[7]);
  }
}

DEVINL void phase0a(const Params& p, char* smem, int bid, int nblk) {
  const int tid = otid();
  float* sc = (float*)smem;
  float* modp = (float*)(p.ws + OFF_MODP);
  const float* cvec = p.in[3];
  const float* cctx = p.in[4];
  const float* ada_w = p.in[5];
  for (int job = bid; job < 384; job += nblk) {
    const int l = job / 96, r = job - l * 96, ks = r / 6, cgp = r - ks * 6;
    __syncthreads();
    for (int i = tid; i < 320; i += 256) {
      const int cond = i >> 6, kk = i & 63;
      const float v = cond == 0 ? cctx[ks * 64 + kk] : cvec[(cond - 1) * DM + ks * 64 + kk];
      sc[i] = silu_f(v);
    }
    __syncthreads();
    const int col = cgp * 1024 + tid * 4;
    const float* wp = ada_w + ((size_t)l * DM + ks * 64) * 6144 + col;
    float a[5][4];
#pragma unroll
    for (int c = 0; c < 5; ++c)
#pragma unroll
      for (int j = 0; j < 4; ++j) a[c][j] = 0.f;
#pragma unroll 8
    for (int kk = 0; kk < 64; ++kk) {
      const float4 w = *(const float4*)(wp + (size_t)kk * 6144);
#pragma unroll
      for (int c = 0; c < 5; ++c) {
        const float s = sc[c * 64 + kk];
        a[c][0] += s * w.x; a[c][1] += s * w.y; a[c][2] += s * w.z; a[c][3] += s * w.w;
      }
    }
#pragma unroll
    for (int c = 0; c < 5; ++c)
      *(float4*)(modp + ((size_t)(ks * 4 + l) * 5 + c) * 6144 + col) = make_float4(a[c][0], a[c][1], a[c][2], a[c][3]);
  }
  const int gt = bid * 256 + tid, nt = nblk * 256;
  {
    const float* lb = p.in[20];
    float* lbs = (float*)(p.ws + OFF_LBS);
    for (int i = gt; i < 2048; i += nt) {
      const float v0 = lb[i], v1 = lb[2048 + i], v2 = lb[4096 + i], v3 = lb[6144 + i];
      const float mx = fmaxf(fmaxf(v0, v1), fmaxf(v2, v3));
      const float e0 = expf(v0 - mx), e1 = expf(v1 - mx), e2 = expf(v2 - mx), e3 = expf(v3 - mx);
      lbs[i] = (e1 + e2 + e3) / (e0 + e1 + e2 + e3);
    }
  }
  float* X = p.out;
  {
    const float4* xp = (const float4*)p.in[0];
    float4* xo = (float4*)X;
    for (int i = gt; i < NPROMPT * DM / 4; i += nt) xo[i] = xp[i];
    const float* xs = p.in[1];
    for (int i = gt; i < 4096 * 256; i += nt) {
      const int t = i >> 8, c = (i & 255) * 4;
      const int part = c >> 8;
      const float pos = (float)((part < 2) ? (t >> 6) : (t & 63));
      float pe[4];
#pragma unroll
      for (int j = 0; j < 4; ++j) {
        const int jj = (c + j) & 255;
        const float freq = expf((-9.210340371976184f * (float)jj) / 256.0f);
        const float arg = pos * freq;
        pe[j] = (part & 1) ? cosf(arg) : sinf(arg);
      }
#pragma unroll
      for (int b = 0; b < 4; ++b) {
        const size_t off = ((size_t)b * 4096 + t) * DM + c;
        float4 v = *(const float4*)(xs + off);
        v.x += pe[0]; v.y += pe[1]; v.z += pe[2]; v.w += pe[3];
        *(float4*)(X + (size_t)NPROMPT * DM + off) = v;
      }
    }
  }
}

DEVINL void phase0b(const Params& p, int bid, int nblk) {
  const int gt = bid * 256 + otid(), nt = nblk * 256;
  const float* modp = (const float*)(p.ws + OFF_MODP);
  float* mod = (float*)(p.ws + OFF_MOD);
  const float* ada_b = p.in[6];
  for (int i = gt; i < 4 * 5 * 6144; i += nt) {
    const int l = i / 30720, col = i % 6144;
    float s = ada_b[l * 6144 + col];
#pragma unroll
    for (int ks = 0; ks < 16; ++ks) s += modp[(size_t)ks * 122880 + i];
    mod[i] = s;
  }
}

DEVINL void norm_phase(const float* __restrict__ X, const float* __restrict__ g, const float* __restrict__ modl,
                       int shift_off, int scale_off, bfr* __restrict__ H, int bid, int nblk) {
  const int tid = otid(); const int lane = tid & 63;
  const int gw = bid * 4 + (tid >> 6), nw = nblk * 4;
  for (int row = gw; row < MTOK; row += nw) {
    const float* xr = X + (size_t)row * DM;
    float4 x[4];
    float ss = 0.f;
#pragma unroll
    for (int i = 0; i < 4; ++i) {
      x[i] = *(const float4*)(xr + i * 256 + lane * 4);
      ss += x[i].x * x[i].x + x[i].y * x[i].y + x[i].z * x[i].z + x[i].w * x[i].w;
    }
    ss = wave_sum(ss, lane);
    const float rstd = rsqrtf(ss * (1.f / DM) + EPS);
    const float* mc = modl + cond_of(row) * 6144;
#pragma unroll
    for (int i = 0; i < 4; ++i) {
      const int c = i * 256 + lane * 4;
      const float4 gg = *(const float4*)(g + c);
      const float4 sh = *(const float4*)(mc + shift_off + c);
      const float4 sc = *(const float4*)(mc + scale_off + c);
      const float h0 = x[i].x * rstd * gg.x * (1.f + sc.x) + sh.x;
      const float h1 = x[i].y * rstd * gg.y * (1.f + sc.y) + sh.y;
      const float h2 = x[i].z * rstd * gg.z * (1.f + sc.z) + sh.z;
      const float h3 = x[i].w * rstd * gg.w * (1.f + sc.w) + sh.w;
      uint2 o; o.x = pk2(h0, h1); o.y = pk2(h2, h3);
      *(uint2*)(H + (size_t)row * DM + c) = o;
    }
  }
}

DEVINL void final_norm_phase(float* X, const float* __restrict__ g, int bid, int nblk) {
  const int tid = otid(); const int lane = tid & 63;
  const int gw = bid * 4 + (tid >> 6), nw = nblk * 4;
  for (int row = gw; row < MTOK; row += nw) {
    float* xr = X + (size_t)row * DM;
    float4 x[4];
    float ss = 0.f;
#pragma unroll
    for (int i = 0; i < 4; ++i) {
      x[i] = *(const float4*)(xr + i * 256 + lane * 4);
      ss += x[i].x * x[i].x + x[i].y * x[i].y + x[i].z * x[i].z + x[i].w * x[i].w;
    }
    ss = wave_sum(ss, lane);
    const float rstd = rsqrtf(ss * (1.f / DM) + EPS);
#pragma unroll
    for (int i = 0; i < 4; ++i) {
      const int c = i * 256 + lane * 4;
      const float4 gg = *(const float4*)(g + c);
      float4 o;
      o.x = x[i].x * rstd * gg.x; o.y = x[i].y * rstd * gg.y; o.z = x[i].z * rstd * gg.z; o.w = x[i].w * rstd * gg.w;
      *(float4*)(xr + c) = o;
    }
  }
}

DEVINL void shortconv_ew_phase(const bfr* __restrict__ G, const float* __restrict__ wdw, bfr* __restrict__ U, int bid, int nblk) {
  const int gt = bid * 256 + otid(), nt = nblk * 256;
  for (int i = gt; i < MTOK * 128; i += nt) {
    const int m = i >> 7, c = (i & 127) * 8;
    int tl, T; tok_pos(m, tl, T);
    const bfr* gr = G + (size_t)m * 3072;
    const uint4 bg = *(const uint4*)(gr + c);
    float accv[8];
#pragma unroll
    for (int j = 0; j < 8; ++j) accv[j] = 0.f;
#pragma unroll
    for (int tap = 0; tap < 3; ++tap) {
      const int d = tap - 1;
      if ((d < 0 && tl == 0) || (d > 0 && tl == T - 1)) continue;
      const bfr* nr = gr + (ptrdiff_t)d * 3072;
      const uint4 cgv = *(const uint4*)(nr + 1024 + c);
      const uint4 xhv = *(const uint4*)(nr + 2048 + c);
      const float4 w0 = *(const float4*)(wdw + tap * DM + c);
      const float4 w1 = *(const float4*)(wdw + tap * DM + c + 4);
      accv[0] += w0.x * bflo(cgv.x) * bflo(xhv.x); accv[1] += w0.y * bfhi(cgv.x) * bfhi(xhv.x);
      accv[2] += w0.z * bflo(cgv.y) * bflo(xhv.y); accv[3] += w0.w * bfhi(cgv.y) * bfhi(xhv.y);
      accv[4] += w1.x * bflo(cgv.z) * bflo(xhv.z); accv[5] += w1.y * bfhi(cgv.z) * bfhi(xhv.z);
      accv[6] += w1.z * bflo(cgv.w) * bflo(xhv.w); accv[7] += w1.w * bfhi(cgv.w) * bfhi(xhv.w);
    }
    uint4 o;
    o.x = pk2(bflo(bg.x) * accv[0], bfhi(bg.x) * accv[1]);
    o.y = pk2(bflo(bg.y) * accv[2], bfhi(bg.y) * accv[3]);
    o.z = pk2(bflo(bg.z) * accv[4], bfhi(bg.z) * accv[5]);
    o.w = pk2(bflo(bg.w) * accv[6], bfhi(bg.w) * accv[7]);
    *(uint4*)(U + (size_t)m * DM + c) = o;
  }
}

DEVINL void pool_ew_phase(const bfr* __restrict__ H, bfr* __restrict__ P, int bid, int nblk) {
  const int gt = bid * 256 + otid(), nt = nblk * 256;
  for (int i = gt; i < MTOK * 128; i += nt) {
    const int m = i >> 7, ch = i & 127, c = ch * 8;
    int tl, T; tok_pos(m, tl, T);
    const int hw = 1 << (ch >> 5);
    const int lo = max(tl - hw, 0), hi = min(tl + hw, T);
    float s[8];
#pragma unroll
    for (int j = 0; j < 8; ++j) s[j] = 0.f;
    const bfr* base = H + (size_t)(m - tl) * DM + c;
    for (int q = lo; q < hi; ++q) {
      const uint4 v = *(const uint4*)(base + (size_t)q * DM);
      s[0] += bflo(v.x); s[1] += bfhi(v.x); s[2] += bflo(v.y); s[3] += bfhi(v.y);
      s[4] += bflo(v.z); s[5] += bfhi(v.z); s[6] += bflo(v.w); s[7] += bfhi(v.w);
    }
    const float inv = 1.f / (float)(hi - lo);
    const uint4 v = *(const uint4*)(base + (size_t)tl * DM);
    uint4 o;
    o.x = pk2(s[0] * inv - bflo(v.x), s[1] * inv - bfhi(v.x));
    o.y = pk2(s[2] * inv - bflo(v.y), s[3] * inv - bfhi(v.y));
    o.z = pk2(s[4] * inv - bflo(v.z), s[5] * inv - bfhi(v.z));
    o.w = pk2(s[6] * inv - bflo(v.w), s[7] * inv - bfhi(v.w));
    *(uint4*)(P + (size_t)m * DM + c) = o;
  }
}

DEVINL void sgu_norm_phase(bfr* UV, const float* __restrict__ g, int bid, int nblk) {
  const int tid = otid(); const int lane = tid & 63;
  const int gw = bid * 4 + (tid >> 6), nw = nblk * 4;
  for (int row = gw; row < MTOK; row += nw) {
    bfr* vr = UV + (size_t)row * 2048 + 1024;
    float x[4][4];
    float ss = 0.f;
#pragma unroll
    for (int i = 0; i < 4; ++i) {
      const uint2 v = *(const uint2*)(vr + i * 256 + lane * 4);
      x[i][0] = bflo(v.x); x[i][1] = bfhi(v.x); x[i][2] = bflo(v.y); x[i][3] = bfhi(v.y);
      ss += x[i][0] * x[i][0] + x[i][1] * x[i][1] + x[i][2] * x[i][2] + x[i][3] * x[i][3];
    }
    ss = wave_sum(ss, lane);
    const float rstd = rsqrtf(ss * (1.f / DM) + EPS);
#pragma unroll
    for (int i = 0; i < 4; ++i) {
      const int c = i * 256 + lane * 4;
      const float4 gg = *(const float4*)(g + c);
      uint2 o;
      o.x = pk2(x[i][0] * rstd * gg.x, x[i][1] * rstd * gg.y);
      o.y = pk2(x[i][2] * rstd * gg.z, x[i][3] * rstd * gg.w);
      *(uint2*)(vr + c) = o;
    }
  }
}

DEVINL void sgu_spatial_phase(bfr* UV, const float* __restrict__ ws_, const float* __restrict__ bs_, char* smem, int bid, int nblk) {
  bfr* sV = (bfr*)smem;
  bfr* sW = sV + 128 * 136;
  const int tid = otid(), lane = tid & 63, wave = tid >> 6, l15 = lane & 15, quad = lane >> 4;
  for (int item = bid; item < 160 * 8; item += nblk) {
    const int chunk = item >> 3, g = item & 7;
    __syncthreads();
    const float* wg = ws_ + (size_t)g * 16384;
#pragma unroll 4
    for (int i = 0; i < 16; ++i) {
      const int idx = tid + 256 * i;
      const int row = idx >> 5, chn = idx & 31;
      const float4 v = *(const float4*)(wg + row * 128 + chn * 4);
      uint2 o; o.x = pk2(v.x, v.y); o.y = pk2(v.z, v.w);
      *(uint2*)(sW + row * 136 + chn * 4) = o;
    }
#pragma unroll 2
    for (int i = 0; i < 8; ++i) {
      const int idx = tid + 256 * i;
      const int q = idx >> 4, chn = idx & 15;
      const uint4 v = *(const uint4*)(UV + (size_t)(chunk * 128 + q) * 2048 + 1024 + g * 128 + chn * 8);
      bfr* d = sV + (chn * 8) * 136 + q;
      d[0 * 136] = (bfr)(v.x & 0xffff); d[1 * 136] = (bfr)(v.x >> 16);
      d[2 * 136] = (bfr)(v.y & 0xffff); d[3 * 136] = (bfr)(v.y >> 16);
      d[4 * 136] = (bfr)(v.z & 0xffff); d[5 * 136] = (bfr)(v.z >> 16);
      d[6 * 136] = (bfr)(v.w & 0xffff); d[7 * 136] = (bfr)(v.w >> 16);
    }
    __syncthreads();
    f32x4 acc[8][2];
#pragma unroll
    for (int i = 0; i < 8; ++i) { acc[i][0] = f32x4{0.f, 0.f, 0.f, 0.f}; acc[i][1] = f32x4{0.f, 0.f, 0.f, 0.f}; }
#pragma unroll
    for (int kk = 0; kk < 4; ++kk) {
      bf16x8 bw[2];
#pragma unroll
      for (int pt = 0; pt < 2; ++pt) bw[pt] = *(const bf16x8*)(sW + (wave * 32 + pt * 16 + l15) * 136 + kk * 32 + quad * 8);
#pragma unroll
      for (int ct = 0; ct < 8; ++ct) {
        const bf16x8 av = *(const bf16x8*)(sV + (ct * 16 + l15) * 136 + kk * 32 + quad * 8);
#pragma unroll
        for (int pt = 0; pt < 2; ++pt)
          acc[ct][pt] = __builtin_amdgcn_mfma_f32_16x16x32_bf16(av, bw[pt], acc[ct][pt], 0, 0, 0);
      }
    }
#pragma unroll
    for (int pt = 0; pt < 2; ++pt) {
      const int pp = wave * 32 + pt * 16 + l15;
      const float bias = bs_[g * 128 + pp];
      bfr* ur = UV + (size_t)(chunk * 128 + pp) * 2048 + g * 128 + quad * 4;
#pragma unroll
      for (int ct = 0; ct < 8; ++ct) {
        const uint2 u = *(const uint2*)(ur + ct * 16);
        uint2 o;
        o.x = pk2(bflo(u.x) * (acc[ct][pt][0] + bias), bfhi(u.x) * (acc[ct][pt][1] + bias));
        o.y = pk2(bflo(u.y) * (acc[ct][pt][2] + bias), bfhi(u.y) * (acc[ct][pt][3] + bias));
        *(uint2*)(ur + ct * 16) = o;
      }
    }
  }
}

DEVINL void hgrn_scan_phase(const Params& p, char* smem, int bid, int nblk, const int mode) {
  bfr* sQe = (bfr*)smem;
  bfr* sKe = sQe + 32 * 136;
  bfr* sKeT = sKe + 32 * 136;
  bfr* sVT = sKeT + 128 * 40;
  bfr* sP = sVT + 64 * 40;
  bfr* sST = sP + 32 * 40;
  float* sLast = (float*)(sST + 64 * 136);
  float* sTot = sLast + 128;
  const int tid = otid(), lane = tid & 63, wave = tid >> 6, l15 = lane & 15, quad = lane >> 4;
  const int cp = lane, qt = wave, i0 = qt * 8;
  const bfr* QZ = (const bfr*)(p.ws + OFF_BIG);
  bfr* Of = (bfr*)(p.ws + OFF_H);
  bfr* Ob = (bfr*)(p.ws + OFF_BIG + 209715200ull);
  const float* lbs = (const float*)(p.ws + OFF_LBS);
  const float* state_rec = p.in[2];
  float* out_state = p.out + (size_t)MTOK * DM;

  float* SLOC = (float*)(p.ws + OFF_BIG + 251658240ull);
  float* DLOC = (float*)(p.ws + OFF_BIG + 251658240ull + 33554432ull);
  const int nitems = mode ? 1536 : 896;
  for (int item = bid; item < nitems; item += nblk) {
    const int eh = item & 1, dir = (item >> 1) & 1, h = (item >> 2) & 7;
    int base, T, nchunks, pos0, slot, seq;
    bool is_prompt = false;
    if (!mode) {
      const int r = item >> 5, seqb = r / 7, j = r - seqb * 7;
      seq = 16 + seqb; base = NPROMPT + seqb * 4096; T = 4096; nchunks = 16; pos0 = j * 512;
      slot = ((seqb * 8 + j) * 8 + h) * 2 + dir;
    } else if (item < 1024) {
      const int r = item >> 5, seqb = r >> 3, j = r & 7;
      seq = 16 + seqb; base = NPROMPT + seqb * 4096; T = 4096; nchunks = 16; pos0 = j * 512;
      slot = ((seqb * 8 + j) * 8 + h) * 2 + dir;
    } else {
      seq = (item - 1024) >> 5; base = seq * 256; T = 256; nchunks = 8; pos0 = 0; slot = 0;
      is_prompt = true;
    }
    bfr* Od = dir ? Ob : Of;
    const float lbv0 = lbs[dir * 1024 + h * 128 + 2 * cp], lbv1 = lbs[dir * 1024 + h * 128 + 2 * cp + 1];
    const int eloc = wave * 16 + l15;
    const int eglob = eh * 64 + eloc;

    f32x4 S[8];
    if (is_prompt || !mode) {
#pragma unroll
      for (int dt = 0; dt < 8; ++dt) S[dt] = f32x4{0.f, 0.f, 0.f, 0.f};
    } else {
      const float* s0 = SLOC + (size_t)slot * 16384;
#pragma unroll
      for (int dt = 0; dt < 8; ++dt)
#pragma unroll
        for (int j = 0; j < 4; ++j) S[dt][j] = s0[(dt * 16 + quad * 4 + j) * 128 + eglob];
    }
    float cum0 = 1.f, cum1 = 1.f;
    __syncthreads();
#pragma unroll
    for (int dt = 0; dt < 8; ++dt) {
      uint2 o; o.x = pk2(S[dt][0], S[dt][1]); o.y = pk2(S[dt][2], S[dt][3]);
      *(uint2*)(sST + eloc * 136 + dt * 16 + quad * 4) = o;
    }

    const unsigned qoff2 = h * 64 + cp, zoff2 = (1 + dir) * 512 + h * 64 + cp;
    const unsigned voff2 = 1536 + h * 64 + eh * 32 + (cp & 31);
    const uint32_t* __restrict__ QZ32 = (const uint32_t*)QZ;
    uint32_t rq[8], rz[8], rv[8];
#pragma unroll
    for (int ii = 0; ii < 8; ++ii) {
      const int pos = pos0 + i0 + ii;
      const unsigned tok = dir ? base + T - 1 - pos : base + pos;
      const unsigned ri = tok * 2560u;
      rq[ii] = QZ32[ri + qoff2]; rz[ii] = QZ32[ri + zoff2]; rv[ii] = QZ32[ri + voff2];
    }

    for (int c = 0; c < nchunks; ++c) {
      float pc0[8], pc1[8], kv0[8], kv1[8];
      float run0 = 1.f, run1 = 1.f;
#pragma unroll
      for (int ii = 0; ii < 8; ++ii) {
        const float z0 = bflo(rz[ii]), z1 = bfhi(rz[ii]);
        const float f0 = lbv0 + (1.f - lbv0) * frcp(1.f + __expf(-z0));
        const float f1 = lbv1 + (1.f - lbv1) * frcp(1.f + __expf(-z1));
        run0 *= f0; run1 *= f1;
        pc0[ii] = run0; pc1[ii] = run1;
        kv0[ii] = 1.f - f0; kv1[ii] = 1.f - f1;
      }
      *(float2*)(sTot + qt * 128 + 2 * cp) = make_float2(run0, run1);
      __syncthreads();
      {
        float off0 = 1.f, off1 = 1.f, tot0 = 1.f, tot1 = 1.f;
#pragma unroll
        for (int q = 0; q < 4; ++q) {
          const float2 t = *(const float2*)(sTot + q * 128 + 2 * cp);
          if (q < qt) { off0 *= t.x; off1 *= t.y; }
          tot0 *= t.x; tot1 *= t.y;
        }
        uint32_t wk0[4], wk1[4], wv0[4], wv1[4];
#pragma unroll
        for (int ii = 0; ii < 8; ii += 2) {
          uint32_t kp[2];
#pragma unroll
          for (int u = 0; u < 2; ++u) {
            const float e0 = pc0[ii + u] * off0, e1 = pc1[ii + u] * off1;
            kp[u] = pk2(kv0[ii + u] * frcp(e0), kv1[ii + u] * frcp(e1));
            *(uint32_t*)(sKe + (i0 + ii + u) * 136 + 2 * cp) = kp[u];
            if (mode) *(uint32_t*)(sQe + (i0 + ii + u) * 136 + 2 * cp) = pk2(bflo(rq[ii + u]) * e0, bfhi(rq[ii + u]) * e1);
          }
          wk0[ii >> 1] = (kp[0] & 0xffffu) | (kp[1] << 16);
          wk1[ii >> 1] = (kp[0] >> 16) | (kp[1] & 0xffff0000u);
          wv0[ii >> 1] = (rv[ii] & 0xffffu) | (rv[ii + 1] << 16);
          wv1[ii >> 1] = (rv[ii] >> 16) | (rv[ii + 1] & 0xffff0000u);
        }
        *(u32x4*)(sKeT + (2 * cp) * 40 + i0) = u32x4{wk0[0], wk0[1], wk0[2], wk0[3]};
        *(u32x4*)(sKeT + (2 * cp + 1) * 40 + i0) = u32x4{wk1[0], wk1[1], wk1[2], wk1[3]};
        if (cp < 32) {
          *(u32x4*)(sVT + (2 * cp) * 40 + i0) = u32x4{wv0[0], wv0[1], wv0[2], wv0[3]};
          *(u32x4*)(sVT + (2 * cp + 1) * 40 + i0) = u32x4{wv1[0], wv1[1], wv1[2], wv1[3]};
        }
        if (qt == 0) *(float2*)(sLast + 2 * cp) = make_float2(tot0, tot1);
        cum0 *= tot0; cum1 *= tot1;
      }
      if (c + 1 < nchunks) {
#pragma unroll
        for (int ii = 0; ii < 8; ++ii) {
          const int pos = pos0 + (c + 1) * 32 + i0 + ii;
          const unsigned tok = dir ? base + T - 1 - pos : base + pos;
          const unsigned ri = tok * 2560u;
          rq[ii] = QZ32[ri + qoff2]; rz[ii] = QZ32[ri + zoff2]; rv[ii] = QZ32[ri + voff2];
        }
      }
      __syncthreads();
      if (mode) {
        const int ti = wave >> 1, si = wave & 1;
        f32x4 sc = f32x4{0.f, 0.f, 0.f, 0.f};
        if (si <= ti) {
#pragma unroll
          for (int kk = 0; kk < 4; ++kk) {
            const bf16x8 a = *(const bf16x8*)(sQe + (ti * 16 + l15) * 136 + kk * 32 + quad * 8);
            const bf16x8 b = *(const bf16x8*)(sKe + (si * 16 + l15) * 136 + kk * 32 + quad * 8);
            sc = __builtin_amdgcn_mfma_f32_16x16x32_bf16(a, b, sc, 0, 0, 0);
          }
        }
#pragma unroll
        for (int j = 0; j < 4; ++j) {
          const int t = ti * 16 + quad * 4 + j, s2 = si * 16 + l15;
          sP[t * 40 + s2] = (s2 <= t) ? f2bf(sc[j]) : (bfr)0;
        }
      }
      f32x4 oacc[2];
      oacc[0] = f32x4{0.f, 0.f, 0.f, 0.f}; oacc[1] = f32x4{0.f, 0.f, 0.f, 0.f};
      if (mode) {
#pragma unroll
      for (int kk = 0; kk < 4; ++kk) {
        const bf16x8 sb = *(const bf16x8*)(sST + eloc * 136 + kk * 32 + quad * 8);
#pragma unroll
        for (int tt = 0; tt < 2; ++tt) {
          const bf16x8 qa = *(const bf16x8*)(sQe + (tt * 16 + l15) * 136 + kk * 32 + quad * 8);
          oacc[tt] = __builtin_amdgcn_mfma_f32_16x16x32_bf16(sb, qa, oacc[tt], 0, 0, 0);
        }
      }
      }
      __syncthreads();
      {
        const bf16x8 vb = *(const bf16x8*)(sVT + eloc * 40 + quad * 8);
        if (mode) {
#pragma unroll
        for (int tt = 0; tt < 2; ++tt) {
          const bf16x8 pb = *(const bf16x8*)(sP + (tt * 16 + l15) * 40 + quad * 8);
          oacc[tt] = __builtin_amdgcn_mfma_f32_16x16x32_bf16(vb, pb, oacc[tt], 0, 0, 0);
          const int pos = pos0 + c * 32 + tt * 16 + l15;
          const int tok = dir ? base + T - 1 - pos : base + pos;
          uint2 o; o.x = pk2(oacc[tt][0], oacc[tt][1]); o.y = pk2(oacc[tt][2], oacc[tt][3]);
          *(uint2*)(Od + (size_t)tok * DM + h * 128 + eh * 64 + wave * 16 + quad * 4) = o;
        }
        }
#pragma unroll
        for (int dt = 0; dt < 8; ++dt) {
          const bf16x8 ka = *(const bf16x8*)(sKeT + (dt * 16 + l15) * 40 + quad * 8);
          const float4 dl = *(const float4*)(sLast + dt * 16 + quad * 4);
          f32x4 sn = __builtin_amdgcn_mfma_f32_16x16x32_bf16(ka, vb, S[dt], 0, 0, 0);
          sn[0] *= dl.x; sn[1] *= dl.y; sn[2] *= dl.z; sn[3] *= dl.w;
          S[dt] = sn;
          uint2 o; o.x = pk2(sn[0], sn[1]); o.y = pk2(sn[2], sn[3]);
          *(uint2*)(sST + eloc * 136 + dt * 16 + quad * 4) = o;
        }
      }
    }
    if (is_prompt || !mode) {
      float* so = is_prompt ? out_state + ((size_t)(seq * 2 + dir) * 8 + h) * 16384 : SLOC + (size_t)slot * 16384;
#pragma unroll
      for (int dt = 0; dt < 8; ++dt)
#pragma unroll
        for (int j = 0; j < 4; ++j) so[(dt * 16 + quad * 4 + j) * 128 + eglob] = S[dt][j];
      if (!mode && eh == 0 && qt == 0) *(float2*)(DLOC + slot * 128 + 2 * cp) = make_float2(cum0, cum1);
    }
  }
}

DEVINL void hgrn_combine_phase(const Params& p, int bid, int nblk) {
  const int gt = bid * 256 + otid(), nt = nblk * 256;
  float* SLOC = (float*)(p.ws + OFF_BIG + 251658240ull);
  const float* DLOC = (const float*)(p.ws + OFF_BIG + 251658240ull + 33554432ull);
  const float* state_rec = p.in[2];
  for (int idx = gt; idx < 4 * 8 * 2 * 16384; idx += nt) {
    const int de = idx & 16383, r = idx >> 14;
    const int dir = r & 1, h = (r >> 1) & 7, seqb = r >> 4;
    const int d = de >> 7;
    float prev = state_rec[((size_t)(seqb * 2 + dir) * 8 + h) * 16384 + de];
#pragma unroll
    for (int j = 0; j < 8; ++j) {
      const int slot = ((seqb * 8 + j) * 8 + h) * 2 + dir;
      float* ptr = SLOC + (size_t)slot * 16384 + de;
      const float a = (j < 7) ? *ptr : 0.f;
      *ptr = prev;
      if (j < 7) prev = DLOC[slot * 128 + d] * prev + a;
    }
  }
}

DEVINL void hgrn_gate_phase(const Params& p, const float* __restrict__ ng, int bid, int nblk) {
  const int tid = otid(); const int lane = tid & 63;
  const int gw = bid * 4 + (tid >> 6), nw = nblk * 4;
  bfr* Of = (bfr*)(p.ws + OFF_H);
  const bfr* Ob = (const bfr*)(p.ws + OFF_BIG + 209715200ull);
  const bfr* QZ = (const bfr*)(p.ws + OFF_BIG);
  for (int row = gw; row < MTOK; row += nw) {
#pragma unroll
    for (int seg = 0; seg < 4; ++seg) {
      const int c = seg * 256 + lane * 4;
      const uint2 a = *(const uint2*)(Of + (size_t)row * DM + c);
      const uint2 b = *(const uint2*)(Ob + (size_t)row * DM + c);
      const uint2 gq = *(const uint2*)(QZ + (size_t)row * 5120 + 4096 + c);
      const float o0 = bflo(a.x) + bflo(b.x), o1 = bfhi(a.x) + bfhi(b.x), o2 = bflo(a.y) + bflo(b.y), o3 = bfhi(a.y) + bfhi(b.y);
      float ss = o0 * o0 + o1 * o1 + o2 * o2 + o3 * o3;
#pragma unroll
      for (int o = 16; o > 0; o >>= 1) ss += shx(ss, o, lane);
      const float rstd = rsqrtf(ss * (1.f / 128.f) + EPS);
      const float4 gg = *(const float4*)(ng + c);
      uint2 o;
      o.x = pk2(o0 * rstd * gg.x * silu_f(bflo(gq.x)), o1 * rstd * gg.y * silu_f(bfhi(gq.x)));
      o.y = pk2(o2 * rstd * gg.z * silu_f(bflo(gq.y)), o3 * rstd * gg.w * silu_f(bfhi(gq.y)));
      *(uint2*)(Of + (size_t)row * DM + c) = o;
    }
  }
}

DEVINL void ffn_act_phase(const bfr* __restrict__ UP, const float* __restrict__ wdw, int hf, bfr* __restrict__ ACT, int bid, int nblk) {
  const int gt = bid * 256 + otid(), nt = nblk * 256;
  for (int i = gt; i < MTOK * 176; i += nt) {
    const int m = i / 176, j = (i - m * 176) * 8;
    int tl, T; tok_pos(m, tl, T);
    const bfr* ur = UP + (size_t)m * DFF;
    float a[8], b[8];
#pragma unroll
    for (int q = 0; q < 8; ++q) { a[q] = 0.f; b[q] = 0.f; }
#pragma unroll
    for (int tap = 0; tap < 3; ++tap) {
      const int d = tap - 1;
      if ((d < 0 && tl == 0) || (d > 0 && tl == T - 1)) continue;
      const bfr* nr = ur + (ptrdiff_t)d * DFF;
      const uint4 av = *(const uint4*)(nr + j);
      const uint4 bv = *(const uint4*)(nr + HALF_FF + j);
      const float* wa = wdw + tap * (2 * DFF) + hf * HALF_FF + j;
      const float* wb = wdw + tap * (2 * DFF) + DFF + hf * HALF_FF + j;
      const float4 wa0 = *(const float4*)wa, wa1 = *(const float4*)(wa + 4);
      const float4 wb0 = *(const float4*)wb, wb1 = *(const float4*)(wb + 4);
      a[0] += wa0.x * bflo(av.x); a[1] += wa0.y * bfhi(av.x); a[2] += wa0.z * bflo(av.y); a[3] += wa0.w * bfhi(av.y);
      a[4] += wa1.x * bflo(av.z); a[5] += wa1.y * bfhi(av.z); a[6] += wa1.z * bflo(av.w); a[7] += wa1.w * bfhi(av.w);
      b[0] += wb0.x * bflo(bv.x); b[1] += wb0.y * bfhi(bv.x); b[2] += wb0.z * bflo(bv.y); b[3] += wb0.w * bfhi(bv.y);
      b[4] += wb1.x * bflo(bv.z); b[5] += wb1.y * bfhi(bv.z); b[6] += wb1.z * bflo(bv.w); b[7] += wb1.w * bfhi(bv.w);
    }
    uint4 o;
    o.x = pk2(silu_f(a[0]) * b[0], silu_f(a[1]) * b[1]);
    o.y = pk2(silu_f(a[2]) * b[2], silu_f(a[3]) * b[3]);
    o.z = pk2(silu_f(a[4]) * b[4], silu_f(a[5]) * b[5]);
    o.w = pk2(silu_f(a[6]) * b[6], silu_f(a[7]) * b[7]);
    *(uint4*)(ACT + (size_t)m * DFF + hf * HALF_FF + j) = o;
  }
}


#define XB_TMO      128
#define XB_XCNT(j)  (256  + 64 * (j))
#define XB_XSUB(j)  (1280 + 64 * (j))
#define XB_XGEN(j)  (2304 + 64 * (j))
#define XB_TOP      3328
#define XB_TOPGEN   3392
#define XCD_BAR_WORDS 3456
#define XB_SPIN_CAP (1u << 22)
#define LAS __attribute__((address_space(3)))
DEVINL unsigned xb_ld(unsigned* p) { return __hip_atomic_load(p, __ATOMIC_RELAXED, __HIP_MEMORY_SCOPE_AGENT); }
DEVINL unsigned xb_add(unsigned* p, unsigned v) { return __hip_atomic_fetch_add(p, v, __ATOMIC_RELAXED, __HIP_MEMORY_SCOPE_AGENT); }
DEVINL unsigned xb_xcc_id() { return (unsigned)__builtin_amdgcn_s_getreg((3 << 11) | 20) & 0xFu; }
#define XB_SPIN(cond, bar) do { unsigned _sp = 0; while (cond) { __builtin_amdgcn_s_sleep(1); \
    if ((++_sp & 255u) == 0u) { if (xb_ld(&(bar)[XB_TMO])) break; if (_sp > XB_SPIN_CAP) { atomicAdd(&(bar)[XB_TMO], 1u); break; } } } } while (0)
struct XcdBarrier { unsigned* bar; unsigned x; volatile LAS unsigned* st; };
DEVINL XcdBarrier xcd_barrier_post(unsigned* bar, volatile LAS unsigned* st) {
  XcdBarrier b; b.bar = bar; b.x = xb_xcc_id(); b.st = st;
  if (threadIdx.x == 0) (void)xb_add(&bar[XB_XCNT(b.x)], 1u);
  return b;
}
DEVINL void xcd_barrier_complete(unsigned* bar, unsigned x, unsigned& nloc, unsigned& nx) {
  const unsigned G = gridDim.x * gridDim.y * gridDim.z;
  unsigned sum, cnt, mine, sp = 0u;
  for (;;) {
    sum = 0u; cnt = 0u; mine = 0u;
#pragma unroll
    for (unsigned j = 0; j < 16; ++j) { const unsigned c = xb_ld(&bar[XB_XCNT(j)]); sum += c; cnt += (c > 0u) ? 1u : 0u; mine = (j == x) ? c : mine; }
    if (sum == G) break;
    __builtin_amdgcn_s_sleep(1);
    if ((++sp & 255u) == 0u) { if (xb_ld(&bar[XB_TMO])) break; if (sp > XB_SPIN_CAP) { atomicAdd(&bar[XB_TMO], 1u); break; } }
  }
  nloc = mine > 0u ? mine : 1u; nx = cnt > 0u ? cnt : 1u;
}
DEVINL void xcd_barrier(const XcdBarrier& b) {
  asm volatile("s_waitcnt vmcnt(0)" ::: "memory");
  __syncthreads();
  if (threadIdx.x == 0) {
    unsigned* bar = b.bar;
    unsigned bx = b.x;
    asm volatile("" : "+s"(bar), "+s"(bx));
    __builtin_amdgcn_s_waitcnt(0);
    unsigned nloc = b.st[0], nx = b.st[1];
    if (nloc == 0u) { xcd_barrier_complete(bar, bx, nloc, nx); b.st[0] = nloc; b.st[1] = nx; }
    const unsigned old = xb_add(&bar[XB_XSUB(bx)], 1u);
    const unsigned gen = old / nloc;
    if (old + 1u == (gen + 1u) * nloc) {
      __builtin_amdgcn_fence(__ATOMIC_RELEASE, "agent");
      asm volatile("s_waitcnt vmcnt(0)" ::: "memory");
      const unsigned og = xb_add(&bar[XB_TOP], 1u);
      const unsigned tg = og / nx;
      if (og + 1u == (tg + 1u) * nx) xb_add(&bar[XB_TOPGEN], 1u);
      else XB_SPIN(xb_ld(&bar[XB_TOPGEN]) == tg, bar);
      __builtin_amdgcn_fence(__ATOMIC_ACQUIRE, "agent");
      xb_add(&bar[XB_XGEN(bx)], 1u);
      asm volatile("s_waitcnt vmcnt(0)" ::: "memory");
    } else {
      XB_SPIN(xb_ld(&bar[XB_XGEN(bx)]) == gen, bar);
      __builtin_amdgcn_fence(__ATOMIC_ACQUIRE, "agent");
      asm volatile("s_waitcnt vmcnt(0)" ::: "memory");
    }
  }
  __syncthreads();
}

constexpr int SMEM_BYTES = 77824;

__global__ void __launch_bounds__(256, 2) mega_kernel(Params p) {
  __shared__ __attribute__((aligned(16))) char smem[SMEM_BYTES];
  cg::grid_group grid = cg::this_grid();
  __shared__ uint4 xb_words;
  if (threadIdx.x == 0) xb_words = make_uint4(0u, 0u, 0u, 0u);
  __syncthreads();
  XcdBarrier xb = xcd_barrier_post((unsigned*)(p.ws + OFF_BAR), (volatile LAS unsigned*)&xb_words);
  const int bid = blockIdx.x, nblk = gridDim.x;

  phase0a(p, smem, osg(bid), nblk);
  grid.sync();
  phase0b(p, osg(bid), nblk);
  xcd_barrier(xb);

  for (int layer = 0; layer < 4; ++layer) {
    Params q = p;
    {
      size_t oz = 0;
      asm volatile("" : "+s"(oz));
      q.ws = p.ws + oz;
      q.out = p.out + oz;
    }
    float* X = q.out;
    bfr* WB = (bfr*)(q.ws + OFF_WB);
    bfr* H = (bfr*)(q.ws + OFF_H);
    bfr* BIG = (bfr*)(q.ws + OFF_BIG);
    const float* MOD = (const float*)(q.ws + OFF_MOD);
    const float* modl = MOD + layer * 30720;
    if (layer == 0) {
      conv_matrix(q.in[9], 1024, 3072, WB + WB_IN, 0, smem, osg(bid), nblk);
      conv_matrix(q.in[11], 1024, 1024, WB + WB_OUT, 0, smem, osg(bid), nblk);
    } else if (layer == 1) {
      for (int g = 0; g < 4; ++g) conv_matrix(q.in[12] + g * 65536, 256, 256, WB + WB_IN + g * 65536, 0, smem, osg(bid), nblk);
    } else if (layer == 2) {
      conv_matrix(q.in[14], 1024, 2048, WB + WB_IN, 0, smem, osg(bid), nblk);
      conv_matrix(q.in[18], 1024, 1024, WB + WB_OUT, 0, smem, osg(bid), nblk);
    } else {
      conv_matrix(q.in[19], 1024, 5120, WB + WB_IN, 0, smem, osg(bid), nblk);
      conv_matrix(q.in[22], 1024, 1024, WB + WB_OUT, 0, smem, osg(bid), nblk);
    }
    conv_matrix(q.in[23] + (size_t)layer * 1024 * 5632, 1024, 5632, WB + WB_UP, 1, smem, osg(bid), nblk);
    conv_matrix(q.in[25] + (size_t)layer * DFF * 1024, DFF, 1024, WB + WB_DOWN, 0, smem, osg(bid), nblk);
    norm_phase(X, q.in[7] + (layer * 2 + 0) * DM, modl, 0, 1024, H, osg(bid), nblk);
    xcd_barrier(xb);

    if (layer == 0) {
      bfr* G = BIG;
      bfr* U = BIG + (size_t)MTOK * 3072;
      gemm_phase(H, DM, WB + WB_IN, 1024, 3072, 1024, EpiStore{G, 3072}, smem, osg(bid), nblk);
      xcd_barrier(xb);
      shortconv_ew_phase(G, q.in[10], U, osg(bid), nblk);
      xcd_barrier(xb);
      gemm_phase(U, DM, WB + WB_OUT, 1024, 1024, 1024, EpiResid{X, modl + 2048, nullptr, 0}, smem, osg(bid), nblk);
      xcd_barrier(xb);
    } else if (layer == 1) {
      bfr* P = BIG;
      pool_ew_phase(H, P, osg(bid), nblk);
      xcd_barrier(xb);
      for (int g = 0; g < 4; ++g)
        gemm_phase(P + g * 256, DM, WB + WB_IN + g * 65536, 256, 256, 256,
                   EpiResid{X, modl + 2048 + g * 256, q.in[13] + g * 256, g * 256}, smem, osg(bid), nblk);
      xcd_barrier(xb);
    } else if (layer == 2) {
      bfr* UV = BIG;
      gemm_phase(H, DM, WB + WB_IN, 1024, 2048, 1024, EpiGelu{UV, 2048}, smem, osg(bid), nblk);
      xcd_barrier(xb);
      sgu_norm_phase(UV, q.in[15], osg(bid), nblk);
      xcd_barrier(xb);
      sgu_spatial_phase(UV, q.in[16], q.in[17], smem, osg(bid), nblk);
      xcd_barrier(xb);
      gemm_phase(UV, 2048, WB + WB_OUT, 1024, 1024, 1024, EpiResid{X, modl + 2048, nullptr, 0}, smem, osg(bid), nblk);
      xcd_barrier(xb);
    } else {
      bfr* QZ = BIG;
      gemm_phase(H, DM, WB + WB_IN, 1024, 5120, 1024, EpiStore{QZ, 5120}, smem, osg(bid), nblk);
      xcd_barrier(xb);
      hgrn_scan_phase(q, smem, osg(bid), nblk, 0);
      xcd_barrier(xb);
      hgrn_combine_phase(q, osg(bid), nblk);
      xcd_barrier(xb);
      hgrn_scan_phase(q, smem, osg(bid), nblk, 1);
      xcd_barrier(xb);
      hgrn_gate_phase(q, q.in[21], osg(bid), nblk);
      xcd_barrier(xb);
      gemm_phase(H, DM, WB + WB_OUT, 1024, 1024, 1024, EpiResid{X, modl + 2048, nullptr, 0}, smem, osg(bid), nblk);
      xcd_barrier(xb);
    }

    norm_phase(X, q.in[7] + (layer * 2 + 1) * DM, modl, 3072, 4096, H, osg(bid), nblk);
    xcd_barrier(xb);
    bfr* ACT = BIG;
    float* EDGE = (float*)(q.ws + OFF_BIG + 115343360ull);
    const float* wdw = q.in[24] + (size_t)layer * 3 * 2 * DFF;
    gemm_phase(H, DM, WB + WB_UP, 1024, 2 * DFF, 1024, EpiFfnUp{ACT, EDGE, wdw}, smem, osg(bid), nblk);
    xcd_barrier(xb);
    ffn_edge_phase(EDGE, wdw, ACT, osg(bid), nblk);
    xcd_barrier(xb);
    gemm_phase(ACT, DFF, WB + WB_DOWN, DFF, 1024, DFF, EpiResid{X, modl + 5120, nullptr, 0}, smem, osg(bid), nblk);
    xcd_barrier(xb);
  }
  final_norm_phase(p.out, p.in[8], osg(bid), nblk);
}

extern "C" void kernel_launch(void* const* d_in, const int* in_sizes, int n_in, void* d_out, int out_size,
                              void* d_ws, size_t ws_size, hipStream_t stream) {
  static int grid_blocks = 0;
  if (!grid_blocks) {
    int dev = 0, cus = 0, per_cu = 0;
    hipGetDevice(&dev);
    hipDeviceGetAttribute(&cus, hipDeviceAttributeMultiprocessorCount, dev);
    hipOccupancyMaxActiveBlocksPerMultiprocessor(&per_cu, mega_kernel, 256, 0);
    if (per_cu > 2) per_cu = 2;
    if (per_cu < 1) per_cu = 1;
    grid_blocks = cus * per_cu;
  }
  if (ws_size < WS_NEED) { fprintf(stderr, "workspace too small: %zu < %zu\n", ws_size, (size_t)WS_NEED); return; }
  Params p{};
  for (int i = 0; i < 26; ++i) p.in[i] = (const float*)d_in[i];
  p.out = (float*)d_out;
  p.ws = (char*)d_ws;
  hipMemsetAsync((char*)d_ws + OFF_BAR, 0, XCD_BAR_WORDS * 4, stream);
  void* args[] = {&p};
  hipError_t e = hipLaunchCooperativeKernel((void*)mega_kernel, dim3(grid_blocks), dim3(256), args, 0, stream);
  if (e != hipSuccess) fprintf(stderr, "cooperative launch failed: %s (grid %d)\n", hipGetErrorString(e), grid_blocks);
}
```

```cpp
#include <hip/hip_runtime.h>
#include <hip/hip_cooperative_groups.h>
#include <stdint.h>
#include <stdio.h>
namespace cg = cooperative_groups;

#define DEVINL __device__ __forceinline__
typedef unsigned short bfr;
using bf16x8 = __attribute__((ext_vector_type(8))) short;
using f32x4 = __attribute__((ext_vector_type(4))) float;
using u32x4 = __attribute__((ext_vector_type(4))) unsigned int;

constexpr int DM = 1024;
constexpr int MTOK = 20480;
constexpr int NPROMPT = 4096;
constexpr int DFF = 2816;
constexpr int HALF_FF = 1408;
constexpr float EPS = 1e-6f;

constexpr size_t OFF_MODP = 0;
constexpr size_t OFF_MOD = 7864320;
constexpr size_t OFF_LBS = OFF_MOD + 491520;
constexpr size_t OFF_BAR = OFF_LBS + 8192;
constexpr size_t OFF_WB = 8388608;
constexpr size_t OFF_H = 41943040;
constexpr size_t OFF_BIG = 83886080;
constexpr size_t WS_NEED = OFF_BIG + 251658240ull + 33554432ull + 262144ull;
constexpr size_t WB_IN = 0, WB_OUT = 5242880, WB_UP = 6291456, WB_DOWN = 12058624;

struct Params {
  const float* in[26];
  float* out;
  char* ws;
};

DEVINL int otid() { int t = threadIdx.x; asm volatile("" : "+v"(t)); return t; }
DEVINL int osg(int x) { asm volatile("" : "+s"(x)); return x; }
typedef __bf16 hbf16x2 __attribute__((ext_vector_type(2)));
typedef float hf32x2 __attribute__((ext_vector_type(2)));
DEVINL uint32_t pk2(float a, float b) {
  hf32x2 v = {a, b};
  hbf16x2 r = __builtin_convertvector(v, hbf16x2);
  return __builtin_bit_cast(uint32_t, r);
}
DEVINL bfr f2bf(float f) { return (bfr)(pk2(f, 0.f) & 0xffffu); }
DEVINL float bf2f(bfr h) { return __uint_as_float(((uint32_t)h) << 16); }
DEVINL float frcp(float x) { return __builtin_amdgcn_rcpf(x); }
DEVINL float bflo(uint32_t u) { return __uint_as_float(u << 16); }
DEVINL float bfhi(uint32_t u) { return __uint_as_float(u & 0xffff0000u); }
DEVINL int cond_of(int m) { return m < NPROMPT ? 0 : 1 + ((m - NPROMPT) >> 12); }
DEVINL float silu_f(float x) { return x * frcp(1.f + __expf(-x)); }
DEVINL float gelu_tanh_f(float x) {
  float y = 0.7978845608028654f * (x + 0.044715f * x * x * x);
  float t = 1.f - 2.f * frcp(__expf(2.f * y) + 1.f);
  return 0.5f * x * (1.f + t);
}
DEVINL float shx(float v, int o, int lane) {
  return __int_as_float(__builtin_amdgcn_ds_bpermute((lane ^ o) << 2, __float_as_int(v)));
}
DEVINL float wave_sum(float v, int lane) {
#pragma unroll
  for (int o = 32; o > 0; o >>= 1) v += shx(v, o, lane);
  return v;
}

DEVINL void tok_pos(int m, int& tl, int& T) {
  if (m < NPROMPT) { tl = m & 255; T = 256; } else { tl = (m - NPROMPT) & 4095; T = 4096; }
}

struct EpiNoPre {};
#define EPI_ELEMENTWISE_TILE                                                                       \
  typedef EpiNoPre Pre;                                                                             \
  DEVINL Pre pre(int tn, int tid) const { return Pre{}; }                                           \
  DEVINL void tile(const f32x4 (&acc)[4][4], const Pre& pre_, int m0, int n0, int tn, int wm, int wn, int l15, \
                   int quad, int tid, char* smem) const {                                           \
    _Pragma("unroll") for (int mt = 0; mt < 4; ++mt)                                                \
      _Pragma("unroll") for (int nt = 0; nt < 4; ++nt)                                              \
        (*this)(m0 + wm * 64 + mt * 16 + l15, n0 + wn * 64 + nt * 16 + quad * 4, acc[mt][nt]);      \
  }
struct EpiStore {
  bfr* C; int ldc;
  DEVINL void tile256(const f32x4 (&acc)[8][4], const EpiNoPre& pre_, int m0, int n0, int tn, int wm, int wn, int l15,
                      int quad, int tid, char* smem) const {
#pragma unroll
    for (int mt = 0; mt < 8; ++mt)
#pragma unroll
      for (int nt = 0; nt < 4; ++nt)
        (*this)(m0 + wm * 128 + mt * 16 + l15, n0 + wn * 64 + nt * 16 + quad * 4, acc[mt][nt]);
  }
  DEVINL void operator()(int m, int n, f32x4 v) const {
    uint2 o; o.x = pk2(v[0], v[1]); o.y = pk2(v[2], v[3]);
    *(uint2*)(C + (size_t)m * ldc + n) = o;
  }
  EPI_ELEMENTWISE_TILE
};
struct EpiGelu {
  bfr* C; int ldc;
  DEVINL void operator()(int m, int n, f32x4 v) const {
    uint2 o; o.x = pk2(gelu_tanh_f(v[0]), gelu_tanh_f(v[1])); o.y = pk2(gelu_tanh_f(v[2]), gelu_tanh_f(v[3]));
    *(uint2*)(C + (size_t)m * ldc + n) = o;
  }
  EPI_ELEMENTWISE_TILE
};
struct EpiResid {
  float* X; const float* gate; const float* cscale; int coff;
  DEVINL void operator()(int m, int n, f32x4 v) const {
    const int cond = cond_of(m);
    const float4 g = *(const float4*)(gate + cond * 6144 + n);
    float4* xp = (float4*)(X + (size_t)m * DM + coff + n);
    float4 x = *xp;
    float s0 = 1.f, s1 = 1.f, s2 = 1.f, s3 = 1.f;
    if (cscale) { const float4 s = *(const float4*)(cscale + n); s0 = s.x; s1 = s.y; s2 = s.z; s3 = s.w; }
    x.x += g.x * v[0] * s0; x.y += g.y * v[1] * s1; x.z += g.z * v[2] * s2; x.w += g.w * v[3] * s3;
    *xp = x;
  }
  EPI_ELEMENTWISE_TILE
};

#define LDS3 __attribute__((address_space(3)))
DEVINL void lds_barrier() { asm volatile("s_waitcnt lgkmcnt(0)\n\ts_barrier" ::: "memory"); }
template <class Epi>
DEVINL void gemm_phase(const bfr* __restrict__ A, int lda, const bfr* __restrict__ Bt, int ldb, int N, int K,
                       const Epi& epi, char* smem, int bid, int nblk) {
  const int tid = otid(), lane = tid & 63, wave = tid >> 6;
  const int wm = wave >> 1, wn = wave & 1, l15 = lane & 15, quad = lane >> 4;
  const int tilesN = N >> 7;
  const int ntiles = (MTOK >> 7) * tilesN;
  const int nk = K >> 6;
  const int srow0 = wave * 8 + (lane >> 3);
  const int lc = (lane & 7) ^ ((srow0 >> 1) & 7);
  const int fsw = (l15 >> 1) & 7;
  char* const dst0 = smem + wave * 1024 + lane * 16;
#define TILE_DECODE(t_, tm_, tn_) {                                                        \
    const int xcd_ = (t_) & 7, u_ = (t_) >> 3, g16_ = 16 * tilesN;                         \
    int ur_;                                                                               \
    if (u_ < g16_) { const int gs_ = 8 * tilesN; const int g_ = u_ / gs_, r_ = u_ - g_ * gs_; tn_ = r_ >> 3; ur_ = g_ * 8 + (r_ & 7); } \
    else { const int r_ = u_ - g16_; tn_ = r_ >> 2; ur_ = 16 + (r_ & 3); }                 \
    tm_ = ur_ * 8 + xcd_; }
#define GLDS_STAGE(pa_, pb_, st_, kt_)                                                                    \
  {                                                                                                       \
    _Pragma("unroll") for (int i = 0; i < 4; ++i) {                                                       \
      __builtin_amdgcn_global_load_lds((const unsigned*)((pa_) + (size_t)(i * 32) * lda + (kt_) * 64),    \
                                       (LDS3 unsigned*)(dst0 + (st_) * 32768 + i * 4096), 16, 0, 0);      \
      __builtin_amdgcn_global_load_lds((const unsigned*)((pb_) + (size_t)(i * 32) * ldb + (kt_) * 64),    \
                                       (LDS3 unsigned*)(dst0 + (st_) * 32768 + 16384 + i * 4096), 16, 0, 0); \
    }                                                                                                     \
  }
  int tile = bid;
  if (tile >= ntiles) return;
  int tm, tn;
  TILE_DECODE(tile, tm, tn)
  const bfr* gA = A + (size_t)((tm << 7) + srow0) * lda + lc * 8;
  const bfr* gB = Bt + (size_t)((tn << 7) + srow0) * ldb + lc * 8;
  __syncthreads();
  GLDS_STAGE(gA, gB, 0, 0)
  for (; tile < ntiles; tile += nblk) {
    const int m0 = tm << 7, n0 = tn << 7, tn_cur = tn;
    const bool has_next = (tile + nblk < ntiles);
    const bfr* gAn = gA; const bfr* gBn = gB;
    if (has_next) {
      TILE_DECODE(tile + nblk, tm, tn)
      gAn = A + (size_t)((tm << 7) + srow0) * lda + lc * 8;
      gBn = Bt + (size_t)((tn << 7) + srow0) * ldb + lc * 8;
    }
    typename Epi::Pre pre = epi.pre(tn_cur, tid);
    f32x4 acc[4][4];
#pragma unroll
    for (int i = 0; i < 4; ++i)
#pragma unroll
      for (int j = 0; j < 4; ++j) acc[i][j] = f32x4{0.f, 0.f, 0.f, 0.f};
    __syncthreads();
    for (int kt = 0; kt < nk; ++kt) {
      const int st = kt & 1;
      const bool cur = (kt + 1 < nk);
      const bool any = cur || has_next;
      const bfr* sa = cur ? gA + (kt + 1) * 64 : gAn;
      const bfr* sb = cur ? gB + (kt + 1) * 64 : gBn;
      char* sd = dst0 + (cur ? (st ^ 1) : 0) * 32768;
      const char* cA = smem + st * 32768 + (wm * 64 + l15) * 128;
      const char* cB = smem + st * 32768 + 16384 + (wn * 64 + l15) * 128;
      {
        const int co0 = (quad ^ fsw) * 16, co1 = ((4 + quad) ^ fsw) * 16;
        bf16x8 af0[4], bf0[4], af1[4], bf1[4];
#pragma unroll
        for (int i = 0; i < 4; ++i) {
          af0[i] = *(const bf16x8*)(cA + i * 2048 + co0);
          bf0[i] = *(const bf16x8*)(cB + i * 2048 + co0);
        }
#pragma unroll
        for (int i = 0; i < 4; ++i) {
          af1[i] = *(const bf16x8*)(cA + i * 2048 + co1);
          bf1[i] = *(const bf16x8*)(cB + i * 2048 + co1);
        }
        __builtin_amdgcn_sched_barrier(0);
#pragma unroll
        for (int mt = 0; mt < 4; ++mt) {
#pragma unroll
          for (int nt = 0; nt < 4; ++nt)
            acc[mt][nt] = __builtin_amdgcn_mfma_f32_16x16x32_bf16(bf0[nt], af0[mt], acc[mt][nt], 0, 0, 0);
          if (any) {
            __builtin_amdgcn_global_load_lds((const unsigned*)(sa + (size_t)(mt * 32) * lda), (LDS3 unsigned*)(sd + mt * 4096), 16, 0, 0);
            __builtin_amdgcn_global_load_lds((const unsigned*)(sb + (size_t)(mt * 32) * ldb), (LDS3 unsigned*)(sd + 16384 + mt * 4096), 16, 0, 0);
          }
          __builtin_amdgcn_sched_barrier(0);
        }
#pragma unroll
        for (int mt = 0; mt < 4; ++mt)
#pragma unroll
          for (int nt = 0; nt < 4; ++nt)
            acc[mt][nt] = __builtin_amdgcn_mfma_f32_16x16x32_bf16(bf1[nt], af1[mt], acc[mt][nt], 0, 0, 0);
        __builtin_amdgcn_sched_barrier(0);
      }
      if (kt + 1 < nk) __syncthreads();
    }
    epi.tile(acc, pre, m0, n0, tn_cur, wm, wn, l15, quad, tid, smem);
    gA = gAn; gB = gBn;
  }
}

constexpr int EDGE_LD = 2 * DFF;
struct FfnPre { f32x4 wa[3], wb[3]; };
DEVINL void ffn_conv_rows(const bfr* T, const FfnPre& pre_, bfr* ACT, float* EDGE, int m0, int n0, int tn, int tid) {
  const int c4 = (tid & 15) * 4, r0 = (tid >> 4) * 8;
  const int ja = tn * 64 + c4;
  int tl, Tlen; tok_pos(m0, tl, Tlen);
  const bool top_ok = (tl == 0), bot_ok = (tl + 128 == Tlen);
  if (tid < 128) {
    const int e = tid >> 5, c = (tid & 31) * 4;
    const int r = (e < 2) ? e : 124 + e;
    const uint2 v = *(const uint2*)(T + r * 136 + c);
    *(f32x4*)(EDGE + ((size_t)(m0 >> 7) * 4 + e) * EDGE_LD + n0 + c) = f32x4{bflo(v.x), bfhi(v.x), bflo(v.y), bfhi(v.y)};
  }
  const f32x4 zero = f32x4{0.f, 0.f, 0.f, 0.f};
#define LDT(dst, row, col) { const uint2 v_ = *(const uint2*)(T + (row) * 136 + (col)); dst = f32x4{bflo(v_.x), bfhi(v_.x), bflo(v_.y), bfhi(v_.y)}; }
  f32x4 pa = zero, pb = zero, ca, cb, na, nb;
  if (r0 > 0) { LDT(pa, r0 - 1, c4) LDT(pb, r0 - 1, 64 + c4) }
  LDT(ca, r0, c4) LDT(cb, r0, 64 + c4)
#pragma unroll
  for (int i = 0; i < 8; ++i) {
    const int r = r0 + i;
    if (r < 127) { LDT(na, r + 1, c4) LDT(nb, r + 1, 64 + c4) }
    else { na = zero; nb = zero; }
    const bool ok = (r > 0 || top_ok) && (r < 127 || bot_ok);
    if (ok) {
      const f32x4 a = pre_.wa[0] * pa + pre_.wa[1] * ca + pre_.wa[2] * na;
      const f32x4 b = pre_.wb[0] * pb + pre_.wb[1] * cb + pre_.wb[2] * nb;
      uint2 o;
      o.x = pk2(silu_f(a[0]) * b[0], silu_f(a[1]) * b[1]);
      o.y = pk2(silu_f(a[2]) * b[2], silu_f(a[3]) * b[3]);
      *(uint2*)(ACT + (size_t)(m0 + r) * DFF + ja) = o;
    }
    pa = ca; pb = cb; ca = na; cb = nb;
  }
#undef LDT
}
struct EpiFfnUp {
  bfr* ACT; float* EDGE; const float* wdw;
  typedef FfnPre Pre;
  DEVINL Pre pre(int tn, int tid) const {
    Pre q;
    const int ja = tn * 64 + (tid & 15) * 4;
#pragma unroll
    for (int t = 0; t < 3; ++t) {
      q.wa[t] = *(const f32x4*)(wdw + t * (2 * DFF) + ja);
      q.wb[t] = *(const f32x4*)(wdw + t * (2 * DFF) + DFF + ja);
    }
    return q;
  }
  DEVINL void tile(const f32x4 (&acc)[4][4], const Pre& pre_, int m0, int n0, int tn, int wm, int wn, int l15, int quad,
                   int tid, char* smem) const {
    bfr* T = (bfr*)(smem + 32768);
    lds_barrier();
#pragma unroll
    for (int mt = 0; mt < 4; ++mt)
#pragma unroll
      for (int nt = 0; nt < 4; ++nt) {
        uint2 o; o.x = pk2(acc[mt][nt][0], acc[mt][nt][1]); o.y = pk2(acc[mt][nt][2], acc[mt][nt][3]);
        *(uint2*)(T + (wm * 64 + mt * 16 + l15) * 136 + wn * 64 + nt * 16 + quad * 4) = o;
      }
    lds_barrier();
    ffn_conv_rows(T, pre_, ACT, EDGE, m0, n0, tn, tid);
  }
  DEVINL void tile256(const f32x4 (&acc)[8][4], const Pre& pre_, int m0, int n0, int tn, int wm, int wn, int l15, int quad,
                      int tid, char* smem) const {
    bfr* T = (bfr*)(smem + 24576);
#pragma unroll
    for (int hh = 0; hh < 2; ++hh) {
      lds_barrier();
      if (wm == hh) {
#pragma unroll
        for (int mt = 0; mt < 8; ++mt)
#pragma unroll
          for (int nt = 0; nt < 4; ++nt) {
            uint2 o; o.x = pk2(acc[mt][nt][0], acc[mt][nt][1]); o.y = pk2(acc[mt][nt][2], acc[mt][nt][3]);
            *(uint2*)(T + (mt * 16 + l15) * 136 + wn * 64 + nt * 16 + quad * 4) = o;
          }
      }
      lds_barrier();
      ffn_conv_rows(T, pre_, ACT, EDGE, m0 + hh * 128, n0, tn, tid);
    }
  }
};


template <class Epi>
DEVINL void gemm256_phase(const bfr* __restrict__ A, int lda, const bfr* __restrict__ Bt, int ldb, int N, int K,
                          const Epi& epi, char* smem, int bid, int nblk) {
  const int tid = otid(), lane = tid & 63, wave = tid >> 6;
  const int wm = wave >> 1, wn = wave & 1, l15 = lane & 15, quad = lane >> 4;
  const int tilesN = N >> 7;
  const int ntiles = (MTOK >> 8) * tilesN;
  const int nk = K >> 5;
  const int srow0 = wave * 16 + (lane >> 2);
  const int lc = (lane & 3) ^ ((0 - (lane >> 4)) & 3);
  const int fsw = (0 - (l15 >> 2)) & 3;
  char* const dst0 = smem + wave * 1024 + lane * 16;
#define TILE_DECODE2(t_, tm_, tn_) { const int xcd_ = (t_) & 7, u_ = (t_) >> 3; const int ur_ = u_ / tilesN; tn_ = u_ - ur_ * tilesN; tm_ = ur_ * 8 + xcd_; }
#define GLDS_STAGE2(pa_, pb_, st_, kt_)                                                                   \
  {                                                                                                       \
    _Pragma("unroll") for (int i = 0; i < 4; ++i)                                                         \
      __builtin_amdgcn_global_load_lds((const unsigned*)((pa_) + (size_t)(i * 64) * lda + (kt_) * 32),    \
                                       (LDS3 unsigned*)(dst0 + (st_) * 24576 + i * 4096), 16, 0, 0);      \
    _Pragma("unroll") for (int i = 0; i < 2; ++i)                                                         \
      __builtin_amdgcn_global_load_lds((const unsigned*)((pb_) + (size_t)(i * 64) * ldb + (kt_) * 32),    \
                                       (LDS3 unsigned*)(dst0 + (st_) * 24576 + 16384 + i * 4096), 16, 0, 0); \
  }
  int tile = bid;
  if (tile >= ntiles) return;
  int tm, tn;
  TILE_DECODE2(tile, tm, tn)
  const bfr* gA = A + (size_t)((tm << 8) + srow0) * lda + lc * 8;
  const bfr* gB = Bt + (size_t)((tn << 7) + srow0) * ldb + lc * 8;
  __syncthreads();
  GLDS_STAGE2(gA, gB, 0, 0)
  for (; tile < ntiles; tile += nblk) {
    const int m0 = tm << 8, n0 = tn << 7, tn_cur = tn;
    const bool has_next = (tile + nblk < ntiles);
    const bfr* gAn = gA; const bfr* gBn = gB;
    if (has_next) {
      TILE_DECODE2(tile + nblk, tm, tn)
      gAn = A + (size_t)((tm << 8) + srow0) * lda + lc * 8;
      gBn = Bt + (size_t)((tn << 7) + srow0) * ldb + lc * 8;
    }
    f32x4 acc[8][4];
#pragma unroll
    for (int i = 0; i < 8; ++i)
#pragma unroll
      for (int j = 0; j < 4; ++j) acc[i][j] = f32x4{0.f, 0.f, 0.f, 0.f};
    __syncthreads();
    for (int kt = 0; kt < nk; ++kt) {
      const int st = kt & 1;
      const bool cur = (kt + 1 < nk);
      const bool any = cur || has_next;
      const bfr* sa = cur ? gA + (kt + 1) * 32 : gAn;
      const bfr* sb = cur ? gB + (kt + 1) * 32 : gBn;
      char* sd = dst0 + (cur ? (st ^ 1) : 0) * 24576;
      const char* cA = smem + st * 24576 + (wm * 128 + l15) * 64 + ((quad ^ fsw) * 16);
      const char* cB = smem + st * 24576 + 16384 + (wn * 64 + l15) * 64 + ((quad ^ fsw) * 16);
      bf16x8 bfg[4];
#pragma unroll
      for (int i = 0; i < 4; ++i) bfg[i] = *(const bf16x8*)(cB + i * 1024);
#pragma unroll
      for (int hm = 0; hm < 2; ++hm) {
        bf16x8 af[4];
#pragma unroll
        for (int i = 0; i < 4; ++i) af[i] = *(const bf16x8*)(cA + (hm * 4 + i) * 1024);
        __builtin_amdgcn_sched_barrier(0);
#pragma unroll
        for (int mt = 0; mt < 4; ++mt) {
#pragma unroll
          for (int nt = 0; nt < 4; ++nt)
            acc[hm * 4 + mt][nt] = __builtin_amdgcn_mfma_f32_16x16x32_bf16(bfg[nt], af[mt], acc[hm * 4 + mt][nt], 0, 0, 0);
          const int g = hm * 4 + mt;
          if (any && g < 4)
            __builtin_amdgcn_global_load_lds((const unsigned*)(sa + (size_t)(g * 64) * lda), (LDS3 unsigned*)(sd + g * 4096), 16, 0, 0);
          else if (any && g < 6)
            __builtin_amdgcn_global_load_lds((const unsigned*)(sb + (size_t)((g - 4) * 64) * ldb), (LDS3 unsigned*)(sd + 16384 + (g - 4) * 4096), 16, 0, 0);
          __builtin_amdgcn_sched_barrier(0);
        }
      }
      if (kt + 1 < nk) __syncthreads();
    }
    {
      typename Epi::Pre pre = epi.pre(tn_cur, tid);
      epi.tile256(acc, pre, m0, n0, tn_cur, wm, wn, l15, quad, tid, smem);
    }
    gA = gAn; gB = gBn;
  }
}

DEVINL void ffn_edge_phase(const float* __restrict__ EDGE, const float* __restrict__ wdw, bfr* __restrict__ ACT, int bid, int nblk) {
  const int gt = bid * 256 + otid(), nt = nblk * 256;
  for (int i = gt; i < 160 * 2 * 704; i += nt) {
    const int cg4 = i % 704, r2 = i / 704, side = r2 & 1, tm = r2 >> 1;
    const int m0 = tm << 7;
    int tl, Tlen; tok_pos(m0, tl, Tlen);
    if (side == 0 ? (tl == 0) : (tl + 128 == Tlen)) continue;
    const int ja = cg4 * 4;
    const int nb_ = ja >> 6, cc = ja & 63;
    const int ea = nb_ * 128 + cc, eb = ea + 64;
    const float* prev; const float* cur; const float* next;
    if (side == 0) {
      prev = EDGE + ((size_t)(tm - 1) * 4 + 3) * EDGE_LD; cur = EDGE + ((size_t)tm * 4 + 0) * EDGE_LD; next = EDGE + ((size_t)tm * 4 + 1) * EDGE_LD;
    } else {
      prev = EDGE + ((size_t)tm * 4 + 2) * EDGE_LD; cur = EDGE + ((size_t)tm * 4 + 3) * EDGE_LD; next = EDGE + ((size_t)(tm + 1) * 4 + 0) * EDGE_LD;
    }
    const f32x4 a = *(const f32x4*)(wdw + ja) * *(const f32x4*)(prev + ea) + *(const f32x4*)(wdw + 2 * DFF + ja) * *(const f32x4*)(cur + ea) +
                    *(const f32x4*)(wdw + 4 * DFF + ja) * *(const f32x4*)(next + ea);
    const f32x4 b = *(const f32x4*)(wdw + DFF + ja) * *(const f32x4*)(prev + eb) + *(const f32x4*)(wdw + 3 * DFF + ja) * *(const f32x4*)(cur + eb) +
                    *(const f32x4*)(wdw + 5 * DFF + ja) * *(const f32x4*)(next + eb);
    uint2 o;
    o.x = pk2(silu_f(a[0]) * b[0], silu_f(a[1]) * b[1]);
    o.y = pk2(silu_f(a[2]) * b[2], silu_f(a[3]) * b[3]);
    const int m = m0 + (side ? 127 : 0);
    *(uint2*)(ACT + (size_t)m * DFF + ja) = o;
  }
}

DEVINL int up_perm(int n0) {
  if (n0 < DFF) return (n0 >> 6) * 128;
  return ((n0 - DFF) >> 6) * 128 + 64;
}
DEVINL void conv_matrix(const float* __restrict__ src, int K, int N, bfr* __restrict__ dst, int perm,
                        char* smem, int bid, int nblk) {
  float* sT = (float*)smem;
  const int tid = otid();
  const int tilesN = N >> 6;
  const int ntiles = (K >> 6) * tilesN;
  const int r = tid >> 4, c4 = tid & 15;
  int t = bid;
  if (t >= ntiles) return;
  f32x4 v0, v1, v2, v3;
  {
    const int tk = t / tilesN, tn = t - tk * tilesN;
    const float* sp = src + (size_t)((tk << 6) + r) * N + (tn << 6) + c4 * 4;
    v0 = *(const f32x4*)(sp); v1 = *(const f32x4*)(sp + (size_t)16 * N);
    v2 = *(const f32x4*)(sp + (size_t)32 * N); v3 = *(const f32x4*)(sp + (size_t)48 * N);
  }
  for (; t < ntiles; t += nblk) {
    const int tk = t / tilesN, tn = t - tk * tilesN;
    const int k0 = tk << 6, n0 = tn << 6;
    __syncthreads();
    {
      float* d = sT + r * 65 + c4 * 4;
      d[0] = v0[0]; d[1] = v0[1]; d[2] = v0[2]; d[3] = v0[3];
      d[16 * 65 + 0] = v1[0]; d[16 * 65 + 1] = v1[1]; d[16 * 65 + 2] = v1[2]; d[16 * 65 + 3] = v1[3];
      d[32 * 65 + 0] = v2[0]; d[32 * 65 + 1] = v2[1]; d[32 * 65 + 2] = v2[2]; d[32 * 65 + 3] = v2[3];
      d[48 * 65 + 0] = v3[0]; d[48 * 65 + 1] = v3[1]; d[48 * 65 + 2] = v3[2]; d[48 * 65 + 3] = v3[3];
    }
    if (t + nblk < ntiles) {
      const int t2 = t + nblk;
      const int tk2 = t2 / tilesN, tn2 = t2 - tk2 * tilesN;
      const float* sp = src + (size_t)((tk2 << 6) + r) * N + (tn2 << 6) + c4 * 4;
      v0 = *(const f32x4*)(sp); v1 = *(const f32x4*)(sp + (size_t)16 * N);
      v2 = *(const f32x4*)(sp + (size_t)32 * N); v3 = *(const f32x4*)(sp + (size_t)48 * N);
    }
    __syncthreads();
    const int n = tid >> 2, kc = tid & 3;
    uint32_t w[8];
#pragma unroll
    for (int j = 0; j < 8; ++j)
      w[j] = pk2(sT[(kc * 16 + 2 * j) * 65 + n], sT[(kc * 16 + 2 * j + 1) * 65 + n]);
    const int nd = (perm ? up_perm(n0) : n0) + n;
    bfr* dp = dst + (size_t)nd * K + k0 + kc * 16;
    *(uint4*)dp = make_uint4(w[0], w[1], w[2], w[3]);
    *(uint4*)(dp + 8) = make_uint4(w[4], w[5], w[6], w[7]);
  }
}

DEVINL void phase0a(const Params& p, char* smem, int bid, int nblk) {
  const int tid = otid();
  float* sc = (float*)smem;
  float* modp = (float*)(p.ws + OFF_MODP);
  const float* cvec = p.in[3];
  const float* cctx = p.in[4];
  const float* ada_w = p.in[5];
  for (int job = bid; job < 384; job += nblk) {
    const int l = job / 96, r = job - l * 96, ks = r / 6, cgp = r - ks * 6;
    __syncthreads();
    for (int i = tid; i < 320; i += 256) {
      const int cond = i >> 6, kk = i & 63;
      const float v = cond == 0 ? cctx[ks * 64 + kk] : cvec[(cond - 1) * DM + ks * 64 + kk];
      sc[i] = silu_f(v);
    }
    __syncthreads();
    const int col = cgp * 1024 + tid * 4;
    const float* wp = ada_w + ((size_t)l * DM + ks * 64) * 6144 + col;
    float a[5][4];
#pragma unroll
    for (int c = 0; c < 5; ++c)
#pragma unroll
      for (int j = 0; j < 4; ++j) a[c][j] = 0.f;
#pragma unroll 8
    for (int kk = 0; kk < 64; ++kk) {
      const float4 w = *(const float4*)(wp + (size_t)kk * 6144);
#pragma unroll
      for (int c = 0; c < 5; ++c) {
        const float s = sc[c * 64 + kk];
        a[c][0] += s * w.x; a[c][1] += s * w.y; a[c][2] += s * w.z; a[c][3] += s * w.w;
      }
    }
#pragma unroll
    for (int c = 0; c < 5; ++c)
      *(float4*)(modp + ((size_t)(ks * 4 + l) * 5 + c) * 6144 + col) = make_float4(a[c][0], a[c][1], a[c][2], a[c][3]);
  }
  const int gt = bid * 256 + tid, nt = nblk * 256;
  {
    const float* lb = p.in[20];
    float* lbs = (float*)(p.ws + OFF_LBS);
    for (int i = gt; i < 2048; i += nt) {
      const float v0 = lb[i], v1 = lb[2048 + i], v2 = lb[4096 + i], v3 = lb[6144 + i];
      const float mx = fmaxf(fmaxf(v0, v1), fmaxf(v2, v3));
      const float e0 = expf(v0 - mx), e1 = expf(v1 - mx), e2 = expf(v2 - mx), e3 = expf(v3 - mx);
      lbs[i] = (e1 + e2 + e3) / (e0 + e1 + e2 + e3);
    }
  }
  float* X = p.out;
  {
    const float4* xp = (const float4*)p.in[0];
    float4* xo = (float4*)X;
    for (int i = gt; i < NPROMPT * DM / 4; i += nt) xo[i] = xp[i];
    const float* xs = p.in[1];
    for (int i = gt; i < 4096 * 256; i += nt) {
      const int t = i >> 8, c = (i & 255) * 4;
      const int part = c >> 8;
      const float pos = (float)((part < 2) ? (t >> 6) : (t & 63));
      float pe[4];
#pragma unroll
      for (int j = 0; j < 4; ++j) {
        const int jj = (c + j) & 255;
        const float freq = expf((-9.210340371976184f * (float)jj) / 256.0f);
        const float arg = pos * freq;
        pe[j] = (part & 1) ? cosf(arg) : sinf(arg);
      }
#pragma unroll
      for (int b = 0; b < 4; ++b) {
        const size_t off = ((size_t)b * 4096 + t) * DM + c;
        float4 v = *(const float4*)(xs + off);
        v.x += pe[0]; v.y += pe[1]; v.z += pe[2]; v.w += pe[3];
        *(float4*)(X + (size_t)NPROMPT * DM + off) = v;
      }
    }
  }
}

DEVINL void phase0b(const Params& p, int bid, int nblk) {
  const int gt = bid * 256 + otid(), nt = nblk * 256;
  const float* modp = (const float*)(p.ws + OFF_MODP);
  float* mod = (float*)(p.ws + OFF_MOD);
  const float* ada_b = p.in[6];
  for (int i = gt; i < 4 * 5 * 6144; i += nt) {
    const int l = i / 30720, col = i % 6144;
    float s = ada_b[l * 6144 + col];
#pragma unroll
    for (int ks = 0; ks < 16; ++ks) s += modp[(size_t)ks * 122880 + i];
    mod[i] = s;
  }
}

DEVINL void norm_phase(const float* __restrict__ X, const float* __restrict__ g, const float* __restrict__ modl,
                       int shift_off, int scale_off, bfr* __restrict__ H, int bid, int nblk) {
  const int tid = otid(); const int lane = tid & 63;
  const int gw = bid * 4 + (tid >> 6), nw = nblk * 4;
  int row = gw;
  if (row >= MTOK) return;
  f32x4 x0, x1, x2, x3;
  {
    const float* xr = X + (size_t)row * DM + lane * 4;
    x0 = *(const f32x4*)(xr); x1 = *(const f32x4*)(xr + 256); x2 = *(const f32x4*)(xr + 512); x3 = *(const f32x4*)(xr + 768);
  }
  for (; row < MTOK; row += nw) {
    const f32x4 c0 = x0, c1 = x1, c2 = x2, c3 = x3;
    if (row + nw < MTOK) {
      const float* xr = X + (size_t)(row + nw) * DM + lane * 4;
      x0 = *(const f32x4*)(xr); x1 = *(const f32x4*)(xr + 256); x2 = *(const f32x4*)(xr + 512); x3 = *(const f32x4*)(xr + 768);
    }
    float ss = 0.f;
#pragma unroll
    for (int j = 0; j < 4; ++j) ss += c0[j] * c0[j] + c1[j] * c1[j] + c2[j] * c2[j] + c3[j] * c3[j];
    ss = wave_sum(ss, lane);
    const float rstd = rsqrtf(ss * (1.f / DM) + EPS);
    const float* mc = modl + cond_of(row) * 6144;
#pragma unroll
    for (int i = 0; i < 4; ++i) {
      const f32x4 xv = (i == 0) ? c0 : (i == 1) ? c1 : (i == 2) ? c2 : c3;
      const int c = i * 256 + lane * 4;
      const float4 gg = *(const float4*)(g + c);
      const float4 sh = *(const float4*)(mc + shift_off + c);
      const float4 sc = *(const float4*)(mc + scale_off + c);
      const float h0 = xv[0] * rstd * gg.x * (1.f + sc.x) + sh.x;
      const float h1 = xv[1] * rstd * gg.y * (1.f + sc.y) + sh.y;
      const float h2 = xv[2] * rstd * gg.z * (1.f + sc.z) + sh.z;
      const float h3 = xv[3] * rstd * gg.w * (1.f + sc.w) + sh.w;
      uint2 o; o.x = pk2(h0, h1); o.y = pk2(h2, h3);
      *(uint2*)(H + (size_t)row * DM + c) = o;
    }
  }
}

DEVINL void final_norm_phase(float* X, const float* __restrict__ g, int bid, int nblk) {
  const int tid = otid(); const int lane = tid & 63;
  const int gw = bid * 4 + (tid >> 6), nw = nblk * 4;
  for (int row = gw; row < MTOK; row += nw) {
    float* xr = X + (size_t)row * DM;
    float4 x[4];
    float ss = 0.f;
#pragma unroll
    for (int i = 0; i < 4; ++i) {
      x[i] = *(const float4*)(xr + i * 256 + lane * 4);
      ss += x[i].x * x[i].x + x[i].y * x[i].y + x[i].z * x[i].z + x[i].w * x[i].w;
    }
    ss = wave_sum(ss, lane);
    const float rstd = rsqrtf(ss * (1.f / DM) + EPS);
#pragma unroll
    for (int i = 0; i < 4; ++i) {
      const int c = i * 256 + lane * 4;
      const float4 gg = *(const float4*)(g + c);
      float4 o;
      o.x = x[i].x * rstd * gg.x; o.y = x[i].y * rstd * gg.y; o.z = x[i].z * rstd * gg.z; o.w = x[i].w * rstd * gg.w;
      *(float4*)(xr + c) = o;
    }
  }
}

DEVINL void shortconv_ew_phase(const bfr* __restrict__ G, const float* __restrict__ wdw, bfr* __restrict__ U, int bid, int nblk) {
  const int gt = bid * 256 + otid(), nt = nblk * 256;
  for (int i = gt; i < MTOK * 128; i += nt) {
    const int m = i >> 7, c = (i & 127) * 8;
    int tl, T; tok_pos(m, tl, T);
    const bfr* gr = G + (size_t)m * 3072;
    const uint4 bg = *(const uint4*)(gr + c);
    float accv[8];
#pragma unroll
    for (int j = 0; j < 8; ++j) accv[j] = 0.f;
#pragma unroll
    for (int tap = 0; tap < 3; ++tap) {
      const int d = tap - 1;
      if ((d < 0 && tl == 0) || (d > 0 && tl == T - 1)) continue;
      const bfr* nr = gr + (ptrdiff_t)d * 3072;
      const uint4 cgv = *(const uint4*)(nr + 1024 + c);
      const uint4 xhv = *(const uint4*)(nr + 2048 + c);
      const float4 w0 = *(const float4*)(wdw + tap * DM + c);
      const float4 w1 = *(const float4*)(wdw + tap * DM + c + 4);
      accv[0] += w0.x * bflo(cgv.x) * bflo(xhv.x); accv[1] += w0.y * bfhi(cgv.x) * bfhi(xhv.x);
      accv[2] += w0.z * bflo(cgv.y) * bflo(xhv.y); accv[3] += w0.w * bfhi(cgv.y) * bfhi(xhv.y);
      accv[4] += w1.x * bflo(cgv.z) * bflo(xhv.z); accv[5] += w1.y * bfhi(cgv.z) * bfhi(xhv.z);
      accv[6] += w1.z * bflo(cgv.w) * bflo(xhv.w); accv[7] += w1.w * bfhi(cgv.w) * bfhi(xhv.w);
    }
    uint4 o;
    o.x = pk2(bflo(bg.x) * accv[0], bfhi(bg.x) * accv[1]);
    o.y = pk2(bflo(bg.y) * accv[2], bfhi(bg.y) * accv[3]);
    o.z = pk2(bflo(bg.z) * accv[4], bfhi(bg.z) * accv[5]);
    o.w = pk2(bflo(bg.w) * accv[6], bfhi(bg.w) * accv[7]);
    *(uint4*)(U + (size_t)m * DM + c) = o;
  }
}

DEVINL void pool_ew_phase(const bfr* __restrict__ H, bfr* __restrict__ P, int bid, int nblk) {
  const int gt = bid * 256 + otid(), nt = nblk * 256;
  for (int i = gt; i < MTOK * 128; i += nt) {
    const int m = i >> 7, ch = i & 127, c = ch * 8;
    int tl, T; tok_pos(m, tl, T);
    const int hw = 1 << (ch >> 5);
    const int lo = max(tl - hw, 0), hi = min(tl + hw, T);
    float s[8];
#pragma unroll
    for (int j = 0; j < 8; ++j) s[j] = 0.f;
    const bfr* base = H + (size_t)(m - tl) * DM + c;
    uint4 wv[16];
#pragma unroll
    for (int j = 0; j < 16; ++j) {
      const int q = tl - hw + j;
      const bool ok = (j < 2 * hw) && (q >= 0) && (q < T);
      wv[j] = ok ? *(const uint4*)(base + (size_t)q * DM) : make_uint4(0u, 0u, 0u, 0u);
    }
#pragma unroll
    for (int j = 0; j < 16; ++j) {
      const uint4 v = wv[j];
      s[0] += bflo(v.x); s[1] += bfhi(v.x); s[2] += bflo(v.y); s[3] += bfhi(v.y);
      s[4] += bflo(v.z); s[5] += bfhi(v.z); s[6] += bflo(v.w); s[7] += bfhi(v.w);
    }
    const float inv = 1.f / (float)(hi - lo);
    const uint4 v = *(const uint4*)(base + (size_t)tl * DM);
    uint4 o;
    o.x = pk2(s[0] * inv - bflo(v.x), s[1] * inv - bfhi(v.x));
    o.y = pk2(s[2] * inv - bflo(v.y), s[3] * inv - bfhi(v.y));
    o.z = pk2(s[4] * inv - bflo(v.z), s[5] * inv - bfhi(v.z));
    o.w = pk2(s[6] * inv - bflo(v.w), s[7] * inv - bfhi(v.w));
    *(uint4*)(P + (size_t)m * DM + c) = o;
  }
}

DEVINL void sgu_norm_phase(bfr* UV, const float* __restrict__ g, int bid, int nblk) {
  const int tid = otid(); const int lane = tid & 63;
  const int gw = bid * 4 + (tid >> 6), nw = nblk * 4;
  for (int row = gw; row < MTOK; row += nw) {
    bfr* vr = UV + (size_t)row * 2048 + 1024;
    float x[4][4];
    float ss = 0.f;
#pragma unroll
    for (int i = 0; i < 4; ++i) {
      const uint2 v = *(const uint2*)(vr + i * 256 + lane * 4);
      x[i][0] = bflo(v.x); x[i][1] = bfhi(v.x); x[i][2] = bflo(v.y); x[i][3] = bfhi(v.y);
      ss += x[i][0] * x[i][0] + x[i][1] * x[i][1] + x[i][2] * x[i][2] + x[i][3] * x[i][3];
    }
    ss = wave_sum(ss, lane);
    const float rstd = rsqrtf(ss * (1.f / DM) + EPS);
#pragma unroll
    for (int i = 0; i < 4; ++i) {
      const int c = i * 256 + lane * 4;
      const float4 gg = *(const float4*)(g + c);
      uint2 o;
      o.x = pk2(x[i][0] * rstd * gg.x, x[i][1] * rstd * gg.y);
      o.y = pk2(x[i][2] * rstd * gg.z, x[i][3] * rstd * gg.w);
      *(uint2*)(vr + c) = o;
    }
  }
}

DEVINL void sgu_spatial_phase(bfr* UV, const float* __restrict__ ws_, const float* __restrict__ bs_, char* smem, int bid, int nblk) {
  bfr* sV = (bfr*)smem;
  bfr* sW = sV + 128 * 136;
  const int tid = otid(), lane = tid & 63, wave = tid >> 6, l15 = lane & 15, quad = lane >> 4;
  for (int item = bid; item < 160 * 8; item += nblk) {
    const int chunk = item >> 3, g = item & 7;
    __syncthreads();
    const float* wg = ws_ + (size_t)g * 16384;
#pragma unroll 4
    for (int i = 0; i < 16; ++i) {
      const int idx = tid + 256 * i;
      const int row = idx >> 5, chn = idx & 31;
      const float4 v = *(const float4*)(wg + row * 128 + chn * 4);
      uint2 o; o.x = pk2(v.x, v.y); o.y = pk2(v.z, v.w);
      *(uint2*)(sW + row * 136 + chn * 4) = o;
    }
#pragma unroll 2
    for (int i = 0; i < 8; ++i) {
      const int idx = tid + 256 * i;
      const int q = idx >> 4, chn = idx & 15;
      const uint4 v = *(const uint4*)(UV + (size_t)(chunk * 128 + q) * 2048 + 1024 + g * 128 + chn * 8);
      bfr* d = sV + (chn * 8) * 136 + q;
      d[0 * 136] = (bfr)(v.x & 0xffff); d[1 * 136] = (bfr)(v.x >> 16);
      d[2 * 136] = (bfr)(v.y & 0xffff); d[3 * 136] = (bfr)(v.y >> 16);
      d[4 * 136] = (bfr)(v.z & 0xffff); d[5 * 136] = (bfr)(v.z >> 16);
      d[6 * 136] = (bfr)(v.w & 0xffff); d[7 * 136] = (bfr)(v.w >> 16);
    }
    __syncthreads();
    f32x4 acc[8][2];
#pragma unroll
    for (int i = 0; i < 8; ++i) { acc[i][0] = f32x4{0.f, 0.f, 0.f, 0.f}; acc[i][1] = f32x4{0.f, 0.f, 0.f, 0.f}; }
#pragma unroll
    for (int kk = 0; kk < 4; ++kk) {
      bf16x8 bw[2];
#pragma unroll
      for (int pt = 0; pt < 2; ++pt) bw[pt] = *(const bf16x8*)(sW + (wave * 32 + pt * 16 + l15) * 136 + kk * 32 + quad * 8);
#pragma unroll
      for (int ct = 0; ct < 8; ++ct) {
        const bf16x8 av = *(const bf16x8*)(sV + (ct * 16 + l15) * 136 + kk * 32 + quad * 8);
#pragma unroll
        for (int pt = 0; pt < 2; ++pt)
          acc[ct][pt] = __builtin_amdgcn_mfma_f32_16x16x32_bf16(av, bw[pt], acc[ct][pt], 0, 0, 0);
      }
    }
#pragma unroll
    for (int pt = 0; pt < 2; ++pt) {
      const int pp = wave * 32 + pt * 16 + l15;
      const float bias = bs_[g * 128 + pp];
      bfr* ur = UV + (size_t)(chunk * 128 + pp) * 2048 + g * 128 + quad * 4;
#pragma unroll
      for (int ct = 0; ct < 8; ++ct) {
        const uint2 u = *(const uint2*)(ur + ct * 16);
        uint2 o;
        o.x = pk2(bflo(u.x) * (acc[ct][pt][0] + bias), bfhi(u.x) * (acc[ct][pt][1] + bias));
        o.y = pk2(bflo(u.y) * (acc[ct][pt][2] + bias), bfhi(u.y) * (acc[ct][pt][3] + bias));
        *(uint2*)(ur + ct * 16) = o;
      }
    }
  }
}

DEVINL void hgrn_scan_phase(const Params& p, char* smem, int bid, int nblk, const int mode) {
  bfr* sQe = (bfr*)smem;
  bfr* sKe = sQe + 32 * 136;
  bfr* sKeT = sKe + 32 * 136;
  bfr* sVT = sKeT + 128 * 40;
  bfr* sP = sVT + 64 * 40;
  bfr* sST = sP + 32 * 40;
  float* sLast = (float*)(sST + 64 * 136);
  float* sTot = sLast + 128;
  const int tid = otid(), lane = tid & 63, wave = tid >> 6, l15 = lane & 15, quad = lane >> 4;
  const int cp = lane, qt = wave, i0 = qt * 8;
  const bfr* QZ = (const bfr*)(p.ws + OFF_BIG);
  bfr* Of = (bfr*)(p.ws + OFF_H);
  bfr* Ob = (bfr*)(p.ws + OFF_BIG + 209715200ull);
  const float* lbs = (const float*)(p.ws + OFF_LBS);
  const float* state_rec = p.in[2];
  float* out_state = p.out + (size_t)MTOK * DM;

  float* SLOC = (float*)(p.ws + OFF_BIG + 251658240ull);
  float* DLOC = (float*)(p.ws + OFF_BIG + 251658240ull + 33554432ull);
  const int nitems = mode ? 1536 : 896;
  for (int item = bid; item < nitems; item += nblk) {
    const int eh = item & 1, dir = (item >> 1) & 1, h = (item >> 2) & 7;
    int base, T, nchunks, pos0, slot, seq;
    bool is_prompt = false;
    if (!mode) {
      const int r = item >> 5, seqb = r / 7, j = r - seqb * 7;
      seq = 16 + seqb; base = NPROMPT + seqb * 4096; T = 4096; nchunks = 16; pos0 = j * 512;
      slot = ((seqb * 8 + j) * 8 + h) * 2 + dir;
    } else if (item < 1024) {
      const int r = item >> 5, seqb = r >> 3, j = r & 7;
      seq = 16 + seqb; base = NPROMPT + seqb * 4096; T = 4096; nchunks = 16; pos0 = j * 512;
      slot = ((seqb * 8 + j) * 8 + h) * 2 + dir;
    } else {
      seq = (item - 1024) >> 5; base = seq * 256; T = 256; nchunks = 8; pos0 = 0; slot = 0;
      is_prompt = true;
    }
    bfr* Od = dir ? Ob : Of;
    const float lbv0 = lbs[dir * 1024 + h * 128 + 2 * cp], lbv1 = lbs[dir * 1024 + h * 128 + 2 * cp + 1];
    const int eloc = wave * 16 + l15;
    const int eglob = eh * 64 + eloc;

    f32x4 S[8];
    if (is_prompt || !mode) {
#pragma unroll
      for (int dt = 0; dt < 8; ++dt) S[dt] = f32x4{0.f, 0.f, 0.f, 0.f};
    } else {
      const float* s0 = SLOC + (size_t)slot * 16384;
#pragma unroll
      for (int dt = 0; dt < 8; ++dt)
#pragma unroll
        for (int j = 0; j < 4; ++j) S[dt][j] = s0[(dt * 16 + quad * 4 + j) * 128 + eglob];
    }
    float cum0 = 1.f, cum1 = 1.f;
    __syncthreads();
#pragma unroll
    for (int dt = 0; dt < 8; ++dt) {
      uint2 o; o.x = pk2(S[dt][0], S[dt][1]); o.y = pk2(S[dt][2], S[dt][3]);
      *(uint2*)(sST + eloc * 136 + dt * 16 + quad * 4) = o;
    }

    const unsigned qoff2 = h * 64 + cp, zoff2 = (1 + dir) * 512 + h * 64 + cp;
    const unsigned voff2 = 1536 + h * 64 + eh * 32 + (cp & 31);
    const uint32_t* __restrict__ QZ32 = (const uint32_t*)QZ;
    uint32_t rq[8], rz[8], rv[8];
#pragma unroll
    for (int ii = 0; ii < 8; ++ii) {
      const int pos = pos0 + i0 + ii;
      const unsigned tok = dir ? base + T - 1 - pos : base + pos;
      const unsigned ri = tok * 2560u;
      rq[ii] = QZ32[ri + qoff2]; rz[ii] = QZ32[ri + zoff2]; rv[ii] = QZ32[ri + voff2];
    }

    for (int c = 0; c < nchunks; ++c) {
      float pc0[8], pc1[8], kv0[8], kv1[8];
      float run0 = 1.f, run1 = 1.f;
#pragma unroll
      for (int ii = 0; ii < 8; ++ii) {
        const float z0 = bflo(rz[ii]), z1 = bfhi(rz[ii]);
        const float f0 = lbv0 + (1.f - lbv0) * frcp(1.f + __expf(-z0));
        const float f1 = lbv1 + (1.f - lbv1) * frcp(1.f + __expf(-z1));
        run0 *= f0; run1 *= f1;
        pc0[ii] = run0; pc1[ii] = run1;
        kv0[ii] = 1.f - f0; kv1[ii] = 1.f - f1;
      }
      *(float2*)(sTot + qt * 128 + 2 * cp) = make_float2(run0, run1);
      __syncthreads();
      {
        float off0 = 1.f, off1 = 1.f, tot0 = 1.f, tot1 = 1.f;
#pragma unroll
        for (int q = 0; q < 4; ++q) {
          const float2 t = *(const float2*)(sTot + q * 128 + 2 * cp);
          if (q < qt) { off0 *= t.x; off1 *= t.y; }
          tot0 *= t.x; tot1 *= t.y;
        }
        uint32_t wk0[4], wk1[4], wv0[4], wv1[4];
#pragma unroll
        for (int ii = 0; ii < 8; ii += 2) {
          uint32_t kp[2];
#pragma unroll
          for (int u = 0; u < 2; ++u) {
            const float e0 = pc0[ii + u] * off0, e1 = pc1[ii + u] * off1;
            kp[u] = pk2(kv0[ii + u] * frcp(e0), kv1[ii + u] * frcp(e1));
            *(uint32_t*)(sKe + (i0 + ii + u) * 136 + 2 * cp) = kp[u];
            if (mode) *(uint32_t*)(sQe + (i0 + ii + u) * 136 + 2 * cp) = pk2(bflo(rq[ii + u]) * e0, bfhi(rq[ii + u]) * e1);
          }
          wk0[ii >> 1] = (kp[0] & 0xffffu) | (kp[1] << 16);
          wk1[ii >> 1] = (kp[0] >> 16) | (kp[1] & 0xffff0000u);
          wv0[ii >> 1] = (rv[ii] & 0xffffu) | (rv[ii + 1] << 16);
          wv1[ii >> 1] = (rv[ii] >> 16) | (rv[ii + 1] & 0xffff0000u);
        }
        *(u32x4*)(sKeT + (2 * cp) * 40 + i0) = u32x4{wk0[0], wk0[1], wk0[2], wk0[3]};
        *(u32x4*)(sKeT + (2 * cp + 1) * 40 + i0) = u32x4{wk1[0], wk1[1], wk1[2], wk1[3]};
        if (cp < 32) {
          *(u32x4*)(sVT + (2 * cp) * 40 + i0) = u32x4{wv0[0], wv0[1], wv0[2], wv0[3]};
          *(u32x4*)(sVT + (2 * cp + 1) * 40 + i0) = u32x4{wv1[0], wv1[1], wv1[2], wv1[3]};
        }
        if (qt == 0) *(float2*)(sLast + 2 * cp) = make_float2(tot0, tot1);
        cum0 *= tot0; cum1 *= tot1;
      }
      if (c + 1 < nchunks) {
#pragma unroll
        for (int ii = 0; ii < 8; ++ii) {
          const int pos = pos0 + (c + 1) * 32 + i0 + ii;
          const unsigned tok = dir ? base + T - 1 - pos : base + pos;
          const unsigned ri = tok * 2560u;
          rq[ii] = QZ32[ri + qoff2]; rz[ii] = QZ32[ri + zoff2]; rv[ii] = QZ32[ri + voff2];
        }
      }
      __syncthreads();
      if (mode) {
        const int ti = wave >> 1, si = wave & 1;
        f32x4 sc = f32x4{0.f, 0.f, 0.f, 0.f};
        if (si <= ti) {
#pragma unroll
          for (int kk = 0; kk < 4; ++kk) {
            const bf16x8 a = *(const bf16x8*)(sQe + (ti * 16 + l15) * 136 + kk * 32 + quad * 8);
            const bf16x8 b = *(const bf16x8*)(sKe + (si * 16 + l15) * 136 + kk * 32 + quad * 8);
            sc = __builtin_amdgcn_mfma_f32_16x16x32_bf16(a, b, sc, 0, 0, 0);
          }
        }
#pragma unroll
        for (int j = 0; j < 4; ++j) {
          const int t = ti * 16 + quad * 4 + j, s2 = si * 16 + l15;
          sP[t * 40 + s2] = (s2 <= t) ? f2bf(sc[j]) : (bfr)0;
        }
      }
      f32x4 oacc[2];
      oacc[0] = f32x4{0.f, 0.f, 0.f, 0.f}; oacc[1] = f32x4{0.f, 0.f, 0.f, 0.f};
      if (mode) {
#pragma unroll
      for (int kk = 0; kk < 4; ++kk) {
        const bf16x8 sb = *(const bf16x8*)(sST + eloc * 136 + kk * 32 + quad * 8);
#pragma unroll
        for (int tt = 0; tt < 2; ++tt) {
          const bf16x8 qa = *(const bf16x8*)(sQe + (tt * 16 + l15) * 136 + kk * 32 + quad * 8);
          oacc[tt] = __builtin_amdgcn_mfma_f32_16x16x32_bf16(sb, qa, oacc[tt], 0, 0, 0);
        }
      }
      }
      __syncthreads();
      {
        const bf16x8 vb = *(const bf16x8*)(sVT + eloc * 40 + quad * 8);
        if (mode) {
#pragma unroll
        for (int tt = 0; tt < 2; ++tt) {
          const bf16x8 pb = *(const bf16x8*)(sP + (tt * 16 + l15) * 40 + quad * 8);
          oacc[tt] = __builtin_amdgcn_mfma_f32_16x16x32_bf16(vb, pb, oacc[tt], 0, 0, 0);
          const int pos = pos0 + c * 32 + tt * 16 + l15;
          const int tok = dir ? base + T - 1 - pos : base + pos;
          uint2 o; o.x = pk2(oacc[tt][0], oacc[tt][1]); o.y = pk2(oacc[tt][2], oacc[tt][3]);
          *(uint2*)(Od + (size_t)tok * DM + h * 128 + eh * 64 + wave * 16 + quad * 4) = o;
        }
        }
#pragma unroll
        for (int dt = 0; dt < 8; ++dt) {
          const bf16x8 ka = *(const bf16x8*)(sKeT + (dt * 16 + l15) * 40 + quad * 8);
          const float4 dl = *(const float4*)(sLast + dt * 16 + quad * 4);
          f32x4 sn = __builtin_amdgcn_mfma_f32_16x16x32_bf16(ka, vb, S[dt], 0, 0, 0);
          sn[0] *= dl.x; sn[1] *= dl.y; sn[2] *= dl.z; sn[3] *= dl.w;
          S[dt] = sn;
          uint2 o; o.x = pk2(sn[0], sn[1]); o.y = pk2(sn[2], sn[3]);
          *(uint2*)(sST + eloc * 136 + dt * 16 + quad * 4) = o;
        }
      }
    }
    if (is_prompt || !mode) {
      float* so = is_prompt ? out_state + ((size_t)(seq * 2 + dir) * 8 + h) * 16384 : SLOC + (size_t)slot * 16384;
#pragma unroll
      for (int dt = 0; dt < 8; ++dt)
#pragma unroll
        for (int j = 0; j < 4; ++j) so[(dt * 16 + quad * 4 + j) * 128 + eglob] = S[dt][j];
      if (!mode && eh == 0 && qt == 0) *(float2*)(DLOC + slot * 128 + 2 * cp) = make_float2(cum0, cum1);
    }
  }
}

DEVINL void hgrn_combine_phase(const Params& p, int bid, int nblk) {
  const int gt = bid * 256 + otid(), nt = nblk * 256;
  float* SLOC = (float*)(p.ws + OFF_BIG + 251658240ull);
  const float* DLOC = (const float*)(p.ws + OFF_BIG + 251658240ull + 33554432ull);
  const float* state_rec = p.in[2];
  for (int idx = gt; idx < 4 * 8 * 2 * 16384; idx += nt) {
    const int de = idx & 16383, r = idx >> 14;
    const int dir = r & 1, h = (r >> 1) & 7, seqb = r >> 4;
    const int d = de >> 7;
    float prev = state_rec[((size_t)(seqb * 2 + dir) * 8 + h) * 16384 + de];
#pragma unroll
    for (int j = 0; j < 8; ++j) {
      const int slot = ((seqb * 8 + j) * 8 + h) * 2 + dir;
      float* ptr = SLOC + (size_t)slot * 16384 + de;
      const float a = (j < 7) ? *ptr : 0.f;
      *ptr = prev;
      if (j < 7) prev = DLOC[slot * 128 + d] * prev + a;
    }
  }
}

DEVINL void hgrn_gate_phase(const Params& p, const float* __restrict__ ng, int bid, int nblk) {
  const int tid = otid(); const int lane = tid & 63;
  const int gw = bid * 4 + (tid >> 6), nw = nblk * 4;
  bfr* Of = (bfr*)(p.ws + OFF_H);
  const bfr* Ob = (const bfr*)(p.ws + OFF_BIG + 209715200ull);
  const bfr* QZ = (const bfr*)(p.ws + OFF_BIG);
  for (int row = gw; row < MTOK; row += nw) {
#pragma unroll
    for (int seg = 0; seg < 4; ++seg) {
      const int c = seg * 256 + lane * 4;
      const uint2 a = *(const uint2*)(Of + (size_t)row * DM + c);
      const uint2 b = *(const uint2*)(Ob + (size_t)row * DM + c);
      const uint2 gq = *(const uint2*)(QZ + (size_t)row * 5120 + 4096 + c);
      const float o0 = bflo(a.x) + bflo(b.x), o1 = bfhi(a.x) + bfhi(b.x), o2 = bflo(a.y) + bflo(b.y), o3 = bfhi(a.y) + bfhi(b.y);
      float ss = o0 * o0 + o1 * o1 + o2 * o2 + o3 * o3;
#pragma unroll
      for (int o = 16; o > 0; o >>= 1) ss += shx(ss, o, lane);
      const float rstd = rsqrtf(ss * (1.f / 128.f) + EPS);
      const float4 gg = *(const float4*)(ng + c);
      uint2 o;
      o.x = pk2(o0 * rstd * gg.x * silu_f(bflo(gq.x)), o1 * rstd * gg.y * silu_f(bfhi(gq.x)));
      o.y = pk2(o2 * rstd * gg.z * silu_f(bflo(gq.y)), o3 * rstd * gg.w * silu_f(bfhi(gq.y)));
      *(uint2*)(Of + (size_t)row * DM + c) = o;
    }
  }
}

DEVINL void ffn_act_phase(const bfr* __restrict__ UP, const float* __restrict__ wdw, int hf, bfr* __restrict__ ACT, int bid, int nblk) {
  const int gt = bid * 256 + otid(), nt = nblk * 256;
  for (int i = gt; i < MTOK * 176; i += nt) {
    const int m = i / 176, j = (i - m * 176) * 8;
    int tl, T; tok_pos(m, tl, T);
    const bfr* ur = UP + (size_t)m * DFF;
    float a[8], b[8];
#pragma unroll
    for (int q = 0; q < 8; ++q) { a[q] = 0.f; b[q] = 0.f; }
#pragma unroll
    for (int tap = 0; tap < 3; ++tap) {
      const int d = tap - 1;
      if ((d < 0 && tl == 0) || (d > 0 && tl == T - 1)) continue;
      const bfr* nr = ur + (ptrdiff_t)d * DFF;
      const uint4 av = *(const uint4*)(nr + j);
      const uint4 bv = *(const uint4*)(nr + HALF_FF + j);
      const float* wa = wdw + tap * (2 * DFF) + hf * HALF_FF + j;
      const float* wb = wdw + tap * (2 * DFF) + DFF + hf * HALF_FF + j;
      const float4 wa0 = *(const float4*)wa, wa1 = *(const float4*)(wa + 4);
      const float4 wb0 = *(const float4*)wb, wb1 = *(const float4*)(wb + 4);
      a[0] += wa0.x * bflo(av.x); a[1] += wa0.y * bfhi(av.x); a[2] += wa0.z * bflo(av.y); a[3] += wa0.w * bfhi(av.y);
      a[4] += wa1.x * bflo(av.z); a[5] += wa1.y * bfhi(av.z); a[6] += wa1.z * bflo(av.w); a[7] += wa1.w * bfhi(av.w);
      b[0] += wb0.x * bflo(bv.x); b[1] += wb0.y * bfhi(bv.x); b[2] += wb0.z * bflo(bv.y); b[3] += wb0.w * bfhi(bv.y);
      b[4] += wb1.x * bflo(bv.z); b[5] += wb1.y * bfhi(bv.z); b[6] += wb1.z * bflo(bv.w); b[7] += wb1.w * bfhi(bv.w);
    }
    uint4 o;
    o.x = pk2(silu_f(a[0]) * b[0], silu_f(a[1]) * b[1]);
    o.y = pk2(silu_f(a[2]) * b[2], silu_f(a[3]) * b[3]);
    o.z = pk2(silu_f(a[4]) * b[4], silu_f(a[5]) * b[5]);
    o.w = pk2(silu_f(a[6]) * b[6], silu_f(a[7]) * b[7]);
    *(uint4*)(ACT + (size_t)m * DFF + hf * HALF_FF + j) = o;
  }
}


#define XB_TMO      128
#define XB_XCNT(j)  (256  + 64 * (j))
#define XB_XSUB(j)  (1280 + 64 * (j))
#define XB_XGEN(j)  (2304 + 64 * (j))
#define XB_TOP      3328
#define XB_TOPGEN   3392
#define XCD_BAR_WORDS 3456
#define XB_SPIN_CAP (1u << 22)
#define LAS __attribute__((address_space(3)))
DEVINL unsigned xb_ld(unsigned* p) { return __hip_atomic_load(p, __ATOMIC_RELAXED, __HIP_MEMORY_SCOPE_AGENT); }
DEVINL unsigned xb_add(unsigned* p, unsigned v) { return __hip_atomic_fetch_add(p, v, __ATOMIC_RELAXED, __HIP_MEMORY_SCOPE_AGENT); }
DEVINL unsigned xb_xcc_id() { return (unsigned)__builtin_amdgcn_s_getreg((3 << 11) | 20) & 0xFu; }
#define XB_SPIN(cond, bar) do { unsigned _sp = 0; while (cond) { __builtin_amdgcn_s_sleep(1); \
    if ((++_sp & 255u) == 0u) { if (xb_ld(&(bar)[XB_TMO])) break; if (_sp > XB_SPIN_CAP) { atomicAdd(&(bar)[XB_TMO], 1u); break; } } } } while (0)
struct XcdBarrier { unsigned* bar; unsigned x; volatile LAS unsigned* st; };
DEVINL XcdBarrier xcd_barrier_post(unsigned* bar, volatile LAS unsigned* st) {
  XcdBarrier b; b.bar = bar; b.x = xb_xcc_id(); b.st = st;
  if (threadIdx.x == 0) (void)xb_add(&bar[XB_XCNT(b.x)], 1u);
  return b;
}
DEVINL void xcd_barrier_complete(unsigned* bar, unsigned x, unsigned& nloc, unsigned& nx) {
  const unsigned G = gridDim.x * gridDim.y * gridDim.z;
  unsigned sum, cnt, mine, sp = 0u;
  for (;;) {
    sum = 0u; cnt = 0u; mine = 0u;
#pragma unroll
    for (unsigned j = 0; j < 16; ++j) { const unsigned c = xb_ld(&bar[XB_XCNT(j)]); sum += c; cnt += (c > 0u) ? 1u : 0u; mine = (j == x) ? c : mine; }
    if (sum == G) break;
    __builtin_amdgcn_s_sleep(1);
    if ((++sp & 255u) == 0u) { if (xb_ld(&bar[XB_TMO])) break; if (sp > XB_SPIN_CAP) { atomicAdd(&bar[XB_TMO], 1u); break; } }
  }
  nloc = mine > 0u ? mine : 1u; nx = cnt > 0u ? cnt : 1u;
}
DEVINL void xcd_barrier(const XcdBarrier& b) {
  asm volatile("s_waitcnt vmcnt(0)" ::: "memory");
  __syncthreads();
  if (threadIdx.x == 0) {
    unsigned* bar = b.bar;
    unsigned bx = b.x;
    asm volatile("" : "+s"(bar), "+s"(bx));
    __builtin_amdgcn_s_waitcnt(0);
    unsigned nloc = b.st[0], nx = b.st[1];
    if (nloc == 0u) { xcd_barrier_complete(bar, bx, nloc, nx); b.st[0] = nloc; b.st[1] = nx; }
    const unsigned old = xb_add(&bar[XB_XSUB(bx)], 1u);
    const unsigned gen = old / nloc;
    if (old + 1u == (gen + 1u) * nloc) {
      __builtin_amdgcn_fence(__ATOMIC_RELEASE, "agent");
      asm volatile("s_waitcnt vmcnt(0)" ::: "memory");
      const unsigned og = xb_add(&bar[XB_TOP], 1u);
      const unsigned tg = og / nx;
      if (og + 1u == (tg + 1u) * nx) xb_add(&bar[XB_TOPGEN], 1u);
      else XB_SPIN(xb_ld(&bar[XB_TOPGEN]) == tg, bar);
      __builtin_amdgcn_fence(__ATOMIC_ACQUIRE, "agent");
      xb_add(&bar[XB_XGEN(bx)], 1u);
      asm volatile("s_waitcnt vmcnt(0)" ::: "memory");
    } else {
      XB_SPIN(xb_ld(&bar[XB_XGEN(bx)]) == gen, bar);
      __builtin_amdgcn_fence(__ATOMIC_ACQUIRE, "agent");
      asm volatile("s_waitcnt vmcnt(0)" ::: "memory");
    }
  }
  __syncthreads();
}

constexpr int SMEM_BYTES = 77824;

__global__ void __launch_bounds__(256, 2) mega_kernel(Params p) {
  __shared__ __attribute__((aligned(16))) char smem[SMEM_BYTES];
  cg::grid_group grid = cg::this_grid();
  __shared__ uint4 xb_words;
  if (threadIdx.x == 0) xb_words = make_uint4(0u, 0u, 0u, 0u);
  __syncthreads();
  XcdBarrier xb = xcd_barrier_post((unsigned*)(p.ws + OFF_BAR), (volatile LAS unsigned*)&xb_words);
  const int bid = blockIdx.x, nblk = gridDim.x;

  phase0a(p, smem, osg(bid), nblk);
  grid.sync();
  phase0b(p, osg(bid), nblk);
  xcd_barrier(xb);

  for (int layer = 0; layer < 4; ++layer) {
    Params q = p;
    {
      size_t oz = 0;
      asm volatile("" : "+s"(oz));
      q.ws = p.ws + oz;
      q.out = p.out + oz;
    }
    float* X = q.out;
    bfr* WB = (bfr*)(q.ws + OFF_WB);
    bfr* H = (bfr*)(q.ws + OFF_H);
    bfr* BIG = (bfr*)(q.ws + OFF_BIG);
    const float* MOD = (const float*)(q.ws + OFF_MOD);
    const float* modl = MOD + layer * 30720;
    if (layer == 0) {
      conv_matrix(q.in[9], 1024, 3072, WB + WB_IN, 0, smem, osg(bid), nblk);
      conv_matrix(q.in[11], 1024, 1024, WB + WB_OUT, 0, smem, osg(bid), nblk);
    } else if (layer == 1) {
      for (int g = 0; g < 4; ++g) conv_matrix(q.in[12] + g * 65536, 256, 256, WB + WB_IN + g * 65536, 0, smem, osg(bid), nblk);
    } else if (layer == 2) {
      conv_matrix(q.in[14], 1024, 2048, WB + WB_IN, 0, smem, osg(bid), nblk);
      conv_matrix(q.in[18], 1024, 1024, WB + WB_OUT, 0, smem, osg(bid), nblk);
    } else {
      conv_matrix(q.in[19], 1024, 5120, WB + WB_IN, 0, smem, osg(bid), nblk);
      conv_matrix(q.in[22], 1024, 1024, WB + WB_OUT, 0, smem, osg(bid), nblk);
    }
    conv_matrix(q.in[23] + (size_t)layer * 1024 * 5632, 1024, 5632, WB + WB_UP, 1, smem, osg(bid), nblk);
    conv_matrix(q.in[25] + (size_t)layer * DFF * 1024, DFF, 1024, WB + WB_DOWN, 0, smem, osg(bid), nblk);
    norm_phase(X, q.in[7] + (layer * 2 + 0) * DM, modl, 0, 1024, H, osg(bid), nblk);
    xcd_barrier(xb);

    if (layer == 0) {
      bfr* G = BIG;
      bfr* U = BIG + (size_t)MTOK * 3072;
      gemm_phase(H, DM, WB + WB_IN, 1024, 3072, 1024, EpiStore{G, 3072}, smem, osg(bid), nblk);
      xcd_barrier(xb);
      shortconv_ew_phase(G, q.in[10], U, osg(bid), nblk);
      xcd_barrier(xb);
      gemm_phase(U, DM, WB + WB_OUT, 1024, 1024, 1024, EpiResid{X, modl + 2048, nullptr, 0}, smem, osg(bid), nblk);
      xcd_barrier(xb);
    } else if (layer == 1) {
      bfr* P = BIG;
      pool_ew_phase(H, P, osg(bid), nblk);
      xcd_barrier(xb);
      for (int g = 0; g < 4; ++g)
        gemm_phase(P + g * 256, DM, WB + WB_IN + g * 65536, 256, 256, 256,
                   EpiResid{X, modl + 2048 + g * 256, q.in[13] + g * 256, g * 256}, smem, osg(bid), nblk);
      xcd_barrier(xb);
    } else if (layer == 2) {
      bfr* UV = BIG;
      gemm_phase(H, DM, WB + WB_IN, 1024, 2048, 1024, EpiGelu{UV, 2048}, smem, osg(bid), nblk);
      xcd_barrier(xb);
      sgu_norm_phase(UV, q.in[15], osg(bid), nblk);
      xcd_barrier(xb);
      sgu_spatial_phase(UV, q.in[16], q.in[17], smem, osg(bid), nblk);
      xcd_barrier(xb);
      gemm_phase(UV, 2048, WB + WB_OUT, 1024, 1024, 1024, EpiResid{X, modl + 2048, nullptr, 0}, smem, osg(bid), nblk);
      xcd_barrier(xb);
    } else {
      bfr* QZ = BIG;
      gemm_phase(H, DM, WB + WB_IN, 1024, 5120, 1024, EpiStore{QZ, 5120}, smem, osg(bid), nblk);
      xcd_barrier(xb);
      hgrn_scan_phase(q, smem, osg(bid), nblk, 0);
      xcd_barrier(xb);
      hgrn_combine_phase(q, osg(bid), nblk);
      xcd_barrier(xb);
      hgrn_scan_phase(q, smem, osg(bid), nblk, 1);
      xcd_barrier(xb);
      hgrn_gate_phase(q, q.in[21], osg(bid), nblk);
      xcd_barrier(xb);
      gemm_phase(H, DM, WB + WB_OUT, 1024, 1024, 1024, EpiResid{X, modl + 2048, nullptr, 0}, smem, osg(bid), nblk);
      xcd_barrier(xb);
    }

    norm_phase(X, q.in[7] + (layer * 2 + 1) * DM, modl, 3072, 4096, H, osg(bid), nblk);
    xcd_barrier(xb);
    bfr* ACT = BIG;
    float* EDGE = (float*)(q.ws + OFF_BIG + 115343360ull);
    const float* wdw = q.in[24] + (size_t)layer * 3 * 2 * DFF;
    gemm_phase(H, DM, WB + WB_UP, 1024, 2 * DFF, 1024, EpiFfnUp{ACT, EDGE, wdw}, smem, osg(bid), nblk);
    xcd_barrier(xb);
    ffn_edge_phase(EDGE, wdw, ACT, osg(bid), nblk);
    xcd_barrier(xb);
    gemm_phase(ACT, DFF, WB + WB_DOWN, DFF, 1024, DFF, EpiResid{X, modl + 5120, nullptr, 0}, smem, osg(bid), nblk);
    xcd_barrier(xb);
  }
  final_norm_phase(p.out, p.in[8], osg(bid), nblk);
}

extern "C" void kernel_launch(void* const* d_in, const int* in_sizes, int n_in, void* d_out, int out_size,
                              void* d_ws, size_t ws_size, hipStream_t stream) {
  static int grid_blocks = 0;
  if (!grid_blocks) {
    int dev = 0, cus = 0, per_cu = 0;
    hipGetDevice(&dev);
    hipDeviceGetAttribute(&cus, hipDeviceAttributeMultiprocessorCount, dev);
    hipOccupancyMaxActiveBlocksPerMultiprocessor(&per_cu, mega_kernel, 256, 0);
    if (per_cu > 2) per_cu = 2;
    if (per_cu < 1) per_cu = 1;
    grid_blocks = cus * per_cu;
  }
  if (ws_size < WS_NEED) { fprintf(stderr, "workspace too small: %zu < %zu\n", ws_size, (size_t)WS_NEED); return; }
  Params p{};
  for (int i = 0; i < 26; ++i) p.in[i] = (const float*)d_in[i];
  p.out = (float*)d_out;
  p.ws = (char*)d_ws;
  hipMemsetAsync((char*)d_ws + OFF_BAR, 0, XCD_BAR_WORDS * 4, stream);
  void* args[] = {&p};
  hipError_t e = hipLaunchCooperativeKernel((void*)mega_kernel, dim3(grid_blocks), dim3(256), args, 0, stream);
  if (e != hipSuccess) fprintf(stderr, "cooperative launch failed: %s (grid %d)\n", hipGetErrorString(e), grid_blocks);
}
```

```cpp
#include <hip/hip_runtime.h>
#include <hip/hip_cooperative_groups.h>
#include <stdint.h>
#include <stdio.h>
namespace cg = cooperative_groups;

#define DEVINL __device__ __forceinline__
typedef unsigned short bfr;
using bf16x8 = __attribute__((ext_vector_type(8))) short;
using f32x4 = __attribute__((ext_vector_type(4))) float;
using u32x4 = __attribute__((ext_vector_type(4))) unsigned int;

constexpr int DM = 1024;
constexpr int MTOK = 20480;
constexpr int NPROMPT = 4096;
constexpr int DFF = 2816;
constexpr int HALF_FF = 1408;
constexpr float EPS = 1e-6f;

constexpr size_t OFF_MODP = 0;
constexpr size_t OFF_MOD = 7864320;
constexpr size_t OFF_LBS = OFF_MOD + 491520;
constexpr size_t OFF_BAR = OFF_LBS + 8192;
constexpr size_t OFF_WB = 8388608;
constexpr size_t OFF_H = 41943040;
constexpr size_t OFF_BIG = 83886080;
constexpr size_t WS_NEED = OFF_BIG + 251658240ull + 33554432ull + 262144ull;
constexpr size_t WB_IN = 0, WB_OUT = 5242880, WB_UP = 6291456, WB_DOWN = 12058624;

struct Params {
  const float* in[26];
  float* out;
  char* ws;
};

DEVINL int otid() { int t = threadIdx.x; asm volatile("" : "+v"(t)); return t; }
DEVINL int osg(int x) { asm volatile("" : "+s"(x)); return x; }
typedef __bf16 hbf16x2 __attribute__((ext_vector_type(2)));
typedef float hf32x2 __attribute__((ext_vector_type(2)));
DEVINL uint32_t pk2(float a, float b) {
  hf32x2 v = {a, b};
  hbf16x2 r = __builtin_convertvector(v, hbf16x2);
  return __builtin_bit_cast(uint32_t, r);
}
DEVINL bfr f2bf(float f) { return (bfr)(pk2(f, 0.f) & 0xffffu); }
DEVINL float bf2f(bfr h) { return __uint_as_float(((uint32_t)h) << 16); }
DEVINL float frcp(float x) { return __builtin_amdgcn_rcpf(x); }
DEVINL float bflo(uint32_t u) { return __uint_as_float(u << 16); }
DEVINL float bfhi(uint32_t u) { return __uint_as_float(u & 0xffff0000u); }
DEVINL int cond_of(int m) { return m < NPROMPT ? 0 : 1 + ((m - NPROMPT) >> 12); }
DEVINL float silu_f(float x) { return x * frcp(1.f + __expf(-x)); }
DEVINL float gelu_tanh_f(float x) {
  float y = 0.7978845608028654f * (x + 0.044715f * x * x * x);
  float t = 1.f - 2.f * frcp(__expf(2.f * y) + 1.f);
  return 0.5f * x * (1.f + t);
}
DEVINL float shx(float v, int o, int lane) {
  return __int_as_float(__builtin_amdgcn_ds_bpermute((lane ^ o) << 2, __float_as_int(v)));
}
DEVINL float wave_sum(float v, int lane) {
#pragma unroll
  for (int o = 32; o > 0; o >>= 1) v += shx(v, o, lane);
  return v;
}

DEVINL void tok_pos(int m, int& tl, int& T) {
  if (m < NPROMPT) { tl = m & 255; T = 256; } else { tl = (m - NPROMPT) & 4095; T = 4096; }
}

struct EpiNoPre {};
#define EPI_ELEMENTWISE_TILE                                                                       \
  typedef EpiNoPre Pre;                                                                             \
  DEVINL Pre pre(int tn, int tid) const { return Pre{}; }                                           \
  DEVINL void tile(const f32x4 (&acc)[4][4], const Pre& pre_, int m0, int n0, int tn, int wm, int wn, int l15, \
                   int quad, int tid, char* smem) const {                                           \
    _Pragma("unroll") for (int mt = 0; mt < 4; ++mt)                                                \
      _Pragma("unroll") for (int nt = 0; nt < 4; ++nt)                                              \
        (*this)(m0 + wm * 64 + mt * 16 + l15, n0 + wn * 64 + nt * 16 + quad * 4, acc[mt][nt]);      \
  }
struct EpiStore {
  bfr* C; int ldc;
  DEVINL void tile256(const f32x4 (&acc)[8][4], const EpiNoPre& pre_, int m0, int n0, int tn, int wm, int wn, int l15,
                      int quad, int tid, char* smem) const {
#pragma unroll
    for (int mt = 0; mt < 8; ++mt)
#pragma unroll
      for (int nt = 0; nt < 4; ++nt)
        (*this)(m0 + wm * 128 + mt * 16 + l15, n0 + wn * 64 + nt * 16 + quad * 4, acc[mt][nt]);
  }
  DEVINL void operator()(int m, int n, f32x4 v) const {
    uint2 o; o.x = pk2(v[0], v[1]); o.y = pk2(v[2], v[3]);
    *(uint2*)(C + (size_t)m * ldc + n) = o;
  }
  EPI_ELEMENTWISE_TILE
};
struct EpiGelu {
  bfr* C; int ldc;
  DEVINL void operator()(int m, int n, f32x4 v) const {
    uint2 o; o.x = pk2(gelu_tanh_f(v[0]), gelu_tanh_f(v[1])); o.y = pk2(gelu_tanh_f(v[2]), gelu_tanh_f(v[3]));
    *(uint2*)(C + (size_t)m * ldc + n) = o;
  }
  EPI_ELEMENTWISE_TILE
};
struct EpiResid {
  float* X; const float* gate; const float* cscale; int coff;
  typedef EpiNoPre Pre;
  static constexpr bool kSplit = false;
  DEVINL Pre pre(int tn, int tid) const { return Pre{}; }
  DEVINL void tile(const f32x4 (&acc)[4][4], const Pre& pre_, int m0, int n0, int tn, int wm, int wn, int l15,
                   int quad, int tid, char* smem) const {
    const int cond = cond_of(m0);
    const int nb = n0 + wn * 64 + quad * 4;
    f32x4 gs[4];
#pragma unroll
    for (int nt = 0; nt < 4; ++nt) {
      gs[nt] = *(const f32x4*)(gate + cond * 6144 + nb + nt * 16);
      if (cscale) gs[nt] = gs[nt] * *(const f32x4*)(cscale + nb + nt * 16);
    }
    float* xb = X + (size_t)(m0 + wm * 64 + l15) * DM + coff + nb;
#pragma unroll
    for (int hm = 0; hm < 2; ++hm) {
      f32x4 xv[2][4];
#pragma unroll
      for (int mi = 0; mi < 2; ++mi)
#pragma unroll
        for (int nt = 0; nt < 4; ++nt)
          xv[mi][nt] = *(const f32x4*)(xb + (size_t)((hm * 2 + mi) * 16) * DM + nt * 16);
#pragma unroll
      for (int mi = 0; mi < 2; ++mi)
#pragma unroll
        for (int nt = 0; nt < 4; ++nt)
          *(f32x4*)(xb + (size_t)((hm * 2 + mi) * 16) * DM + nt * 16) = xv[mi][nt] + gs[nt] * acc[hm * 2 + mi][nt];
    }
  }
};


#define LDS3 __attribute__((address_space(3)))
DEVINL void lds_barrier() { asm volatile("s_waitcnt lgkmcnt(0)\n\ts_barrier" ::: "memory"); }
template <class Epi>
DEVINL void gemm_phase(const bfr* __restrict__ A, int lda, const bfr* __restrict__ Bt, int ldb, int N, int K,
                       const Epi& epi, char* smem, int bid, int nblk) {
  const int tid = otid(), lane = tid & 63, wave = tid >> 6;
  const int wm = wave >> 1, wn = wave & 1, l15 = lane & 15, quad = lane >> 4;
  const int tilesN = N >> 7;
  const int ntiles = (MTOK >> 7) * tilesN;
  const int nk = K >> 6;
  const int srow0 = wave * 8 + (lane >> 3);
  const int lc = (lane & 7) ^ ((srow0 >> 1) & 7);
  const int fsw = (l15 >> 1) & 7;
  char* const dst0 = smem + wave * 1024 + lane * 16;
#define TILE_DECODE(t_, tm_, tn_) {                                                        \
    const int xcd_ = (t_) & 7, u_ = (t_) >> 3, g16_ = 16 * tilesN;                         \
    int ur_;                                                                               \
    if (u_ < g16_) { const int gs_ = 8 * tilesN; const int g_ = u_ / gs_, r_ = u_ - g_ * gs_; tn_ = r_ >> 3; ur_ = g_ * 8 + (r_ & 7); } \
    else { const int r_ = u_ - g16_; tn_ = r_ >> 2; ur_ = 16 + (r_ & 3); }                 \
    tm_ = ur_ * 8 + xcd_; }
#define GLDS_STAGE(pa_, pb_, st_, kt_)                                                                    \
  {                                                                                                       \
    _Pragma("unroll") for (int i = 0; i < 4; ++i) {                                                       \
      __builtin_amdgcn_global_load_lds((const unsigned*)((pa_) + (size_t)(i * 32) * lda + (kt_) * 64),    \
                                       (LDS3 unsigned*)(dst0 + (st_) * 32768 + i * 4096), 16, 0, 0);      \
      __builtin_amdgcn_global_load_lds((const unsigned*)((pb_) + (size_t)(i * 32) * ldb + (kt_) * 64),    \
                                       (LDS3 unsigned*)(dst0 + (st_) * 32768 + 16384 + i * 4096), 16, 0, 0); \
    }                                                                                                     \
  }
  int tile = bid;
  if (tile >= ntiles) return;
  int tm, tn;
  TILE_DECODE(tile, tm, tn)
  const bfr* gA = A + (size_t)((tm << 7) + srow0) * lda + lc * 8;
  const bfr* gB = Bt + (size_t)((tn << 7) + srow0) * ldb + lc * 8;
  __syncthreads();
  GLDS_STAGE(gA, gB, 0, 0)
  for (; tile < ntiles; tile += nblk) {
    const int m0 = tm << 7, n0 = tn << 7, tn_cur = tn;
    const bool has_next = (tile + nblk < ntiles);
    const bfr* gAn = gA; const bfr* gBn = gB;
    if (has_next) {
      TILE_DECODE(tile + nblk, tm, tn)
      gAn = A + (size_t)((tm << 7) + srow0) * lda + lc * 8;
      gBn = Bt + (size_t)((tn << 7) + srow0) * ldb + lc * 8;
    }
    typename Epi::Pre pre = epi.pre(tn_cur, tid);
    f32x4 acc[4][4];
#pragma unroll
    for (int i = 0; i < 4; ++i)
#pragma unroll
      for (int j = 0; j < 4; ++j) acc[i][j] = f32x4{0.f, 0.f, 0.f, 0.f};
    __syncthreads();
    for (int kt = 0; kt < nk; ++kt) {
      const int st = kt & 1;
      const bool cur = (kt + 1 < nk);
      const bool any = cur || has_next;
      const bfr* sa = cur ? gA + (kt + 1) * 64 : gAn;
      const bfr* sb = cur ? gB + (kt + 1) * 64 : gBn;
      char* sd = dst0 + (cur ? (st ^ 1) : 0) * 32768;
      const char* cA = smem + st * 32768 + (wm * 64 + l15) * 128;
      const char* cB = smem + st * 32768 + 16384 + (wn * 64 + l15) * 128;
      {
        const int co0 = (quad ^ fsw) * 16, co1 = ((4 + quad) ^ fsw) * 16;
        bf16x8 af0[4], bf0[4], af1[4], bf1[4];
#pragma unroll
        for (int i = 0; i < 4; ++i) {
          af0[i] = *(const bf16x8*)(cA + i * 2048 + co0);
          bf0[i] = *(const bf16x8*)(cB + i * 2048 + co0);
        }
#pragma unroll
        for (int i = 0; i < 4; ++i) {
          af1[i] = *(const bf16x8*)(cA + i * 2048 + co1);
          bf1[i] = *(const bf16x8*)(cB + i * 2048 + co1);
        }
        __builtin_amdgcn_sched_barrier(0);
#pragma unroll
        for (int mt = 0; mt < 4; ++mt) {
#pragma unroll
          for (int nt = 0; nt < 4; ++nt)
            acc[mt][nt] = __builtin_amdgcn_mfma_f32_16x16x32_bf16(bf0[nt], af0[mt], acc[mt][nt], 0, 0, 0);
          if (any) {
            __builtin_amdgcn_global_load_lds((const unsigned*)(sa + (size_t)(mt * 32) * lda), (LDS3 unsigned*)(sd + mt * 4096), 16, 0, 0);
            __builtin_amdgcn_global_load_lds((const unsigned*)(sb + (size_t)(mt * 32) * ldb), (LDS3 unsigned*)(sd + 16384 + mt * 4096), 16, 0, 0);
          }
          __builtin_amdgcn_sched_barrier(0);
        }
#pragma unroll
        for (int mt = 0; mt < 4; ++mt)
#pragma unroll
          for (int nt = 0; nt < 4; ++nt)
            acc[mt][nt] = __builtin_amdgcn_mfma_f32_16x16x32_bf16(bf1[nt], af1[mt], acc[mt][nt], 0, 0, 0);
        __builtin_amdgcn_sched_barrier(0);
      }
      if (kt + 1 < nk) __syncthreads();
    }
    epi.tile(acc, pre, m0, n0, tn_cur, wm, wn, l15, quad, tid, smem);
    gA = gAn; gB = gBn;
  }
}

constexpr int EDGE_LD = 2 * DFF;
struct FfnPre { f32x4 wa[3], wb[3]; };
DEVINL void ffn_conv_rows(const bfr* T, const FfnPre& pre_, bfr* ACT, float* EDGE, int m0, int n0, int tn, int tid) {
  const int c4 = (tid & 15) * 4, r0 = (tid >> 4) * 8;
  const int ja = tn * 64 + c4;
  int tl, Tlen; tok_pos(m0, tl, Tlen);
  const bool top_ok = (tl == 0), bot_ok = (tl + 128 == Tlen);
  if (tid < 128) {
    const int e = tid >> 5, c = (tid & 31) * 4;
    const int r = (e < 2) ? e : 124 + e;
    const uint2 v = *(const uint2*)(T + r * 136 + c);
    *(f32x4*)(EDGE + ((size_t)(m0 >> 7) * 4 + e) * EDGE_LD + n0 + c) = f32x4{bflo(v.x), bfhi(v.x), bflo(v.y), bfhi(v.y)};
  }
  const f32x4 zero = f32x4{0.f, 0.f, 0.f, 0.f};
#define LDT(dst, row, col) { const uint2 v_ = *(const uint2*)(T + (row) * 136 + (col)); dst = f32x4{bflo(v_.x), bfhi(v_.x), bflo(v_.y), bfhi(v_.y)}; }
  f32x4 pa = zero, pb = zero, ca, cb, na, nb;
  if (r0 > 0) { LDT(pa, r0 - 1, c4) LDT(pb, r0 - 1, 64 + c4) }
  LDT(ca, r0, c4) LDT(cb, r0, 64 + c4)
#pragma unroll
  for (int i = 0; i < 8; ++i) {
    const int r = r0 + i;
    if (r < 127) { LDT(na, r + 1, c4) LDT(nb, r + 1, 64 + c4) }
    else { na = zero; nb = zero; }
    const bool ok = (r > 0 || top_ok) && (r < 127 || bot_ok);
    if (ok) {
      const f32x4 a = pre_.wa[0] * pa + pre_.wa[1] * ca + pre_.wa[2] * na;
      const f32x4 b = pre_.wb[0] * pb + pre_.wb[1] * cb + pre_.wb[2] * nb;
      uint2 o;
      o.x = pk2(silu_f(a[0]) * b[0], silu_f(a[1]) * b[1]);
      o.y = pk2(silu_f(a[2]) * b[2], silu_f(a[3]) * b[3]);
      *(uint2*)(ACT + (size_t)(m0 + r) * DFF + ja) = o;
    }
    pa = ca; pb = cb; ca = na; cb = nb;
  }
#undef LDT
}
struct EpiFfnUp {
  bfr* ACT; float* EDGE; const float* wdw;
  typedef FfnPre Pre;
  DEVINL Pre pre(int tn, int tid) const {
    Pre q;
    const int ja = tn * 64 + (tid & 15) * 4;
#pragma unroll
    for (int t = 0; t < 3; ++t) {
      q.wa[t] = *(const f32x4*)(wdw + t * (2 * DFF) + ja);
      q.wb[t] = *(const f32x4*)(wdw + t * (2 * DFF) + DFF + ja);
    }
    return q;
  }
  DEVINL void tile(const f32x4 (&acc)[4][4], const Pre& pre_, int m0, int n0, int tn, int wm, int wn, int l15, int quad,
                   int tid, char* smem) const {
    bfr* T = (bfr*)(smem + 32768);
    lds_barrier();
#pragma unroll
    for (int mt = 0; mt < 4; ++mt)
#pragma unroll
      for (int nt = 0; nt < 4; ++nt) {
        uint2 o; o.x = pk2(acc[mt][nt][0], acc[mt][nt][1]); o.y = pk2(acc[mt][nt][2], acc[mt][nt][3]);
        *(uint2*)(T + (wm * 64 + mt * 16 + l15) * 136 + wn * 64 + nt * 16 + quad * 4) = o;
      }
    lds_barrier();
    ffn_conv_rows(T, pre_, ACT, EDGE, m0, n0, tn, tid);
  }
  DEVINL void tile256(const f32x4 (&acc)[8][4], const Pre& pre_, int m0, int n0, int tn, int wm, int wn, int l15, int quad,
                      int tid, char* smem) const {
    bfr* T = (bfr*)(smem + 24576);
#pragma unroll
    for (int hh = 0; hh < 2; ++hh) {
      lds_barrier();
      if (wm == hh) {
#pragma unroll
        for (int mt = 0; mt < 8; ++mt)
#pragma unroll
          for (int nt = 0; nt < 4; ++nt) {
            uint2 o; o.x = pk2(acc[mt][nt][0], acc[mt][nt][1]); o.y = pk2(acc[mt][nt][2], acc[mt][nt][3]);
            *(uint2*)(T + (mt * 16 + l15) * 136 + wn * 64 + nt * 16 + quad * 4) = o;
          }
      }
      lds_barrier();
      ffn_conv_rows(T, pre_, ACT, EDGE, m0 + hh * 128, n0, tn, tid);
    }
  }
};


template <class Epi>
DEVINL void gemm256_phase(const bfr* __restrict__ A, int lda, const bfr* __restrict__ Bt, int ldb, int N, int K,
                          const Epi& epi, char* smem, int bid, int nblk) {
  const int tid = otid(), lane = tid & 63, wave = tid >> 6;
  const int wm = wave >> 1, wn = wave & 1, l15 = lane & 15, quad = lane >> 4;
  const int tilesN = N >> 7;
  const int ntiles = (MTOK >> 8) * tilesN;
  const int nk = K >> 5;
  const int srow0 = wave * 16 + (lane >> 2);
  const int lc = (lane & 3) ^ ((0 - (lane >> 4)) & 3);
  const int fsw = (0 - (l15 >> 2)) & 3;
  char* const dst0 = smem + wave * 1024 + lane * 16;
#define TILE_DECODE2(t_, tm_, tn_) { const int xcd_ = (t_) & 7, u_ = (t_) >> 3; const int ur_ = u_ / tilesN; tn_ = u_ - ur_ * tilesN; tm_ = ur_ * 8 + xcd_; }
#define GLDS_STAGE2(pa_, pb_, st_, kt_)                                                                   \
  {                                                                                                       \
    _Pragma("unroll") for (int i = 0; i < 4; ++i)                                                         \
      __builtin_amdgcn_global_load_lds((const unsigned*)((pa_) + (size_t)(i * 64) * lda + (kt_) * 32),    \
                                       (LDS3 unsigned*)(dst0 + (st_) * 24576 + i * 4096), 16, 0, 0);      \
    _Pragma("unroll") for (int i = 0; i < 2; ++i)                                                         \
      __builtin_amdgcn_global_load_lds((const unsigned*)((pb_) + (size_t)(i * 64) * ldb + (kt_) * 32),    \
                                       (LDS3 unsigned*)(dst0 + (st_) * 24576 + 16384 + i * 4096), 16, 0, 0); \
  }
  int tile = bid;
  if (tile >= ntiles) return;
  int tm, tn;
  TILE_DECODE2(tile, tm, tn)
  const bfr* gA = A + (size_t)((tm << 8) + srow0) * lda + lc * 8;
  const bfr* gB = Bt + (size_t)((tn << 7) + srow0) * ldb + lc * 8;
  __syncthreads();
  GLDS_STAGE2(gA, gB, 0, 0)
  for (; tile < ntiles; tile += nblk) {
    const int m0 = tm << 8, n0 = tn << 7, tn_cur = tn;
    const bool has_next = (tile + nblk < ntiles);
    const bfr* gAn = gA; const bfr* gBn = gB;
    if (has_next) {
      TILE_DECODE2(tile + nblk, tm, tn)
      gAn = A + (size_t)((tm << 8) + srow0) * lda + lc * 8;
      gBn = Bt + (size_t)((tn << 7) + srow0) * ldb + lc * 8;
    }
    f32x4 acc[8][4];
#pragma unroll
    for (int i = 0; i < 8; ++i)
#pragma unroll
      for (int j = 0; j < 4; ++j) acc[i][j] = f32x4{0.f, 0.f, 0.f, 0.f};
    __syncthreads();
    for (int kt = 0; kt < nk; ++kt) {
      const int st = kt & 1;
      const bool cur = (kt + 1 < nk);
      const bool any = cur || has_next;
      const bfr* sa = cur ? gA + (kt + 1) * 32 : gAn;
      const bfr* sb = cur ? gB + (kt + 1) * 32 : gBn;
      char* sd = dst0 + (cur ? (st ^ 1) : 0) * 24576;
      const char* cA = smem + st * 24576 + (wm * 128 + l15) * 64 + ((quad ^ fsw) * 16);
      const char* cB = smem + st * 24576 + 16384 + (wn * 64 + l15) * 64 + ((quad ^ fsw) * 16);
      bf16x8 bfg[4];
#pragma unroll
      for (int i = 0; i < 4; ++i) bfg[i] = *(const bf16x8*)(cB + i * 1024);
#pragma unroll
      for (int hm = 0; hm < 2; ++hm) {
        bf16x8 af[4];
#pragma unroll
        for (int i = 0; i < 4; ++i) af[i] = *(const bf16x8*)(cA + (hm * 4 + i) * 1024);
        __builtin_amdgcn_sched_barrier(0);
#pragma unroll
        for (int mt = 0; mt < 4; ++mt) {
#pragma unroll
          for (int nt = 0; nt < 4; ++nt)
            acc[hm * 4 + mt][nt] = __builtin_amdgcn_mfma_f32_16x16x32_bf16(bfg[nt], af[mt], acc[hm * 4 + mt][nt], 0, 0, 0);
          const int g = hm * 4 + mt;
          if (any && g < 4)
            __builtin_amdgcn_global_load_lds((const unsigned*)(sa + (size_t)(g * 64) * lda), (LDS3 unsigned*)(sd + g * 4096), 16, 0, 0);
          else if (any && g < 6)
            __builtin_amdgcn_global_load_lds((const unsigned*)(sb + (size_t)((g - 4) * 64) * ldb), (LDS3 unsigned*)(sd + 16384 + (g - 4) * 4096), 16, 0, 0);
          __builtin_amdgcn_sched_barrier(0);
        }
      }
      if (kt + 1 < nk) __syncthreads();
    }
    {
      typename Epi::Pre pre = epi.pre(tn_cur, tid);
      epi.tile256(acc, pre, m0, n0, tn_cur, wm, wn, l15, quad, tid, smem);
    }
    gA = gAn; gB = gBn;
  }
}

DEVINL void ffn_edge_phase(const float* __restrict__ EDGE, const float* __restrict__ wdw, bfr* __restrict__ ACT, int bid, int nblk) {
  const int gt = bid * 256 + otid(), nt = nblk * 256;
  for (int i = gt; i < 160 * 2 * 704; i += nt) {
    const int cg4 = i % 704, r2 = i / 704, side = r2 & 1, tm = r2 >> 1;
    const int m0 = tm << 7;
    int tl, Tlen; tok_pos(m0, tl, Tlen);
    if (side == 0 ? (tl == 0) : (tl + 128 == Tlen)) continue;
    const int ja = cg4 * 4;
    const int nb_ = ja >> 6, cc = ja & 63;
    const int ea = nb_ * 128 + cc, eb = ea + 64;
    const float* prev; const float* cur; const float* next;
    if (side == 0) {
      prev = EDGE + ((size_t)(tm - 1) * 4 + 3) * EDGE_LD; cur = EDGE + ((size_t)tm * 4 + 0) * EDGE_LD; next = EDGE + ((size_t)tm * 4 + 1) * EDGE_LD;
    } else {
      prev = EDGE + ((size_t)tm * 4 + 2) * EDGE_LD; cur = EDGE + ((size_t)tm * 4 + 3) * EDGE_LD; next = EDGE + ((size_t)(tm + 1) * 4 + 0) * EDGE_LD;
    }
    const f32x4 a = *(const f32x4*)(wdw + ja) * *(const f32x4*)(prev + ea) + *(const f32x4*)(wdw + 2 * DFF + ja) * *(const f32x4*)(cur + ea) +
                    *(const f32x4*)(wdw + 4 * DFF + ja) * *(const f32x4*)(next + ea);
    const f32x4 b = *(const f32x4*)(wdw + DFF + ja) * *(const f32x4*)(prev + eb) + *(const f32x4*)(wdw + 3 * DFF + ja) * *(const f32x4*)(cur + eb) +
                    *(const f32x4*)(wdw + 5 * DFF + ja) * *(const f32x4*)(next + eb);
    uint2 o;
    o.x = pk2(silu_f(a[0]) * b[0], silu_f(a[1]) * b[1]);
    o.y = pk2(silu_f(a[2]) * b[2], silu_f(a[3]) * b[3]);
    const int m = m0 + (side ? 127 : 0);
    *(uint2*)(ACT + (size_t)m * DFF + ja) = o;
  }
}

DEVINL int up_perm(int n0) {
  if (n0 < DFF) return (n0 >> 6) * 128;
  return ((n0 - DFF) >> 6) * 128 + 64;
}
DEVINL void conv_matrix(const float* __restrict__ src, int K, int N, bfr* __restrict__ dst, int perm,
                        char* smem, int bid, int nblk) {
  float* sT = (float*)smem;
  const int tid = otid();
  const int tilesN = N >> 6;
  const int ntiles = (K >> 6) * tilesN;
  const int r = tid >> 4, c4 = tid & 15;
  int t = bid;
  if (t >= ntiles) return;
  f32x4 v0, v1, v2, v3;
  {
    const int tk = t / tilesN, tn = t - tk * tilesN;
    const float* sp = src + (size_t)((tk << 6) + r) * N + (tn << 6) + c4 * 4;
    v0 = *(const f32x4*)(sp); v1 = *(const f32x4*)(sp + (size_t)16 * N);
    v2 = *(const f32x4*)(sp + (size_t)32 * N); v3 = *(const f32x4*)(sp + (size_t)48 * N);
  }
  for (; t < ntiles; t += nblk) {
    const int tk = t / tilesN, tn = t - tk * tilesN;
    const int k0 = tk << 6, n0 = tn << 6;
    __syncthreads();
    {
      float* d = sT + r * 65 + c4 * 4;
      d[0] = v0[0]; d[1] = v0[1]; d[2] = v0[2]; d[3] = v0[3];
      d[16 * 65 + 0] = v1[0]; d[16 * 65 + 1] = v1[1]; d[16 * 65 + 2] = v1[2]; d[16 * 65 + 3] = v1[3];
      d[32 * 65 + 0] = v2[0]; d[32 * 65 + 1] = v2[1]; d[32 * 65 + 2] = v2[2]; d[32 * 65 + 3] = v2[3];
      d[48 * 65 + 0] = v3[0]; d[48 * 65 + 1] = v3[1]; d[48 * 65 + 2] = v3[2]; d[48 * 65 + 3] = v3[3];
    }
    if (t + nblk < ntiles) {
      const int t2 = t + nblk;
      const int tk2 = t2 / tilesN, tn2 = t2 - tk2 * tilesN;
      const float* sp = src + (size_t)((tk2 << 6) + r) * N + (tn2 << 6) + c4 * 4;
      v0 = *(const f32x4*)(sp); v1 = *(const f32x4*)(sp + (size_t)16 * N);
      v2 = *(const f32x4*)(sp + (size_t)32 * N); v3 = *(const f32x4*)(sp + (size_t)48 * N);
    }
    __syncthreads();
    const int n = tid >> 2, kc = tid & 3;
    uint32_t w[8];
#pragma unroll
    for (int j = 0; j < 8; ++j)
      w[j] = pk2(sT[(kc * 16 + 2 * j) * 65 + n], sT[(kc * 16 + 2 * j + 1) * 65 + n]);
    const int nd = (perm ? up_perm(n0) : n0) + n;
    bfr* dp = dst + (size_t)nd * K + k0 + kc * 16;
    *(uint4*)dp = make_uint4(w[0], w[1], w[2], w[3]);
    *(uint4*)(dp + 8) = make_uint4(w[4], w[5], w[6], w[7]);
  }
}

DEVINL void phase0a(const Params& p, char* smem, int bid, int nblk) {
  const int tid = otid();
  float* sc = (float*)smem;
  float* modp = (float*)(p.ws + OFF_MODP);
  const float* cvec = p.in[3];
  const float* cctx = p.in[4];
  const float* ada_w = p.in[5];
  for (int job = bid; job < 384; job += nblk) {
    const int l = job / 96, r = job - l * 96, ks = r / 6, cgp = r - ks * 6;
    __syncthreads();
    for (int i = tid; i < 320; i += 256) {
      const int cond = i >> 6, kk = i & 63;
      const float v = cond == 0 ? cctx[ks * 64 + kk] : cvec[(cond - 1) * DM + ks * 64 + kk];
      sc[i] = silu_f(v);
    }
    __syncthreads();
    const int col = cgp * 1024 + tid * 4;
    const float* wp = ada_w + ((size_t)l * DM + ks * 64) * 6144 + col;
    float a[5][4];
#pragma unroll
    for (int c = 0; c < 5; ++c)
#pragma unroll
      for (int j = 0; j < 4; ++j) a[c][j] = 0.f;
#pragma unroll 8
    for (int kk = 0; kk < 64; ++kk) {
      const float4 w = *(const float4*)(wp + (size_t)kk * 6144);
#pragma unroll
      for (int c = 0; c < 5; ++c) {
        const float s = sc[c * 64 + kk];
        a[c][0] += s * w.x; a[c][1] += s * w.y; a[c][2] += s * w.z; a[c][3] += s * w.w;
      }
    }
#pragma unroll
    for (int c = 0; c < 5; ++c)
      *(float4*)(modp + ((size_t)(ks * 4 + l) * 5 + c) * 6144 + col) = make_float4(a[c][0], a[c][1], a[c][2], a[c][3]);
  }
  const int gt = bid * 256 + tid, nt = nblk * 256;
  {
    const float* lb = p.in[20];
    float* lbs = (float*)(p.ws + OFF_LBS);
    for (int i = gt; i < 2048; i += nt) {
      const float v0 = lb[i], v1 = lb[2048 + i], v2 = lb[4096 + i], v3 = lb[6144 + i];
      const float mx = fmaxf(fmaxf(v0, v1), fmaxf(v2, v3));
      const float e0 = expf(v0 - mx), e1 = expf(v1 - mx), e2 = expf(v2 - mx), e3 = expf(v3 - mx);
      lbs[i] = (e1 + e2 + e3) / (e0 + e1 + e2 + e3);
    }
  }
  float* X = p.out;
  {
    const float4* xp = (const float4*)p.in[0];
    float4* xo = (float4*)X;
    for (int i = gt; i < NPROMPT * DM / 4; i += nt) xo[i] = xp[i];
    const float* xs = p.in[1];
    for (int i = gt; i < 4096 * 256; i += nt) {
      const int t = i >> 8, c = (i & 255) * 4;
      const int part = c >> 8;
      const float pos = (float)((part < 2) ? (t >> 6) : (t & 63));
      float pe[4];
#pragma unroll
      for (int j = 0; j < 4; ++j) {
        const int jj = (c + j) & 255;
        const float freq = expf((-9.210340371976184f * (float)jj) / 256.0f);
        const float arg = pos * freq;
        pe[j] = (part & 1) ? cosf(arg) : sinf(arg);
      }
#pragma unroll
      for (int b = 0; b < 4; ++b) {
        const size_t off = ((size_t)b * 4096 + t) * DM + c;
        float4 v = *(const float4*)(xs + off);
        v.x += pe[0]; v.y += pe[1]; v.z += pe[2]; v.w += pe[3];
        *(float4*)(X + (size_t)NPROMPT * DM + off) = v;
      }
    }
  }
}

DEVINL void phase0b(const Params& p, int bid, int nblk) {
  const int gt = bid * 256 + otid(), nt = nblk * 256;
  const float* modp = (const float*)(p.ws + OFF_MODP);
  float* mod = (float*)(p.ws + OFF_MOD);
  const float* ada_b = p.in[6];
  for (int i = gt; i < 4 * 5 * 6144; i += nt) {
    const int l = i / 30720, col = i % 6144;
    float s = ada_b[l * 6144 + col];
#pragma unroll
    for (int ks = 0; ks < 16; ++ks) s += modp[(size_t)ks * 122880 + i];
    mod[i] = s;
  }
}

DEVINL void norm_phase(const float* __restrict__ X, const float* __restrict__ g, const float* __restrict__ modl,
                       int shift_off, int scale_off, bfr* __restrict__ H, int bid, int nblk) {
  const int tid = otid(); const int lane = tid & 63;
  const int gw = bid * 4 + (tid >> 6), nw = nblk * 4;
  int row = gw;
  if (row >= MTOK) return;
  f32x4 x0, x1, x2, x3;
  {
    const float* xr = X + (size_t)row * DM + lane * 4;
    x0 = *(const f32x4*)(xr); x1 = *(const f32x4*)(xr + 256); x2 = *(const f32x4*)(xr + 512); x3 = *(const f32x4*)(xr + 768);
  }
  for (; row < MTOK; row += nw) {
    const f32x4 c0 = x0, c1 = x1, c2 = x2, c3 = x3;
    if (row + nw < MTOK) {
      const float* xr = X + (size_t)(row + nw) * DM + lane * 4;
      x0 = *(const f32x4*)(xr); x1 = *(const f32x4*)(xr + 256); x2 = *(const f32x4*)(xr + 512); x3 = *(const f32x4*)(xr + 768);
    }
    float ss = 0.f;
#pragma unroll
    for (int j = 0; j < 4; ++j) ss += c0[j] * c0[j] + c1[j] * c1[j] + c2[j] * c2[j] + c3[j] * c3[j];
    ss = wave_sum(ss, lane);
    const float rstd = rsqrtf(ss * (1.f / DM) + EPS);
    const float* mc = modl + cond_of(row) * 6144;
#pragma unroll
    for (int i = 0; i < 4; ++i) {
      const f32x4 xv = (i == 0) ? c0 : (i == 1) ? c1 : (i == 2) ? c2 : c3;
      const int c = i * 256 + lane * 4;
      const float4 gg = *(const float4*)(g + c);
      const float4 sh = *(const float4*)(mc + shift_off + c);
      const float4 sc = *(const float4*)(mc + scale_off + c);
      const float h0 = xv[0] * rstd * gg.x * (1.f + sc.x) + sh.x;
      const float h1 = xv[1] * rstd * gg.y * (1.f + sc.y) + sh.y;
      const float h2 = xv[2] * rstd * gg.z * (1.f + sc.z) + sh.z;
      const float h3 = xv[3] * rstd * gg.w * (1.f + sc.w) + sh.w;
      uint2 o; o.x = pk2(h0, h1); o.y = pk2(h2, h3);
      *(uint2*)(H + (size_t)row * DM + c) = o;
    }
  }
}

DEVINL void final_norm_phase(float* X, const float* __restrict__ g, int bid, int nblk) {
  const int tid = otid(); const int lane = tid & 63;
  const int gw = bid * 4 + (tid >> 6), nw = nblk * 4;
  for (int row = gw; row < MTOK; row += nw) {
    float* xr = X + (size_t)row * DM;
    float4 x[4];
    float ss = 0.f;
#pragma unroll
    for (int i = 0; i < 4; ++i) {
      x[i] = *(const float4*)(xr + i * 256 + lane * 4);
      ss += x[i].x * x[i].x + x[i].y * x[i].y + x[i].z * x[i].z + x[i].w * x[i].w;
    }
    ss = wave_sum(ss, lane);
    const float rstd = rsqrtf(ss * (1.f / DM) + EPS);
#pragma unroll
    for (int i = 0; i < 4; ++i) {
      const int c = i * 256 + lane * 4;
      const float4 gg = *(const float4*)(g + c);
      float4 o;
      o.x = x[i].x * rstd * gg.x; o.y = x[i].y * rstd * gg.y; o.z = x[i].z * rstd * gg.z; o.w = x[i].w * rstd * gg.w;
      *(float4*)(xr + c) = o;
    }
  }
}

DEVINL void shortconv_ew_phase(const bfr* __restrict__ G, const float* __restrict__ wdw, bfr* __restrict__ U, int bid, int nblk) {
  const int gt = bid * 256 + otid(), nt = nblk * 256;
  for (int i = gt; i < MTOK * 128; i += nt) {
    const int m = i >> 7, c = (i & 127) * 8;
    int tl, T; tok_pos(m, tl, T);
    const bfr* gr = G + (size_t)m * 3072;
    const uint4 bg = *(const uint4*)(gr + c);
    float accv[8];
#pragma unroll
    for (int j = 0; j < 8; ++j) accv[j] = 0.f;
#pragma unroll
    for (int tap = 0; tap < 3; ++tap) {
      const int d = tap - 1;
      if ((d < 0 && tl == 0) || (d > 0 && tl == T - 1)) continue;
      const bfr* nr = gr + (ptrdiff_t)d * 3072;
      const uint4 cgv = *(const uint4*)(nr + 1024 + c);
      const uint4 xhv = *(const uint4*)(nr + 2048 + c);
      const float4 w0 = *(const float4*)(wdw + tap * DM + c);
      const float4 w1 = *(const float4*)(wdw + tap * DM + c + 4);
      accv[0] += w0.x * bflo(cgv.x) * bflo(xhv.x); accv[1] += w0.y * bfhi(cgv.x) * bfhi(xhv.x);
      accv[2] += w0.z * bflo(cgv.y) * bflo(xhv.y); accv[3] += w0.w * bfhi(cgv.y) * bfhi(xhv.y);
      accv[4] += w1.x * bflo(cgv.z) * bflo(xhv.z); accv[5] += w1.y * bfhi(cgv.z) * bfhi(xhv.z);
      accv[6] += w1.z * bflo(cgv.w) * bflo(xhv.w); accv[7] += w1.w * bfhi(cgv.w) * bfhi(xhv.w);
    }
    uint4 o;
    o.x = pk2(bflo(bg.x) * accv[0], bfhi(bg.x) * accv[1]);
    o.y = pk2(bflo(bg.y) * accv[2], bfhi(bg.y) * accv[3]);
    o.z = pk2(bflo(bg.z) * accv[4], bfhi(bg.z) * accv[5]);
    o.w = pk2(bflo(bg.w) * accv[6], bfhi(bg.w) * accv[7]);
    *(uint4*)(U + (size_t)m * DM + c) = o;
  }
}

DEVINL void pool_ew_phase(const bfr* __restrict__ H, bfr* __restrict__ P, int bid, int nblk) {
  const int gt = bid * 256 + otid(), nt = nblk * 256;
  for (int i = gt; i < MTOK * 128; i += nt) {
    const int m = i >> 7, ch = i & 127, c = ch * 8;
    int tl, T; tok_pos(m, tl, T);
    const int hw = 1 << (ch >> 5);
    const int lo = max(tl - hw, 0), hi = min(tl + hw, T);
    float s[8];
#pragma unroll
    for (int j = 0; j < 8; ++j) s[j] = 0.f;
    const bfr* base = H + (size_t)(m - tl) * DM + c;
    uint4 wv[16];
#pragma unroll
    for (int j = 0; j < 16; ++j) {
      const int q = tl - hw + j;
      const bool ok = (j < 2 * hw) && (q >= 0) && (q < T);
      wv[j] = ok ? *(const uint4*)(base + (size_t)q * DM) : make_uint4(0u, 0u, 0u, 0u);
    }
#pragma unroll
    for (int j = 0; j < 16; ++j) {
      const uint4 v = wv[j];
      s[0] += bflo(v.x); s[1] += bfhi(v.x); s[2] += bflo(v.y); s[3] += bfhi(v.y);
      s[4] += bflo(v.z); s[5] += bfhi(v.z); s[6] += bflo(v.w); s[7] += bfhi(v.w);
    }
    const float inv = 1.f / (float)(hi - lo);
    const uint4 v = *(const uint4*)(base + (size_t)tl * DM);
    uint4 o;
    o.x = pk2(s[0] * inv - bflo(v.x), s[1] * inv - bfhi(v.x));
    o.y = pk2(s[2] * inv - bflo(v.y), s[3] * inv - bfhi(v.y));
    o.z = pk2(s[4] * inv - bflo(v.z), s[5] * inv - bfhi(v.z));
    o.w = pk2(s[6] * inv - bflo(v.w), s[7] * inv - bfhi(v.w));
    *(uint4*)(P + (size_t)m * DM + c) = o;
  }
}

DEVINL void sgu_norm_phase(bfr* UV, const float* __restrict__ g, int bid, int nblk) {
  const int tid = otid(); const int lane = tid & 63;
  const int gw = bid * 4 + (tid >> 6), nw = nblk * 4;
  for (int row = gw; row < MTOK; row += nw) {
    bfr* vr = UV + (size_t)row * 2048 + 1024;
    float x[4][4];
    float ss = 0.f;
#pragma unroll
    for (int i = 0; i < 4; ++i) {
      const uint2 v = *(const uint2*)(vr + i * 256 + lane * 4);
      x[i][0] = bflo(v.x); x[i][1] = bfhi(v.x); x[i][2] = bflo(v.y); x[i][3] = bfhi(v.y);
      ss += x[i][0] * x[i][0] + x[i][1] * x[i][1] + x[i][2] * x[i][2] + x[i][3] * x[i][3];
    }
    ss = wave_sum(ss, lane);
    const float rstd = rsqrtf(ss * (1.f / DM) + EPS);
#pragma unroll
    for (int i = 0; i < 4; ++i) {
      const int c = i * 256 + lane * 4;
      const float4 gg = *(const float4*)(g + c);
      uint2 o;
      o.x = pk2(x[i][0] * rstd * gg.x, x[i][1] * rstd * gg.y);
      o.y = pk2(x[i][2] * rstd * gg.z, x[i][3] * rstd * gg.w);
      *(uint2*)(vr + c) = o;
    }
  }
}

DEVINL void sgu_spatial_phase(bfr* UV, const float* __restrict__ ws_, const float* __restrict__ bs_, char* smem, int bid, int nblk) {
  bfr* sV = (bfr*)smem;
  bfr* sW = sV + 128 * 136;
  const int tid = otid(), lane = tid & 63, wave = tid >> 6, l15 = lane & 15, quad = lane >> 4;
  for (int item = bid; item < 160 * 8; item += nblk) {
    const int chunk = item >> 3, g = item & 7;
    __syncthreads();
    const float* wg = ws_ + (size_t)g * 16384;
#pragma unroll 4
    for (int i = 0; i < 16; ++i) {
      const int idx = tid + 256 * i;
      const int row = idx >> 5, chn = idx & 31;
      const float4 v = *(const float4*)(wg + row * 128 + chn * 4);
      uint2 o; o.x = pk2(v.x, v.y); o.y = pk2(v.z, v.w);
      *(uint2*)(sW + row * 136 + chn * 4) = o;
    }
#pragma unroll 2
    for (int i = 0; i < 8; ++i) {
      const int idx = tid + 256 * i;
      const int q = idx >> 4, chn = idx & 15;
      const uint4 v = *(const uint4*)(UV + (size_t)(chunk * 128 + q) * 2048 + 1024 + g * 128 + chn * 8);
      bfr* d = sV + (chn * 8) * 136 + q;
      d[0 * 136] = (bfr)(v.x & 0xffff); d[1 * 136] = (bfr)(v.x >> 16);
      d[2 * 136] = (bfr)(v.y & 0xffff); d[3 * 136] = (bfr)(v.y >> 16);
      d[4 * 136] = (bfr)(v.z & 0xffff); d[5 * 136] = (bfr)(v.z >> 16);
      d[6 * 136] = (bfr)(v.w & 0xffff); d[7 * 136] = (bfr)(v.w >> 16);
    }
    __syncthreads();
    f32x4 acc[8][2];
#pragma unroll
    for (int i = 0; i < 8; ++i) { acc[i][0] = f32x4{0.f, 0.f, 0.f, 0.f}; acc[i][1] = f32x4{0.f, 0.f, 0.f, 0.f}; }
#pragma unroll
    for (int kk = 0; kk < 4; ++kk) {
      bf16x8 bw[2];
#pragma unroll
      for (int pt = 0; pt < 2; ++pt) bw[pt] = *(const bf16x8*)(sW + (wave * 32 + pt * 16 + l15) * 136 + kk * 32 + quad * 8);
#pragma unroll
      for (int ct = 0; ct < 8; ++ct) {
        const bf16x8 av = *(const bf16x8*)(sV + (ct * 16 + l15) * 136 + kk * 32 + quad * 8);
#pragma unroll
        for (int pt = 0; pt < 2; ++pt)
          acc[ct][pt] = __builtin_amdgcn_mfma_f32_16x16x32_bf16(av, bw[pt], acc[ct][pt], 0, 0, 0);
      }
    }
#pragma unroll
    for (int pt = 0; pt < 2; ++pt) {
      const int pp = wave * 32 + pt * 16 + l15;
      const float bias = bs_[g * 128 + pp];
      bfr* ur = UV + (size_t)(chunk * 128 + pp) * 2048 + g * 128 + quad * 4;
#pragma unroll
      for (int ct = 0; ct < 8; ++ct) {
        const uint2 u = *(const uint2*)(ur + ct * 16);
        uint2 o;
        o.x = pk2(bflo(u.x) * (acc[ct][pt][0] + bias), bfhi(u.x) * (acc[ct][pt][1] + bias));
        o.y = pk2(bflo(u.y) * (acc[ct][pt][2] + bias), bfhi(u.y) * (acc[ct][pt][3] + bias));
        *(uint2*)(ur + ct * 16) = o;
      }
    }
  }
}

DEVINL void hgrn_scan_phase(const Params& p, char* smem, int bid, int nblk, const int mode) {
  bfr* sQe = (bfr*)smem;
  bfr* sKe = sQe + 32 * 136;
  bfr* sKeT = sKe + 32 * 136;
  bfr* sVT = sKeT + 128 * 40;
  bfr* sP = sVT + 64 * 40;
  bfr* sST = sP + 32 * 40;
  float* sLast = (float*)(sST + 64 * 136);
  float* sTot = sLast + 128;
  const int tid = otid(), lane = tid & 63, wave = tid >> 6, l15 = lane & 15, quad = lane >> 4;
  const int cp = lane, qt = wave, i0 = qt * 8;
  const bfr* QZ = (const bfr*)(p.ws + OFF_BIG);
  bfr* Of = (bfr*)(p.ws + OFF_H);
  bfr* Ob = (bfr*)(p.ws + OFF_BIG + 209715200ull);
  const float* lbs = (const float*)(p.ws + OFF_LBS);
  const float* state_rec = p.in[2];
  float* out_state = p.out + (size_t)MTOK * DM;

  float* SLOC = (float*)(p.ws + OFF_BIG + 251658240ull);
  float* DLOC = (float*)(p.ws + OFF_BIG + 251658240ull + 33554432ull);
  const int nitems = mode ? 1536 : 896;
  for (int item = bid; item < nitems; item += nblk) {
    const int eh = item & 1, dir = (item >> 1) & 1, h = (item >> 2) & 7;
    int base, T, nchunks, pos0, slot, seq;
    bool is_prompt = false;
    if (!mode) {
      const int r = item >> 5, seqb = r / 7, j = r - seqb * 7;
      seq = 16 + seqb; base = NPROMPT + seqb * 4096; T = 4096; nchunks = 16; pos0 = j * 512;
      slot = ((seqb * 8 + j) * 8 + h) * 2 + dir;
    } else if (item < 1024) {
      const int r = item >> 5, seqb = r >> 3, j = r & 7;
      seq = 16 + seqb; base = NPROMPT + seqb * 4096; T = 4096; nchunks = 16; pos0 = j * 512;
      slot = ((seqb * 8 + j) * 8 + h) * 2 + dir;
    } else {
      seq = (item - 1024) >> 5; base = seq * 256; T = 256; nchunks = 8; pos0 = 0; slot = 0;
      is_prompt = true;
    }
    bfr* Od = dir ? Ob : Of;
    const float lbv0 = lbs[dir * 1024 + h * 128 + 2 * cp], lbv1 = lbs[dir * 1024 + h * 128 + 2 * cp + 1];
    const int eloc = wave * 16 + l15;
    const int eglob = eh * 64 + eloc;

    f32x4 S[8];
    if (is_prompt || !mode) {
#pragma unroll
      for (int dt = 0; dt < 8; ++dt) S[dt] = f32x4{0.f, 0.f, 0.f, 0.f};
    } else {
      const float* s0 = SLOC + (size_t)slot * 16384;
#pragma unroll
      for (int dt = 0; dt < 8; ++dt)
#pragma unroll
        for (int j = 0; j < 4; ++j) S[dt][j] = s0[(dt * 16 + quad * 4 + j) * 128 + eglob];
    }
    float cum0 = 1.f, cum1 = 1.f;
    __syncthreads();
#pragma unroll
    for (int dt = 0; dt < 8; ++dt) {
      uint2 o; o.x = pk2(S[dt][0], S[dt][1]); o.y = pk2(S[dt][2], S[dt][3]);
      *(uint2*)(sST + eloc * 136 + dt * 16 + quad * 4) = o;
    }

    const unsigned qoff2 = h * 64 + cp, zoff2 = (1 + dir) * 512 + h * 64 + cp;
    const unsigned voff2 = 1536 + h * 64 + eh * 32 + (cp & 31);
    const uint32_t* __restrict__ QZ32 = (const uint32_t*)QZ;
    uint32_t rq[8], rz[8], rv[8];
#pragma unroll
    for (int ii = 0; ii < 8; ++ii) {
      const int pos = pos0 + i0 + ii;
      const unsigned tok = dir ? base + T - 1 - pos : base + pos;
      const unsigned ri = tok * 2560u;
      rq[ii] = QZ32[ri + qoff2]; rz[ii] = QZ32[ri + zoff2]; rv[ii] = QZ32[ri + voff2];
    }

    for (int c = 0; c < nchunks; ++c) {
      float pc0[8], pc1[8], kv0[8], kv1[8];
      float run0 = 1.f, run1 = 1.f;
#pragma unroll
      for (int ii = 0; ii < 8; ++ii) {
        const float z0 = bflo(rz[ii]), z1 = bfhi(rz[ii]);
        const float f0 = lbv0 + (1.f - lbv0) * frcp(1.f + __expf(-z0));
        const float f1 = lbv1 + (1.f - lbv1) * frcp(1.f + __expf(-z1));
        run0 *= f0; run1 *= f1;
        pc0[ii] = run0; pc1[ii] = run1;
        kv0[ii] = 1.f - f0; kv1[ii] = 1.f - f1;
      }
      *(float2*)(sTot + qt * 128 + 2 * cp) = make_float2(run0, run1);
      __syncthreads();
      {
        float off0 = 1.f, off1 = 1.f, tot0 = 1.f, tot1 = 1.f;
#pragma unroll
        for (int q = 0; q < 4; ++q) {
          const float2 t = *(const float2*)(sTot + q * 128 + 2 * cp);
          if (q < qt) { off0 *= t.x; off1 *= t.y; }
          tot0 *= t.x; tot1 *= t.y;
        }
        uint32_t wk0[4], wk1[4], wv0[4], wv1[4];
#pragma unroll
        for (int ii = 0; ii < 8; ii += 2) {
          uint32_t kp[2];
#pragma unroll
          for (int u = 0; u < 2; ++u) {
            const float e0 = pc0[ii + u] * off0, e1 = pc1[ii + u] * off1;
            kp[u] = pk2(kv0[ii + u] * frcp(e0), kv1[ii + u] * frcp(e1));
            *(uint32_t*)(sKe + (i0 + ii + u) * 136 + 2 * cp) = kp[u];
            if (mode) *(uint32_t*)(sQe + (i0 + ii + u) * 136 + 2 * cp) = pk2(bflo(rq[ii + u]) * e0, bfhi(rq[ii + u]) * e1);
          }
          wk0[ii >> 1] = (kp[0] & 0xffffu) | (kp[1] << 16);
          wk1[ii >> 1] = (kp[0] >> 16) | (kp[1] & 0xffff0000u);
          wv0[ii >> 1] = (rv[ii] & 0xffffu) | (rv[ii + 1] << 16);
          wv1[ii >> 1] = (rv[ii] >> 16) | (rv[ii + 1] & 0xffff0000u);
        }
        *(u32x4*)(sKeT + (2 * cp) * 40 + i0) = u32x4{wk0[0], wk0[1], wk0[2], wk0[3]};
        *(u32x4*)(sKeT + (2 * cp + 1) * 40 + i0) = u32x4{wk1[0], wk1[1], wk1[2], wk1[3]};
        if (cp < 32) {
          *(u32x4*)(sVT + (2 * cp) * 40 + i0) = u32x4{wv0[0], wv0[1], wv0[2], wv0[3]};
          *(u32x4*)(sVT + (2 * cp + 1) * 40 + i0) = u32x4{wv1[0], wv1[1], wv1[2], wv1[3]};
        }
        if (qt == 0) *(float2*)(sLast + 2 * cp) = make_float2(tot0, tot1);
        cum0 *= tot0; cum1 *= tot1;
      }
      if (c + 1 < nchunks) {
#pragma unroll
        for (int ii = 0; ii < 8; ++ii) {
          const int pos = pos0 + (c + 1) * 32 + i0 + ii;
          const unsigned tok = dir ? base + T - 1 - pos : base + pos;
          const unsigned ri = tok * 2560u;
          rq[ii] = QZ32[ri + qoff2]; rz[ii] = QZ32[ri + zoff2]; rv[ii] = QZ32[ri + voff2];
        }
      }
      __syncthreads();
      if (mode) {
        const int ti = wave >> 1, si = wave & 1;
        f32x4 sc = f32x4{0.f, 0.f, 0.f, 0.f};
        if (si <= ti) {
#pragma unroll
          for (int kk = 0; kk < 4; ++kk) {
            const bf16x8 a = *(const bf16x8*)(sQe + (ti * 16 + l15) * 136 + kk * 32 + quad * 8);
            const bf16x8 b = *(const bf16x8*)(sKe + (si * 16 + l15) * 136 + kk * 32 + quad * 8);
            sc = __builtin_amdgcn_mfma_f32_16x16x32_bf16(a, b, sc, 0, 0, 0);
          }
        }
#pragma unroll
        for (int j = 0; j < 4; ++j) {
          const int t = ti * 16 + quad * 4 + j, s2 = si * 16 + l15;
          sP[t * 40 + s2] = (s2 <= t) ? f2bf(sc[j]) : (bfr)0;
        }
      }
      f32x4 oacc[2];
      oacc[0] = f32x4{0.f, 0.f, 0.f, 0.f}; oacc[1] = f32x4{0.f, 0.f, 0.f, 0.f};
      if (mode) {
#pragma unroll
      for (int kk = 0; kk < 4; ++kk) {
        const bf16x8 sb = *(const bf16x8*)(sST + eloc * 136 + kk * 32 + quad * 8);
#pragma unroll
        for (int tt = 0; tt < 2; ++tt) {
          const bf16x8 qa = *(const bf16x8*)(sQe + (tt * 16 + l15) * 136 + kk * 32 + quad * 8);
          oacc[tt] = __builtin_amdgcn_mfma_f32_16x16x32_bf16(sb, qa, oacc[tt], 0, 0, 0);
        }
      }
      }
      __syncthreads();
      {
        const bf16x8 vb = *(const bf16x8*)(sVT + eloc * 40 + quad * 8);
        if (mode) {
#pragma unroll
        for (int tt = 0; tt < 2; ++tt) {
          const bf16x8 pb = *(const bf16x8*)(sP + (tt * 16 + l15) * 40 + quad * 8);
          oacc[tt] = __builtin_amdgcn_mfma_f32_16x16x32_bf16(vb, pb, oacc[tt], 0, 0, 0);
          const int pos = pos0 + c * 32 + tt * 16 + l15;
          const int tok = dir ? base + T - 1 - pos : base + pos;
          uint2 o; o.x = pk2(oacc[tt][0], oacc[tt][1]); o.y = pk2(oacc[tt][2], oacc[tt][3]);
          *(uint2*)(Od + (size_t)tok * DM + h * 128 + eh * 64 + wave * 16 + quad * 4) = o;
        }
        }
#pragma unroll
        for (int dt = 0; dt < 8; ++dt) {
          const bf16x8 ka = *(const bf16x8*)(sKeT + (dt * 16 + l15) * 40 + quad * 8);
          const float4 dl = *(const float4*)(sLast + dt * 16 + quad * 4);
          f32x4 sn = __builtin_amdgcn_mfma_f32_16x16x32_bf16(ka, vb, S[dt], 0, 0, 0);
          sn[0] *= dl.x; sn[1] *= dl.y; sn[2] *= dl.z; sn[3] *= dl.w;
          S[dt] = sn;
          uint2 o; o.x = pk2(sn[0], sn[1]); o.y = pk2(sn[2], sn[3]);
          *(uint2*)(sST + eloc * 136 + dt * 16 + quad * 4) = o;
        }
      }
    }
    if (is_prompt || !mode) {
      float* so = is_prompt ? out_state + ((size_t)(seq * 2 + dir) * 8 + h) * 16384 : SLOC + (size_t)slot * 16384;
#pragma unroll
      for (int dt = 0; dt < 8; ++dt)
#pragma unroll
        for (int j = 0; j < 4; ++j) so[(dt * 16 + quad * 4 + j) * 128 + eglob] = S[dt][j];
      if (!mode && eh == 0 && qt == 0) *(float2*)(DLOC + slot * 128 + 2 * cp) = make_float2(cum0, cum1);
    }
  }
}

DEVINL void hgrn_combine_phase(const Params& p, int bid, int nblk) {
  const int gt = bid * 256 + otid(), nt = nblk * 256;
  float* SLOC = (float*)(p.ws + OFF_BIG + 251658240ull);
  const float* DLOC = (const float*)(p.ws + OFF_BIG + 251658240ull + 33554432ull);
  const float* state_rec = p.in[2];
  for (int idx = gt; idx < 4 * 8 * 2 * 16384; idx += nt) {
    const int de = idx & 16383, r = idx >> 14;
    const int dir = r & 1, h = (r >> 1) & 7, seqb = r >> 4;
    const int d = de >> 7;
    float prev = state_rec[((size_t)(seqb * 2 + dir) * 8 + h) * 16384 + de];
#pragma unroll
    for (int j = 0; j < 8; ++j) {
      const int slot = ((seqb * 8 + j) * 8 + h) * 2 + dir;
      float* ptr = SLOC + (size_t)slot * 16384 + de;
      const float a = (j < 7) ? *ptr : 0.f;
      *ptr = prev;
      if (j < 7) prev = DLOC[slot * 128 + d] * prev + a;
    }
  }
}

DEVINL void hgrn_gate_phase(const Params& p, const float* __restrict__ ng, int bid, int nblk) {
  const int tid = otid(); const int lane = tid & 63;
  const int gw = bid * 4 + (tid >> 6), nw = nblk * 4;
  bfr* Of = (bfr*)(p.ws + OFF_H);
  const bfr* Ob = (const bfr*)(p.ws + OFF_BIG + 209715200ull);
  const bfr* QZ = (const bfr*)(p.ws + OFF_BIG);
  for (int row = gw; row < MTOK; row += nw) {
#pragma unroll
    for (int seg = 0; seg < 4; ++seg) {
      const int c = seg * 256 + lane * 4;
      const uint2 a = *(const uint2*)(Of + (size_t)row * DM + c);
      const uint2 b = *(const uint2*)(Ob + (size_t)row * DM + c);
      const uint2 gq = *(const uint2*)(QZ + (size_t)row * 5120 + 4096 + c);
      const float o0 = bflo(a.x) + bflo(b.x), o1 = bfhi(a.x) + bfhi(b.x), o2 = bflo(a.y) + bflo(b.y), o3 = bfhi(a.y) + bfhi(b.y);
      float ss = o0 * o0 + o1 * o1 + o2 * o2 + o3 * o3;
#pragma unroll
      for (int o = 16; o > 0; o >>= 1) ss += shx(ss, o, lane);
      const float rstd = rsqrtf(ss * (1.f / 128.f) + EPS);
      const float4 gg = *(const float4*)(ng + c);
      uint2 o;
      o.x = pk2(o0 * rstd * gg.x * silu_f(bflo(gq.x)), o1 * rstd * gg.y * silu_f(bfhi(gq.x)));
      o.y = pk2(o2 * rstd * gg.z * silu_f(bflo(gq.y)), o3 * rstd * gg.w * silu_f(bfhi(gq.y)));
      *(uint2*)(Of + (size_t)row * DM + c) = o;
    }
  }
}

DEVINL void ffn_act_phase(const bfr* __restrict__ UP, const float* __restrict__ wdw, int hf, bfr* __restrict__ ACT, int bid, int nblk) {
  const int gt = bid * 256 + otid(), nt = nblk * 256;
  for (int i = gt; i < MTOK * 176; i += nt) {
    const int m = i / 176, j = (i - m * 176) * 8;
    int tl, T; tok_pos(m, tl, T);
    const bfr* ur = UP + (size_t)m * DFF;
    float a[8], b[8];
#pragma unroll
    for (int q = 0; q < 8; ++q) { a[q] = 0.f; b[q] = 0.f; }
#pragma unroll
    for (int tap = 0; tap < 3; ++tap) {
      const int d = tap - 1;
      if ((d < 0 && tl == 0) || (d > 0 && tl == T - 1)) continue;
      const bfr* nr = ur + (ptrdiff_t)d * DFF;
      const uint4 av = *(const uint4*)(nr + j);
      const uint4 bv = *(const uint4*)(nr + HALF_FF + j);
      const float* wa = wdw + tap * (2 * DFF) + hf * HALF_FF + j;
      const float* wb = wdw + tap * (2 * DFF) + DFF + hf * HALF_FF + j;
      const float4 wa0 = *(const float4*)wa, wa1 = *(const float4*)(wa + 4);
      const float4 wb0 = *(const float4*)wb, wb1 = *(const float4*)(wb + 4);
      a[0] += wa0.x * bflo(av.x); a[1] += wa0.y * bfhi(av.x); a[2] += wa0.z * bflo(av.y); a[3] += wa0.w * bfhi(av.y);
      a[4] += wa1.x * bflo(av.z); a[5] += wa1.y * bfhi(av.z); a[6] += wa1.z * bflo(av.w); a[7] += wa1.w * bfhi(av.w);
      b[0] += wb0.x * bflo(bv.x); b[1] += wb0.y * bfhi(bv.x); b[2] += wb0.z * bflo(bv.y); b[3] += wb0.w * bfhi(bv.y);
      b[4] += wb1.x * bflo(bv.z); b[5] += wb1.y * bfhi(bv.z); b[6] += wb1.z * bflo(bv.w); b[7] += wb1.w * bfhi(bv.w);
    }
    uint4 o;
    o.x = pk2(silu_f(a[0]) * b[0], silu_f(a[1]) * b[1]);
    o.y = pk2(silu_f(a[2]) * b[2], silu_f(a[3]) * b[3]);
    o.z = pk2(silu_f(a[4]) * b[4], silu_f(a[5]) * b[5]);
    o.w = pk2(silu_f(a[6]) * b[6], silu_f(a[7]) * b[7]);
    *(uint4*)(ACT + (size_t)m * DFF + hf * HALF_FF + j) = o;
  }
}


#define XB_TMO      128
#define XB_XCNT(j)  (256  + 64 * (j))
#define XB_XSUB(j)  (1280 + 64 * (j))
#define XB_XGEN(j)  (2304 + 64 * (j))
#define XB_TOP      3328
#define XB_TOPGEN   3392
#define XCD_BAR_WORDS 3456
#define XB_SPIN_CAP (1u << 22)
#define LAS __attribute__((address_space(3)))
DEVINL unsigned xb_ld(unsigned* p) { return __hip_atomic_load(p, __ATOMIC_RELAXED, __HIP_MEMORY_SCOPE_AGENT); }
DEVINL unsigned xb_add(unsigned* p, unsigned v) { return __hip_atomic_fetch_add(p, v, __ATOMIC_RELAXED, __HIP_MEMORY_SCOPE_AGENT); }
DEVINL unsigned xb_xcc_id() { return (unsigned)__builtin_amdgcn_s_getreg((3 << 11) | 20) & 0xFu; }
#define XB_SPIN(cond, bar) do { unsigned _sp = 0; while (cond) { __builtin_amdgcn_s_sleep(1); \
    if ((++_sp & 255u) == 0u) { if (xb_ld(&(bar)[XB_TMO])) break; if (_sp > XB_SPIN_CAP) { atomicAdd(&(bar)[XB_TMO], 1u); break; } } } } while (0)
struct XcdBarrier { unsigned* bar; unsigned x; volatile LAS unsigned* st; };
DEVINL XcdBarrier xcd_barrier_post(unsigned* bar, volatile LAS unsigned* st) {
  XcdBarrier b; b.bar = bar; b.x = xb_xcc_id(); b.st = st;
  if (threadIdx.x == 0) (void)xb_add(&bar[XB_XCNT(b.x)], 1u);
  return b;
}
DEVINL void xcd_barrier_complete(unsigned* bar, unsigned x, unsigned& nloc, unsigned& nx) {
  const unsigned G = gridDim.x * gridDim.y * gridDim.z;
  unsigned sum, cnt, mine, sp = 0u;
  for (;;) {
    sum = 0u; cnt = 0u; mine = 0u;
#pragma unroll
    for (unsigned j = 0; j < 16; ++j) { const unsigned c = xb_ld(&bar[XB_XCNT(j)]); sum += c; cnt += (c > 0u) ? 1u : 0u; mine = (j == x) ? c : mine; }
    if (sum == G) break;
    __builtin_amdgcn_s_sleep(1);
    if ((++sp & 255u) == 0u) { if (xb_ld(&bar[XB_TMO])) break; if (sp > XB_SPIN_CAP) { atomicAdd(&bar[XB_TMO], 1u); break; } }
  }
  nloc = mine > 0u ? mine : 1u; nx = cnt > 0u ? cnt : 1u;
}
DEVINL void xcd_barrier(const XcdBarrier& b) {
  asm volatile("s_waitcnt vmcnt(0)" ::: "memory");
  __syncthreads();
  if (threadIdx.x == 0) {
    unsigned* bar = b.bar;
    unsigned bx = b.x;
    asm volatile("" : "+s"(bar), "+s"(bx));
    __builtin_amdgcn_s_waitcnt(0);
    unsigned nloc = b.st[0], nx = b.st[1];
    if (nloc == 0u) { xcd_barrier_complete(bar, bx, nloc, nx); b.st[0] = nloc; b.st[1] = nx; }
    const unsigned old = xb_add(&bar[XB_XSUB(bx)], 1u);
    const unsigned gen = old / nloc;
    if (old + 1u == (gen + 1u) * nloc) {
      __builtin_amdgcn_fence(__ATOMIC_RELEASE, "agent");
      asm volatile("s_waitcnt vmcnt(0)" ::: "memory");
      const unsigned og = xb_add(&bar[XB_TOP], 1u);
      const unsigned tg = og / nx;
      if (og + 1u == (tg + 1u) * nx) xb_add(&bar[XB_TOPGEN], 1u);
      else XB_SPIN(xb_ld(&bar[XB_TOPGEN]) == tg, bar);
      __builtin_amdgcn_fence(__ATOMIC_ACQUIRE, "agent");
      xb_add(&bar[XB_XGEN(bx)], 1u);
      asm volatile("s_waitcnt vmcnt(0)" ::: "memory");
    } else {
      XB_SPIN(xb_ld(&bar[XB_XGEN(bx)]) == gen, bar);
      __builtin_amdgcn_fence(__ATOMIC_ACQUIRE, "agent");
      asm volatile("s_waitcnt vmcnt(0)" ::: "memory");
    }
  }
  __syncthreads();
}

constexpr int SMEM_BYTES = 77824;

__global__ void __launch_bounds__(256, 2) mega_kernel(Params p) {
  __shared__ __attribute__((aligned(16))) char smem[SMEM_BYTES];
  cg::grid_group grid = cg::this_grid();
  __shared__ uint4 xb_words;
  if (threadIdx.x == 0) xb_words = make_uint4(0u, 0u, 0u, 0u);
  __syncthreads();
  XcdBarrier xb = xcd_barrier_post((unsigned*)(p.ws + OFF_BAR), (volatile LAS unsigned*)&xb_words);
  const int bid = blockIdx.x, nblk = gridDim.x;

  phase0a(p, smem, osg(bid), nblk);
  grid.sync();
  phase0b(p, osg(bid), nblk);
  xcd_barrier(xb);

  for (int layer = 0; layer < 4; ++layer) {
    Params q = p;
    {
      size_t oz = 0;
      asm volatile("" : "+s"(oz));
      q.ws = p.ws + oz;
      q.out = p.out + oz;
    }
    float* X = q.out;
    bfr* WB = (bfr*)(q.ws + OFF_WB);
    bfr* H = (bfr*)(q.ws + OFF_H);
    bfr* BIG = (bfr*)(q.ws + OFF_BIG);
    const float* MOD = (const float*)(q.ws + OFF_MOD);
    const float* modl = MOD + layer * 30720;
    if (layer == 0) {
      conv_matrix(q.in[9], 1024, 3072, WB + WB_IN, 0, smem, osg(bid), nblk);
      conv_matrix(q.in[11], 1024, 1024, WB + WB_OUT, 0, smem, osg(bid), nblk);
    } else if (layer == 1) {
      for (int g = 0; g < 4; ++g) conv_matrix(q.in[12] + g * 65536, 256, 256, WB + WB_IN + g * 65536, 0, smem, osg(bid), nblk);
    } else if (layer == 2) {
      conv_matrix(q.in[14], 1024, 2048, WB + WB_IN, 0, smem, osg(bid), nblk);
      conv_matrix(q.in[18], 1024, 1024, WB + WB_OUT, 0, smem, osg(bid), nblk);
    } else {
      conv_matrix(q.in[19], 1024, 5120, WB + WB_IN, 0, smem, osg(bid), nblk);
      conv_matrix(q.in[22], 1024, 1024, WB + WB_OUT, 0, smem, osg(bid), nblk);
    }
    conv_matrix(q.in[23] + (size_t)layer * 1024 * 5632, 1024, 5632, WB + WB_UP, 1, smem, osg(bid), nblk);
    conv_matrix(q.in[25] + (size_t)layer * DFF * 1024, DFF, 1024, WB + WB_DOWN, 0, smem, osg(bid), nblk);
    norm_phase(X, q.in[7] + (layer * 2 + 0) * DM, modl, 0, 1024, H, osg(bid), nblk);
    xcd_barrier(xb);

    if (layer == 0) {
      bfr* G = BIG;
      bfr* U = BIG + (size_t)MTOK * 3072;
      gemm_phase(H, DM, WB + WB_IN, 1024, 3072, 1024, EpiStore{G, 3072}, smem, osg(bid), nblk);
      xcd_barrier(xb);
      shortconv_ew_phase(G, q.in[10], U, osg(bid), nblk);
      xcd_barrier(xb);
      gemm_phase(U, DM, WB + WB_OUT, 1024, 1024, 1024, EpiResid{X, modl + 2048, nullptr, 0}, smem, osg(bid), nblk);
      xcd_barrier(xb);
    } else if (layer == 1) {
      bfr* P = BIG;
      pool_ew_phase(H, P, osg(bid), nblk);
      xcd_barrier(xb);
      for (int g = 0; g < 4; ++g)
        gemm_phase(P + g * 256, DM, WB + WB_IN + g * 65536, 256, 256, 256,
                   EpiResid{X, modl + 2048 + g * 256, q.in[13] + g * 256, g * 256}, smem, osg(bid), nblk);
      xcd_barrier(xb);
    } else if (layer == 2) {
      bfr* UV = BIG;
      gemm_phase(H, DM, WB + WB_IN, 1024, 2048, 1024, EpiGelu{UV, 2048}, smem, osg(bid), nblk);
      xcd_barrier(xb);
      sgu_norm_phase(UV, q.in[15], osg(bid), nblk);
      xcd_barrier(xb);
      sgu_spatial_phase(UV, q.in[16], q.in[17], smem, osg(bid), nblk);
      xcd_barrier(xb);
      gemm_phase(UV, 2048, WB + WB_OUT, 1024, 1024, 1024, EpiResid{X, modl + 2048, nullptr, 0}, smem, osg(bid), nblk);
      xcd_barrier(xb);
    } else {
      bfr* QZ = BIG;
      gemm_phase(H, DM, WB + WB_IN, 1024, 5120, 1024, EpiStore{QZ, 5120}, smem, osg(bid), nblk);
      xcd_barrier(xb);
      hgrn_scan_phase(q, smem, osg(bid), nblk, 0);
      xcd_barrier(xb);
      hgrn_combine_phase(q, osg(bid), nblk);
      xcd_barrier(xb);
      hgrn_scan_phase(q, smem, osg(bid), nblk, 1);
      xcd_barrier(xb);
      hgrn_gate_phase(q, q.in[21], osg(bid), nblk);
      xcd_barrier(xb);
      gemm_phase(H, DM, WB + WB_OUT, 1024, 1024, 1024, EpiResid{X, modl + 2048, nullptr, 0}, smem, osg(bid), nblk);
      xcd_barrier(xb);
    }

    norm_phase(X, q.in[7] + (layer * 2 + 1) * DM, modl, 3072, 4096, H, osg(bid), nblk);
    xcd_barrier(xb);
    bfr* ACT = BIG;
    float* EDGE = (float*)(q.ws + OFF_BIG + 115343360ull);
    const float* wdw = q.in[24] + (size_t)layer * 3 * 2 * DFF;
    gemm_phase(H, DM, WB + WB_UP, 1024, 2 * DFF, 1024, EpiFfnUp{ACT, EDGE, wdw}, smem, osg(bid), nblk);
    xcd_barrier(xb);
    ffn_edge_phase(EDGE, wdw, ACT, osg(bid), nblk);
    xcd_barrier(xb);
    gemm_phase(ACT, DFF, WB + WB_DOWN, DFF, 1024, DFF, EpiResid{X, modl + 5120, nullptr, 0}, smem, osg(bid), nblk);
    xcd_barrier(xb);
  }
  final_norm_phase(p.out, p.in[8], osg(bid), nblk);
}

extern "C" void kernel_launch(void* const* d_in, const int* in_sizes, int n_in, void* d_out, int out_size,
                              void* d_ws, size_t ws_size, hipStream_t stream) {
  static int grid_blocks = 0;
  if (!grid_blocks) {
    int dev = 0, cus = 0, per_cu = 0;
    hipGetDevice(&dev);
    hipDeviceGetAttribute(&cus, hipDeviceAttributeMultiprocessorCount, dev);
    hipOccupancyMaxActiveBlocksPerMultiprocessor(&per_cu, mega_kernel, 256, 0);
    if (per_cu > 2) per_cu = 2;
    if (per_cu < 1) per_cu = 1;
    grid_blocks = cus * per_cu;
  }
  if (ws_size < WS_NEED) { fprintf(stderr, "workspace too small: %zu < %zu\n", ws_size, (size_t)WS_NEED); return; }
  Params p{};
  for (int i = 0; i < 26; ++i) p.in[i] = (const float*)d_in[i];
  p.out = (float*)d_out;
  p.ws = (char*)d_ws;
  hipMemsetAsync((char*)d_ws + OFF_BAR, 0, XCD_BAR_WORDS * 4, stream);
  void* args[] = {&p};
  hipError_t e = hipLaunchCooperativeKernel((void*)mega_kernel, dim3(grid_blocks), dim3(256), args, 0, stream);
  if (e != hipSuccess) fprintf(stderr, "cooperative launch failed: %s (grid %d)\n", hipGetErrorString(e), grid_blocks);
}
```

```cpp
#include <hip/hip_runtime.h>
#include <hip/hip_cooperative_groups.h>
#include <stdint.h>
#include <stdio.h>
namespace cg = cooperative_groups;

#define DEVINL __device__ __forceinline__
typedef unsigned short bfr;
using bf16x8 = __attribute__((ext_vector_type(8))) short;
using f32x4 = __attribute__((ext_vector_type(4))) float;
using u32x4 = __attribute__((ext_vector_type(4))) unsigned int;

constexpr int DM = 1024;
constexpr int MTOK = 20480;
constexpr int NPROMPT = 4096;
constexpr int DFF = 2816;
constexpr int HALF_FF = 1408;
constexpr float EPS = 1e-6f;

constexpr size_t OFF_MODP = 0;
constexpr size_t OFF_MOD = 7864320;
constexpr size_t OFF_LBS = OFF_MOD + 491520;
constexpr size_t OFF_BAR = OFF_LBS + 8192;
constexpr size_t OFF_WB = 8388608;
constexpr size_t OFF_H = 41943040;
constexpr size_t OFF_BIG = 83886080;
constexpr size_t WS_NEED = OFF_BIG + 251658240ull + 33554432ull + 262144ull;
constexpr size_t WB_IN = 0, WB_OUT = 5242880, WB_UP = 6291456, WB_DOWN = 12058624;

struct Params {
  const float* in[26];
  float* out;
  char* ws;
};

DEVINL int otid() { int t = threadIdx.x; asm volatile("" : "+v"(t)); return t; }
DEVINL int osg(int x) { asm volatile("" : "+s"(x)); return x; }
typedef __bf16 hbf16x2 __attribute__((ext_vector_type(2)));
typedef float hf32x2 __attribute__((ext_vector_type(2)));
DEVINL uint32_t pk2(float a, float b) {
  hf32x2 v = {a, b};
  hbf16x2 r = __builtin_convertvector(v, hbf16x2);
  return __builtin_bit_cast(uint32_t, r);
}
DEVINL bfr f2bf(float f) { return (bfr)(pk2(f, 0.f) & 0xffffu); }
DEVINL float bf2f(bfr h) { return __uint_as_float(((uint32_t)h) << 16); }
DEVINL float frcp(float x) { return __builtin_amdgcn_rcpf(x); }
DEVINL float bflo(uint32_t u) { return __uint_as_float(u << 16); }
DEVINL float bfhi(uint32_t u) { return __uint_as_float(u & 0xffff0000u); }
DEVINL int cond_of(int m) { return m < NPROMPT ? 0 : 1 + ((m - NPROMPT) >> 12); }
DEVINL float silu_f(float x) { return x * frcp(1.f + __expf(-x)); }
DEVINL float gelu_tanh_f(float x) {
  float y = 0.7978845608028654f * (x + 0.044715f * x * x * x);
  float t = 1.f - 2.f * frcp(__expf(2.f * y) + 1.f);
  return 0.5f * x * (1.f + t);
}
DEVINL float shx(float v, int o, int lane) {
  return __int_as_float(__builtin_amdgcn_ds_bpermute((lane ^ o) << 2, __float_as_int(v)));
}
DEVINL float wave_sum(float v, int lane) {
#pragma unroll
  for (int o = 32; o > 0; o >>= 1) v += shx(v, o, lane);
  return v;
}

DEVINL void tok_pos(int m, int& tl, int& T) {
  if (m < NPROMPT) { tl = m & 255; T = 256; } else { tl = (m - NPROMPT) & 4095; T = 4096; }
}

struct EpiNoPre {};
#define EPI_ELEMENTWISE_TILE                                                                       \
  typedef EpiNoPre Pre;                                                                             \
  static constexpr bool kLdsEpi = false;                                                            \
  DEVINL Pre pre(int tn, int tid) const { return Pre{}; }                                           \
  DEVINL void tile(const f32x4 (&acc)[4][4], const Pre& pre_, int m0, int n0, int tn, int wm, int wn, int l15, \
                   int quad, int tid, char* smem) const {                                           \
    _Pragma("unroll") for (int mt = 0; mt < 4; ++mt)                                                \
      _Pragma("unroll") for (int nt = 0; nt < 4; ++nt)                                              \
        (*this)(m0 + wm * 64 + mt * 16 + l15, n0 + wn * 64 + nt * 16 + quad * 4, acc[mt][nt]);      \
  }
struct EpiStore {
  bfr* C; int ldc;
  DEVINL void tile256(const f32x4 (&acc)[8][4], const EpiNoPre& pre_, int m0, int n0, int tn, int wm, int wn, int l15,
                      int quad, int tid, char* smem) const {
#pragma unroll
    for (int mt = 0; mt < 8; ++mt)
#pragma unroll
      for (int nt = 0; nt < 4; ++nt)
        (*this)(m0 + wm * 128 + mt * 16 + l15, n0 + wn * 64 + nt * 16 + quad * 4, acc[mt][nt]);
  }
  DEVINL void operator()(int m, int n, f32x4 v) const {
    uint2 o; o.x = pk2(v[0], v[1]); o.y = pk2(v[2], v[3]);
    *(uint2*)(C + (size_t)m * ldc + n) = o;
  }
  EPI_ELEMENTWISE_TILE
};
struct EpiGelu {
  bfr* C; int ldc;
  DEVINL void operator()(int m, int n, f32x4 v) const {
    uint2 o; o.x = pk2(gelu_tanh_f(v[0]), gelu_tanh_f(v[1])); o.y = pk2(gelu_tanh_f(v[2]), gelu_tanh_f(v[3]));
    *(uint2*)(C + (size_t)m * ldc + n) = o;
  }
  EPI_ELEMENTWISE_TILE
};
struct EpiResid {
  float* X; const float* gate; const float* cscale; int coff;
  typedef EpiNoPre Pre;
  static constexpr bool kLdsEpi = false;
  static constexpr bool kSplit = false;
  DEVINL Pre pre(int tn, int tid) const { return Pre{}; }
  DEVINL void tile(const f32x4 (&acc)[4][4], const Pre& pre_, int m0, int n0, int tn, int wm, int wn, int l15,
                   int quad, int tid, char* smem) const {
    const int cond = cond_of(m0);
    const int nb = n0 + wn * 64 + quad * 4;
    f32x4 gs[4];
#pragma unroll
    for (int nt = 0; nt < 4; ++nt) {
      gs[nt] = *(const f32x4*)(gate + cond * 6144 + nb + nt * 16);
      if (cscale) gs[nt] = gs[nt] * *(const f32x4*)(cscale + nb + nt * 16);
    }
    float* xb = X + (size_t)(m0 + wm * 64 + l15) * DM + coff + nb;
#pragma unroll
    for (int hm = 0; hm < 2; ++hm) {
      f32x4 xv[2][4];
#pragma unroll
      for (int mi = 0; mi < 2; ++mi)
#pragma unroll
        for (int nt = 0; nt < 4; ++nt)
          xv[mi][nt] = *(const f32x4*)(xb + (size_t)((hm * 2 + mi) * 16) * DM + nt * 16);
#pragma unroll
      for (int mi = 0; mi < 2; ++mi)
#pragma unroll
        for (int nt = 0; nt < 4; ++nt)
          *(f32x4*)(xb + (size_t)((hm * 2 + mi) * 16) * DM + nt * 16) = xv[mi][nt] + gs[nt] * acc[hm * 2 + mi][nt];
    }
  }
};


#define LDS3 __attribute__((address_space(3)))
DEVINL void lds_barrier() { asm volatile("s_waitcnt lgkmcnt(0)\n\ts_barrier" ::: "memory"); }
template <class Epi>
DEVINL void gemm_phase(const bfr* __restrict__ A, int lda, const bfr* __restrict__ Bt, int ldb, int N, int K,
                       const Epi& epi, char* smem, int bid, int nblk) {
  const int tid = otid(), lane = tid & 63, wave = tid >> 6;
  const int wm = wave >> 1, wn = wave & 1, l15 = lane & 15, quad = lane >> 4;
  const int tilesN = N >> 7;
  const int ntiles = (MTOK >> 7) * tilesN;
  const int nk = K >> 6;
  const int srow0 = wave * 8 + (lane >> 3);
  const int lc = (lane & 7) ^ ((srow0 >> 1) & 7);
  const int fsw = (l15 >> 1) & 7;
  char* const dst0 = smem + wave * 1024 + lane * 16;
#define TILE_DECODE(t_, tm_, tn_) {                                                        \
    const int xcd_ = (t_) & 7, u_ = (t_) >> 3, g16_ = 16 * tilesN;                         \
    int ur_;                                                                               \
    if (u_ < g16_) { const int gs_ = 8 * tilesN; const int g_ = u_ / gs_, r_ = u_ - g_ * gs_; tn_ = r_ >> 3; ur_ = g_ * 8 + (r_ & 7); } \
    else { const int r_ = u_ - g16_; tn_ = r_ >> 2; ur_ = 16 + (r_ & 3); }                 \
    tm_ = ur_ * 8 + xcd_; }
#define GLDS_STAGE(pa_, pb_, st_, kt_)                                                                    \
  {                                                                                                       \
    _Pragma("unroll") for (int i = 0; i < 4; ++i) {                                                       \
      __builtin_amdgcn_global_load_lds((const unsigned*)((pa_) + (size_t)(i * 32) * lda + (kt_) * 64),    \
                                       (LDS3 unsigned*)(dst0 + (st_) * 32768 + i * 4096), 16, 0, 0);      \
      __builtin_amdgcn_global_load_lds((const unsigned*)((pb_) + (size_t)(i * 32) * ldb + (kt_) * 64),    \
                                       (LDS3 unsigned*)(dst0 + (st_) * 32768 + 16384 + i * 4096), 16, 0, 0); \
    }                                                                                                     \
  }
  int tile = bid;
  if (tile >= ntiles) return;
  int tm, tn;
  TILE_DECODE(tile, tm, tn)
  const bfr* gA = A + (size_t)((tm << 7) + srow0) * lda + lc * 8;
  const bfr* gB = Bt + (size_t)((tn << 7) + srow0) * ldb + lc * 8;
  __syncthreads();
  GLDS_STAGE(gA, gB, 0, 0)
  for (; tile < ntiles; tile += nblk) {
    const int m0 = tm << 7, n0 = tn << 7, tn_cur = tn;
    const bool has_next = (tile + nblk < ntiles);
    const bfr* gAn = gA; const bfr* gBn = gB;
    if (has_next) {
      TILE_DECODE(tile + nblk, tm, tn)
      gAn = A + (size_t)((tm << 7) + srow0) * lda + lc * 8;
      gBn = Bt + (size_t)((tn << 7) + srow0) * ldb + lc * 8;
    }
    typename Epi::Pre pre = epi.pre(tn_cur, tid);
    f32x4 acc[4][4];
#pragma unroll
    for (int i = 0; i < 4; ++i)
#pragma unroll
      for (int j = 0; j < 4; ++j) acc[i][j] = f32x4{0.f, 0.f, 0.f, 0.f};
    __syncthreads();
    for (int kt = 0; kt < nk; ++kt) {
      const int st = kt & 1;
      const bool cur = (kt + 1 < nk);
      const bool any = cur || has_next;
      const bfr* sa = cur ? gA + (kt + 1) * 64 : gAn;
      const bfr* sb = cur ? gB + (kt + 1) * 64 : gBn;
      char* sd = dst0 + (cur ? (st ^ 1) : 0) * 32768;
      const char* cA = smem + st * 32768 + (wm * 64 + l15) * 128;
      const char* cB = smem + st * 32768 + 16384 + (wn * 64 + l15) * 128;
      {
        const int co0 = (quad ^ fsw) * 16, co1 = ((4 + quad) ^ fsw) * 16;
        bf16x8 af0[4], bf0[4], af1[4], bf1[4];
#pragma unroll
        for (int i = 0; i < 4; ++i) {
          af0[i] = *(const bf16x8*)(cA + i * 2048 + co0);
          bf0[i] = *(const bf16x8*)(cB + i * 2048 + co0);
        }
#pragma unroll
        for (int i = 0; i < 4; ++i) {
          af1[i] = *(const bf16x8*)(cA + i * 2048 + co1);
          bf1[i] = *(const bf16x8*)(cB + i * 2048 + co1);
        }
        __builtin_amdgcn_sched_barrier(0);
#pragma unroll
        for (int mt = 0; mt < 4; ++mt) {
#pragma unroll
          for (int nt = 0; nt < 4; ++nt)
            acc[mt][nt] = __builtin_amdgcn_mfma_f32_16x16x32_bf16(bf0[nt], af0[mt], acc[mt][nt], 0, 0, 0);
          if (any) {
            __builtin_amdgcn_global_load_lds((const unsigned*)(sa + (size_t)(mt * 32) * lda), (LDS3 unsigned*)(sd + mt * 4096), 16, 0, 0);
            __builtin_amdgcn_global_load_lds((const unsigned*)(sb + (size_t)(mt * 32) * ldb), (LDS3 unsigned*)(sd + 16384 + mt * 4096), 16, 0, 0);
          }
          __builtin_amdgcn_sched_barrier(0);
        }
#pragma unroll
        for (int mt = 0; mt < 4; ++mt)
#pragma unroll
          for (int nt = 0; nt < 4; ++nt)
            acc[mt][nt] = __builtin_amdgcn_mfma_f32_16x16x32_bf16(bf1[nt], af1[mt], acc[mt][nt], 0, 0, 0);
        __builtin_amdgcn_sched_barrier(0);
      }
      if (kt + 1 < nk) __syncthreads();
    }
    epi.tile(acc, pre, m0, n0, tn_cur, wm, wn, l15, quad, tid, smem);
    gA = gAn; gB = gBn;
  }
}

constexpr int EDGE_LD = 2 * DFF;
struct FfnPre { f32x4 wa[3], wb[3]; };
DEVINL void ffn_conv_rows(const bfr* T, const FfnPre& pre_, bfr* ACT, float* EDGE, int m0, int n0, int tn, int tid) {
  const int c4 = (tid & 15) * 4, r0 = (tid >> 4) * 8;
  const int ja = tn * 64 + c4;
  int tl, Tlen; tok_pos(m0, tl, Tlen);
  const bool top_ok = (tl == 0), bot_ok = (tl + 128 == Tlen);
  if (tid < 128) {
    const int e = tid >> 5, c = (tid & 31) * 4;
    const int r = (e < 2) ? e : 124 + e;
    const uint2 v = *(const uint2*)(T + r * 136 + c);
    *(f32x4*)(EDGE + ((size_t)(m0 >> 7) * 4 + e) * EDGE_LD + n0 + c) = f32x4{bflo(v.x), bfhi(v.x), bflo(v.y), bfhi(v.y)};
  }
  const f32x4 zero = f32x4{0.f, 0.f, 0.f, 0.f};
#define LDT(dst, row, col) { const uint2 v_ = *(const uint2*)(T + (row) * 136 + (col)); dst = f32x4{bflo(v_.x), bfhi(v_.x), bflo(v_.y), bfhi(v_.y)}; }
  f32x4 pa = zero, pb = zero, ca, cb, na, nb;
  if (r0 > 0) { LDT(pa, r0 - 1, c4) LDT(pb, r0 - 1, 64 + c4) }
  LDT(ca, r0, c4) LDT(cb, r0, 64 + c4)
#pragma unroll
  for (int i = 0; i < 8; ++i) {
    const int r = r0 + i;
    if (r < 127) { LDT(na, r + 1, c4) LDT(nb, r + 1, 64 + c4) }
    else { na = zero; nb = zero; }
    const bool ok = (r > 0 || top_ok) && (r < 127 || bot_ok);
    if (ok) {
      const f32x4 a = pre_.wa[0] * pa + pre_.wa[1] * ca + pre_.wa[2] * na;
      const f32x4 b = pre_.wb[0] * pb + pre_.wb[1] * cb + pre_.wb[2] * nb;
      uint2 o;
      o.x = pk2(silu_f(a[0]) * b[0], silu_f(a[1]) * b[1]);
      o.y = pk2(silu_f(a[2]) * b[2], silu_f(a[3]) * b[3]);
      *(uint2*)(ACT + (size_t)(m0 + r) * DFF + ja) = o;
    }
    pa = ca; pb = cb; ca = na; cb = nb;
  }
#undef LDT
}
struct EpiFfnUp {
  bfr* ACT; float* EDGE; const float* wdw;
  typedef FfnPre Pre;
  static constexpr bool kLdsEpi = true;
  DEVINL Pre pre(int tn, int tid) const {
    Pre q;
    const int ja = tn * 64 + (tid & 15) * 4;
#pragma unroll
    for (int t = 0; t < 3; ++t) {
      q.wa[t] = *(const f32x4*)(wdw + t * (2 * DFF) + ja);
      q.wb[t] = *(const f32x4*)(wdw + t * (2 * DFF) + DFF + ja);
    }
    return q;
  }
  DEVINL void tile(const f32x4 (&acc)[4][4], const Pre& pre_, int m0, int n0, int tn, int wm, int wn, int l15, int quad,
                   int tid, char* smem) const {
    bfr* T = (bfr*)(smem + 32768);
    lds_barrier();
#pragma unroll
    for (int mt = 0; mt < 4; ++mt)
#pragma unroll
      for (int nt = 0; nt < 4; ++nt) {
        uint2 o; o.x = pk2(acc[mt][nt][0], acc[mt][nt][1]); o.y = pk2(acc[mt][nt][2], acc[mt][nt][3]);
        *(uint2*)(T + (wm * 64 + mt * 16 + l15) * 136 + wn * 64 + nt * 16 + quad * 4) = o;
      }
    lds_barrier();
    ffn_conv_rows(T, pre_, ACT, EDGE, m0, n0, tn, tid);
  }
  DEVINL void tile256(const f32x4 (&acc)[8][4], const Pre& pre_, int m0, int n0, int tn, int wm, int wn, int l15, int quad,
                      int tid, char* smem) const {
    bfr* T = (bfr*)smem;
#pragma unroll
    for (int hh = 0; hh < 2; ++hh) {
      lds_barrier();
      if (wm == hh) {
#pragma unroll
        for (int mt = 0; mt < 8; ++mt)
#pragma unroll
          for (int nt = 0; nt < 4; ++nt) {
            uint2 o; o.x = pk2(acc[mt][nt][0], acc[mt][nt][1]); o.y = pk2(acc[mt][nt][2], acc[mt][nt][3]);
            *(uint2*)(T + (mt * 16 + l15) * 136 + wn * 64 + nt * 16 + quad * 4) = o;
          }
      }
      lds_barrier();
      ffn_conv_rows(T, pre_, ACT, EDGE, m0 + hh * 128, n0, tn, tid);
    }
  }
};


template <class Epi>
DEVINL void gemm256_phase(const bfr* __restrict__ A, int lda, const bfr* __restrict__ Bt, int ldb, int N, int K,
                          const Epi& epi, char* smem, int bid, int nblk) {
  const int tid = otid(), lane = tid & 63, wave = tid >> 6;
  const int wm = wave >> 1, wn = wave & 1, l15 = lane & 15, quad = lane >> 4;
  const int tilesN = N >> 7;
  const int ntiles = (MTOK >> 8) * tilesN;
  const int nk = K >> 5;
  const int srow0 = wave * 16 + (lane >> 2);
  const int lc = (lane & 3) ^ ((0 - (lane >> 4)) & 3);
  const int fsw = (0 - (l15 >> 2)) & 3;
  char* const dst0 = smem + wave * 1024 + lane * 16;
#define TILE_DECODE2(t_, tm_, tn_) { const int xcd_ = (t_) & 7, u_ = (t_) >> 3; const int ur_ = u_ / tilesN; tn_ = u_ - ur_ * tilesN; tm_ = ur_ * 8 + xcd_; }
#define GLDS_STAGE2(pa_, pb_, st_, kt_)                                                                   \
  {                                                                                                       \
    _Pragma("unroll") for (int i = 0; i < 4; ++i)                                                         \
      __builtin_amdgcn_global_load_lds((const unsigned*)((pa_) + (size_t)(i * 64) * lda + (kt_) * 32),    \
                                       (LDS3 unsigned*)(dst0 + (st_) * 24576 + i * 4096), 16, 0, 0);      \
    _Pragma("unroll") for (int i = 0; i < 2; ++i)                                                         \
      __builtin_amdgcn_global_load_lds((const unsigned*)((pb_) + (size_t)(i * 64) * ldb + (kt_) * 32),    \
                                       (LDS3 unsigned*)(dst0 + (st_) * 24576 + 16384 + i * 4096), 16, 0, 0); \
  }
  int tile = bid;
  if (tile >= ntiles) return;
  int tm, tn;
  TILE_DECODE2(tile, tm, tn)
  const bfr* gA = A + (size_t)((tm << 8) + srow0) * lda + lc * 8;
  const bfr* gB = Bt + (size_t)((tn << 7) + srow0) * ldb + lc * 8;
  __syncthreads();
  GLDS_STAGE2(gA, gB, 0, 0)
  for (; tile < ntiles; tile += nblk) {
    const int m0 = tm << 8, n0 = tn << 7, tn_cur = tn;
    const bool has_next = (tile + nblk < ntiles);
    const bfr* gAn = gA; const bfr* gBn = gB;
    if (has_next) {
      TILE_DECODE2(tile + nblk, tm, tn)
      gAn = A + (size_t)((tm << 8) + srow0) * lda + lc * 8;
      gBn = Bt + (size_t)((tn << 7) + srow0) * ldb + lc * 8;
    }
    f32x4 acc[8][4];
#pragma unroll
    for (int i = 0; i < 8; ++i)
#pragma unroll
      for (int j = 0; j < 4; ++j) acc[i][j] = f32x4{0.f, 0.f, 0.f, 0.f};
    __syncthreads();
    for (int kt = 0; kt < nk; ++kt) {
      const int st = kt & 1;
      const bool cur = (kt + 1 < nk);
      const bool any = cur || has_next;
      const bfr* sa = cur ? gA + (kt + 1) * 32 : gAn;
      const bfr* sb = cur ? gB + (kt + 1) * 32 : gBn;
      char* sd = dst0 + (cur ? (st ^ 1) : 0) * 24576;
      const char* cA = smem + st * 24576 + (wm * 128 + l15) * 64 + ((quad ^ fsw) * 16);
      const char* cB = smem + st * 24576 + 16384 + (wn * 64 + l15) * 64 + ((quad ^ fsw) * 16);
      bf16x8 bfg[4];
#pragma unroll
      for (int i = 0; i < 4; ++i) bfg[i] = *(const bf16x8*)(cB + i * 1024);
#pragma unroll
      for (int hm = 0; hm < 2; ++hm) {
        bf16x8 af[4];
#pragma unroll
        for (int i = 0; i < 4; ++i) af[i] = *(const bf16x8*)(cA + (hm * 4 + i) * 1024);
        __builtin_amdgcn_sched_barrier(0);
#pragma unroll
        for (int mt = 0; mt < 4; ++mt) {
#pragma unroll
          for (int nt = 0; nt < 4; ++nt)
            acc[hm * 4 + mt][nt] = __builtin_amdgcn_mfma_f32_16x16x32_bf16(bfg[nt], af[mt], acc[hm * 4 + mt][nt], 0, 0, 0);
          const int g = hm * 4 + mt;
          if (any && g < 4)
            __builtin_amdgcn_global_load_lds((const unsigned*)(sa + (size_t)(g * 64) * lda), (LDS3 unsigned*)(sd + g * 4096), 16, 0, 0);
          else if (any && g < 6)
            __builtin_amdgcn_global_load_lds((const unsigned*)(sb + (size_t)((g - 4) * 64) * ldb), (LDS3 unsigned*)(sd + 16384 + (g - 4) * 4096), 16, 0, 0);
          __builtin_amdgcn_sched_barrier(0);
        }
      }
      if (kt + 1 < nk) __syncthreads();
    }
    {
      typename Epi::Pre pre = epi.pre(tn_cur, tid);
      epi.tile256(acc, pre, m0, n0, tn_cur, wm, wn, l15, quad, tid, smem);
    }
    gA = gAn; gB = gBn;
  }
}


template <class Epi>
DEVINL void gemm256s_phase(const bfr* __restrict__ A, int lda, const bfr* __restrict__ Bt, int ldb, int N, int K,
                           const Epi& epi, char* smem, int bid, int nblk) {
  const int tid = otid(), lane = tid & 63, wave = tid >> 6;
  const int wm = wave >> 1, wn = wave & 1, l15 = lane & 15, quad = lane >> 4;
  const int tilesN = N >> 7;
  const int ntiles = (MTOK >> 8) * tilesN;
  const int nk = K >> 6;
  const int srow0 = wave * 8 + (lane >> 3);
  const int lc = (lane & 7) ^ ((srow0 >> 1) & 7);
  const int fsw = (l15 >> 1) & 7;
  char* const dst0 = smem + wave * 1024 + lane * 16;
#define TILE_DECODE3(t_, tm_, tn_) { const int xcd_ = (t_) & 7, u_ = (t_) >> 3; const int gs_ = 5 * tilesN; const int g_ = u_ / gs_, r_ = u_ - g_ * gs_; \
    tn_ = r_ / 5; tm_ = (g_ * 5 + (r_ - tn_ * 5)) * 8 + xcd_; }
  if (bid >= ntiles) return;
  int ptile = bid, pkt = 0;
  bool pvalid = true;
  int ptm, ptn;
  TILE_DECODE3(ptile, ptm, ptn)
  const bfr* pA = A + (size_t)((ptm << 8) + srow0) * lda + lc * 8;
  const bfr* pB = Bt + (size_t)((ptn << 7) + srow0) * ldb + lc * 8;
#define DMA_ISSUE3()                                                                                      \
  {                                                                                                       \
    _Pragma("unroll") for (int i = 0; i < 8; ++i)                                                         \
      __builtin_amdgcn_global_load_lds((const unsigned*)(pA + (size_t)(i * 32) * lda + pkt * 64),         \
                                       (LDS3 unsigned*)(dst0 + i * 4096), 16, 0, 0);                      \
    _Pragma("unroll") for (int i = 0; i < 4; ++i)                                                         \
      __builtin_amdgcn_global_load_lds((const unsigned*)(pB + (size_t)(i * 32) * ldb + pkt * 64),         \
                                       (LDS3 unsigned*)(dst0 + 32768 + i * 4096), 16, 0, 0);              \
    if (++pkt == nk) {                                                                                    \
      pkt = 0; ptile += nblk;                                                                             \
      if (ptile < ntiles) {                                                                               \
        TILE_DECODE3(ptile, ptm, ptn)                                                                     \
        pA = A + (size_t)((ptm << 8) + srow0) * lda + lc * 8;                                             \
        pB = Bt + (size_t)((ptn << 7) + srow0) * ldb + lc * 8;                                            \
      } else pvalid = false;                                                                              \
    }                                                                                                     \
  }
  __syncthreads();
  DMA_ISSUE3()
  bool deferred = false;
  const char* cA = smem + (wm * 128 + l15) * 128;
  const char* cB = smem + 32768 + (wn * 64 + l15) * 128;
  for (int tile = bid; tile < ntiles; tile += nblk) {
    int tm, tn;
    TILE_DECODE3(tile, tm, tn)
    const int m0 = tm << 8, n0 = tn << 7;
    if (deferred) { DMA_ISSUE3() deferred = false; }
    f32x4 acc[8][4];
#pragma unroll
    for (int i = 0; i < 8; ++i)
#pragma unroll
      for (int j = 0; j < 4; ++j) acc[i][j] = f32x4{0.f, 0.f, 0.f, 0.f};
    for (int kt = 0; kt < nk; ++kt) {
      asm volatile("s_waitcnt vmcnt(0)\n\ts_barrier" ::: "memory");
      const int co0 = (quad ^ fsw) * 16, co1 = ((4 + quad) ^ fsw) * 16;
      bf16x8 af[8], bfg[4];
#pragma unroll
      for (int i = 0; i < 4; ++i) bfg[i] = *(const bf16x8*)(cB + i * 2048 + co0);
#pragma unroll
      for (int i = 0; i < 8; ++i) af[i] = *(const bf16x8*)(cA + i * 2048 + co0);
      __builtin_amdgcn_sched_barrier(0);
#pragma unroll
      for (int mt = 0; mt < 8; ++mt)
#pragma unroll
        for (int nt = 0; nt < 4; ++nt)
          acc[mt][nt] = __builtin_amdgcn_mfma_f32_16x16x32_bf16(bfg[nt], af[mt], acc[mt][nt], 0, 0, 0);
      __builtin_amdgcn_sched_barrier(0);
#pragma unroll
      for (int i = 0; i < 4; ++i) bfg[i] = *(const bf16x8*)(cB + i * 2048 + co1);
#pragma unroll
      for (int i = 0; i < 8; ++i) af[i] = *(const bf16x8*)(cA + i * 2048 + co1);
      asm volatile("s_waitcnt lgkmcnt(0)\n\ts_barrier" ::: "memory");
      if (pvalid) {
        if (Epi::kLdsEpi && kt == nk - 1) deferred = true;
        else DMA_ISSUE3()
      }
      __builtin_amdgcn_sched_barrier(0);
#pragma unroll
      for (int mt = 0; mt < 8; ++mt)
#pragma unroll
        for (int nt = 0; nt < 4; ++nt)
          acc[mt][nt] = __builtin_amdgcn_mfma_f32_16x16x32_bf16(bfg[nt], af[mt], acc[mt][nt], 0, 0, 0);
      __builtin_amdgcn_sched_barrier(0);
    }
    {
      typename Epi::Pre pre = epi.pre(tn, tid);
      epi.tile256(acc, pre, m0, n0, tn, wm, wn, l15, quad, tid, smem);
    }
    if (Epi::kLdsEpi) lds_barrier();
  }
  asm volatile("s_waitcnt vmcnt(0)" ::: "memory");
}

DEVINL void ffn_edge_phase(const float* __restrict__ EDGE, const float* __restrict__ wdw, bfr* __restrict__ ACT, int bid, int nblk) {
  const int gt = bid * 256 + otid(), nt = nblk * 256;
  for (int i = gt; i < 160 * 2 * 704; i += nt) {
    const int cg4 = i % 704, r2 = i / 704, side = r2 & 1, tm = r2 >> 1;
    const int m0 = tm << 7;
    int tl, Tlen; tok_pos(m0, tl, Tlen);
    if (side == 0 ? (tl == 0) : (tl + 128 == Tlen)) continue;
    const int ja = cg4 * 4;
    const int nb_ = ja >> 6, cc = ja & 63;
    const int ea = nb_ * 128 + cc, eb = ea + 64;
    const float* prev; const float* cur; const float* next;
    if (side == 0) {
      prev = EDGE + ((size_t)(tm - 1) * 4 + 3) * EDGE_LD; cur = EDGE + ((size_t)tm * 4 + 0) * EDGE_LD; next = EDGE + ((size_t)tm * 4 + 1) * EDGE_LD;
    } else {
      prev = EDGE + ((size_t)tm * 4 + 2) * EDGE_LD; cur = EDGE + ((size_t)tm * 4 + 3) * EDGE_LD; next = EDGE + ((size_t)(tm + 1) * 4 + 0) * EDGE_LD;
    }
    const f32x4 a = *(const f32x4*)(wdw + ja) * *(const f32x4*)(prev + ea) + *(const f32x4*)(wdw + 2 * DFF + ja) * *(const f32x4*)(cur + ea) +
                    *(const f32x4*)(wdw + 4 * DFF + ja) * *(const f32x4*)(next + ea);
    const f32x4 b = *(const f32x4*)(wdw + DFF + ja) * *(const f32x4*)(prev + eb) + *(const f32x4*)(wdw + 3 * DFF + ja) * *(const f32x4*)(cur + eb) +
                    *(const f32x4*)(wdw + 5 * DFF + ja) * *(const f32x4*)(next + eb);
    uint2 o;
    o.x = pk2(silu_f(a[0]) * b[0], silu_f(a[1]) * b[1]);
    o.y = pk2(silu_f(a[2]) * b[2], silu_f(a[3]) * b[3]);
    const int m = m0 + (side ? 127 : 0);
    *(uint2*)(ACT + (size_t)m * DFF + ja) = o;
  }
}

DEVINL int up_perm(int n0) {
  if (n0 < DFF) return (n0 >> 6) * 128;
  return ((n0 - DFF) >> 6) * 128 + 64;
}
DEVINL void conv_matrix(const float* __restrict__ src, int K, int N, bfr* __restrict__ dst, int perm,
                        char* smem, int bid, int nblk) {
  float* sT = (float*)smem;
  const int tid = otid();
  const int tilesN = N >> 6;
  const int ntiles = (K >> 6) * tilesN;
  const int r = tid >> 4, c4 = tid & 15;
  int t = bid;
  if (t >= ntiles) return;
  f32x4 v0, v1, v2, v3;
  {
    const int tk = t / tilesN, tn = t - tk * tilesN;
    const float* sp = src + (size_t)((tk << 6) + r) * N + (tn << 6) + c4 * 4;
    v0 = *(const f32x4*)(sp); v1 = *(const f32x4*)(sp + (size_t)16 * N);
    v2 = *(const f32x4*)(sp + (size_t)32 * N); v3 = *(const f32x4*)(sp + (size_t)48 * N);
  }
  for (; t < ntiles; t += nblk) {
    const int tk = t / tilesN, tn = t - tk * tilesN;
    const int k0 = tk << 6, n0 = tn << 6;
    __syncthreads();
    {
      float* d = sT + r * 65 + c4 * 4;
      d[0] = v0[0]; d[1] = v0[1]; d[2] = v0[2]; d[3] = v0[3];
      d[16 * 65 + 0] = v1[0]; d[16 * 65 + 1] = v1[1]; d[16 * 65 + 2] = v1[2]; d[16 * 65 + 3] = v1[3];
      d[32 * 65 + 0] = v2[0]; d[32 * 65 + 1] = v2[1]; d[32 * 65 + 2] = v2[2]; d[32 * 65 + 3] = v2[3];
      d[48 * 65 + 0] = v3[0]; d[48 * 65 + 1] = v3[1]; d[48 * 65 + 2] = v3[2]; d[48 * 65 + 3] = v3[3];
    }
    if (t + nblk < ntiles) {
      const int t2 = t + nblk;
      const int tk2 = t2 / tilesN, tn2 = t2 - tk2 * tilesN;
      const float* sp = src + (size_t)((tk2 << 6) + r) * N + (tn2 << 6) + c4 * 4;
      v0 = *(const f32x4*)(sp); v1 = *(const f32x4*)(sp + (size_t)16 * N);
      v2 = *(const f32x4*)(sp + (size_t)32 * N); v3 = *(const f32x4*)(sp + (size_t)48 * N);
    }
    __syncthreads();
    const int n = tid >> 2, kc = tid & 3;
    uint32_t w[8];
#pragma unroll
    for (int j = 0; j < 8; ++j)
      w[j] = pk2(sT[(kc * 16 + 2 * j) * 65 + n], sT[(kc * 16 + 2 * j + 1) * 65 + n]);
    const int nd = (perm ? up_perm(n0) : n0) + n;
    bfr* dp = dst + (size_t)nd * K + k0 + kc * 16;
    *(uint4*)dp = make_uint4(w[0], w[1], w[2], w[3]);
    *(uint4*)(dp + 8) = make_uint4(w[4], w[5], w[6], w[7]);
  }
}

DEVINL void phase0a(const Params& p, char* smem, int bid, int nblk) {
  const int tid = otid();
  float* sc = (float*)smem;
  float* modp = (float*)(p.ws + OFF_MODP);
  const float* cvec = p.in[3];
  const float* cctx = p.in[4];
  const float* ada_w = p.in[5];
  for (int job = bid; job < 384; job += nblk) {
    const int l = job / 96, r = job - l * 96, ks = r / 6, cgp = r - ks * 6;
    __syncthreads();
    for (int i = tid; i < 320; i += 256) {
      const int cond = i >> 6, kk = i & 63;
      const float v = cond == 0 ? cctx[ks * 64 + kk] : cvec[(cond - 1) * DM + ks * 64 + kk];
      sc[i] = silu_f(v);
    }
    __syncthreads();
    const int col = cgp * 1024 + tid * 4;
    const float* wp = ada_w + ((size_t)l * DM + ks * 64) * 6144 + col;
    float a[5][4];
#pragma unroll
    for (int c = 0; c < 5; ++c)
#pragma unroll
      for (int j = 0; j < 4; ++j) a[c][j] = 0.f;
#pragma unroll 8
    for (int kk = 0; kk < 64; ++kk) {
      const float4 w = *(const float4*)(wp + (size_t)kk * 6144);
#pragma unroll
      for (int c = 0; c < 5; ++c) {
        const float s = sc[c * 64 + kk];
        a[c][0] += s * w.x; a[c][1] += s * w.y; a[c][2] += s * w.z; a[c][3] += s * w.w;
      }
    }
#pragma unroll
    for (int c = 0; c < 5; ++c)
      *(float4*)(modp + ((size_t)(ks * 4 + l) * 5 + c) * 6144 + col) = make_float4(a[c][0], a[c][1], a[c][2], a[c][3]);
  }
  const int gt = bid * 256 + tid, nt = nblk * 256;
  {
    const float* lb = p.in[20];
    float* lbs = (float*)(p.ws + OFF_LBS);
    for (int i = gt; i < 2048; i += nt) {
      const float v0 = lb[i], v1 = lb[2048 + i], v2 = lb[4096 + i], v3 = lb[6144 + i];
      const float mx = fmaxf(fmaxf(v0, v1), fmaxf(v2, v3));
      const float e0 = expf(v0 - mx), e1 = expf(v1 - mx), e2 = expf(v2 - mx), e3 = expf(v3 - mx);
      lbs[i] = (e1 + e2 + e3) / (e0 + e1 + e2 + e3);
    }
  }
  float* X = p.out;
  {
    const float4* xp = (const float4*)p.in[0];
    float4* xo = (float4*)X;
    for (int i = gt; i < NPROMPT * DM / 4; i += nt) xo[i] = xp[i];
    const float* xs = p.in[1];
    for (int i = gt; i < 4096 * 256; i += nt) {
      const int t = i >> 8, c = (i & 255) * 4;
      const int part = c >> 8;
      const float pos = (float)((part < 2) ? (t >> 6) : (t & 63));
      float pe[4];
#pragma unroll
      for (int j = 0; j < 4; ++j) {
        const int jj = (c + j) & 255;
        const float freq = expf((-9.210340371976184f * (float)jj) / 256.0f);
        const float arg = pos * freq;
        pe[j] = (part & 1) ? cosf(arg) : sinf(arg);
      }
#pragma unroll
      for (int b = 0; b < 4; ++b) {
        const size_t off = ((size_t)b * 4096 + t) * DM + c;
        float4 v = *(const float4*)(xs + off);
        v.x += pe[0]; v.y += pe[1]; v.z += pe[2]; v.w += pe[3];
        *(float4*)(X + (size_t)NPROMPT * DM + off) = v;
      }
    }
  }
}

DEVINL void phase0b(const Params& p, int bid, int nblk) {
  const int gt = bid * 256 + otid(), nt = nblk * 256;
  const float* modp = (const float*)(p.ws + OFF_MODP);
  float* mod = (float*)(p.ws + OFF_MOD);
  const float* ada_b = p.in[6];
  for (int i = gt; i < 4 * 5 * 6144; i += nt) {
    const int l = i / 30720, col = i % 6144;
    float s = ada_b[l * 6144 + col];
#pragma unroll
    for (int ks = 0; ks < 16; ++ks) s += modp[(size_t)ks * 122880 + i];
    mod[i] = s;
  }
}

DEVINL void norm_phase(const float* __restrict__ X, const float* __restrict__ g, const float* __restrict__ modl,
                       int shift_off, int scale_off, bfr* __restrict__ H, int bid, int nblk) {
  const int tid = otid(); const int lane = tid & 63;
  const int gw = bid * 4 + (tid >> 6), nw = nblk * 4;
  int row = gw;
  if (row >= MTOK) return;
  f32x4 x0, x1, x2, x3;
  {
    const float* xr = X + (size_t)row * DM + lane * 4;
    x0 = *(const f32x4*)(xr); x1 = *(const f32x4*)(xr + 256); x2 = *(const f32x4*)(xr + 512); x3 = *(const f32x4*)(xr + 768);
  }
  for (; row < MTOK; row += nw) {
    const f32x4 c0 = x0, c1 = x1, c2 = x2, c3 = x3;
    if (row + nw < MTOK) {
      const float* xr = X + (size_t)(row + nw) * DM + lane * 4;
      x0 = *(const f32x4*)(xr); x1 = *(const f32x4*)(xr + 256); x2 = *(const f32x4*)(xr + 512); x3 = *(const f32x4*)(xr + 768);
    }
    float ss = 0.f;
#pragma unroll
    for (int j = 0; j < 4; ++j) ss += c0[j] * c0[j] + c1[j] * c1[j] + c2[j] * c2[j] + c3[j] * c3[j];
    ss = wave_sum(ss, lane);
    const float rstd = rsqrtf(ss * (1.f / DM) + EPS);
    const float* mc = modl + cond_of(row) * 6144;
#pragma unroll
    for (int i = 0; i < 4; ++i) {
      const f32x4 xv = (i == 0) ? c0 : (i == 1) ? c1 : (i == 2) ? c2 : c3;
      const int c = i * 256 + lane * 4;
      const float4 gg = *(const float4*)(g + c);
      const float4 sh = *(const float4*)(mc + shift_off + c);
      const float4 sc = *(const float4*)(mc + scale_off + c);
      const float h0 = xv[0] * rstd * gg.x * (1.f + sc.x) + sh.x;
      const float h1 = xv[1] * rstd * gg.y * (1.f + sc.y) + sh.y;
      const float h2 = xv[2] * rstd * gg.z * (1.f + sc.z) + sh.z;
      const float h3 = xv[3] * rstd * gg.w * (1.f + sc.w) + sh.w;
      uint2 o; o.x = pk2(h0, h1); o.y = pk2(h2, h3);
      *(uint2*)(H + (size_t)row * DM + c) = o;
    }
  }
}

DEVINL void final_norm_phase(float* X, const float* __restrict__ g, int bid, int nblk) {
  const int tid = otid(); const int lane = tid & 63;
  const int gw = bid * 4 + (tid >> 6), nw = nblk * 4;
  for (int row = gw; row < MTOK; row += nw) {
    float* xr = X + (size_t)row * DM;
    float4 x[4];
    float ss = 0.f;
#pragma unroll
    for (int i = 0; i < 4; ++i) {
      x[i] = *(const float4*)(xr + i * 256 + lane * 4);
      ss += x[i].x * x[i].x + x[i].y * x[i].y + x[i].z * x[i].z + x[i].w * x[i].w;
    }
    ss = wave_sum(ss, lane);
    const float rstd = rsqrtf(ss * (1.f / DM) + EPS);
#pragma unroll
    for (int i = 0; i < 4; ++i) {
      const int c = i * 256 + lane * 4;
      const float4 gg = *(const float4*)(g + c);
      float4 o;
      o.x = x[i].x * rstd * gg.x; o.y = x[i].y * rstd * gg.y; o.z = x[i].z * rstd * gg.z; o.w = x[i].w * rstd * gg.w;
      *(float4*)(xr + c) = o;
    }
  }
}

DEVINL void shortconv_ew_phase(const bfr* __restrict__ G, const float* __restrict__ wdw, bfr* __restrict__ U, int bid, int nblk) {
  const int gt = bid * 256 + otid(), nt = nblk * 256;
  for (int i = gt; i < MTOK * 128; i += nt) {
    const int m = i >> 7, c = (i & 127) * 8;
    int tl, T; tok_pos(m, tl, T);
    const bfr* gr = G + (size_t)m * 3072;
    const uint4 bg = *(const uint4*)(gr + c);
    float accv[8];
#pragma unroll
    for (int j = 0; j < 8; ++j) accv[j] = 0.f;
#pragma unroll
    for (int tap = 0; tap < 3; ++tap) {
      const int d = tap - 1;
      if ((d < 0 && tl == 0) || (d > 0 && tl == T - 1)) continue;
      const bfr* nr = gr + (ptrdiff_t)d * 3072;
      const uint4 cgv = *(const uint4*)(nr + 1024 + c);
      const uint4 xhv = *(const uint4*)(nr + 2048 + c);
      const float4 w0 = *(const float4*)(wdw + tap * DM + c);
      const float4 w1 = *(const float4*)(wdw + tap * DM + c + 4);
      accv[0] += w0.x * bflo(cgv.x) * bflo(xhv.x); accv[1] += w0.y * bfhi(cgv.x) * bfhi(xhv.x);
      accv[2] += w0.z * bflo(cgv.y) * bflo(xhv.y); accv[3] += w0.w * bfhi(cgv.y) * bfhi(xhv.y);
      accv[4] += w1.x * bflo(cgv.z) * bflo(xhv.z); accv[5] += w1.y * bfhi(cgv.z) * bfhi(xhv.z);
      accv[6] += w1.z * bflo(cgv.w) * bflo(xhv.w); accv[7] += w1.w * bfhi(cgv.w) * bfhi(xhv.w);
    }
    uint4 o;
    o.x = pk2(bflo(bg.x) * accv[0], bfhi(bg.x) * accv[1]);
    o.y = pk2(bflo(bg.y) * accv[2], bfhi(bg.y) * accv[3]);
    o.z = pk2(bflo(bg.z) * accv[4], bfhi(bg.z) * accv[5]);
    o.w = pk2(bflo(bg.w) * accv[6], bfhi(bg.w) * accv[7]);
    *(uint4*)(U + (size_t)m * DM + c) = o;
  }
}

DEVINL void pool_ew_phase(const bfr* __restrict__ H, bfr* __restrict__ P, int bid, int nblk) {
  const int gt = bid * 256 + otid(), nt = nblk * 256;
  for (int i = gt; i < MTOK * 128; i += nt) {
    const int m = i >> 7, ch = i & 127, c = ch * 8;
    int tl, T; tok_pos(m, tl, T);
    const int hw = 1 << (ch >> 5);
    const int lo = max(tl - hw, 0), hi = min(tl + hw, T);
    float s[8];
#pragma unroll
    for (int j = 0; j < 8; ++j) s[j] = 0.f;
    const bfr* base = H + (size_t)(m - tl) * DM + c;
    uint4 wv[16];
#pragma unroll
    for (int j = 0; j < 16; ++j) {
      const int q = tl - hw + j;
      const bool ok = (j < 2 * hw) && (q >= 0) && (q < T);
      wv[j] = ok ? *(const uint4*)(base + (size_t)q * DM) : make_uint4(0u, 0u, 0u, 0u);
    }
#pragma unroll
    for (int j = 0; j < 16; ++j) {
      const uint4 v = wv[j];
      s[0] += bflo(v.x); s[1] += bfhi(v.x); s[2] += bflo(v.y); s[3] += bfhi(v.y);
      s[4] += bflo(v.z); s[5] += bfhi(v.z); s[6] += bflo(v.w); s[7] += bfhi(v.w);
    }
    const float inv = 1.f / (float)(hi - lo);
    const uint4 v = *(const uint4*)(base + (size_t)tl * DM);
    uint4 o;
    o.x = pk2(s[0] * inv - bflo(v.x), s[1] * inv - bfhi(v.x));
    o.y = pk2(s[2] * inv - bflo(v.y), s[3] * inv - bfhi(v.y));
    o.z = pk2(s[4] * inv - bflo(v.z), s[5] * inv - bfhi(v.z));
    o.w = pk2(s[6] * inv - bflo(v.w), s[7] * inv - bfhi(v.w));
    *(uint4*)(P + (size_t)m * DM + c) = o;
  }
}

DEVINL void sgu_norm_phase(bfr* UV, const float* __restrict__ g, int bid, int nblk) {
  const int tid = otid(); const int lane = tid & 63;
  const int gw = bid * 4 + (tid >> 6), nw = nblk * 4;
  for (int row = gw; row < MTOK; row += nw) {
    bfr* vr = UV + (size_t)row * 2048 + 1024;
    float x[4][4];
    float ss = 0.f;
#pragma unroll
    for (int i = 0; i < 4; ++i) {
      const uint2 v = *(const uint2*)(vr + i * 256 + lane * 4);
      x[i][0] = bflo(v.x); x[i][1] = bfhi(v.x); x[i][2] = bflo(v.y); x[i][3] = bfhi(v.y);
      ss += x[i][0] * x[i][0] + x[i][1] * x[i][1] + x[i][2] * x[i][2] + x[i][3] * x[i][3];
    }
    ss = wave_sum(ss, lane);
    const float rstd = rsqrtf(ss * (1.f / DM) + EPS);
#pragma unroll
    for (int i = 0; i < 4; ++i) {
      const int c = i * 256 + lane * 4;
      const float4 gg = *(const float4*)(g + c);
      uint2 o;
      o.x = pk2(x[i][0] * rstd * gg.x, x[i][1] * rstd * gg.y);
      o.y = pk2(x[i][2] * rstd * gg.z, x[i][3] * rstd * gg.w);
      *(uint2*)(vr + c) = o;
    }
  }
}

DEVINL void sgu_spatial_phase(bfr* UV, const float* __restrict__ ws_, const float* __restrict__ bs_, char* smem, int bid, int nblk) {
  bfr* sV = (bfr*)smem;
  bfr* sW = sV + 128 * 136;
  const int tid = otid(), lane = tid & 63, wave = tid >> 6, l15 = lane & 15, quad = lane >> 4;
  for (int item = bid; item < 160 * 8; item += nblk) {
    const int chunk = item >> 3, g = item & 7;
    __syncthreads();
    const float* wg = ws_ + (size_t)g * 16384;
#pragma unroll 4
    for (int i = 0; i < 16; ++i) {
      const int idx = tid + 256 * i;
      const int row = idx >> 5, chn = idx & 31;
      const float4 v = *(const float4*)(wg + row * 128 + chn * 4);
      uint2 o; o.x = pk2(v.x, v.y); o.y = pk2(v.z, v.w);
      *(uint2*)(sW + row * 136 + chn * 4) = o;
    }
#pragma unroll 2
    for (int i = 0; i < 8; ++i) {
      const int idx = tid + 256 * i;
      const int q = idx >> 4, chn = idx & 15;
      const uint4 v = *(const uint4*)(UV + (size_t)(chunk * 128 + q) * 2048 + 1024 + g * 128 + chn * 8);
      bfr* d = sV + (chn * 8) * 136 + q;
      d[0 * 136] = (bfr)(v.x & 0xffff); d[1 * 136] = (bfr)(v.x >> 16);
      d[2 * 136] = (bfr)(v.y & 0xffff); d[3 * 136] = (bfr)(v.y >> 16);
      d[4 * 136] = (bfr)(v.z & 0xffff); d[5 * 136] = (bfr)(v.z >> 16);
      d[6 * 136] = (bfr)(v.w & 0xffff); d[7 * 136] = (bfr)(v.w >> 16);
    }
    __syncthreads();
    f32x4 acc[8][2];
#pragma unroll
    for (int i = 0; i < 8; ++i) { acc[i][0] = f32x4{0.f, 0.f, 0.f, 0.f}; acc[i][1] = f32x4{0.f, 0.f, 0.f, 0.f}; }
#pragma unroll
    for (int kk = 0; kk < 4; ++kk) {
      bf16x8 bw[2];
#pragma unroll
      for (int pt = 0; pt < 2; ++pt) bw[pt] = *(const bf16x8*)(sW + (wave * 32 + pt * 16 + l15) * 136 + kk * 32 + quad * 8);
#pragma unroll
      for (int ct = 0; ct < 8; ++ct) {
        const bf16x8 av = *(const bf16x8*)(sV + (ct * 16 + l15) * 136 + kk * 32 + quad * 8);
#pragma unroll
        for (int pt = 0; pt < 2; ++pt)
          acc[ct][pt] = __builtin_amdgcn_mfma_f32_16x16x32_bf16(av, bw[pt], acc[ct][pt], 0, 0, 0);
      }
    }
#pragma unroll
    for (int pt = 0; pt < 2; ++pt) {
      const int pp = wave * 32 + pt * 16 + l15;
      const float bias = bs_[g * 128 + pp];
      bfr* ur = UV + (size_t)(chunk * 128 + pp) * 2048 + g * 128 + quad * 4;
#pragma unroll
      for (int ct = 0; ct < 8; ++ct) {
        const uint2 u = *(const uint2*)(ur + ct * 16);
        uint2 o;
        o.x = pk2(bflo(u.x) * (acc[ct][pt][0] + bias), bfhi(u.x) * (acc[ct][pt][1] + bias));
        o.y = pk2(bflo(u.y) * (acc[ct][pt][2] + bias), bfhi(u.y) * (acc[ct][pt][3] + bias));
        *(uint2*)(ur + ct * 16) = o;
      }
    }
  }
}

DEVINL void hgrn_scan_phase(const Params& p, char* smem, int bid, int nblk, const int mode) {
  bfr* sQe = (bfr*)smem;
  bfr* sKe = sQe + 32 * 136;
  bfr* sKeT = sKe + 32 * 136;
  bfr* sVT = sKeT + 128 * 40;
  bfr* sP = sVT + 64 * 40;
  bfr* sST = sP + 32 * 40;
  float* sLast = (float*)(sST + 64 * 136);
  float* sTot = sLast + 128;
  const int tid = otid(), lane = tid & 63, wave = tid >> 6, l15 = lane & 15, quad = lane >> 4;
  const int cp = lane, qt = wave, i0 = qt * 8;
  const bfr* QZ = (const bfr*)(p.ws + OFF_BIG);
  bfr* Of = (bfr*)(p.ws + OFF_H);
  bfr* Ob = (bfr*)(p.ws + OFF_BIG + 209715200ull);
  const float* lbs = (const float*)(p.ws + OFF_LBS);
  const float* state_rec = p.in[2];
  float* out_state = p.out + (size_t)MTOK * DM;

  float* SLOC = (float*)(p.ws + OFF_BIG + 251658240ull);
  float* DLOC = (float*)(p.ws + OFF_BIG + 251658240ull + 33554432ull);
  const int nitems = mode ? 1536 : 896;
  for (int item = bid; item < nitems; item += nblk) {
    const int eh = item & 1, dir = (item >> 1) & 1, h = (item >> 2) & 7;
    int base, T, nchunks, pos0, slot, seq;
    bool is_prompt = false;
    if (!mode) {
      const int r = item >> 5, seqb = r / 7, j = r - seqb * 7;
      seq = 16 + seqb; base = NPROMPT + seqb * 4096; T = 4096; nchunks = 16; pos0 = j * 512;
      slot = ((seqb * 8 + j) * 8 + h) * 2 + dir;
    } else if (item < 1024) {
      const int r = item >> 5, seqb = r >> 3, j = r & 7;
      seq = 16 + seqb; base = NPROMPT + seqb * 4096; T = 4096; nchunks = 16; pos0 = j * 512;
      slot = ((seqb * 8 + j) * 8 + h) * 2 + dir;
    } else {
      seq = (item - 1024) >> 5; base = seq * 256; T = 256; nchunks = 8; pos0 = 0; slot = 0;
      is_prompt = true;
    }
    bfr* Od = dir ? Ob : Of;
    const float lbv0 = lbs[dir * 1024 + h * 128 + 2 * cp], lbv1 = lbs[dir * 1024 + h * 128 + 2 * cp + 1];
    const int eloc = wave * 16 + l15;
    const int eglob = eh * 64 + eloc;

    f32x4 S[8];
    if (is_prompt || !mode) {
#pragma unroll
      for (int dt = 0; dt < 8; ++dt) S[dt] = f32x4{0.f, 0.f, 0.f, 0.f};
    } else {
      const float* s0 = SLOC + (size_t)slot * 16384;
#pragma unroll
      for (int dt = 0; dt < 8; ++dt)
#pragma unroll
        for (int j = 0; j < 4; ++j) S[dt][j] = s0[(dt * 16 + quad * 4 + j) * 128 + eglob];
    }
    float cum0 = 1.f, cum1 = 1.f;
    __syncthreads();
#pragma unroll
    for (int dt = 0; dt < 8; ++dt) {
      uint2 o; o.x = pk2(S[dt][0], S[dt][1]); o.y = pk2(S[dt][2], S[dt][3]);
      *(uint2*)(sST + eloc * 136 + dt * 16 + quad * 4) = o;
    }

    const unsigned qoff2 = h * 64 + cp, zoff2 = (1 + dir) * 512 + h * 64 + cp;
    const unsigned voff2 = 1536 + h * 64 + eh * 32 + (cp & 31);
    const uint32_t* __restrict__ QZ32 = (const uint32_t*)QZ;
    uint32_t rq[8], rz[8], rv[8];
#pragma unroll
    for (int ii = 0; ii < 8; ++ii) {
      const int pos = pos0 + i0 + ii;
      const unsigned tok = dir ? base + T - 1 - pos : base + pos;
      const unsigned ri = tok * 2560u;
      rq[ii] = QZ32[ri + qoff2]; rz[ii] = QZ32[ri + zoff2]; rv[ii] = QZ32[ri + voff2];
    }

    for (int c = 0; c < nchunks; ++c) {
      float pc0[8], pc1[8], kv0[8], kv1[8];
      float run0 = 1.f, run1 = 1.f;
#pragma unroll
      for (int ii = 0; ii < 8; ++ii) {
        const float z0 = bflo(rz[ii]), z1 = bfhi(rz[ii]);
        const float f0 = lbv0 + (1.f - lbv0) * frcp(1.f + __expf(-z0));
        const float f1 = lbv1 + (1.f - lbv1) * frcp(1.f + __expf(-z1));
        run0 *= f0; run1 *= f1;
        pc0[ii] = run0; pc1[ii] = run1;
        kv0[ii] = 1.f - f0; kv1[ii] = 1.f - f1;
      }
      *(float2*)(sTot + qt * 128 + 2 * cp) = make_float2(run0, run1);
      __syncthreads();
      {
        float off0 = 1.f, off1 = 1.f, tot0 = 1.f, tot1 = 1.f;
#pragma unroll
        for (int q = 0; q < 4; ++q) {
          const float2 t = *(const float2*)(sTot + q * 128 + 2 * cp);
          if (q < qt) { off0 *= t.x; off1 *= t.y; }
          tot0 *= t.x; tot1 *= t.y;
        }
        uint32_t wk0[4], wk1[4], wv0[4], wv1[4];
#pragma unroll
        for (int ii = 0; ii < 8; ii += 2) {
          uint32_t kp[2];
#pragma unroll
          for (int u = 0; u < 2; ++u) {
            const float e0 = pc0[ii + u] * off0, e1 = pc1[ii + u] * off1;
            kp[u] = pk2(kv0[ii + u] * frcp(e0), kv1[ii + u] * frcp(e1));
            *(uint32_t*)(sKe + (i0 + ii + u) * 136 + 2 * cp) = kp[u];
            if (mode) *(uint32_t*)(sQe + (i0 + ii + u) * 136 + 2 * cp) = pk2(bflo(rq[ii + u]) * e0, bfhi(rq[ii + u]) * e1);
          }
          wk0[ii >> 1] = (kp[0] & 0xffffu) | (kp[1] << 16);
          wk1[ii >> 1] = (kp[0] >> 16) | (kp[1] & 0xffff0000u);
          wv0[ii >> 1] = (rv[ii] & 0xffffu) | (rv[ii + 1] << 16);
          wv1[ii >> 1] = (rv[ii] >> 16) | (rv[ii + 1] & 0xffff0000u);
        }
        *(u32x4*)(sKeT + (2 * cp) * 40 + i0) = u32x4{wk0[0], wk0[1], wk0[2], wk0[3]};
        *(u32x4*)(sKeT + (2 * cp + 1) * 40 + i0) = u32x4{wk1[0], wk1[1], wk1[2], wk1[3]};
        if (cp < 32) {
          *(u32x4*)(sVT + (2 * cp) * 40 + i0) = u32x4{wv0[0], wv0[1], wv0[2], wv0[3]};
          *(u32x4*)(sVT + (2 * cp + 1) * 40 + i0) = u32x4{wv1[0], wv1[1], wv1[2], wv1[3]};
        }
        if (qt == 0) *(float2*)(sLast + 2 * cp) = make_float2(tot0, tot1);
        cum0 *= tot0; cum1 *= tot1;
      }
      if (c + 1 < nchunks) {
#pragma unroll
        for (int ii = 0; ii < 8; ++ii) {
          const int pos = pos0 + (c + 1) * 32 + i0 + ii;
          const unsigned tok = dir ? base + T - 1 - pos : base + pos;
          const unsigned ri = tok * 2560u;
          rq[ii] = QZ32[ri + qoff2]; rz[ii] = QZ32[ri + zoff2]; rv[ii] = QZ32[ri + voff2];
        }
      }
      __syncthreads();
      if (mode) {
        const int ti = wave >> 1, si = wave & 1;
        f32x4 sc = f32x4{0.f, 0.f, 0.f, 0.f};
        if (si <= ti) {
#pragma unroll
          for (int kk = 0; kk < 4; ++kk) {
            const bf16x8 a = *(const bf16x8*)(sQe + (ti * 16 + l15) * 136 + kk * 32 + quad * 8);
            const bf16x8 b = *(const bf16x8*)(sKe + (si * 16 + l15) * 136 + kk * 32 + quad * 8);
            sc = __builtin_amdgcn_mfma_f32_16x16x32_bf16(a, b, sc, 0, 0, 0);
          }
        }
#pragma unroll
        for (int j = 0; j < 4; ++j) {
          const int t = ti * 16 + quad * 4 + j, s2 = si * 16 + l15;
          sP[t * 40 + s2] = (s2 <= t) ? f2bf(sc[j]) : (bfr)0;
        }
      }
      f32x4 oacc[2];
      oacc[0] = f32x4{0.f, 0.f, 0.f, 0.f}; oacc[1] = f32x4{0.f, 0.f, 0.f, 0.f};
      if (mode) {
#pragma unroll
      for (int kk = 0; kk < 4; ++kk) {
        const bf16x8 sb = *(const bf16x8*)(sST + eloc * 136 + kk * 32 + quad * 8);
#pragma unroll
        for (int tt = 0; tt < 2; ++tt) {
          const bf16x8 qa = *(const bf16x8*)(sQe + (tt * 16 + l15) * 136 + kk * 32 + quad * 8);
          oacc[tt] = __builtin_amdgcn_mfma_f32_16x16x32_bf16(sb, qa, oacc[tt], 0, 0, 0);
        }
      }
      }
      __syncthreads();
      {
        const bf16x8 vb = *(const bf16x8*)(sVT + eloc * 40 + quad * 8);
        if (mode) {
#pragma unroll
        for (int tt = 0; tt < 2; ++tt) {
          const bf16x8 pb = *(const bf16x8*)(sP + (tt * 16 + l15) * 40 + quad * 8);
          oacc[tt] = __builtin_amdgcn_mfma_f32_16x16x32_bf16(vb, pb, oacc[tt], 0, 0, 0);
          const int pos = pos0 + c * 32 + tt * 16 + l15;
          const int tok = dir ? base + T - 1 - pos : base + pos;
          uint2 o; o.x = pk2(oacc[tt][0], oacc[tt][1]); o.y = pk2(oacc[tt][2], oacc[tt][3]);
          *(uint2*)(Od + (size_t)tok * DM + h * 128 + eh * 64 + wave * 16 + quad * 4) = o;
        }
        }
#pragma unroll
        for (int dt = 0; dt < 8; ++dt) {
          const bf16x8 ka = *(const bf16x8*)(sKeT + (dt * 16 + l15) * 40 + quad * 8);
          const float4 dl = *(const float4*)(sLast + dt * 16 + quad * 4);
          f32x4 sn = __builtin_amdgcn_mfma_f32_16x16x32_bf16(ka, vb, S[dt], 0, 0, 0);
          sn[0] *= dl.x; sn[1] *= dl.y; sn[2] *= dl.z; sn[3] *= dl.w;
          S[dt] = sn;
          uint2 o; o.x = pk2(sn[0], sn[1]); o.y = pk2(sn[2], sn[3]);
          *(uint2*)(sST + eloc * 136 + dt * 16 + quad * 4) = o;
        }
      }
    }
    if (is_prompt || !mode) {
      float* so = is_prompt ? out_state + ((size_t)(seq * 2 + dir) * 8 + h) * 16384 : SLOC + (size_t)slot * 16384;
#pragma unroll
      for (int dt = 0; dt < 8; ++dt)
#pragma unroll
        for (int j = 0; j < 4; ++j) so[(dt * 16 + quad * 4 + j) * 128 + eglob] = S[dt][j];
      if (!mode && eh == 0 && qt == 0) *(float2*)(DLOC + slot * 128 + 2 * cp) = make_float2(cum0, cum1);
    }
  }
}

DEVINL void hgrn_combine_phase(const Params& p, int bid, int nblk) {
  const int gt = bid * 256 + otid(), nt = nblk * 256;
  float* SLOC = (float*)(p.ws + OFF_BIG + 251658240ull);
  const float* DLOC = (const float*)(p.ws + OFF_BIG + 251658240ull + 33554432ull);
  const float* state_rec = p.in[2];
  for (int idx = gt; idx < 4 * 8 * 2 * 16384; idx += nt) {
    const int de = idx & 16383, r = idx >> 14;
    const int dir = r & 1, h = (r >> 1) & 7, seqb = r >> 4;
    const int d = de >> 7;
    float prev = state_rec[((size_t)(seqb * 2 + dir) * 8 + h) * 16384 + de];
#pragma unroll
    for (int j = 0; j < 8; ++j) {
      const int slot = ((seqb * 8 + j) * 8 + h) * 2 + dir;
      float* ptr = SLOC + (size_t)slot * 16384 + de;
      const float a = (j < 7) ? *ptr : 0.f;
      *ptr = prev;
      if (j < 7) prev = DLOC[slot * 128 + d] * prev + a;
    }
  }
}

DEVINL void hgrn_gate_phase(const Params& p, const float* __restrict__ ng, int bid, int nblk) {
  const int tid = otid(); const int lane = tid & 63;
  const int gw = bid * 4 + (tid >> 6), nw = nblk * 4;
  bfr* Of = (bfr*)(p.ws + OFF_H);
  const bfr* Ob = (const bfr*)(p.ws + OFF_BIG + 209715200ull);
  const bfr* QZ = (const bfr*)(p.ws + OFF_BIG);
  for (int row = gw; row < MTOK; row += nw) {
#pragma unroll
    for (int seg = 0; seg < 4; ++seg) {
      const int c = seg * 256 + lane * 4;
      const uint2 a = *(const uint2*)(Of + (size_t)row * DM + c);
      const uint2 b = *(const uint2*)(Ob + (size_t)row * DM + c);
      const uint2 gq = *(const uint2*)(QZ + (size_t)row * 5120 + 4096 + c);
      const float o0 = bflo(a.x) + bflo(b.x), o1 = bfhi(a.x) + bfhi(b.x), o2 = bflo(a.y) + bflo(b.y), o3 = bfhi(a.y) + bfhi(b.y);
      float ss = o0 * o0 + o1 * o1 + o2 * o2 + o3 * o3;
#pragma unroll
      for (int o = 16; o > 0; o >>= 1) ss += shx(ss, o, lane);
      const float rstd = rsqrtf(ss * (1.f / 128.f) + EPS);
      const float4 gg = *(const float4*)(ng + c);
      uint2 o;
      o.x = pk2(o0 * rstd * gg.x * silu_f(bflo(gq.x)), o1 * rstd * gg.y * silu_f(bfhi(gq.x)));
      o.y = pk2(o2 * rstd * gg.z * silu_f(bflo(gq.y)), o3 * rstd * gg.w * silu_f(bfhi(gq.y)));
      *(uint2*)(Of + (size_t)row * DM + c) = o;
    }
  }
}

DEVINL void ffn_act_phase(const bfr* __restrict__ UP, const float* __restrict__ wdw, int hf, bfr* __restrict__ ACT, int bid, int nblk) {
  const int gt = bid * 256 + otid(), nt = nblk * 256;
  for (int i = gt; i < MTOK * 176; i += nt) {
    const int m = i / 176, j = (i - m * 176) * 8;
    int tl, T; tok_pos(m, tl, T);
    const bfr* ur = UP + (size_t)m * DFF;
    float a[8], b[8];
#pragma unroll
    for (int q = 0; q < 8; ++q) { a[q] = 0.f; b[q] = 0.f; }
#pragma unroll
    for (int tap = 0; tap < 3; ++tap) {
      const int d = tap - 1;
      if ((d < 0 && tl == 0) || (d > 0 && tl == T - 1)) continue;
      const bfr* nr = ur + (ptrdiff_t)d * DFF;
      const uint4 av = *(const uint4*)(nr + j);
      const uint4 bv = *(const uint4*)(nr + HALF_FF + j);
      const float* wa = wdw + tap * (2 * DFF) + hf * HALF_FF + j;
      const float* wb = wdw + tap * (2 * DFF) + DFF + hf * HALF_FF + j;
      const float4 wa0 = *(const float4*)wa, wa1 = *(const float4*)(wa + 4);
      const float4 wb0 = *(const float4*)wb, wb1 = *(const float4*)(wb + 4);
      a[0] += wa0.x * bflo(av.x); a[1] += wa0.y * bfhi(av.x); a[2] += wa0.z * bflo(av.y); a[3] += wa0.w * bfhi(av.y);
      a[4] += wa1.x * bflo(av.z); a[5] += wa1.y * bfhi(av.z); a[6] += wa1.z * bflo(av.w); a[7] += wa1.w * bfhi(av.w);
      b[0] += wb0.x * bflo(bv.x); b[1] += wb0.y * bfhi(bv.x); b[2] += wb0.z * bflo(bv.y); b[3] += wb0.w * bfhi(bv.y);
      b[4] += wb1.x * bflo(bv.z); b[5] += wb1.y * bfhi(bv.z); b[6] += wb1.z * bflo(bv.w); b[7] += wb1.w * bfhi(bv.w);
    }
    uint4 o;
    o.x = pk2(silu_f(a[0]) * b[0], silu_f(a[1]) * b[1]);
    o.y = pk2(silu_f(a[2]) * b[2], silu_f(a[3]) * b[3]);
    o.z = pk2(silu_f(a[4]) * b[4], silu_f(a[5]) * b[5]);
    o.w = pk2(silu_f(a[6]) * b[6], silu_f(a[7]) * b[7]);
    *(uint4*)(ACT + (size_t)m * DFF + hf * HALF_FF + j) = o;
  }
}


#define XB_TMO      128
#define XB_XCNT(j)  (256  + 64 * (j))
#define XB_XSUB(j)  (1280 + 64 * (j))
#define XB_XGEN(j)  (2304 + 64 * (j))
#define XB_TOP      3328
#define XB_TOPGEN   3392
#define XCD_BAR_WORDS 3456
#define XB_SPIN_CAP (1u << 22)
#define LAS __attribute__((address_space(3)))
DEVINL unsigned xb_ld(unsigned* p) { return __hip_atomic_load(p, __ATOMIC_RELAXED, __HIP_MEMORY_SCOPE_AGENT); }
DEVINL unsigned xb_add(unsigned* p, unsigned v) { return __hip_atomic_fetch_add(p, v, __ATOMIC_RELAXED, __HIP_MEMORY_SCOPE_AGENT); }
DEVINL unsigned xb_xcc_id() { return (unsigned)__builtin_amdgcn_s_getreg((3 << 11) | 20) & 0xFu; }
#define XB_SPIN(cond, bar) do { unsigned _sp = 0; while (cond) { __builtin_amdgcn_s_sleep(1); \
    if ((++_sp & 255u) == 0u) { if (xb_ld(&(bar)[XB_TMO])) break; if (_sp > XB_SPIN_CAP) { atomicAdd(&(bar)[XB_TMO], 1u); break; } } } } while (0)
struct XcdBarrier { unsigned* bar; unsigned x; volatile LAS unsigned* st; };
DEVINL XcdBarrier xcd_barrier_post(unsigned* bar, volatile LAS unsigned* st) {
  XcdBarrier b; b.bar = bar; b.x = xb_xcc_id(); b.st = st;
  if (threadIdx.x == 0) (void)xb_add(&bar[XB_XCNT(b.x)], 1u);
  return b;
}
DEVINL void xcd_barrier_complete(unsigned* bar, unsigned x, unsigned& nloc, unsigned& nx) {
  const unsigned G = gridDim.x * gridDim.y * gridDim.z;
  unsigned sum, cnt, mine, sp = 0u;
  for (;;) {
    sum = 0u; cnt = 0u; mine = 0u;
#pragma unroll
    for (unsigned j = 0; j < 16; ++j) { const unsigned c = xb_ld(&bar[XB_XCNT(j)]); sum += c; cnt += (c > 0u) ? 1u : 0u; mine = (j == x) ? c : mine; }
    if (sum == G) break;
    __builtin_amdgcn_s_sleep(1);
    if ((++sp & 255u) == 0u) { if (xb_ld(&bar[XB_TMO])) break; if (sp > XB_SPIN_CAP) { atomicAdd(&bar[XB_TMO], 1u); break; } }
  }
  nloc = mine > 0u ? mine : 1u; nx = cnt > 0u ? cnt : 1u;
}
DEVINL void xcd_barrier(const XcdBarrier& b) {
  asm volatile("s_waitcnt vmcnt(0)" ::: "memory");
  __syncthreads();
  if (threadIdx.x == 0) {
    unsigned* bar = b.bar;
    unsigned bx = b.x;
    asm volatile("" : "+s"(bar), "+s"(bx));
    __builtin_amdgcn_s_waitcnt(0);
    unsigned nloc = b.st[0], nx = b.st[1];
    if (nloc == 0u) { xcd_barrier_complete(bar, bx, nloc, nx); b.st[0] = nloc; b.st[1] = nx; }
    const unsigned old = xb_add(&bar[XB_XSUB(bx)], 1u);
    const unsigned gen = old / nloc;
    if (old + 1u == (gen + 1u) * nloc) {
      __builtin_amdgcn_fence(__ATOMIC_RELEASE, "agent");
      asm volatile("s_waitcnt vmcnt(0)" ::: "memory");
      const unsigned og = xb_add(&bar[XB_TOP], 1u);
      const unsigned tg = og / nx;
      if (og + 1u == (tg + 1u) * nx) xb_add(&bar[XB_TOPGEN], 1u);
      else XB_SPIN(xb_ld(&bar[XB_TOPGEN]) == tg, bar);
      __builtin_amdgcn_fence(__ATOMIC_ACQUIRE, "agent");
      xb_add(&bar[XB_XGEN(bx)], 1u);
      asm volatile("s_waitcnt vmcnt(0)" ::: "memory");
    } else {
      XB_SPIN(xb_ld(&bar[XB_XGEN(bx)]) == gen, bar);
      __builtin_amdgcn_fence(__ATOMIC_ACQUIRE, "agent");
      asm volatile("s_waitcnt vmcnt(0)" ::: "memory");
    }
  }
  __syncthreads();
}

constexpr int SMEM_BYTES = 77824;

__global__ void __launch_bounds__(256, 2) mega_kernel(Params p) {
  __shared__ __attribute__((aligned(16))) char smem[SMEM_BYTES];
  cg::grid_group grid = cg::this_grid();
  __shared__ uint4 xb_words;
  if (threadIdx.x == 0) xb_words = make_uint4(0u, 0u, 0u, 0u);
  __syncthreads();
  XcdBarrier xb = xcd_barrier_post((unsigned*)(p.ws + OFF_BAR), (volatile LAS unsigned*)&xb_words);
  const int bid = blockIdx.x, nblk = gridDim.x;

  phase0a(p, smem, osg(bid), nblk);
  grid.sync();
  phase0b(p, osg(bid), nblk);
  xcd_barrier(xb);

  for (int layer = 0; layer < 4; ++layer) {
    Params q = p;
    {
      size_t oz = 0;
      asm volatile("" : "+s"(oz));
      q.ws = p.ws + oz;
      q.out = p.out + oz;
    }
    float* X = q.out;
    bfr* WB = (bfr*)(q.ws + OFF_WB);
    bfr* H = (bfr*)(q.ws + OFF_H);
    bfr* BIG = (bfr*)(q.ws + OFF_BIG);
    const float* MOD = (const float*)(q.ws + OFF_MOD);
    const float* modl = MOD + layer * 30720;
    if (layer == 0) {
      conv_matrix(q.in[9], 1024, 3072, WB + WB_IN, 0, smem, osg(bid), nblk);
      conv_matrix(q.in[11], 1024, 1024, WB + WB_OUT, 0, smem, osg(bid), nblk);
    } else if (layer == 1) {
      for (int g = 0; g < 4; ++g) conv_matrix(q.in[12] + g * 65536, 256, 256, WB + WB_IN + g * 65536, 0, smem, osg(bid), nblk);
    } else if (layer == 2) {
      conv_matrix(q.in[14], 1024, 2048, WB + WB_IN, 0, smem, osg(bid), nblk);
      conv_matrix(q.in[18], 1024, 1024, WB + WB_OUT, 0, smem, osg(bid), nblk);
    } else {
      conv_matrix(q.in[19], 1024, 5120, WB + WB_IN, 0, smem, osg(bid), nblk);
      conv_matrix(q.in[22], 1024, 1024, WB + WB_OUT, 0, smem, osg(bid), nblk);
    }
    conv_matrix(q.in[23] + (size_t)layer * 1024 * 5632, 1024, 5632, WB + WB_UP, 1, smem, osg(bid), nblk);
    conv_matrix(q.in[25] + (size_t)layer * DFF * 1024, DFF, 1024, WB + WB_DOWN, 0, smem, osg(bid), nblk);
    norm_phase(X, q.in[7] + (layer * 2 + 0) * DM, modl, 0, 1024, H, osg(bid), nblk);
    xcd_barrier(xb);

    if (layer == 0) {
      bfr* G = BIG;
      bfr* U = BIG + (size_t)MTOK * 3072;
      gemm256s_phase(H, DM, WB + WB_IN, 1024, 3072, 1024, EpiStore{G, 3072}, smem, osg(bid), nblk);
      xcd_barrier(xb);
      shortconv_ew_phase(G, q.in[10], U, osg(bid), nblk);
      xcd_barrier(xb);
      gemm_phase(U, DM, WB + WB_OUT, 1024, 1024, 1024, EpiResid{X, modl + 2048, nullptr, 0}, smem, osg(bid), nblk);
      xcd_barrier(xb);
    } else if (layer == 1) {
      bfr* P = BIG;
      pool_ew_phase(H, P, osg(bid), nblk);
      xcd_barrier(xb);
      for (int g = 0; g < 4; ++g)
        gemm_phase(P + g * 256, DM, WB + WB_IN + g * 65536, 256, 256, 256,
                   EpiResid{X, modl + 2048 + g * 256, q.in[13] + g * 256, g * 256}, smem, osg(bid), nblk);
      xcd_barrier(xb);
    } else if (layer == 2) {
      bfr* UV = BIG;
      gemm_phase(H, DM, WB + WB_IN, 1024, 2048, 1024, EpiGelu{UV, 2048}, smem, osg(bid), nblk);
      xcd_barrier(xb);
      sgu_norm_phase(UV, q.in[15], osg(bid), nblk);
      xcd_barrier(xb);
      sgu_spatial_phase(UV, q.in[16], q.in[17], smem, osg(bid), nblk);
      xcd_barrier(xb);
      gemm_phase(UV, 2048, WB + WB_OUT, 1024, 1024, 1024, EpiResid{X, modl + 2048, nullptr, 0}, smem, osg(bid), nblk);
      xcd_barrier(xb);
    } else {
      bfr* QZ = BIG;
      gemm256s_phase(H, DM, WB + WB_IN, 1024, 5120, 1024, EpiStore{QZ, 5120}, smem, osg(bid), nblk);
      xcd_barrier(xb);
      hgrn_scan_phase(q, smem, osg(bid), nblk, 0);
      xcd_barrier(xb);
      hgrn_combine_phase(q, osg(bid), nblk);
      xcd_barrier(xb);
      hgrn_scan_phase(q, smem, osg(bid), nblk, 1);
      xcd_barrier(xb);
      hgrn_gate_phase(q, q.in[21], osg(bid), nblk);
      xcd_barrier(xb);
      gemm_phase(H, DM, WB + WB_OUT, 1024, 1024, 1024, EpiResid{X, modl + 2048, nullptr, 0}, smem, osg(bid), nblk);
      xcd_barrier(xb);
    }

    norm_phase(X, q.in[7] + (layer * 2 + 1) * DM, modl, 3072, 4096, H, osg(bid), nblk);
    xcd_barrier(xb);
    bfr* ACT = BIG;
    float* EDGE = (float*)(q.ws + OFF_BIG + 115343360ull);
    const float* wdw = q.in[24] + (size_t)layer * 3 * 2 * DFF;
    gemm256s_phase(H, DM, WB + WB_UP, 1024, 2 * DFF, 1024, EpiFfnUp{ACT, EDGE, wdw}, smem, osg(bid), nblk);
    xcd_barrier(xb);
    ffn_edge_phase(EDGE, wdw, ACT, osg(bid), nblk);
    xcd_barrier(xb);
    gemm_phase(ACT, DFF, WB + WB_DOWN, DFF, 1024, DFF, EpiResid{X, modl + 5120, nullptr, 0}, smem, osg(bid), nblk);
    xcd_barrier(xb);
  }
  final_norm_phase(p.out, p.in[8], osg(bid), nblk);
}

extern "C" void kernel_launch(void* const* d_in, const int* in_sizes, int n_in, void* d_out, int out_size,
                              void* d_ws, size_t ws_size, hipStream_t stream) {
  static int grid_blocks = 0;
  if (!grid_blocks) {
    int dev = 0, cus = 0, per_cu = 0;
    hipGetDevice(&dev);
    hipDeviceGetAttribute(&cus, hipDeviceAttributeMultiprocessorCount, dev);
    hipOccupancyMaxActiveBlocksPerMultiprocessor(&per_cu, mega_kernel, 256, 0);
    if (per_cu > 2) per_cu = 2;
    if (per_cu < 1) per_cu = 1;
    grid_blocks = cus * per_cu;
  }
  if (ws_size < WS_NEED) { fprintf(stderr, "workspace too small: %zu < %zu\n", ws_size, (size_t)WS_NEED); return; }
  Params p{};
  for (int i = 0; i < 26; ++i) p.in[i] = (const float*)d_in[i];
  p.out = (float*)d_out;
  p.ws = (char*)d_ws;
  hipMemsetAsync((char*)d_ws + OFF_BAR, 0, XCD_BAR_WORDS * 4, stream);
  void* args[] = {&p};
  hipError_t e = hipLaunchCooperativeKernel((void*)mega_kernel, dim3(grid_blocks), dim3(256), args, 0, stream);
  if (e != hipSuccess) fprintf(stderr, "cooperative launch failed: %s (grid %d)\n", hipGetErrorString(e), grid_blocks);
}
```

```cpp
#include <hip/hip_runtime.h>
#include <hip/hip_cooperative_groups.h>
#include <stdint.h>
#include <stdio.h>
namespace cg = cooperative_groups;

#define DEVINL __device__ __forceinline__
typedef unsigned short bfr;
using bf16x8 = __attribute__((ext_vector_type(8))) short;
using f32x4 = __attribute__((ext_vector_type(4))) float;
using u32x4 = __attribute__((ext_vector_type(4))) unsigned int;

constexpr int DM = 1024;
constexpr int MTOK = 20480;
constexpr int NPROMPT = 4096;
constexpr int DFF = 2816;
constexpr int HALF_FF = 1408;
constexpr float EPS = 1e-6f;

constexpr size_t OFF_MODP = 0;
constexpr size_t OFF_MOD = 7864320;
constexpr size_t OFF_LBS = OFF_MOD + 491520;
constexpr size_t OFF_BAR = OFF_LBS + 8192;
constexpr size_t OFF_WB = 8388608;
constexpr size_t OFF_H = 41943040;
constexpr size_t OFF_BIG = 83886080;
constexpr size_t WS_NEED = OFF_BIG + 251658240ull + 33554432ull + 262144ull;
constexpr size_t WB_IN = 0, WB_OUT = 5242880, WB_UP = 6291456, WB_DOWN = 12058624;

struct Params {
  const float* in[26];
  float* out;
  char* ws;
};

DEVINL int otid() { int t = threadIdx.x; asm volatile("" : "+v"(t)); return t; }
DEVINL int osg(int x) { asm volatile("" : "+s"(x)); return x; }
typedef __bf16 hbf16x2 __attribute__((ext_vector_type(2)));
typedef float hf32x2 __attribute__((ext_vector_type(2)));
DEVINL uint32_t pk2(float a, float b) {
  hf32x2 v = {a, b};
  hbf16x2 r = __builtin_convertvector(v, hbf16x2);
  return __builtin_bit_cast(uint32_t, r);
}
DEVINL bfr f2bf(float f) { return (bfr)(pk2(f, 0.f) & 0xffffu); }
DEVINL float bf2f(bfr h) { return __uint_as_float(((uint32_t)h) << 16); }
DEVINL float frcp(float x) { return __builtin_amdgcn_rcpf(x); }
DEVINL float bflo(uint32_t u) { return __uint_as_float(u << 16); }
DEVINL float bfhi(uint32_t u) { return __uint_as_float(u & 0xffff0000u); }
DEVINL int cond_of(int m) { return m < NPROMPT ? 0 : 1 + ((m - NPROMPT) >> 12); }
DEVINL float silu_f(float x) { return x * frcp(1.f + __expf(-x)); }
DEVINL float gelu_tanh_f(float x) {
  float y = 0.7978845608028654f * (x + 0.044715f * x * x * x);
  float t = 1.f - 2.f * frcp(__expf(2.f * y) + 1.f);
  return 0.5f * x * (1.f + t);
}
DEVINL float shx(float v, int o, int lane) {
  return __int_as_float(__builtin_amdgcn_ds_bpermute((lane ^ o) << 2, __float_as_int(v)));
}
DEVINL float wave_sum(float v, int lane) {
#pragma unroll
  for (int o = 32; o > 0; o >>= 1) v += shx(v, o, lane);
  return v;
}

DEVINL void tok_pos(int m, int& tl, int& T) {
  if (m < NPROMPT) { tl = m & 255; T = 256; } else { tl = (m - NPROMPT) & 4095; T = 4096; }
}

struct EpiNoPre {};
#define EPI_ELEMENTWISE_TILE                                                                       \
  typedef EpiNoPre Pre;                                                                             \
  static constexpr bool kLdsEpi = false;                                                            \
  DEVINL Pre pre(int tn, int tid) const { return Pre{}; }                                           \
  DEVINL void tile(const f32x4 (&acc)[4][4], const Pre& pre_, int m0, int n0, int tn, int wm, int wn, int l15, \
                   int quad, int tid, char* smem) const {                                           \
    _Pragma("unroll") for (int mt = 0; mt < 4; ++mt)                                                \
      _Pragma("unroll") for (int nt = 0; nt < 4; ++nt)                                              \
        (*this)(m0 + wm * 64 + mt * 16 + l15, n0 + wn * 64 + nt * 16 + quad * 4, acc[mt][nt]);      \
  }
struct EpiStore {
  bfr* C; int ldc;
  DEVINL void tile256(const f32x4 (&acc)[8][4], const EpiNoPre& pre_, int m0, int n0, int tn, int wm, int wn, int l15,
                      int quad, int tid, char* smem) const {
#pragma unroll
    for (int mt = 0; mt < 8; ++mt)
#pragma unroll
      for (int nt = 0; nt < 4; ++nt)
        (*this)(m0 + wm * 128 + mt * 16 + l15, n0 + wn * 64 + nt * 16 + quad * 4, acc[mt][nt]);
  }
  DEVINL void operator()(int m, int n, f32x4 v) const {
    uint2 o; o.x = pk2(v[0], v[1]); o.y = pk2(v[2], v[3]);
    *(uint2*)(C + (size_t)m * ldc + n) = o;
  }
  EPI_ELEMENTWISE_TILE
};
struct EpiGelu {
  bfr* C; int ldc;
  DEVINL void operator()(int m, int n, f32x4 v) const {
    uint2 o; o.x = pk2(gelu_tanh_f(v[0]), gelu_tanh_f(v[1])); o.y = pk2(gelu_tanh_f(v[2]), gelu_tanh_f(v[3]));
    *(uint2*)(C + (size_t)m * ldc + n) = o;
  }
  EPI_ELEMENTWISE_TILE
};
struct EpiResid {
  float* X; const float* gate; const float* cscale; int coff;
  typedef EpiNoPre Pre;
  static constexpr bool kLdsEpi = false;
  static constexpr bool kSplit = false;
  DEVINL Pre pre(int tn, int tid) const { return Pre{}; }
  DEVINL void tile(const f32x4 (&acc)[4][4], const Pre& pre_, int m0, int n0, int tn, int wm, int wn, int l15,
                   int quad, int tid, char* smem) const {
    const int cond = cond_of(m0);
    const int nb = n0 + wn * 64 + quad * 4;
    f32x4 gs[4];
#pragma unroll
    for (int nt = 0; nt < 4; ++nt) {
      gs[nt] = *(const f32x4*)(gate + cond * 6144 + nb + nt * 16);
      if (cscale) gs[nt] = gs[nt] * *(const f32x4*)(cscale + nb + nt * 16);
    }
    float* xb = X + (size_t)(m0 + wm * 64 + l15) * DM + coff + nb;
#pragma unroll
    for (int hm = 0; hm < 2; ++hm) {
      f32x4 xv[2][4];
#pragma unroll
      for (int mi = 0; mi < 2; ++mi)
#pragma unroll
        for (int nt = 0; nt < 4; ++nt)
          xv[mi][nt] = *(const f32x4*)(xb + (size_t)((hm * 2 + mi) * 16) * DM + nt * 16);
#pragma unroll
      for (int mi = 0; mi < 2; ++mi)
#pragma unroll
        for (int nt = 0; nt < 4; ++nt)
          *(f32x4*)(xb + (size_t)((hm * 2 + mi) * 16) * DM + nt * 16) = xv[mi][nt] + gs[nt] * acc[hm * 2 + mi][nt];
    }
  }
};


#define LDS3 __attribute__((address_space(3)))
DEVINL void lds_barrier() { asm volatile("s_waitcnt lgkmcnt(0)\n\ts_barrier" ::: "memory"); }
template <class Epi>
DEVINL void gemm_phase(const bfr* __restrict__ A, int lda, const bfr* __restrict__ Bt, int ldb, int N, int K,
                       const Epi& epi, char* smem, int bid, int nblk) {
  const int tid = otid(), lane = tid & 63, wave = tid >> 6;
  const int wm = wave >> 1, wn = wave & 1, l15 = lane & 15, quad = lane >> 4;
  const int tilesN = N >> 7;
  const int ntiles = (MTOK >> 7) * tilesN;
  const int nk = K >> 6;
  const int srow0 = wave * 8 + (lane >> 3);
  const int lc = (lane & 7) ^ ((srow0 >> 1) & 7);
  const int fsw = (l15 >> 1) & 7;
  char* const dst0 = smem + wave * 1024 + lane * 16;
#define TILE_DECODE(t_, tm_, tn_) {                                                        \
    const int xcd_ = (t_) & 7, u_ = (t_) >> 3, g16_ = 16 * tilesN;                         \
    int ur_;                                                                               \
    if (u_ < g16_) { const int gs_ = 8 * tilesN; const int g_ = u_ / gs_, r_ = u_ - g_ * gs_; tn_ = r_ >> 3; ur_ = g_ * 8 + (r_ & 7); } \
    else { const int r_ = u_ - g16_; tn_ = r_ >> 2; ur_ = 16 + (r_ & 3); }                 \
    tm_ = ur_ * 8 + xcd_; }
#define GLDS_STAGE(pa_, pb_, st_, kt_)                                                                    \
  {                                                                                                       \
    _Pragma("unroll") for (int i = 0; i < 4; ++i) {                                                       \
      __builtin_amdgcn_global_load_lds((const unsigned*)((pa_) + (size_t)(i * 32) * lda + (kt_) * 64),    \
                                       (LDS3 unsigned*)(dst0 + (st_) * 32768 + i * 4096), 16, 0, 0);      \
      __builtin_amdgcn_global_load_lds((const unsigned*)((pb_) + (size_t)(i * 32) * ldb + (kt_) * 64),    \
                                       (LDS3 unsigned*)(dst0 + (st_) * 32768 + 16384 + i * 4096), 16, 0, 0); \
    }                                                                                                     \
  }
  int tile = bid;
  if (tile >= ntiles) return;
  int tm, tn;
  TILE_DECODE(tile, tm, tn)
  const bfr* gA = A + (size_t)((tm << 7) + srow0) * lda + lc * 8;
  const bfr* gB = Bt + (size_t)((tn << 7) + srow0) * ldb + lc * 8;
  __syncthreads();
  GLDS_STAGE(gA, gB, 0, 0)
  for (; tile < ntiles; tile += nblk) {
    const int m0 = tm << 7, n0 = tn << 7, tn_cur = tn;
    const bool has_next = (tile + nblk < ntiles);
    const bfr* gAn = gA; const bfr* gBn = gB;
    if (has_next) {
      TILE_DECODE(tile + nblk, tm, tn)
      gAn = A + (size_t)((tm << 7) + srow0) * lda + lc * 8;
      gBn = Bt + (size_t)((tn << 7) + srow0) * ldb + lc * 8;
    }
    typename Epi::Pre pre = epi.pre(tn_cur, tid);
    f32x4 acc[4][4];
#pragma unroll
    for (int i = 0; i < 4; ++i)
#pragma unroll
      for (int j = 0; j < 4; ++j) acc[i][j] = f32x4{0.f, 0.f, 0.f, 0.f};
    __syncthreads();
    for (int kt = 0; kt < nk; ++kt) {
      const int st = kt & 1;
      const bool cur = (kt + 1 < nk);
      const bool any = cur || has_next;
      const bfr* sa = cur ? gA + (kt + 1) * 64 : gAn;
      const bfr* sb = cur ? gB + (kt + 1) * 64 : gBn;
      char* sd = dst0 + (cur ? (st ^ 1) : 0) * 32768;
      const char* cA = smem + st * 32768 + (wm * 64 + l15) * 128;
      const char* cB = smem + st * 32768 + 16384 + (wn * 64 + l15) * 128;
      {
        const int co0 = (quad ^ fsw) * 16, co1 = ((4 + quad) ^ fsw) * 16;
        bf16x8 af0[4], bf0[4], af1[4], bf1[4];
#pragma unroll
        for (int i = 0; i < 4; ++i) {
          af0[i] = *(const bf16x8*)(cA + i * 2048 + co0);
          bf0[i] = *(const bf16x8*)(cB + i * 2048 + co0);
        }
#pragma unroll
        for (int i = 0; i < 4; ++i) {
          af1[i] = *(const bf16x8*)(cA + i * 2048 + co1);
          bf1[i] = *(const bf16x8*)(cB + i * 2048 + co1);
        }
        __builtin_amdgcn_sched_barrier(0);
#pragma unroll
        for (int mt = 0; mt < 4; ++mt) {
#pragma unroll
          for (int nt = 0; nt < 4; ++nt)
            acc[mt][nt] = __builtin_amdgcn_mfma_f32_16x16x32_bf16(bf0[nt], af0[mt], acc[mt][nt], 0, 0, 0);
          if (any) {
            __builtin_amdgcn_global_load_lds((const unsigned*)(sa + (size_t)(mt * 32) * lda), (LDS3 unsigned*)(sd + mt * 4096), 16, 0, 0);
            __builtin_amdgcn_global_load_lds((const unsigned*)(sb + (size_t)(mt * 32) * ldb), (LDS3 unsigned*)(sd + 16384 + mt * 4096), 16, 0, 0);
          }
          __builtin_amdgcn_sched_barrier(0);
        }
#pragma unroll
        for (int mt = 0; mt < 4; ++mt)
#pragma unroll
          for (int nt = 0; nt < 4; ++nt)
            acc[mt][nt] = __builtin_amdgcn_mfma_f32_16x16x32_bf16(bf1[nt], af1[mt], acc[mt][nt], 0, 0, 0);
        __builtin_amdgcn_sched_barrier(0);
      }
      if (kt + 1 < nk) __syncthreads();
    }
    epi.tile(acc, pre, m0, n0, tn_cur, wm, wn, l15, quad, tid, smem);
    gA = gAn; gB = gBn;
  }
}

constexpr int EDGE_LD = 2 * DFF;
struct FfnPre { f32x4 wa[3], wb[3]; };
DEVINL void ffn_conv_rows(const bfr* T, const FfnPre& pre_, bfr* ACT, float* EDGE, int m0, int n0, int tn, int tid) {
  const int c4 = (tid & 15) * 4, r0 = (tid >> 4) * 8;
  const int ja = tn * 64 + c4;
  int tl, Tlen; tok_pos(m0, tl, Tlen);
  const bool top_ok = (tl == 0), bot_ok = (tl + 128 == Tlen);
  if (tid < 128) {
    const int e = tid >> 5, c = (tid & 31) * 4;
    const int r = (e < 2) ? e : 124 + e;
    const uint2 v = *(const uint2*)(T + r * 136 + c);
    *(f32x4*)(EDGE + ((size_t)(m0 >> 7) * 4 + e) * EDGE_LD + n0 + c) = f32x4{bflo(v.x), bfhi(v.x), bflo(v.y), bfhi(v.y)};
  }
  const f32x4 zero = f32x4{0.f, 0.f, 0.f, 0.f};
#define LDT(dst, row, col) { const uint2 v_ = *(const uint2*)(T + (row) * 136 + (col)); dst = f32x4{bflo(v_.x), bfhi(v_.x), bflo(v_.y), bfhi(v_.y)}; }
  f32x4 pa = zero, pb = zero, ca, cb, na, nb;
  if (r0 > 0) { LDT(pa, r0 - 1, c4) LDT(pb, r0 - 1, 64 + c4) }
  LDT(ca, r0, c4) LDT(cb, r0, 64 + c4)
#pragma unroll
  for (int i = 0; i < 8; ++i) {
    const int r = r0 + i;
    if (r < 127) { LDT(na, r + 1, c4) LDT(nb, r + 1, 64 + c4) }
    else { na = zero; nb = zero; }
    const bool ok = (r > 0 || top_ok) && (r < 127 || bot_ok);
    if (ok) {
      const f32x4 a = pre_.wa[0] * pa + pre_.wa[1] * ca + pre_.wa[2] * na;
      const f32x4 b = pre_.wb[0] * pb + pre_.wb[1] * cb + pre_.wb[2] * nb;
      uint2 o;
      o.x = pk2(silu_f(a[0]) * b[0], silu_f(a[1]) * b[1]);
      o.y = pk2(silu_f(a[2]) * b[2], silu_f(a[3]) * b[3]);
      *(uint2*)(ACT + (size_t)(m0 + r) * DFF + ja) = o;
    }
    pa = ca; pb = cb; ca = na; cb = nb;
  }
#undef LDT
}
struct EpiFfnUp {
  bfr* ACT; float* EDGE; const float* wdw;
  typedef FfnPre Pre;
  static constexpr bool kLdsEpi = true;
  DEVINL Pre pre(int tn, int tid) const {
    Pre q;
    const int ja = tn * 64 + (tid & 15) * 4;
#pragma unroll
    for (int t = 0; t < 3; ++t) {
      q.wa[t] = *(const f32x4*)(wdw + t * (2 * DFF) + ja);
      q.wb[t] = *(const f32x4*)(wdw + t * (2 * DFF) + DFF + ja);
    }
    return q;
  }
  DEVINL void tile(const f32x4 (&acc)[4][4], const Pre& pre_, int m0, int n0, int tn, int wm, int wn, int l15, int quad,
                   int tid, char* smem) const {
    bfr* T = (bfr*)(smem + 32768);
    lds_barrier();
#pragma unroll
    for (int mt = 0; mt < 4; ++mt)
#pragma unroll
      for (int nt = 0; nt < 4; ++nt) {
        uint2 o; o.x = pk2(acc[mt][nt][0], acc[mt][nt][1]); o.y = pk2(acc[mt][nt][2], acc[mt][nt][3]);
        *(uint2*)(T + (wm * 64 + mt * 16 + l15) * 136 + wn * 64 + nt * 16 + quad * 4) = o;
      }
    lds_barrier();
    ffn_conv_rows(T, pre_, ACT, EDGE, m0, n0, tn, tid);
  }
  DEVINL void tile256(const f32x4 (&acc)[8][4], const Pre& pre_, int m0, int n0, int tn, int wm, int wn, int l15, int quad,
                      int tid, char* smem) const {
    bfr* T = (bfr*)smem;
#pragma unroll
    for (int hh = 0; hh < 2; ++hh) {
      lds_barrier();
      if (wm == hh) {
#pragma unroll
        for (int mt = 0; mt < 8; ++mt)
#pragma unroll
          for (int nt = 0; nt < 4; ++nt) {
            uint2 o; o.x = pk2(acc[mt][nt][0], acc[mt][nt][1]); o.y = pk2(acc[mt][nt][2], acc[mt][nt][3]);
            *(uint2*)(T + (mt * 16 + l15) * 136 + wn * 64 + nt * 16 + quad * 4) = o;
          }
      }
      lds_barrier();
      ffn_conv_rows(T, pre_, ACT, EDGE, m0 + hh * 128, n0, tn, tid);
    }
  }
};


template <class Epi>
DEVINL void gemm256_phase(const bfr* __restrict__ A, int lda, const bfr* __restrict__ Bt, int ldb, int N, int K,
                          const Epi& epi, char* smem, int bid, int nblk) {
  const int tid = otid(), lane = tid & 63, wave = tid >> 6;
  const int wm = wave >> 1, wn = wave & 1, l15 = lane & 15, quad = lane >> 4;
  const int tilesN = N >> 7;
  const int ntiles = (MTOK >> 8) * tilesN;
  const int nk = K >> 5;
  const int srow0 = wave * 16 + (lane >> 2);
  const int lc = (lane & 3) ^ ((0 - (lane >> 4)) & 3);
  const int fsw = (0 - (l15 >> 2)) & 3;
  char* const dst0 = smem + wave * 1024 + lane * 16;
#define TILE_DECODE2(t_, tm_, tn_) { const int xcd_ = (t_) & 7, u_ = (t_) >> 3; const int ur_ = u_ / tilesN; tn_ = u_ - ur_ * tilesN; tm_ = ur_ * 8 + xcd_; }
#define GLDS_STAGE2(pa_, pb_, st_, kt_)                                                                   \
  {                                                                                                       \
    _Pragma("unroll") for (int i = 0; i < 4; ++i)                                                         \
      __builtin_amdgcn_global_load_lds((const unsigned*)((pa_) + (size_t)(i * 64) * lda + (kt_) * 32),    \
                                       (LDS3 unsigned*)(dst0 + (st_) * 24576 + i * 4096), 16, 0, 0);      \
    _Pragma("unroll") for (int i = 0; i < 2; ++i)                                                         \
      __builtin_amdgcn_global_load_lds((const unsigned*)((pb_) + (size_t)(i * 64) * ldb + (kt_) * 32),    \
                                       (LDS3 unsigned*)(dst0 + (st_) * 24576 + 16384 + i * 4096), 16, 0, 0); \
  }
  int tile = bid;
  if (tile >= ntiles) return;
  int tm, tn;
  TILE_DECODE2(tile, tm, tn)
  const bfr* gA = A + (size_t)((tm << 8) + srow0) * lda + lc * 8;
  const bfr* gB = Bt + (size_t)((tn << 7) + srow0) * ldb + lc * 8;
  __syncthreads();
  GLDS_STAGE2(gA, gB, 0, 0)
  for (; tile < ntiles; tile += nblk) {
    const int m0 = tm << 8, n0 = tn << 7, tn_cur = tn;
    const bool has_next = (tile + nblk < ntiles);
    const bfr* gAn = gA; const bfr* gBn = gB;
    if (has_next) {
      TILE_DECODE2(tile + nblk, tm, tn)
      gAn = A + (size_t)((tm << 8) + srow0) * lda + lc * 8;
      gBn = Bt + (size_t)((tn << 7) + srow0) * ldb + lc * 8;
    }
    f32x4 acc[8][4];
#pragma unroll
    for (int i = 0; i < 8; ++i)
#pragma unroll
      for (int j = 0; j < 4; ++j) acc[i][j] = f32x4{0.f, 0.f, 0.f, 0.f};
    __syncthreads();
    for (int kt = 0; kt < nk; ++kt) {
      const int st = kt & 1;
      const bool cur = (kt + 1 < nk);
      const bool any = cur || has_next;
      const bfr* sa = cur ? gA + (kt + 1) * 32 : gAn;
      const bfr* sb = cur ? gB + (kt + 1) * 32 : gBn;
      char* sd = dst0 + (cur ? (st ^ 1) : 0) * 24576;
      const char* cA = smem + st * 24576 + (wm * 128 + l15) * 64 + ((quad ^ fsw) * 16);
      const char* cB = smem + st * 24576 + 16384 + (wn * 64 + l15) * 64 + ((quad ^ fsw) * 16);
      bf16x8 bfg[4];
#pragma unroll
      for (int i = 0; i < 4; ++i) bfg[i] = *(const bf16x8*)(cB + i * 1024);
#pragma unroll
      for (int hm = 0; hm < 2; ++hm) {
        bf16x8 af[4];
#pragma unroll
        for (int i = 0; i < 4; ++i) af[i] = *(const bf16x8*)(cA + (hm * 4 + i) * 1024);
        __builtin_amdgcn_sched_barrier(0);
#pragma unroll
        for (int mt = 0; mt < 4; ++mt) {
#pragma unroll
          for (int nt = 0; nt < 4; ++nt)
            acc[hm * 4 + mt][nt] = __builtin_amdgcn_mfma_f32_16x16x32_bf16(bfg[nt], af[mt], acc[hm * 4 + mt][nt], 0, 0, 0);
          const int g = hm * 4 + mt;
          if (any && g < 4)
            __builtin_amdgcn_global_load_lds((const unsigned*)(sa + (size_t)(g * 64) * lda), (LDS3 unsigned*)(sd + g * 4096), 16, 0, 0);
          else if (any && g < 6)
            __builtin_amdgcn_global_load_lds((const unsigned*)(sb + (size_t)((g - 4) * 64) * ldb), (LDS3 unsigned*)(sd + 16384 + (g - 4) * 4096), 16, 0, 0);
          __builtin_amdgcn_sched_barrier(0);
        }
      }
      if (kt + 1 < nk) __syncthreads();
    }
    {
      typename Epi::Pre pre = epi.pre(tn_cur, tid);
      epi.tile256(acc, pre, m0, n0, tn_cur, wm, wn, l15, quad, tid, smem);
    }
    gA = gAn; gB = gBn;
  }
}


template <class Epi>
DEVINL void gemm256s_phase(const bfr* __restrict__ A, int lda, const bfr* __restrict__ Bt, int ldb, int N, int K,
                           const Epi& epi, char* smem, int bid, int nblk) {
  const int tid = otid(), lane = tid & 63, wave = tid >> 6;
  const int wm = wave >> 1, wn = wave & 1, l15 = lane & 15, quad = lane >> 4;
  const int tilesN = N >> 7;
  const int ntiles = (MTOK >> 8) * tilesN;
  const int nk = K >> 6;
  const int srow0 = wave * 8 + (lane >> 3);
  const int lc = (lane & 7) ^ ((srow0 >> 1) & 7);
  const int fsw = (l15 >> 1) & 7;
  char* const dst0 = smem + wave * 1024 + lane * 16;
#define TILE_DECODE3(t_, tm_, tn_) { const int xcd_ = (t_) & 7, u_ = (t_) >> 3; const int gs_ = 5 * tilesN; const int g_ = u_ / gs_, r_ = u_ - g_ * gs_; \
    tn_ = r_ / 5; tm_ = (g_ * 5 + (r_ - tn_ * 5)) * 8 + xcd_; }
  if (bid >= ntiles) return;
  int ptile = bid, pkt = 0;
  bool pvalid = true;
  int ptm, ptn;
  TILE_DECODE3(ptile, ptm, ptn)
  const bfr* pA = A + (size_t)((ptm << 8) + srow0) * lda + lc * 8;
  const bfr* pB = Bt + (size_t)((ptn << 7) + srow0) * ldb + lc * 8;
#define DMA_B3(buf_)                                                                                      \
  {                                                                                                       \
    _Pragma("unroll") for (int i = 0; i < 4; ++i)                                                         \
      __builtin_amdgcn_global_load_lds((const unsigned*)(pB + (size_t)(i * 32) * ldb + pkt * 64),         \
                                       (LDS3 unsigned*)(dst0 + 34816 + (buf_) * 16384 + i * 4096), 16, 0, 0); \
  }
#define DMA_A3()                                                                                          \
  {                                                                                                       \
    _Pragma("unroll") for (int i = 0; i < 8; ++i)                                                         \
      __builtin_amdgcn_global_load_lds((const unsigned*)(pA + (size_t)(i * 32) * lda + pkt * 64),         \
                                       (LDS3 unsigned*)(dst0 + i * 4096), 16, 0, 0);                      \
    if (++pkt == nk) {                                                                                    \
      pkt = 0; ptile += nblk;                                                                             \
      if (ptile < ntiles) {                                                                               \
        TILE_DECODE3(ptile, ptm, ptn)                                                                     \
        pA = A + (size_t)((ptm << 8) + srow0) * lda + lc * 8;                                             \
        pB = Bt + (size_t)((ptn << 7) + srow0) * ldb + lc * 8;                                            \
      } else pvalid = false;                                                                              \
    }                                                                                                     \
  }
  __syncthreads();
  DMA_B3(0)
  DMA_A3()
  bool deferred = false;
  int bbuf = 0;
  const char* cA = smem + (wm * 128 + l15) * 128;
  const char* cB0 = smem + 34816 + (wn * 64 + l15) * 128;
  for (int tile = bid; tile < ntiles; tile += nblk) {
    int tm, tn;
    TILE_DECODE3(tile, tm, tn)
    const int m0 = tm << 8, n0 = tn << 7;
    if (deferred) { DMA_A3() deferred = false; }
    f32x4 acc[8][4];
#pragma unroll
    for (int i = 0; i < 8; ++i)
#pragma unroll
      for (int j = 0; j < 4; ++j) acc[i][j] = f32x4{0.f, 0.f, 0.f, 0.f};
    for (int kt = 0; kt < nk; ++kt) {
      asm volatile("s_waitcnt vmcnt(0)\n\ts_barrier" ::: "memory");
      const char* cB = cB0 + bbuf * 16384;
      const int co0 = (quad ^ fsw) * 16, co1 = ((4 + quad) ^ fsw) * 16;
      bf16x8 af[8], bfg[4];
#pragma unroll
      for (int i = 0; i < 4; ++i) bfg[i] = *(const bf16x8*)(cB + i * 2048 + co0);
#pragma unroll
      for (int i = 0; i < 8; ++i) af[i] = *(const bf16x8*)(cA + i * 2048 + co0);
      __builtin_amdgcn_sched_barrier(0);
      if (pvalid) DMA_B3(bbuf ^ 1)
      __builtin_amdgcn_sched_barrier(0);
#pragma unroll
      for (int mt = 0; mt < 8; ++mt)
#pragma unroll
        for (int nt = 0; nt < 4; ++nt)
          acc[mt][nt] = __builtin_amdgcn_mfma_f32_16x16x32_bf16(bfg[nt], af[mt], acc[mt][nt], 0, 0, 0);
      __builtin_amdgcn_sched_barrier(0);
#pragma unroll
      for (int i = 0; i < 4; ++i) bfg[i] = *(const bf16x8*)(cB + i * 2048 + co1);
#pragma unroll
      for (int i = 0; i < 8; ++i) af[i] = *(const bf16x8*)(cA + i * 2048 + co1);
      asm volatile("s_waitcnt lgkmcnt(0)\n\ts_barrier" ::: "memory");
      if (pvalid) {
        if (Epi::kLdsEpi && kt == nk - 1) deferred = true;
        else DMA_A3()
      }
      bbuf ^= 1;
      __builtin_amdgcn_sched_barrier(0);
#pragma unroll
      for (int mt = 0; mt < 8; ++mt)
#pragma unroll
        for (int nt = 0; nt < 4; ++nt)
          acc[mt][nt] = __builtin_amdgcn_mfma_f32_16x16x32_bf16(bfg[nt], af[mt], acc[mt][nt], 0, 0, 0);
      __builtin_amdgcn_sched_barrier(0);
    }
    {
      typename Epi::Pre pre = epi.pre(tn, tid);
      epi.tile256(acc, pre, m0, n0, tn, wm, wn, l15, quad, tid, smem);
    }
    if (Epi::kLdsEpi) lds_barrier();
  }
  asm volatile("s_waitcnt vmcnt(0)" ::: "memory");
}

DEVINL void ffn_edge_phase(const float* __restrict__ EDGE, const float* __restrict__ wdw, bfr* __restrict__ ACT, int bid, int nblk) {
  const int gt = bid * 256 + otid(), nt = nblk * 256;
  for (int i = gt; i < 160 * 2 * 704; i += nt) {
    const int cg4 = i % 704, r2 = i / 704, side = r2 & 1, tm = r2 >> 1;
    const int m0 = tm << 7;
    int tl, Tlen; tok_pos(m0, tl, Tlen);
    if (side == 0 ? (tl == 0) : (tl + 128 == Tlen)) continue;
    const int ja = cg4 * 4;
    const int nb_ = ja >> 6, cc = ja & 63;
    const int ea = nb_ * 128 + cc, eb = ea + 64;
    const float* prev; const float* cur; const float* next;
    if (side == 0) {
      prev = EDGE + ((size_t)(tm - 1) * 4 + 3) * EDGE_LD; cur = EDGE + ((size_t)tm * 4 + 0) * EDGE_LD; next = EDGE + ((size_t)tm * 4 + 1) * EDGE_LD;
    } else {
      prev = EDGE + ((size_t)tm * 4 + 2) * EDGE_LD; cur = EDGE + ((size_t)tm * 4 + 3) * EDGE_LD; next = EDGE + ((size_t)(tm + 1) * 4 + 0) * EDGE_LD;
    }
    const f32x4 a = *(const f32x4*)(wdw + ja) * *(const f32x4*)(prev + ea) + *(const f32x4*)(wdw + 2 * DFF + ja) * *(const f32x4*)(cur + ea) +
                    *(const f32x4*)(wdw + 4 * DFF + ja) * *(const f32x4*)(next + ea);
    const f32x4 b = *(const f32x4*)(wdw + DFF + ja) * *(const f32x4*)(prev + eb) + *(const f32x4*)(wdw + 3 * DFF + ja) * *(const f32x4*)(cur + eb) +
                    *(const f32x4*)(wdw + 5 * DFF + ja) * *(const f32x4*)(next + eb);
    uint2 o;
    o.x = pk2(silu_f(a[0]) * b[0], silu_f(a[1]) * b[1]);
    o.y = pk2(silu_f(a[2]) * b[2], silu_f(a[3]) * b[3]);
    const int m = m0 + (side ? 127 : 0);
    *(uint2*)(ACT + (size_t)m * DFF + ja) = o;
  }
}

DEVINL int up_perm(int n0) {
  if (n0 < DFF) return (n0 >> 6) * 128;
  return ((n0 - DFF) >> 6) * 128 + 64;
}
DEVINL void conv_matrix(const float* __restrict__ src, int K, int N, bfr* __restrict__ dst, int perm,
                        char* smem, int bid, int nblk) {
  float* sT = (float*)smem;
  const int tid = otid();
  const int tilesN = N >> 6;
  const int ntiles = (K >> 6) * tilesN;
  const int r = tid >> 4, c4 = tid & 15;
  int t = bid;
  if (t >= ntiles) return;
  f32x4 v0, v1, v2, v3;
  {
    const int tk = t / tilesN, tn = t - tk * tilesN;
    const float* sp = src + (size_t)((tk << 6) + r) * N + (tn << 6) + c4 * 4;
    v0 = *(const f32x4*)(sp); v1 = *(const f32x4*)(sp + (size_t)16 * N);
    v2 = *(const f32x4*)(sp + (size_t)32 * N); v3 = *(const f32x4*)(sp + (size_t)48 * N);
  }
  for (; t < ntiles; t += nblk) {
    const int tk = t / tilesN, tn = t - tk * tilesN;
    const int k0 = tk << 6, n0 = tn << 6;
    __syncthreads();
    {
      float* d = sT + r * 65 + c4 * 4;
      d[0] = v0[0]; d[1] = v0[1]; d[2] = v0[2]; d[3] = v0[3];
      d[16 * 65 + 0] = v1[0]; d[16 * 65 + 1] = v1[1]; d[16 * 65 + 2] = v1[2]; d[16 * 65 + 3] = v1[3];
      d[32 * 65 + 0] = v2[0]; d[32 * 65 + 1] = v2[1]; d[32 * 65 + 2] = v2[2]; d[32 * 65 + 3] = v2[3];
      d[48 * 65 + 0] = v3[0]; d[48 * 65 + 1] = v3[1]; d[48 * 65 + 2] = v3[2]; d[48 * 65 + 3] = v3[3];
    }
    if (t + nblk < ntiles) {
      const int t2 = t + nblk;
      const int tk2 = t2 / tilesN, tn2 = t2 - tk2 * tilesN;
      const float* sp = src + (size_t)((tk2 << 6) + r) * N + (tn2 << 6) + c4 * 4;
      v0 = *(const f32x4*)(sp); v1 = *(const f32x4*)(sp + (size_t)16 * N);
      v2 = *(const f32x4*)(sp + (size_t)32 * N); v3 = *(const f32x4*)(sp + (size_t)48 * N);
    }
    __syncthreads();
    const int n = tid >> 2, kc = tid & 3;
    uint32_t w[8];
#pragma unroll
    for (int j = 0; j < 8; ++j)
      w[j] = pk2(sT[(kc * 16 + 2 * j) * 65 + n], sT[(kc * 16 + 2 * j + 1) * 65 + n]);
    const int nd = (perm ? up_perm(n0) : n0) + n;
    bfr* dp = dst + (size_t)nd * K + k0 + kc * 16;
    *(uint4*)dp = make_uint4(w[0], w[1], w[2], w[3]);
    *(uint4*)(dp + 8) = make_uint4(w[4], w[5], w[6], w[7]);
  }
}

DEVINL void phase0a(const Params& p, char* smem, int bid, int nblk) {
  const int tid = otid();
  float* sc = (float*)smem;
  float* modp = (float*)(p.ws + OFF_MODP);
  const float* cvec = p.in[3];
  const float* cctx = p.in[4];
  const float* ada_w = p.in[5];
  for (int job = bid; job < 384; job += nblk) {
    const int l = job / 96, r = job - l * 96, ks = r / 6, cgp = r - ks * 6;
    __syncthreads();
    for (int i = tid; i < 320; i += 256) {
      const int cond = i >> 6, kk = i & 63;
      const float v = cond == 0 ? cctx[ks * 64 + kk] : cvec[(cond - 1) * DM + ks * 64 + kk];
      sc[i] = silu_f(v);
    }
    __syncthreads();
    const int col = cgp * 1024 + tid * 4;
    const float* wp = ada_w + ((size_t)l * DM + ks * 64) * 6144 + col;
    float a[5][4];
#pragma unroll
    for (int c = 0; c < 5; ++c)
#pragma unroll
      for (int j = 0; j < 4; ++j) a[c][j] = 0.f;
#pragma unroll 8
    for (int kk = 0; kk < 64; ++kk) {
      const float4 w = *(const float4*)(wp + (size_t)kk * 6144);
#pragma unroll
      for (int c = 0; c < 5; ++c) {
        const float s = sc[c * 64 + kk];
        a[c][0] += s * w.x; a[c][1] += s * w.y; a[c][2] += s * w.z; a[c][3] += s * w.w;
      }
    }
#pragma unroll
    for (int c = 0; c < 5; ++c)
      *(float4*)(modp + ((size_t)(ks * 4 + l) * 5 + c) * 6144 + col) = make_float4(a[c][0], a[c][1], a[c][2], a[c][3]);
  }
  const int gt = bid * 256 + tid, nt = nblk * 256;
  {
    const float* lb = p.in[20];
    float* lbs = (float*)(p.ws + OFF_LBS);
    for (int i = gt; i < 2048; i += nt) {
      const float v0 = lb[i], v1 = lb[2048 + i], v2 = lb[4096 + i], v3 = lb[6144 + i];
      const float mx = fmaxf(fmaxf(v0, v1), fmaxf(v2, v3));
      const float e0 = expf(v0 - mx), e1 = expf(v1 - mx), e2 = expf(v2 - mx), e3 = expf(v3 - mx);
      lbs[i] = (e1 + e2 + e3) / (e0 + e1 + e2 + e3);
    }
  }
  float* X = p.out;
  {
    const float4* xp = (const float4*)p.in[0];
    float4* xo = (float4*)X;
    for (int i = gt; i < NPROMPT * DM / 4; i += nt) xo[i] = xp[i];
    const float* xs = p.in[1];
    for (int i = gt; i < 4096 * 256; i += nt) {
      const int t = i >> 8, c = (i & 255) * 4;
      const int part = c >> 8;
      const float pos = (float)((part < 2) ? (t >> 6) : (t & 63));
      float pe[4];
#pragma unroll
      for (int j = 0; j < 4; ++j) {
        const int jj = (c + j) & 255;
        const float freq = expf((-9.210340371976184f * (float)jj) / 256.0f);
        const float arg = pos * freq;
        pe[j] = (part & 1) ? cosf(arg) : sinf(arg);
      }
#pragma unroll
      for (int b = 0; b < 4; ++b) {
        const size_t off = ((size_t)b * 4096 + t) * DM + c;
        float4 v = *(const float4*)(xs + off);
        v.x += pe[0]; v.y += pe[1]; v.z += pe[2]; v.w += pe[3];
        *(float4*)(X + (size_t)NPROMPT * DM + off) = v;
      }
    }
  }
}

DEVINL void phase0b(const Params& p, int bid, int nblk) {
  const int gt = bid * 256 + otid(), nt = nblk * 256;
  const float* modp = (const float*)(p.ws + OFF_MODP);
  float* mod = (float*)(p.ws + OFF_MOD);
  const float* ada_b = p.in[6];
  for (int i = gt; i < 4 * 5 * 6144; i += nt) {
    const int l = i / 30720, col = i % 6144;
    float s = ada_b[l * 6144 + col];
#pragma unroll
    for (int ks = 0; ks < 16; ++ks) s += modp[(size_t)ks * 122880 + i];
    mod[i] = s;
  }
}

DEVINL void norm_phase(const float* __restrict__ X, const float* __restrict__ g, const float* __restrict__ modl,
                       int shift_off, int scale_off, bfr* __restrict__ H, int bid, int nblk) {
  const int tid = otid(); const int lane = tid & 63;
  const int gw = bid * 4 + (tid >> 6), nw = nblk * 4;
  int row = gw;
  if (row >= MTOK) return;
  f32x4 x0, x1, x2, x3;
  {
    const float* xr = X + (size_t)row * DM + lane * 4;
    x0 = *(const f32x4*)(xr); x1 = *(const f32x4*)(xr + 256); x2 = *(const f32x4*)(xr + 512); x3 = *(const f32x4*)(xr + 768);
  }
  for (; row < MTOK; row += nw) {
    const f32x4 c0 = x0, c1 = x1, c2 = x2, c3 = x3;
    if (row + nw < MTOK) {
      const float* xr = X + (size_t)(row + nw) * DM + lane * 4;
      x0 = *(const f32x4*)(xr); x1 = *(const f32x4*)(xr + 256); x2 = *(const f32x4*)(xr + 512); x3 = *(const f32x4*)(xr + 768);
    }
    float ss = 0.f;
#pragma unroll
    for (int j = 0; j < 4; ++j) ss += c0[j] * c0[j] + c1[j] * c1[j] + c2[j] * c2[j] + c3[j] * c3[j];
    ss = wave_sum(ss, lane);
    const float rstd = rsqrtf(ss * (1.f / DM) + EPS);
    const float* mc = modl + cond_of(row) * 6144;
#pragma unroll
    for (int i = 0; i < 4; ++i) {
      const f32x4 xv = (i == 0) ? c0 : (i == 1) ? c1 : (i == 2) ? c2 : c3;
      const int c = i * 256 + lane * 4;
      const float4 gg = *(const float4*)(g + c);
      const float4 sh = *(const float4*)(mc + shift_off + c);
      const float4 sc = *(const float4*)(mc + scale_off + c);
      const float h0 = xv[0] * rstd * gg.x * (1.f + sc.x) + sh.x;
      const float h1 = xv[1] * rstd * gg.y * (1.f + sc.y) + sh.y;
      const float h2 = xv[2] * rstd * gg.z * (1.f + sc.z) + sh.z;
      const float h3 = xv[3] * rstd * gg.w * (1.f + sc.w) + sh.w;
      uint2 o; o.x = pk2(h0, h1); o.y = pk2(h2, h3);
      *(uint2*)(H + (size_t)row * DM + c) = o;
    }
  }
}

DEVINL void final_norm_phase(float* X, const float* __restrict__ g, int bid, int nblk) {
  const int tid = otid(); const int lane = tid & 63;
  const int gw = bid * 4 + (tid >> 6), nw = nblk * 4;
  for (int row = gw; row < MTOK; row += nw) {
    float* xr = X + (size_t)row * DM;
    float4 x[4];
    float ss = 0.f;
#pragma unroll
    for (int i = 0; i < 4; ++i) {
      x[i] = *(const float4*)(xr + i * 256 + lane * 4);
      ss += x[i].x * x[i].x + x[i].y * x[i].y + x[i].z * x[i].z + x[i].w * x[i].w;
    }
    ss = wave_sum(ss, lane);
    const float rstd = rsqrtf(ss * (1.f / DM) + EPS);
#pragma unroll
    for (int i = 0; i < 4; ++i) {
      const int c = i * 256 + lane * 4;
      const float4 gg = *(const float4*)(g + c);
      float4 o;
      o.x = x[i].x * rstd * gg.x; o.y = x[i].y * rstd * gg.y; o.z = x[i].z * rstd * gg.z; o.w = x[i].w * rstd * gg.w;
      *(float4*)(xr + c) = o;
    }
  }
}

DEVINL void shortconv_ew_phase(const bfr* __restrict__ G, const float* __restrict__ wdw, bfr* __restrict__ U, int bid, int nblk) {
  const int gt = bid * 256 + otid(), nt = nblk * 256;
  for (int i = gt; i < MTOK * 128; i += nt) {
    const int m = i >> 7, c = (i & 127) * 8;
    int tl, T; tok_pos(m, tl, T);
    const bfr* gr = G + (size_t)m * 3072;
    const uint4 bg = *(const uint4*)(gr + c);
    float accv[8];
#pragma unroll
    for (int j = 0; j < 8; ++j) accv[j] = 0.f;
#pragma unroll
    for (int tap = 0; tap < 3; ++tap) {
      const int d = tap - 1;
      if ((d < 0 && tl == 0) || (d > 0 && tl == T - 1)) continue;
      const bfr* nr = gr + (ptrdiff_t)d * 3072;
      const uint4 cgv = *(const uint4*)(nr + 1024 + c);
      const uint4 xhv = *(const uint4*)(nr + 2048 + c);
      const float4 w0 = *(const float4*)(wdw + tap * DM + c);
      const float4 w1 = *(const float4*)(wdw + tap * DM + c + 4);
      accv[0] += w0.x * bflo(cgv.x) * bflo(xhv.x); accv[1] += w0.y * bfhi(cgv.x) * bfhi(xhv.x);
      accv[2] += w0.z * bflo(cgv.y) * bflo(xhv.y); accv[3] += w0.w * bfhi(cgv.y) * bfhi(xhv.y);
      accv[4] += w1.x * bflo(cgv.z) * bflo(xhv.z); accv[5] += w1.y * bfhi(cgv.z) * bfhi(xhv.z);
      accv[6] += w1.z * bflo(cgv.w) * bflo(xhv.w); accv[7] += w1.w * bfhi(cgv.w) * bfhi(xhv.w);
    }
    uint4 o;
    o.x = pk2(bflo(bg.x) * accv[0], bfhi(bg.x) * accv[1]);
    o.y = pk2(bflo(bg.y) * accv[2], bfhi(bg.y) * accv[3]);
    o.z = pk2(bflo(bg.z) * accv[4], bfhi(bg.z) * accv[5]);
    o.w = pk2(bflo(bg.w) * accv[6], bfhi(bg.w) * accv[7]);
    *(uint4*)(U + (size_t)m * DM + c) = o;
  }
}

DEVINL void pool_ew_phase(const bfr* __restrict__ H, bfr* __restrict__ P, int bid, int nblk) {
  const int gt = bid * 256 + otid(), nt = nblk * 256;
  for (int i = gt; i < MTOK * 128; i += nt) {
    const int m = i >> 7, ch = i & 127, c = ch * 8;
    int tl, T; tok_pos(m, tl, T);
    const int hw = 1 << (ch >> 5);
    const int lo = max(tl - hw, 0), hi = min(tl + hw, T);
    float s[8];
#pragma unroll
    for (int j = 0; j < 8; ++j) s[j] = 0.f;
    const bfr* base = H + (size_t)(m - tl) * DM + c;
    uint4 wv[16];
#pragma unroll
    for (int j = 0; j < 16; ++j) {
      const int q = tl - hw + j;
      const bool ok = (j < 2 * hw) && (q >= 0) && (q < T);
      wv[j] = ok ? *(const uint4*)(base + (size_t)q * DM) : make_uint4(0u, 0u, 0u, 0u);
    }
#pragma unroll
    for (int j = 0; j < 16; ++j) {
      const uint4 v = wv[j];
      s[0] += bflo(v.x); s[1] += bfhi(v.x); s[2] += bflo(v.y); s[3] += bfhi(v.y);
      s[4] += bflo(v.z); s[5] += bfhi(v.z); s[6] += bflo(v.w); s[7] += bfhi(v.w);
    }
    const float inv = 1.f / (float)(hi - lo);
    const uint4 v = *(const uint4*)(base + (size_t)tl * DM);
    uint4 o;
    o.x = pk2(s[0] * inv - bflo(v.x), s[1] * inv - bfhi(v.x));
    o.y = pk2(s[2] * inv - bflo(v.y), s[3] * inv - bfhi(v.y));
    o.z = pk2(s[4] * inv - bflo(v.z), s[5] * inv - bfhi(v.z));
    o.w = pk2(s[6] * inv - bflo(v.w), s[7] * inv - bfhi(v.w));
    *(uint4*)(P + (size_t)m * DM + c) = o;
  }
}

DEVINL void sgu_norm_phase(bfr* UV, const float* __restrict__ g, int bid, int nblk) {
  const int tid = otid(); const int lane = tid & 63;
  const int gw = bid * 4 + (tid >> 6), nw = nblk * 4;
  for (int row = gw; row < MTOK; row += nw) {
    bfr* vr = UV + (size_t)row * 2048 + 1024;
    float x[4][4];
    float ss = 0.f;
#pragma unroll
    for (int i = 0; i < 4; ++i) {
      const uint2 v = *(const uint2*)(vr + i * 256 + lane * 4);
      x[i][0] = bflo(v.x); x[i][1] = bfhi(v.x); x[i][2] = bflo(v.y); x[i][3] = bfhi(v.y);
      ss += x[i][0] * x[i][0] + x[i][1] * x[i][1] + x[i][2] * x[i][2] + x[i][3] * x[i][3];
    }
    ss = wave_sum(ss, lane);
    const float rstd = rsqrtf(ss * (1.f / DM) + EPS);
#pragma unroll
    for (int i = 0; i < 4; ++i) {
      const int c = i * 256 + lane * 4;
      const float4 gg = *(const float4*)(g + c);
      uint2 o;
      o.x = pk2(x[i][0] * rstd * gg.x, x[i][1] * rstd * gg.y);
      o.y = pk2(x[i][2] * rstd * gg.z, x[i][3] * rstd * gg.w);
      *(uint2*)(vr + c) = o;
    }
  }
}

DEVINL void sgu_spatial_phase(bfr* UV, const float* __restrict__ ws_, const float* __restrict__ bs_, char* smem, int bid, int nblk) {
  bfr* sV = (bfr*)smem;
  bfr* sW = sV + 128 * 136;
  const int tid = otid(), lane = tid & 63, wave = tid >> 6, l15 = lane & 15, quad = lane >> 4;
  for (int item = bid; item < 160 * 8; item += nblk) {
    const int chunk = item >> 3, g = item & 7;
    __syncthreads();
    const float* wg = ws_ + (size_t)g * 16384;
#pragma unroll 4
    for (int i = 0; i < 16; ++i) {
      const int idx = tid + 256 * i;
      const int row = idx >> 5, chn = idx & 31;
      const float4 v = *(const float4*)(wg + row * 128 + chn * 4);
      uint2 o; o.x = pk2(v.x, v.y); o.y = pk2(v.z, v.w);
      *(uint2*)(sW + row * 136 + chn * 4) = o;
    }
#pragma unroll 2
    for (int i = 0; i < 8; ++i) {
      const int idx = tid + 256 * i;
      const int q = idx >> 4, chn = idx & 15;
      const uint4 v = *(const uint4*)(UV + (size_t)(chunk * 128 + q) * 2048 + 1024 + g * 128 + chn * 8);
      bfr* d = sV + (chn * 8) * 136 + q;
      d[0 * 136] = (bfr)(v.x & 0xffff); d[1 * 136] = (bfr)(v.x >> 16);
      d[2 * 136] = (bfr)(v.y & 0xffff); d[3 * 136] = (bfr)(v.y >> 16);
      d[4 * 136] = (bfr)(v.z & 0xffff); d[5 * 136] = (bfr)(v.z >> 16);
      d[6 * 136] = (bfr)(v.w & 0xffff); d[7 * 136] = (bfr)(v.w >> 16);
    }
    __syncthreads();
    f32x4 acc[8][2];
#pragma unroll
    for (int i = 0; i < 8; ++i) { acc[i][0] = f32x4{0.f, 0.f, 0.f, 0.f}; acc[i][1] = f32x4{0.f, 0.f, 0.f, 0.f}; }
#pragma unroll
    for (int kk = 0; kk < 4; ++kk) {
      bf16x8 bw[2];
#pragma unroll
      for (int pt = 0; pt < 2; ++pt) bw[pt] = *(const bf16x8*)(sW + (wave * 32 + pt * 16 + l15) * 136 + kk * 32 + quad * 8);
#pragma unroll
      for (int ct = 0; ct < 8; ++ct) {
        const bf16x8 av = *(const bf16x8*)(sV + (ct * 16 + l15) * 136 + kk * 32 + quad * 8);
#pragma unroll
        for (int pt = 0; pt < 2; ++pt)
          acc[ct][pt] = __builtin_amdgcn_mfma_f32_16x16x32_bf16(av, bw[pt], acc[ct][pt], 0, 0, 0);
      }
    }
#pragma unroll
    for (int pt = 0; pt < 2; ++pt) {
      const int pp = wave * 32 + pt * 16 + l15;
      const float bias = bs_[g * 128 + pp];
      bfr* ur = UV + (size_t)(chunk * 128 + pp) * 2048 + g * 128 + quad * 4;
#pragma unroll
      for (int ct = 0; ct < 8; ++ct) {
        const uint2 u = *(const uint2*)(ur + ct * 16);
        uint2 o;
        o.x = pk2(bflo(u.x) * (acc[ct][pt][0] + bias), bfhi(u.x) * (acc[ct][pt][1] + bias));
        o.y = pk2(bflo(u.y) * (acc[ct][pt][2] + bias), bfhi(u.y) * (acc[ct][pt][3] + bias));
        *(uint2*)(ur + ct * 16) = o;
      }
    }
  }
}

DEVINL void hgrn_scan_phase(const Params& p, char* smem, int bid, int nblk, const int mode) {
  bfr* sQe = (bfr*)smem;
  bfr* sKe = sQe + 32 * 136;
  bfr* sKeT = sKe + 32 * 136;
  bfr* sVT = sKeT + 128 * 40;
  bfr* sP = sVT + 64 * 40;
  bfr* sST = sP + 32 * 40;
  float* sLast = (float*)(sST + 64 * 136);
  float* sTot = sLast + 128;
  const int tid = otid(), lane = tid & 63, wave = tid >> 6, l15 = lane & 15, quad = lane >> 4;
  const int cp = lane, qt = wave, i0 = qt * 8;
  const bfr* QZ = (const bfr*)(p.ws + OFF_BIG);
  bfr* Of = (bfr*)(p.ws + OFF_H);
  bfr* Ob = (bfr*)(p.ws + OFF_BIG + 209715200ull);
  const float* lbs = (const float*)(p.ws + OFF_LBS);
  const float* state_rec = p.in[2];
  float* out_state = p.out + (size_t)MTOK * DM;

  float* SLOC = (float*)(p.ws + OFF_BIG + 251658240ull);
  float* DLOC = (float*)(p.ws + OFF_BIG + 251658240ull + 33554432ull);
  const int nitems = mode ? 1536 : 896;
  for (int item = bid; item < nitems; item += nblk) {
    const int eh = item & 1, dir = (item >> 1) & 1, h = (item >> 2) & 7;
    int base, T, nchunks, pos0, slot, seq;
    bool is_prompt = false;
    if (!mode) {
      const int r = item >> 5, seqb = r / 7, j = r - seqb * 7;
      seq = 16 + seqb; base = NPROMPT + seqb * 4096; T = 4096; nchunks = 16; pos0 = j * 512;
      slot = ((seqb * 8 + j) * 8 + h) * 2 + dir;
    } else if (item < 1024) {
      const int r = item >> 5, seqb = r >> 3, j = r & 7;
      seq = 16 + seqb; base = NPROMPT + seqb * 4096; T = 4096; nchunks = 16; pos0 = j * 512;
      slot = ((seqb * 8 + j) * 8 + h) * 2 + dir;
    } else {
      seq = (item - 1024) >> 5; base = seq * 256; T = 256; nchunks = 8; pos0 = 0; slot = 0;
      is_prompt = true;
    }
    bfr* Od = dir ? Ob : Of;
    const float lbv0 = lbs[dir * 1024 + h * 128 + 2 * cp], lbv1 = lbs[dir * 1024 + h * 128 + 2 * cp + 1];
    const int eloc = wave * 16 + l15;
    const int eglob = eh * 64 + eloc;

    f32x4 S[8];
    if (is_prompt || !mode) {
#pragma unroll
      for (int dt = 0; dt < 8; ++dt) S[dt] = f32x4{0.f, 0.f, 0.f, 0.f};
    } else {
      const float* s0 = SLOC + (size_t)slot * 16384;
#pragma unroll
      for (int dt = 0; dt < 8; ++dt)
#pragma unroll
        for (int j = 0; j < 4; ++j) S[dt][j] = s0[(dt * 16 + quad * 4 + j) * 128 + eglob];
    }
    float cum0 = 1.f, cum1 = 1.f;
    __syncthreads();
#pragma unroll
    for (int dt = 0; dt < 8; ++dt) {
      uint2 o; o.x = pk2(S[dt][0], S[dt][1]); o.y = pk2(S[dt][2], S[dt][3]);
      *(uint2*)(sST + eloc * 136 + dt * 16 + quad * 4) = o;
    }

    const unsigned qoff2 = h * 64 + cp, zoff2 = (1 + dir) * 512 + h * 64 + cp;
    const unsigned voff2 = 1536 + h * 64 + eh * 32 + (cp & 31);
    const uint32_t* __restrict__ QZ32 = (const uint32_t*)QZ;
    uint32_t rq[8], rz[8], rv[8];
#pragma unroll
    for (int ii = 0; ii < 8; ++ii) {
      const int pos = pos0 + i0 + ii;
      const unsigned tok = dir ? base + T - 1 - pos : base + pos;
      const unsigned ri = tok * 2560u;
      rq[ii] = QZ32[ri + qoff2]; rz[ii] = QZ32[ri + zoff2]; rv[ii] = QZ32[ri + voff2];
    }

    for (int c = 0; c < nchunks; ++c) {
      float pc0[8], pc1[8], kv0[8], kv1[8];
      float run0 = 1.f, run1 = 1.f;
#pragma unroll
      for (int ii = 0; ii < 8; ++ii) {
        const float z0 = bflo(rz[ii]), z1 = bfhi(rz[ii]);
        const float f0 = lbv0 + (1.f - lbv0) * frcp(1.f + __expf(-z0));
        const float f1 = lbv1 + (1.f - lbv1) * frcp(1.f + __expf(-z1));
        run0 *= f0; run1 *= f1;
        pc0[ii] = run0; pc1[ii] = run1;
        kv0[ii] = 1.f - f0; kv1[ii] = 1.f - f1;
      }
      *(float2*)(sTot + qt * 128 + 2 * cp) = make_float2(run0, run1);
      __syncthreads();
      {
        float off0 = 1.f, off1 = 1.f, tot0 = 1.f, tot1 = 1.f;
#pragma unroll
        for (int q = 0; q < 4; ++q) {
          const float2 t = *(const float2*)(sTot + q * 128 + 2 * cp);
          if (q < qt) { off0 *= t.x; off1 *= t.y; }
          tot0 *= t.x; tot1 *= t.y;
        }
        uint32_t wk0[4], wk1[4], wv0[4], wv1[4];
#pragma unroll
        for (int ii = 0; ii < 8; ii += 2) {
          uint32_t kp[2];
#pragma unroll
          for (int u = 0; u < 2; ++u) {
            const float e0 = pc0[ii + u] * off0, e1 = pc1[ii + u] * off1;
            kp[u] = pk2(kv0[ii + u] * frcp(e0), kv1[ii + u] * frcp(e1));
            *(uint32_t*)(sKe + (i0 + ii + u) * 136 + 2 * cp) = kp[u];
            if (mode) *(uint32_t*)(sQe + (i0 + ii + u) * 136 + 2 * cp) = pk2(bflo(rq[ii + u]) * e0, bfhi(rq[ii + u]) * e1);
          }
          wk0[ii >> 1] = (kp[0] & 0xffffu) | (kp[1] << 16);
          wk1[ii >> 1] = (kp[0] >> 16) | (kp[1] & 0xffff0000u);
          wv0[ii >> 1] = (rv[ii] & 0xffffu) | (rv[ii + 1] << 16);
          wv1[ii >> 1] = (rv[ii] >> 16) | (rv[ii + 1] & 0xffff0000u);
        }
        *(u32x4*)(sKeT + (2 * cp) * 40 + i0) = u32x4{wk0[0], wk0[1], wk0[2], wk0[3]};
        *(u32x4*)(sKeT + (2 * cp + 1) * 40 + i0) = u32x4{wk1[0], wk1[1], wk1[2], wk1[3]};
        if (cp < 32) {
          *(u32x4*)(sVT + (2 * cp) * 40 + i0) = u32x4{wv0[0], wv0[1], wv0[2], wv0[3]};
          *(u32x4*)(sVT + (2 * cp + 1) * 40 + i0) = u32x4{wv1[0], wv1[1], wv1[2], wv1[3]};
        }
        if (qt == 0) *(float2*)(sLast + 2 * cp) = make_float2(tot0, tot1);
        cum0 *= tot0; cum1 *= tot1;
      }
      if (c + 1 < nchunks) {
#pragma unroll
        for (int ii = 0; ii < 8; ++ii) {
          const int pos = pos0 + (c + 1) * 32 + i0 + ii;
          const unsigned tok = dir ? base + T - 1 - pos : base + pos;
          const unsigned ri = tok * 2560u;
          rq[ii] = QZ32[ri + qoff2]; rz[ii] = QZ32[ri + zoff2]; rv[ii] = QZ32[ri + voff2];
        }
      }
      __syncthreads();
      if (mode) {
        const int ti = wave >> 1, si = wave & 1;
        f32x4 sc = f32x4{0.f, 0.f, 0.f, 0.f};
        if (si <= ti) {
#pragma unroll
          for (int kk = 0; kk < 4; ++kk) {
            const bf16x8 a = *(const bf16x8*)(sQe + (ti * 16 + l15) * 136 + kk * 32 + quad * 8);
            const bf16x8 b = *(const bf16x8*)(sKe + (si * 16 + l15) * 136 + kk * 32 + quad * 8);
            sc = __builtin_amdgcn_mfma_f32_16x16x32_bf16(a, b, sc, 0, 0, 0);
          }
        }
#pragma unroll
        for (int j = 0; j < 4; ++j) {
          const int t = ti * 16 + quad * 4 + j, s2 = si * 16 + l15;
          sP[t * 40 + s2] = (s2 <= t) ? f2bf(sc[j]) : (bfr)0;
        }
      }
      f32x4 oacc[2];
      oacc[0] = f32x4{0.f, 0.f, 0.f, 0.f}; oacc[1] = f32x4{0.f, 0.f, 0.f, 0.f};
      if (mode) {
#pragma unroll
      for (int kk = 0; kk < 4; ++kk) {
        const bf16x8 sb = *(const bf16x8*)(sST + eloc * 136 + kk * 32 + quad * 8);
#pragma unroll
        for (int tt = 0; tt < 2; ++tt) {
          const bf16x8 qa = *(const bf16x8*)(sQe + (tt * 16 + l15) * 136 + kk * 32 + quad * 8);
          oacc[tt] = __builtin_amdgcn_mfma_f32_16x16x32_bf16(sb, qa, oacc[tt], 0, 0, 0);
        }
      }
      }
      __syncthreads();
      {
        const bf16x8 vb = *(const bf16x8*)(sVT + eloc * 40 + quad * 8);
        if (mode) {
#pragma unroll
        for (int tt = 0; tt < 2; ++tt) {
          const bf16x8 pb = *(const bf16x8*)(sP + (tt * 16 + l15) * 40 + quad * 8);
          oacc[tt] = __builtin_amdgcn_mfma_f32_16x16x32_bf16(vb, pb, oacc[tt], 0, 0, 0);
          const int pos = pos0 + c * 32 + tt * 16 + l15;
          const int tok = dir ? base + T - 1 - pos : base + pos;
          uint2 o; o.x = pk2(oacc[tt][0], oacc[tt][1]); o.y = pk2(oacc[tt][2], oacc[tt][3]);
          *(uint2*)(Od + (size_t)tok * DM + h * 128 + eh * 64 + wave * 16 + quad * 4) = o;
        }
        }
#pragma unroll
        for (int dt = 0; dt < 8; ++dt) {
          const bf16x8 ka = *(const bf16x8*)(sKeT + (dt * 16 + l15) * 40 + quad * 8);
          const float4 dl = *(const float4*)(sLast + dt * 16 + quad * 4);
          f32x4 sn = __builtin_amdgcn_mfma_f32_16x16x32_bf16(ka, vb, S[dt], 0, 0, 0);
          sn[0] *= dl.x; sn[1] *= dl.y; sn[2] *= dl.z; sn[3] *= dl.w;
          S[dt] = sn;
          uint2 o; o.x = pk2(sn[0], sn[1]); o.y = pk2(sn[2], sn[3]);
          *(uint2*)(sST + eloc * 136 + dt * 16 + quad * 4) = o;
        }
      }
    }
    if (is_prompt || !mode) {
      float* so = is_prompt ? out_state + ((size_t)(seq * 2 + dir) * 8 + h) * 16384 : SLOC + (size_t)slot * 16384;
#pragma unroll
      for (int dt = 0; dt < 8; ++dt)
#pragma unroll
        for (int j = 0; j < 4; ++j) so[(dt * 16 + quad * 4 + j) * 128 + eglob] = S[dt][j];
      if (!mode && eh == 0 && qt == 0) *(float2*)(DLOC + slot * 128 + 2 * cp) = make_float2(cum0, cum1);
    }
  }
}

DEVINL void hgrn_combine_phase(const Params& p, int bid, int nblk) {
  const int gt = bid * 256 + otid(), nt = nblk * 256;
  float* SLOC = (float*)(p.ws + OFF_BIG + 251658240ull);
  const float* DLOC = (const float*)(p.ws + OFF_BIG + 251658240ull + 33554432ull);
  const float* state_rec = p.in[2];
  for (int idx = gt; idx < 4 * 8 * 2 * 16384; idx += nt) {
    const int de = idx & 16383, r = idx >> 14;
    const int dir = r & 1, h = (r >> 1) & 7, seqb = r >> 4;
    const int d = de >> 7;
    float prev = state_rec[((size_t)(seqb * 2 + dir) * 8 + h) * 16384 + de];
#pragma unroll
    for (int j = 0; j < 8; ++j) {
      const int slot = ((seqb * 8 + j) * 8 + h) * 2 + dir;
      float* ptr = SLOC + (size_t)slot * 16384 + de;
      const float a = (j < 7) ? *ptr : 0.f;
      *ptr = prev;
      if (j < 7) prev = DLOC[slot * 128 + d] * prev + a;
    }
  }
}

DEVINL void hgrn_gate_phase(const Params& p, const float* __restrict__ ng, int bid, int nblk) {
  const int tid = otid(); const int lane = tid & 63;
  const int gw = bid * 4 + (tid >> 6), nw = nblk * 4;
  bfr* Of = (bfr*)(p.ws + OFF_H);
  const bfr* Ob = (const bfr*)(p.ws + OFF_BIG + 209715200ull);
  const bfr* QZ = (const bfr*)(p.ws + OFF_BIG);
  for (int row = gw; row < MTOK; row += nw) {
#pragma unroll
    for (int seg = 0; seg < 4; ++seg) {
      const int c = seg * 256 + lane * 4;
      const uint2 a = *(const uint2*)(Of + (size_t)row * DM + c);
      const uint2 b = *(const uint2*)(Ob + (size_t)row * DM + c);
      const uint2 gq = *(const uint2*)(QZ + (size_t)row * 5120 + 4096 + c);
      const float o0 = bflo(a.x) + bflo(b.x), o1 = bfhi(a.x) + bfhi(b.x), o2 = bflo(a.y) + bflo(b.y), o3 = bfhi(a.y) + bfhi(b.y);
      float ss = o0 * o0 + o1 * o1 + o2 * o2 + o3 * o3;
#pragma unroll
      for (int o = 16; o > 0; o >>= 1) ss += shx(ss, o, lane);
      const float rstd = rsqrtf(ss * (1.f / 128.f) + EPS);
      const float4 gg = *(const float4*)(ng + c);
      uint2 o;
      o.x = pk2(o0 * rstd * gg.x * silu_f(bflo(gq.x)), o1 * rstd * gg.y * silu_f(bfhi(gq.x)));
      o.y = pk2(o2 * rstd * gg.z * silu_f(bflo(gq.y)), o3 * rstd * gg.w * silu_f(bfhi(gq.y)));
      *(uint2*)(Of + (size_t)row * DM + c) = o;
    }
  }
}

DEVINL void ffn_act_phase(const bfr* __restrict__ UP, const float* __restrict__ wdw, int hf, bfr* __restrict__ ACT, int bid, int nblk) {
  const int gt = bid * 256 + otid(), nt = nblk * 256;
  for (int i = gt; i < MTOK * 176; i += nt) {
    const int m = i / 176, j = (i - m * 176) * 8;
    int tl, T; tok_pos(m, tl, T);
    const bfr* ur = UP + (size_t)m * DFF;
    float a[8], b[8];
#pragma unroll
    for (int q = 0; q < 8; ++q) { a[q] = 0.f; b[q] = 0.f; }
#pragma unroll
    for (int tap = 0; tap < 3; ++tap) {
      const int d = tap - 1;
      if ((d < 0 && tl == 0) || (d > 0 && tl == T - 1)) continue;
      const bfr* nr = ur + (ptrdiff_t)d * DFF;
      const uint4 av = *(const uint4*)(nr + j);
      const uint4 bv = *(const uint4*)(nr + HALF_FF + j);
      const float* wa = wdw + tap * (2 * DFF) + hf * HALF_FF + j;
      const float* wb = wdw + tap * (2 * DFF) + DFF + hf * HALF_FF + j;
      const float4 wa0 = *(const float4*)wa, wa1 = *(const float4*)(wa + 4);
      const float4 wb0 = *(const float4*)wb, wb1 = *(const float4*)(wb + 4);
      a[0] += wa0.x * bflo(av.x); a[1] += wa0.y * bfhi(av.x); a[2] += wa0.z * bflo(av.y); a[3] += wa0.w * bfhi(av.y);
      a[4] += wa1.x * bflo(av.z); a[5] += wa1.y * bfhi(av.z); a[6] += wa1.z * bflo(av.w); a[7] += wa1.w * bfhi(av.w);
      b[0] += wb0.x * bflo(bv.x); b[1] += wb0.y * bfhi(bv.x); b[2] += wb0.z * bflo(bv.y); b[3] += wb0.w * bfhi(bv.y);
      b[4] += wb1.x * bflo(bv.z); b[5] += wb1.y * bfhi(bv.z); b[6] += wb1.z * bflo(bv.w); b[7] += wb1.w * bfhi(bv.w);
    }
    uint4 o;
    o.x = pk2(silu_f(a[0]) * b[0], silu_f(a[1]) * b[1]);
    o.y = pk2(silu_f(a[2]) * b[2], silu_f(a[3]) * b[3]);
    o.z = pk2(silu_f(a[4]) * b[4], silu_f(a[5]) * b[5]);
    o.w = pk2(silu_f(a[6]) * b[6], silu_f(a[7]) * b[7]);
    *(uint4*)(ACT + (size_t)m * DFF + hf * HALF_FF + j) = o;
  }
}


#define XB_TMO      128
#define XB_XCNT(j)  (256  + 64 * (j))
#define XB_XSUB(j)  (1280 + 64 * (j))
#define XB_XGEN(j)  (2304 + 64 * (j))
#define XB_TOP      3328
#define XB_TOPGEN   3392
#define XCD_BAR_WORDS 3456
#define XB_SPIN_CAP (1u << 22)
#define LAS __attribute__((address_space(3)))
DEVINL unsigned xb_ld(unsigned* p) { return __hip_atomic_load(p, __ATOMIC_RELAXED, __HIP_MEMORY_SCOPE_AGENT); }
DEVINL unsigned xb_add(unsigned* p, unsigned v) { return __hip_atomic_fetch_add(p, v, __ATOMIC_RELAXED, __HIP_MEMORY_SCOPE_AGENT); }
DEVINL unsigned xb_xcc_id() { return (unsigned)__builtin_amdgcn_s_getreg((3 << 11) | 20) & 0xFu; }
#define XB_SPIN(cond, bar) do { unsigned _sp = 0; while (cond) { __builtin_amdgcn_s_sleep(1); \
    if ((++_sp & 255u) == 0u) { if (xb_ld(&(bar)[XB_TMO])) break; if (_sp > XB_SPIN_CAP) { atomicAdd(&(bar)[XB_TMO], 1u); break; } } } } while (0)
struct XcdBarrier { unsigned* bar; unsigned x; volatile LAS unsigned* st; };
DEVINL XcdBarrier xcd_barrier_post(unsigned* bar, volatile LAS unsigned* st) {
  XcdBarrier b; b.bar = bar; b.x = xb_xcc_id(); b.st = st;
  if (threadIdx.x == 0) (void)xb_add(&bar[XB_XCNT(b.x)], 1u);
  return b;
}
DEVINL void xcd_barrier_complete(unsigned* bar, unsigned x, unsigned& nloc, unsigned& nx) {
  const unsigned G = gridDim.x * gridDim.y * gridDim.z;
  unsigned sum, cnt, mine, sp = 0u;
  for (;;) {
    sum = 0u; cnt = 0u; mine = 0u;
#pragma unroll
    for (unsigned j = 0; j < 16; ++j) { const unsigned c = xb_ld(&bar[XB_XCNT(j)]); sum += c; cnt += (c > 0u) ? 1u : 0u; mine = (j == x) ? c : mine; }
    if (sum == G) break;
    __builtin_amdgcn_s_sleep(1);
    if ((++sp & 255u) == 0u) { if (xb_ld(&bar[XB_TMO])) break; if (sp > XB_SPIN_CAP) { atomicAdd(&bar[XB_TMO], 1u); break; } }
  }
  nloc = mine > 0u ? mine : 1u; nx = cnt > 0u ? cnt : 1u;
}
DEVINL void xcd_barrier(const XcdBarrier& b) {
  asm volatile("s_waitcnt vmcnt(0)" ::: "memory");
  __syncthreads();
  if (threadIdx.x == 0) {
    unsigned* bar = b.bar;
    unsigned bx = b.x;
    asm volatile("" : "+s"(bar), "+s"(bx));
    __builtin_amdgcn_s_waitcnt(0);
    unsigned nloc = b.st[0], nx = b.st[1];
    if (nloc == 0u) { xcd_barrier_complete(bar, bx, nloc, nx); b.st[0] = nloc; b.st[1] = nx; }
    const unsigned old = xb_add(&bar[XB_XSUB(bx)], 1u);
    const unsigned gen = old / nloc;
    if (old + 1u == (gen + 1u) * nloc) {
      __builtin_amdgcn_fence(__ATOMIC_RELEASE, "agent");
      asm volatile("s_waitcnt vmcnt(0)" ::: "memory");
      const unsigned og = xb_add(&bar[XB_TOP], 1u);
      const unsigned tg = og / nx;
      if (og + 1u == (tg + 1u) * nx) xb_add(&bar[XB_TOPGEN], 1u);
      else XB_SPIN(xb_ld(&bar[XB_TOPGEN]) == tg, bar);
      __builtin_amdgcn_fence(__ATOMIC_ACQUIRE, "agent");
      xb_add(&bar[XB_XGEN(bx)], 1u);
      asm volatile("s_waitcnt vmcnt(0)" ::: "memory");
    } else {
      XB_SPIN(xb_ld(&bar[XB_XGEN(bx)]) == gen, bar);
      __builtin_amdgcn_fence(__ATOMIC_ACQUIRE, "agent");
      asm volatile("s_waitcnt vmcnt(0)" ::: "memory");
    }
  }
  __syncthreads();
}

constexpr int SMEM_BYTES = 77824;

__global__ void __launch_bounds__(256, 2) mega_kernel(Params p) {
  __shared__ __attribute__((aligned(16))) char smem[SMEM_BYTES];
  cg::grid_group grid = cg::this_grid();
  __shared__ uint4 xb_words;
  if (threadIdx.x == 0) xb_words = make_uint4(0u, 0u, 0u, 0u);
  __syncthreads();
  XcdBarrier xb = xcd_barrier_post((unsigned*)(p.ws + OFF_BAR), (volatile LAS unsigned*)&xb_words);
  const int bid = blockIdx.x, nblk = gridDim.x;

  phase0a(p, smem, osg(bid), nblk);
  grid.sync();
  phase0b(p, osg(bid), nblk);
  xcd_barrier(xb);

  for (int layer = 0; layer < 4; ++layer) {
    Params q = p;
    {
      size_t oz = 0;
      asm volatile("" : "+s"(oz));
      q.ws = p.ws + oz;
      q.out = p.out + oz;
    }
    float* X = q.out;
    bfr* WB = (bfr*)(q.ws + OFF_WB);
    bfr* H = (bfr*)(q.ws + OFF_H);
    bfr* BIG = (bfr*)(q.ws + OFF_BIG);
    const float* MOD = (const float*)(q.ws + OFF_MOD);
    const float* modl = MOD + layer * 30720;
    if (layer == 0) {
      conv_matrix(q.in[9], 1024, 3072, WB + WB_IN, 0, smem, osg(bid), nblk);
      conv_matrix(q.in[11], 1024, 1024, WB + WB_OUT, 0, smem, osg(bid), nblk);
    } else if (layer == 1) {
      for (int g = 0; g < 4; ++g) conv_matrix(q.in[12] + g * 65536, 256, 256, WB + WB_IN + g * 65536, 0, smem, osg(bid), nblk);
    } else if (layer == 2) {
      conv_matrix(q.in[14], 1024, 2048, WB + WB_IN, 0, smem, osg(bid), nblk);
      conv_matrix(q.in[18], 1024, 1024, WB + WB_OUT, 0, smem, osg(bid), nblk);
    } else {
      conv_matrix(q.in[19], 1024, 5120, WB + WB_IN, 0, smem, osg(bid), nblk);
      conv_matrix(q.in[22], 1024, 1024, WB + WB_OUT, 0, smem, osg(bid), nblk);
    }
    conv_matrix(q.in[23] + (size_t)layer * 1024 * 5632, 1024, 5632, WB + WB_UP, 1, smem, osg(bid), nblk);
    conv_matrix(q.in[25] + (size_t)layer * DFF * 1024, DFF, 1024, WB + WB_DOWN, 0, smem, osg(bid), nblk);
    norm_phase(X, q.in[7] + (layer * 2 + 0) * DM, modl, 0, 1024, H, osg(bid), nblk);
    xcd_barrier(xb);

    if (layer == 0) {
      bfr* G = BIG;
      bfr* U = BIG + (size_t)MTOK * 3072;
      gemm256s_phase(H, DM, WB + WB_IN, 1024, 3072, 1024, EpiStore{G, 3072}, smem, osg(bid), nblk);
      xcd_barrier(xb);
      shortconv_ew_phase(G, q.in[10], U, osg(bid), nblk);
      xcd_barrier(xb);
      gemm_phase(U, DM, WB + WB_OUT, 1024, 1024, 1024, EpiResid{X, modl + 2048, nullptr, 0}, smem, osg(bid), nblk);
      xcd_barrier(xb);
    } else if (layer == 1) {
      bfr* P = BIG;
      pool_ew_phase(H, P, osg(bid), nblk);
      xcd_barrier(xb);
      for (int g = 0; g < 4; ++g)
        gemm_phase(P + g * 256, DM, WB + WB_IN + g * 65536, 256, 256, 256,
                   EpiResid{X, modl + 2048 + g * 256, q.in[13] + g * 256, g * 256}, smem, osg(bid), nblk);
      xcd_barrier(xb);
    } else if (layer == 2) {
      bfr* UV = BIG;
      gemm_phase(H, DM, WB + WB_IN, 1024, 2048, 1024, EpiGelu{UV, 2048}, smem, osg(bid), nblk);
      xcd_barrier(xb);
      sgu_norm_phase(UV, q.in[15], osg(bid), nblk);
      xcd_barrier(xb);
      sgu_spatial_phase(UV, q.in[16], q.in[17], smem, osg(bid), nblk);
      xcd_barrier(xb);
      gemm_phase(UV, 2048, WB + WB_OUT, 1024, 1024, 1024, EpiResid{X, modl + 2048, nullptr, 0}, smem, osg(bid), nblk);
      xcd_barrier(xb);
    } else {
      bfr* QZ = BIG;
      gemm256s_phase(H, DM, WB + WB_IN, 1024, 5120, 1024, EpiStore{QZ, 5120}, smem, osg(bid), nblk);
      xcd_barrier(xb);
      hgrn_scan_phase(q, smem, osg(bid), nblk, 0);
      xcd_barrier(xb);
      hgrn_combine_phase(q, osg(bid), nblk);
      xcd_barrier(xb);
      hgrn_scan_phase(q, smem, osg(bid), nblk, 1);
      xcd_barrier(xb);
      hgrn_gate_phase(q, q.in[21], osg(bid), nblk);
      xcd_barrier(xb);
      gemm_phase(H, DM, WB + WB_OUT, 1024, 1024, 1024, EpiResid{X, modl + 2048, nullptr, 0}, smem, osg(bid), nblk);
      xcd_barrier(xb);
    }

    norm_phase(X, q.in[7] + (layer * 2 + 1) * DM, modl, 3072, 4096, H, osg(bid), nblk);
    xcd_barrier(xb);
    bfr* ACT = BIG;
    float* EDGE = (float*)(q.ws + OFF_BIG + 115343360ull);
    const float* wdw = q.in[24] + (size_t)layer * 3 * 2 * DFF;
    gemm256s_phase(H, DM, WB + WB_UP, 1024, 2 * DFF, 1024, EpiFfnUp{ACT, EDGE, wdw}, smem, osg(bid), nblk);
    xcd_barrier(xb);
    ffn_edge_phase(EDGE, wdw, ACT, osg(bid), nblk);
    xcd_barrier(xb);
    gemm_phase(ACT, DFF, WB + WB_DOWN, DFF, 1024, DFF, EpiResid{X, modl + 5120, nullptr, 0}, smem, osg(bid), nblk);
    xcd_barrier(xb);
  }
  final_norm_phase(p.out, p.in[8], osg(bid), nblk);
}

extern "C" void kernel_launch(void* const* d_in, const int* in_sizes, int n_in, void* d_out, int out_size,
                              void* d_ws, size_t ws_size, hipStream_t stream) {
  static int grid_blocks = 0;
  if (!grid_blocks) {
    int dev = 0, cus = 0, per_cu = 0;
    hipGetDevice(&dev);
    hipDeviceGetAttribute(&cus, hipDeviceAttributeMultiprocessorCount, dev);
    hipOccupancyMaxActiveBlocksPerMultiprocessor(&per_cu, mega_kernel, 256, 0);
    if (per_cu > 2) per_cu = 2;
    if (per_cu < 1) per_cu = 1;
    grid_blocks = cus * per_cu;
  }
  if (ws_size < WS_NEED) { fprintf(stderr, "workspace too small: %zu < %zu\n", ws_size, (size_t)WS_NEED); return; }
  Params p{};
  for (int i = 0; i < 26; ++i) p.in[i] = (const float*)d_in[i];
  p.out = (float*)d_out;
  p.ws = (char*)d_ws;
  hipMemsetAsync((char*)d_ws + OFF_BAR, 0, XCD_BAR_WORDS * 4, stream);
  void* args[] = {&p};
  hipError_t e = hipLaunchCooperativeKernel((void*)mega_kernel, dim3(grid_blocks), dim3(256), args, 0, stream);
  if (e != hipSuccess) fprintf(stderr, "cooperative launch failed: %s (grid %d)\n", hipGetErrorString(e), grid_blocks);
}
```

```cpp
#include <hip/hip_runtime.h>
#include <hip/hip_cooperative_groups.h>
#include <stdint.h>
#include <stdio.h>
namespace cg = cooperative_groups;

#define DEVINL __device__ __forceinline__
typedef unsigned short bfr;
using bf16x8 = __attribute__((ext_vector_type(8))) short;
using f32x4 = __attribute__((ext_vector_type(4))) float;
using u32x4 = __attribute__((ext_vector_type(4))) unsigned int;

constexpr int DM = 1024;
constexpr int MTOK = 20480;
constexpr int NPROMPT = 4096;
constexpr int DFF = 2816;
constexpr int HALF_FF = 1408;
constexpr float EPS = 1e-6f;

constexpr size_t OFF_MODP = 0;
constexpr size_t OFF_MOD = 7864320;
constexpr size_t OFF_LBS = OFF_MOD + 491520;
constexpr size_t OFF_BAR = OFF_LBS + 8192;
constexpr size_t OFF_WB = 8388608;
constexpr size_t OFF_H = 41943040;
constexpr size_t OFF_BIG = 83886080;
constexpr size_t WS_NEED = OFF_BIG + 251658240ull + 33554432ull + 262144ull;
constexpr size_t WB_IN = 0, WB_OUT = 5242880, WB_UP = 6291456, WB_DOWN = 12058624;

struct Params {
  const float* in[26];
  float* out;
  char* ws;
};

DEVINL int otid() { int t = threadIdx.x; asm volatile("" : "+v"(t)); return t; }
DEVINL int osg(int x) { asm volatile("" : "+s"(x)); return x; }
typedef __bf16 hbf16x2 __attribute__((ext_vector_type(2)));
typedef float hf32x2 __attribute__((ext_vector_type(2)));
DEVINL uint32_t pk2(float a, float b) {
  hf32x2 v = {a, b};
  hbf16x2 r = __builtin_convertvector(v, hbf16x2);
  return __builtin_bit_cast(uint32_t, r);
}
DEVINL bfr f2bf(float f) { return (bfr)(pk2(f, 0.f) & 0xffffu); }
DEVINL float bf2f(bfr h) { return __uint_as_float(((uint32_t)h) << 16); }
DEVINL float frcp(float x) { return __builtin_amdgcn_rcpf(x); }
DEVINL float bflo(uint32_t u) { return __uint_as_float(u << 16); }
DEVINL float bfhi(uint32_t u) { return __uint_as_float(u & 0xffff0000u); }
DEVINL int cond_of(int m) { return m < NPROMPT ? 0 : 1 + ((m - NPROMPT) >> 12); }
DEVINL float silu_f(float x) { return x * frcp(1.f + __expf(-x)); }
DEVINL float gelu_tanh_f(float x) {
  float y = 0.7978845608028654f * (x + 0.044715f * x * x * x);
  float t = 1.f - 2.f * frcp(__expf(2.f * y) + 1.f);
  return 0.5f * x * (1.f + t);
}
DEVINL float shx(float v, int o, int lane) {
  return __int_as_float(__builtin_amdgcn_ds_bpermute((lane ^ o) << 2, __float_as_int(v)));
}
DEVINL float wave_sum(float v, int lane) {
#pragma unroll
  for (int o = 32; o > 0; o >>= 1) v += shx(v, o, lane);
  return v;
}

DEVINL void tok_pos(int m, int& tl, int& T) {
  if (m < NPROMPT) { tl = m & 255; T = 256; } else { tl = (m - NPROMPT) & 4095; T = 4096; }
}

struct EpiNoPre {};
#define EPI_ELEMENTWISE_TILE                                                                       \
  typedef EpiNoPre Pre;                                                                             \
  static constexpr bool kLdsEpi = false;                                                            \
  DEVINL Pre pre(int tn, int tid) const { return Pre{}; }                                           \
  DEVINL void tile(const f32x4 (&acc)[4][4], const Pre& pre_, int m0, int n0, int tn, int wm, int wn, int l15, \
                   int quad, int tid, char* smem) const {                                           \
    _Pragma("unroll") for (int mt = 0; mt < 4; ++mt)                                                \
      _Pragma("unroll") for (int nt = 0; nt < 4; ++nt)                                              \
        (*this)(m0 + wm * 64 + mt * 16 + l15, n0 + wn * 64 + nt * 16 + quad * 4, acc[mt][nt]);      \
  }
struct EpiStore {
  bfr* C; int ldc;
  DEVINL void tile256(const f32x4 (&acc)[8][4], const EpiNoPre& pre_, int m0, int n0, int tn, int wm, int wn, int l15,
                      int quad, int tid, char* smem) const {
#pragma unroll
    for (int mt = 0; mt < 8; ++mt)
#pragma unroll
      for (int nt = 0; nt < 4; ++nt)
        (*this)(m0 + wm * 128 + mt * 16 + l15, n0 + wn * 64 + nt * 16 + quad * 4, acc[mt][nt]);
  }
  DEVINL void operator()(int m, int n, f32x4 v) const {
    uint2 o; o.x = pk2(v[0], v[1]); o.y = pk2(v[2], v[3]);
    *(uint2*)(C + (size_t)m * ldc + n) = o;
  }
  EPI_ELEMENTWISE_TILE
};
struct EpiGelu {
  bfr* C; int ldc;
  DEVINL void operator()(int m, int n, f32x4 v) const {
    uint2 o; o.x = pk2(gelu_tanh_f(v[0]), gelu_tanh_f(v[1])); o.y = pk2(gelu_tanh_f(v[2]), gelu_tanh_f(v[3]));
    *(uint2*)(C + (size_t)m * ldc + n) = o;
  }
  EPI_ELEMENTWISE_TILE
};
struct EpiResid {
  float* X; const float* gate; const float* cscale; int coff;
  typedef EpiNoPre Pre;
  static constexpr bool kLdsEpi = false;
  static constexpr bool kSplit = false;
  DEVINL Pre pre(int tn, int tid) const { return Pre{}; }
  DEVINL void tile(const f32x4 (&acc)[4][4], const Pre& pre_, int m0, int n0, int tn, int wm, int wn, int l15,
                   int quad, int tid, char* smem) const {
    const int cond = cond_of(m0);
    const int nb = n0 + wn * 64 + quad * 4;
    f32x4 gs[4];
#pragma unroll
    for (int nt = 0; nt < 4; ++nt) {
      gs[nt] = *(const f32x4*)(gate + cond * 6144 + nb + nt * 16);
      if (cscale) gs[nt] = gs[nt] * *(const f32x4*)(cscale + nb + nt * 16);
    }
    float* xb = X + (size_t)(m0 + wm * 64 + l15) * DM + coff + nb;
#pragma unroll
    for (int hm = 0; hm < 2; ++hm) {
      f32x4 xv[2][4];
#pragma unroll
      for (int mi = 0; mi < 2; ++mi)
#pragma unroll
        for (int nt = 0; nt < 4; ++nt)
          xv[mi][nt] = *(const f32x4*)(xb + (size_t)((hm * 2 + mi) * 16) * DM + nt * 16);
#pragma unroll
      for (int mi = 0; mi < 2; ++mi)
#pragma unroll
        for (int nt = 0; nt < 4; ++nt)
          *(f32x4*)(xb + (size_t)((hm * 2 + mi) * 16) * DM + nt * 16) = xv[mi][nt] + gs[nt] * acc[hm * 2 + mi][nt];
    }
  }
};


#define LDS3 __attribute__((address_space(3)))
DEVINL void lds_barrier() { asm volatile("s_waitcnt lgkmcnt(0)\n\ts_barrier" ::: "memory"); }
template <class Epi>
DEVINL void gemm_phase(const bfr* __restrict__ A, int lda, const bfr* __restrict__ Bt, int ldb, int N, int K,
                       const Epi& epi, char* smem, int bid, int nblk) {
  const int tid = otid(), lane = tid & 63, wave = tid >> 6;
  const int wm = wave >> 1, wn = wave & 1, l15 = lane & 15, quad = lane >> 4;
  const int tilesN = N >> 7;
  const int ntiles = (MTOK >> 7) * tilesN;
  const int nk = K >> 6;
  const int srow0 = wave * 8 + (lane >> 3);
  const int lc = (lane & 7) ^ ((srow0 >> 1) & 7);
  const int fsw = (l15 >> 1) & 7;
  char* const dst0 = smem + wave * 1024 + lane * 16;
#define TILE_DECODE(t_, tm_, tn_) {                                                        \
    const int xcd_ = (t_) & 7, u_ = (t_) >> 3, g16_ = 16 * tilesN;                         \
    int ur_;                                                                               \
    if (u_ < g16_) { const int gs_ = 8 * tilesN; const int g_ = u_ / gs_, r_ = u_ - g_ * gs_; tn_ = r_ >> 3; ur_ = g_ * 8 + (r_ & 7); } \
    else { const int r_ = u_ - g16_; tn_ = r_ >> 2; ur_ = 16 + (r_ & 3); }                 \
    tm_ = ur_ * 8 + xcd_; }
#define GLDS_STAGE(pa_, pb_, st_, kt_)                                                                    \
  {                                                                                                       \
    _Pragma("unroll") for (int i = 0; i < 4; ++i) {                                                       \
      __builtin_amdgcn_global_load_lds((const unsigned*)((pa_) + (size_t)(i * 32) * lda + (kt_) * 64),    \
                                       (LDS3 unsigned*)(dst0 + (st_) * 32768 + i * 4096), 16, 0, 0);      \
      __builtin_amdgcn_global_load_lds((const unsigned*)((pb_) + (size_t)(i * 32) * ldb + (kt_) * 64),    \
                                       (LDS3 unsigned*)(dst0 + (st_) * 32768 + 16384 + i * 4096), 16, 0, 0); \
    }                                                                                                     \
  }
  int tile = bid;
  if (tile >= ntiles) return;
  int tm, tn;
  TILE_DECODE(tile, tm, tn)
  const bfr* gA = A + (size_t)((tm << 7) + srow0) * lda + lc * 8;
  const bfr* gB = Bt + (size_t)((tn << 7) + srow0) * ldb + lc * 8;
  __syncthreads();
  GLDS_STAGE(gA, gB, 0, 0)
  for (; tile < ntiles; tile += nblk) {
    const int m0 = tm << 7, n0 = tn << 7, tn_cur = tn;
    const bool has_next = (tile + nblk < ntiles);
    const bfr* gAn = gA; const bfr* gBn = gB;
    if (has_next) {
      TILE_DECODE(tile + nblk, tm, tn)
      gAn = A + (size_t)((tm << 7) + srow0) * lda + lc * 8;
      gBn = Bt + (size_t)((tn << 7) + srow0) * ldb + lc * 8;
    }
    typename Epi::Pre pre = epi.pre(tn_cur, tid);
    f32x4 acc[4][4];
#pragma unroll
    for (int i = 0; i < 4; ++i)
#pragma unroll
      for (int j = 0; j < 4; ++j) acc[i][j] = f32x4{0.f, 0.f, 0.f, 0.f};
    __syncthreads();
    for (int kt = 0; kt < nk; ++kt) {
      const int st = kt & 1;
      const bool cur = (kt + 1 < nk);
      const bool any = cur || has_next;
      const bfr* sa = cur ? gA + (kt + 1) * 64 : gAn;
      const bfr* sb = cur ? gB + (kt + 1) * 64 : gBn;
      char* sd = dst0 + (cur ? (st ^ 1) : 0) * 32768;
      const char* cA = smem + st * 32768 + (wm * 64 + l15) * 128;
      const char* cB = smem + st * 32768 + 16384 + (wn * 64 + l15) * 128;
      {
        const int co0 = (quad ^ fsw) * 16, co1 = ((4 + quad) ^ fsw) * 16;
        bf16x8 af0[4], bf0[4], af1[4], bf1[4];
#pragma unroll
        for (int i = 0; i < 4; ++i) {
          af0[i] = *(const bf16x8*)(cA + i * 2048 + co0);
          bf0[i] = *(const bf16x8*)(cB + i * 2048 + co0);
        }
#pragma unroll
        for (int i = 0; i < 4; ++i) {
          af1[i] = *(const bf16x8*)(cA + i * 2048 + co1);
          bf1[i] = *(const bf16x8*)(cB + i * 2048 + co1);
        }
        __builtin_amdgcn_sched_barrier(0);
#pragma unroll
        for (int mt = 0; mt < 4; ++mt) {
#pragma unroll
          for (int nt = 0; nt < 4; ++nt)
            acc[mt][nt] = __builtin_amdgcn_mfma_f32_16x16x32_bf16(bf0[nt], af0[mt], acc[mt][nt], 0, 0, 0);
          if (any) {
            __builtin_amdgcn_global_load_lds((const unsigned*)(sa + (size_t)(mt * 32) * lda), (LDS3 unsigned*)(sd + mt * 4096), 16, 0, 0);
            __builtin_amdgcn_global_load_lds((const unsigned*)(sb + (size_t)(mt * 32) * ldb), (LDS3 unsigned*)(sd + 16384 + mt * 4096), 16, 0, 0);
          }
          __builtin_amdgcn_sched_barrier(0);
        }
#pragma unroll
        for (int mt = 0; mt < 4; ++mt)
#pragma unroll
          for (int nt = 0; nt < 4; ++nt)
            acc[mt][nt] = __builtin_amdgcn_mfma_f32_16x16x32_bf16(bf1[nt], af1[mt], acc[mt][nt], 0, 0, 0);
        __builtin_amdgcn_sched_barrier(0);
      }
      if (kt + 1 < nk) __syncthreads();
    }
    epi.tile(acc, pre, m0, n0, tn_cur, wm, wn, l15, quad, tid, smem);
    gA = gAn; gB = gBn;
  }
}

constexpr int EDGE_LD = 2 * DFF;
struct FfnPre { f32x4 wa[3], wb[3]; };
DEVINL void ffn_conv_rows(const bfr* T, const FfnPre& pre_, bfr* ACT, float* EDGE, int m0, int n0, int tn, int tid) {
  const int c4 = (tid & 15) * 4, r0 = (tid >> 4) * 8;
  const int ja = tn * 64 + c4;
  int tl, Tlen; tok_pos(m0, tl, Tlen);
  const bool top_ok = (tl == 0), bot_ok = (tl + 128 == Tlen);
  if (tid < 128) {
    const int e = tid >> 5, c = (tid & 31) * 4;
    const int r = (e < 2) ? e : 124 + e;
    const uint2 v = *(const uint2*)(T + r * 136 + c);
    *(f32x4*)(EDGE + ((size_t)(m0 >> 7) * 4 + e) * EDGE_LD + n0 + c) = f32x4{bflo(v.x), bfhi(v.x), bflo(v.y), bfhi(v.y)};
  }
  const f32x4 zero = f32x4{0.f, 0.f, 0.f, 0.f};
#define LDT(dst, row, col) { const uint2 v_ = *(const uint2*)(T + (row) * 136 + (col)); dst = f32x4{bflo(v_.x), bfhi(v_.x), bflo(v_.y), bfhi(v_.y)}; }
  f32x4 pa = zero, pb = zero, ca, cb, na, nb;
  if (r0 > 0) { LDT(pa, r0 - 1, c4) LDT(pb, r0 - 1, 64 + c4) }
  LDT(ca, r0, c4) LDT(cb, r0, 64 + c4)
#pragma unroll
  for (int i = 0; i < 8; ++i) {
    const int r = r0 + i;
    if (r < 127) { LDT(na, r + 1, c4) LDT(nb, r + 1, 64 + c4) }
    else { na = zero; nb = zero; }
    const bool ok = (r > 0 || top_ok) && (r < 127 || bot_ok);
    if (ok) {
      const f32x4 a = pre_.wa[0] * pa + pre_.wa[1] * ca + pre_.wa[2] * na;
      const f32x4 b = pre_.wb[0] * pb + pre_.wb[1] * cb + pre_.wb[2] * nb;
      uint2 o;
      o.x = pk2(silu_f(a[0]) * b[0], silu_f(a[1]) * b[1]);
      o.y = pk2(silu_f(a[2]) * b[2], silu_f(a[3]) * b[3]);
      *(uint2*)(ACT + (size_t)(m0 + r) * DFF + ja) = o;
    }
    pa = ca; pb = cb; ca = na; cb = nb;
  }
#undef LDT
}
struct EpiFfnUp {
  bfr* ACT; float* EDGE; const float* wdw;
  typedef FfnPre Pre;
  static constexpr bool kLdsEpi = true;
  DEVINL Pre pre(int tn, int tid) const {
    Pre q;
    const int ja = tn * 64 + (tid & 15) * 4;
#pragma unroll
    for (int t = 0; t < 3; ++t) {
      q.wa[t] = *(const f32x4*)(wdw + t * (2 * DFF) + ja);
      q.wb[t] = *(const f32x4*)(wdw + t * (2 * DFF) + DFF + ja);
    }
    return q;
  }
  DEVINL void tile(const f32x4 (&acc)[4][4], const Pre& pre_, int m0, int n0, int tn, int wm, int wn, int l15, int quad,
                   int tid, char* smem) const {
    bfr* T = (bfr*)(smem + 32768);
    lds_barrier();
#pragma unroll
    for (int mt = 0; mt < 4; ++mt)
#pragma unroll
      for (int nt = 0; nt < 4; ++nt) {
        uint2 o; o.x = pk2(acc[mt][nt][0], acc[mt][nt][1]); o.y = pk2(acc[mt][nt][2], acc[mt][nt][3]);
        *(uint2*)(T + (wm * 64 + mt * 16 + l15) * 136 + wn * 64 + nt * 16 + quad * 4) = o;
      }
    lds_barrier();
    ffn_conv_rows(T, pre_, ACT, EDGE, m0, n0, tn, tid);
  }
  DEVINL void tile256(const f32x4 (&acc)[8][4], const Pre& pre_, int m0, int n0, int tn, int wm, int wn, int l15, int quad,
                      int tid, char* smem) const {
    bfr* T = (bfr*)smem;
#pragma unroll
    for (int hh = 0; hh < 2; ++hh) {
      lds_barrier();
      if (wm == hh) {
#pragma unroll
        for (int mt = 0; mt < 8; ++mt)
#pragma unroll
          for (int nt = 0; nt < 4; ++nt) {
            uint2 o; o.x = pk2(acc[mt][nt][0], acc[mt][nt][1]); o.y = pk2(acc[mt][nt][2], acc[mt][nt][3]);
            *(uint2*)(T + (mt * 16 + l15) * 136 + wn * 64 + nt * 16 + quad * 4) = o;
          }
      }
      lds_barrier();
      ffn_conv_rows(T, pre_, ACT, EDGE, m0 + hh * 128, n0, tn, tid);
    }
  }
};


template <class Epi>
DEVINL void gemm256_phase(const bfr* __restrict__ A, int lda, const bfr* __restrict__ Bt, int ldb, int N, int K,
                          const Epi& epi, char* smem, int bid, int nblk) {
  const int tid = otid(), lane = tid & 63, wave = tid >> 6;
  const int wm = wave >> 1, wn = wave & 1, l15 = lane & 15, quad = lane >> 4;
  const int tilesN = N >> 7;
  const int ntiles = (MTOK >> 8) * tilesN;
  const int nk = K >> 5;
  const int srow0 = wave * 16 + (lane >> 2);
  const int lc = (lane & 3) ^ ((0 - (lane >> 4)) & 3);
  const int fsw = (0 - (l15 >> 2)) & 3;
  char* const dst0 = smem + wave * 1024 + lane * 16;
#define TILE_DECODE2(t_, tm_, tn_) { const int xcd_ = (t_) & 7, u_ = (t_) >> 3; const int ur_ = u_ / tilesN; tn_ = u_ - ur_ * tilesN; tm_ = ur_ * 8 + xcd_; }
#define GLDS_STAGE2(pa_, pb_, st_, kt_)                                                                   \
  {                                                                                                       \
    _Pragma("unroll") for (int i = 0; i < 4; ++i)                                                         \
      __builtin_amdgcn_global_load_lds((const unsigned*)((pa_) + (size_t)(i * 64) * lda + (kt_) * 32),    \
                                       (LDS3 unsigned*)(dst0 + (st_) * 24576 + i * 4096), 16, 0, 0);      \
    _Pragma("unroll") for (int i = 0; i < 2; ++i)                                                         \
      __builtin_amdgcn_global_load_lds((const unsigned*)((pb_) + (size_t)(i * 64) * ldb + (kt_) * 32),    \
                                       (LDS3 unsigned*)(dst0 + (st_) * 24576 + 16384 + i * 4096), 16, 0, 0); \
  }
  int tile = bid;
  if (tile >= ntiles) return;
  int tm, tn;
  TILE_DECODE2(tile, tm, tn)
  const bfr* gA = A + (size_t)((tm << 8) + srow0) * lda + lc * 8;
  const bfr* gB = Bt + (size_t)((tn << 7) + srow0) * ldb + lc * 8;
  __syncthreads();
  GLDS_STAGE2(gA, gB, 0, 0)
  for (; tile < ntiles; tile += nblk) {
    const int m0 = tm << 8, n0 = tn << 7, tn_cur = tn;
    const bool has_next = (tile + nblk < ntiles);
    const bfr* gAn = gA; const bfr* gBn = gB;
    if (has_next) {
      TILE_DECODE2(tile + nblk, tm, tn)
      gAn = A + (size_t)((tm << 8) + srow0) * lda + lc * 8;
      gBn = Bt + (size_t)((tn << 7) + srow0) * ldb + lc * 8;
    }
    f32x4 acc[8][4];
#pragma unroll
    for (int i = 0; i < 8; ++i)
#pragma unroll
      for (int j = 0; j < 4; ++j) acc[i][j] = f32x4{0.f, 0.f, 0.f, 0.f};
    __syncthreads();
    for (int kt = 0; kt < nk; ++kt) {
      const int st = kt & 1;
      const bool cur = (kt + 1 < nk);
      const bool any = cur || has_next;
      const bfr* sa = cur ? gA + (kt + 1) * 32 : gAn;
      const bfr* sb = cur ? gB + (kt + 1) * 32 : gBn;
      char* sd = dst0 + (cur ? (st ^ 1) : 0) * 24576;
      const char* cA = smem + st * 24576 + (wm * 128 + l15) * 64 + ((quad ^ fsw) * 16);
      const char* cB = smem + st * 24576 + 16384 + (wn * 64 + l15) * 64 + ((quad ^ fsw) * 16);
      bf16x8 bfg[4];
#pragma unroll
      for (int i = 0; i < 4; ++i) bfg[i] = *(const bf16x8*)(cB + i * 1024);
#pragma unroll
      for (int hm = 0; hm < 2; ++hm) {
        bf16x8 af[4];
#pragma unroll
        for (int i = 0; i < 4; ++i) af[i] = *(const bf16x8*)(cA + (hm * 4 + i) * 1024);
        __builtin_amdgcn_sched_barrier(0);
#pragma unroll
        for (int mt = 0; mt < 4; ++mt) {
#pragma unroll
          for (int nt = 0; nt < 4; ++nt)
            acc[hm * 4 + mt][nt] = __builtin_amdgcn_mfma_f32_16x16x32_bf16(bfg[nt], af[mt], acc[hm * 4 + mt][nt], 0, 0, 0);
          const int g = hm * 4 + mt;
          if (any && g < 4)
            __builtin_amdgcn_global_load_lds((const unsigned*)(sa + (size_t)(g * 64) * lda), (LDS3 unsigned*)(sd + g * 4096), 16, 0, 0);
          else if (any && g < 6)
            __builtin_amdgcn_global_load_lds((const unsigned*)(sb + (size_t)((g - 4) * 64) * ldb), (LDS3 unsigned*)(sd + 16384 + (g - 4) * 4096), 16, 0, 0);
          __builtin_amdgcn_sched_barrier(0);
        }
      }
      if (kt + 1 < nk) __syncthreads();
    }
    {
      typename Epi::Pre pre = epi.pre(tn_cur, tid);
      epi.tile256(acc, pre, m0, n0, tn_cur, wm, wn, l15, quad, tid, smem);
    }
    gA = gAn; gB = gBn;
  }
}


template <class Epi>
DEVINL void gemm256s_phase(const bfr* __restrict__ A, int lda, const bfr* __restrict__ Bt, int ldb, int N, int K,
                           const Epi& epi, char* smem, int bid, int nblk) {
  const int tid = otid(), lane = tid & 63, wave = tid >> 6;
  const int wm = wave >> 1, wn = wave & 1, l15 = lane & 15, quad = lane >> 4;
  const int tilesN = N >> 7;
  const int ntiles = (MTOK >> 8) * tilesN;
  const int nk = K >> 6;
  const int srow0 = wave * 8 + (lane >> 3);
  const int lc = (lane & 7) ^ ((srow0 >> 1) & 7);
  const int fsw = (l15 >> 1) & 7;
  char* const dst0 = smem + wave * 1024 + lane * 16;
#define TILE_DECODE3(t_, tm_, tn_) { const int xcd_ = (t_) & 7, u_ = (t_) >> 3; const int gs_ = 5 * tilesN; const int g_ = u_ / gs_, r_ = u_ - g_ * gs_; \
    tn_ = r_ / 5; tm_ = (g_ * 5 + (r_ - tn_ * 5)) * 8 + xcd_; }
  if (bid >= ntiles) return;
  int ptile = bid, pkt = 0;
  bool pvalid = true;
  int ptm, ptn;
  TILE_DECODE3(ptile, ptm, ptn)
  const bfr* pA = A + (size_t)((ptm << 8) + srow0) * lda + lc * 8;
  const bfr* pB = Bt + (size_t)((ptn << 7) + srow0) * ldb + lc * 8;
#define DMA_B3(buf_)                                                                                      \
  {                                                                                                       \
    _Pragma("unroll") for (int i = 0; i < 4; ++i)                                                         \
      __builtin_amdgcn_global_load_lds((const unsigned*)(pB + (size_t)(i * 32) * ldb + pkt * 64),         \
                                       (LDS3 unsigned*)(dst0 + 34816 + (buf_) * 16384 + i * 4096), 16, 0, 0); \
  }
#define DMA_A3()                                                                                          \
  {                                                                                                       \
    _Pragma("unroll") for (int i = 0; i < 8; ++i)                                                         \
      __builtin_amdgcn_global_load_lds((const unsigned*)(pA + (size_t)(i * 32) * lda + pkt * 64),         \
                                       (LDS3 unsigned*)(dst0 + i * 4096), 16, 0, 0);                      \
    if (++pkt == nk) {                                                                                    \
      pkt = 0; ptile += nblk;                                                                             \
      if (ptile < ntiles) {                                                                               \
        TILE_DECODE3(ptile, ptm, ptn)                                                                     \
        pA = A + (size_t)((ptm << 8) + srow0) * lda + lc * 8;                                             \
        pB = Bt + (size_t)((ptn << 7) + srow0) * ldb + lc * 8;                                            \
      } else pvalid = false;                                                                              \
    }                                                                                                     \
  }
  __syncthreads();
  DMA_B3(0)
  DMA_A3()
  bool deferred = false;
  int bbuf = 0;
  const char* cA = smem + (wm * 128 + l15) * 128;
  const char* cB0 = smem + 34816 + (wn * 64 + l15) * 128;
  for (int tile = bid; tile < ntiles; tile += nblk) {
    int tm, tn;
    TILE_DECODE3(tile, tm, tn)
    const int m0 = tm << 8, n0 = tn << 7;
    if (deferred) { DMA_A3() deferred = false; }
    f32x4 acc[8][4];
#pragma unroll
    for (int i = 0; i < 8; ++i)
#pragma unroll
      for (int j = 0; j < 4; ++j) acc[i][j] = f32x4{0.f, 0.f, 0.f, 0.f};
    for (int kt = 0; kt < nk; ++kt) {
      asm volatile("s_waitcnt vmcnt(0)\n\ts_barrier" ::: "memory");
      const char* cB = cB0 + bbuf * 16384;
      const int co0 = (quad ^ fsw) * 16, co1 = ((4 + quad) ^ fsw) * 16;
      bf16x8 af[8], bfg[4];
#pragma unroll
      for (int i = 0; i < 4; ++i) bfg[i] = *(const bf16x8*)(cB + i * 2048 + co0);
#pragma unroll
      for (int i = 0; i < 8; ++i) af[i] = *(const bf16x8*)(cA + i * 2048 + co0);
      __builtin_amdgcn_sched_barrier(0);
      __builtin_amdgcn_s_setprio(3);
      if (pvalid) DMA_B3(bbuf ^ 1)
      __builtin_amdgcn_s_setprio(0);
      __builtin_amdgcn_sched_barrier(0);
#pragma unroll
      for (int mt = 0; mt < 8; ++mt)
#pragma unroll
        for (int nt = 0; nt < 4; ++nt)
          acc[mt][nt] = __builtin_amdgcn_mfma_f32_16x16x32_bf16(bfg[nt], af[mt], acc[mt][nt], 0, 0, 0);
      __builtin_amdgcn_sched_barrier(0);
#pragma unroll
      for (int i = 0; i < 4; ++i) bfg[i] = *(const bf16x8*)(cB + i * 2048 + co1);
#pragma unroll
      for (int i = 0; i < 8; ++i) af[i] = *(const bf16x8*)(cA + i * 2048 + co1);
      asm volatile("s_waitcnt lgkmcnt(0)\n\ts_barrier" ::: "memory");
      __builtin_amdgcn_s_setprio(3);
      if (pvalid) {
        if (Epi::kLdsEpi && kt == nk - 1) deferred = true;
        else DMA_A3()
      }
      __builtin_amdgcn_s_setprio(0);
      bbuf ^= 1;
      __builtin_amdgcn_sched_barrier(0);
#pragma unroll
      for (int mt = 0; mt < 8; ++mt)
#pragma unroll
        for (int nt = 0; nt < 4; ++nt)
          acc[mt][nt] = __builtin_amdgcn_mfma_f32_16x16x32_bf16(bfg[nt], af[mt], acc[mt][nt], 0, 0, 0);
      __builtin_amdgcn_sched_barrier(0);
    }
    {
      typename Epi::Pre pre = epi.pre(tn, tid);
      epi.tile256(acc, pre, m0, n0, tn, wm, wn, l15, quad, tid, smem);
    }
    if (Epi::kLdsEpi) lds_barrier();
  }
  asm volatile("s_waitcnt vmcnt(0)" ::: "memory");
}

DEVINL void ffn_edge_phase(const float* __restrict__ EDGE, const float* __restrict__ wdw, bfr* __restrict__ ACT, int bid, int nblk) {
  const int gt = bid * 256 + otid(), nt = nblk * 256;
  for (int i = gt; i < 160 * 2 * 704; i += nt) {
    const int cg4 = i % 704, r2 = i / 704, side = r2 & 1, tm = r2 >> 1;
    const int m0 = tm << 7;
    int tl, Tlen; tok_pos(m0, tl, Tlen);
    if (side == 0 ? (tl == 0) : (tl + 128 == Tlen)) continue;
    const int ja = cg4 * 4;
    const int nb_ = ja >> 6, cc = ja & 63;
    const int ea = nb_ * 128 + cc, eb = ea + 64;
    const float* prev; const float* cur; const float* next;
    if (side == 0) {
      prev = EDGE + ((size_t)(tm - 1) * 4 + 3) * EDGE_LD; cur = EDGE + ((size_t)tm * 4 + 0) * EDGE_LD; next = EDGE + ((size_t)tm * 4 + 1) * EDGE_LD;
    } else {
      prev = EDGE + ((size_t)tm * 4 + 2) * EDGE_LD; cur = EDGE + ((size_t)tm * 4 + 3) * EDGE_LD; next = EDGE + ((size_t)(tm + 1) * 4 + 0) * EDGE_LD;
    }
    const f32x4 a = *(const f32x4*)(wdw + ja) * *(const f32x4*)(prev + ea) + *(const f32x4*)(wdw + 2 * DFF + ja) * *(const f32x4*)(cur + ea) +
                    *(const f32x4*)(wdw + 4 * DFF + ja) * *(const f32x4*)(next + ea);
    const f32x4 b = *(const f32x4*)(wdw + DFF + ja) * *(const f32x4*)(prev + eb) + *(const f32x4*)(wdw + 3 * DFF + ja) * *(const f32x4*)(cur + eb) +
                    *(const f32x4*)(wdw + 5 * DFF + ja) * *(const f32x4*)(next + eb);
    uint2 o;
    o.x = pk2(silu_f(a[0]) * b[0], silu_f(a[1]) * b[1]);
    o.y = pk2(silu_f(a[2]) * b[2], silu_f(a[3]) * b[3]);
    const int m = m0 + (side ? 127 : 0);
    *(uint2*)(ACT + (size_t)m * DFF + ja) = o;
  }
}

DEVINL int up_perm(int n0) {
  if (n0 < DFF) return (n0 >> 6) * 128;
  return ((n0 - DFF) >> 6) * 128 + 64;
}
DEVINL void conv_matrix(const float* __restrict__ src, int K, int N, bfr* __restrict__ dst, int perm,
                        char* smem, int bid, int nblk) {
  float* sT = (float*)smem;
  const int tid = otid();
  const int tilesN = N >> 6;
  const int ntiles = (K >> 6) * tilesN;
  const int r = tid >> 4, c4 = tid & 15;
  int t = bid;
  if (t >= ntiles) return;
  f32x4 v0, v1, v2, v3;
  {
    const int tk = t / tilesN, tn = t - tk * tilesN;
    const float* sp = src + (size_t)((tk << 6) + r) * N + (tn << 6) + c4 * 4;
    v0 = *(const f32x4*)(sp); v1 = *(const f32x4*)(sp + (size_t)16 * N);
    v2 = *(const f32x4*)(sp + (size_t)32 * N); v3 = *(const f32x4*)(sp + (size_t)48 * N);
  }
  for (; t < ntiles; t += nblk) {
    const int tk = t / tilesN, tn = t - tk * tilesN;
    const int k0 = tk << 6, n0 = tn << 6;
    __syncthreads();
    {
      float* d = sT + r * 65 + c4 * 4;
      d[0] = v0[0]; d[1] = v0[1]; d[2] = v0[2]; d[3] = v0[3];
      d[16 * 65 + 0] = v1[0]; d[16 * 65 + 1] = v1[1]; d[16 * 65 + 2] = v1[2]; d[16 * 65 + 3] = v1[3];
      d[32 * 65 + 0] = v2[0]; d[32 * 65 + 1] = v2[1]; d[32 * 65 + 2] = v2[2]; d[32 * 65 + 3] = v2[3];
      d[48 * 65 + 0] = v3[0]; d[48 * 65 + 1] = v3[1]; d[48 * 65 + 2] = v3[2]; d[48 * 65 + 3] = v3[3];
    }
    if (t + nblk < ntiles) {
      const int t2 = t + nblk;
      const int tk2 = t2 / tilesN, tn2 = t2 - tk2 * tilesN;
      const float* sp = src + (size_t)((tk2 << 6) + r) * N + (tn2 << 6) + c4 * 4;
      v0 = *(const f32x4*)(sp); v1 = *(const f32x4*)(sp + (size_t)16 * N);
      v2 = *(const f32x4*)(sp + (size_t)32 * N); v3 = *(const f32x4*)(sp + (size_t)48 * N);
    }
    __syncthreads();
    const int n = tid >> 2, kc = tid & 3;
    uint32_t w[8];
#pragma unroll
    for (int j = 0; j < 8; ++j)
      w[j] = pk2(sT[(kc * 16 + 2 * j) * 65 + n], sT[(kc * 16 + 2 * j + 1) * 65 + n]);
    const int nd = (perm ? up_perm(n0) : n0) + n;
    bfr* dp = dst + (size_t)nd * K + k0 + kc * 16;
    *(uint4*)dp = make_uint4(w[0], w[1], w[2], w[3]);
    *(uint4*)(dp + 8) = make_uint4(w[4], w[5], w[6], w[7]);
  }
}

DEVINL void phase0a(const Params& p, char* smem, int bid, int nblk) {
  const int tid = otid();
  float* sc = (float*)smem;
  float* modp = (float*)(p.ws + OFF_MODP);
  const float* cvec = p.in[3];
  const float* cctx = p.in[4];
  const float* ada_w = p.in[5];
  for (int job = bid; job < 384; job += nblk) {
    const int l = job / 96, r = job - l * 96, ks = r / 6, cgp = r - ks * 6;
    __syncthreads();
    for (int i = tid; i < 320; i += 256) {
      const int cond = i >> 6, kk = i & 63;
      const float v = cond == 0 ? cctx[ks * 64 + kk] : cvec[(cond - 1) * DM + ks * 64 + kk];
      sc[i] = silu_f(v);
    }
    __syncthreads();
    const int col = cgp * 1024 + tid * 4;
    const float* wp = ada_w + ((size_t)l * DM + ks * 64) * 6144 + col;
    float a[5][4];
#pragma unroll
    for (int c = 0; c < 5; ++c)
#pragma unroll
      for (int j = 0; j < 4; ++j) a[c][j] = 0.f;
#pragma unroll 8
    for (int kk = 0; kk < 64; ++kk) {
      const float4 w = *(const float4*)(wp + (size_t)kk * 6144);
#pragma unroll
      for (int c = 0; c < 5; ++c) {
        const float s = sc[c * 64 + kk];
        a[c][0] += s * w.x; a[c][1] += s * w.y; a[c][2] += s * w.z; a[c][3] += s * w.w;
      }
    }
#pragma unroll
    for (int c = 0; c < 5; ++c)
      *(float4*)(modp + ((size_t)(ks * 4 + l) * 5 + c) * 6144 + col) = make_float4(a[c][0], a[c][1], a[c][2], a[c][3]);
  }
  const int gt = bid * 256 + tid, nt = nblk * 256;
  {
    const float* lb = p.in[20];
    float* lbs = (float*)(p.ws + OFF_LBS);
    for (int i = gt; i < 2048; i += nt) {
      const float v0 = lb[i], v1 = lb[2048 + i], v2 = lb[4096 + i], v3 = lb[6144 + i];
      const float mx = fmaxf(fmaxf(v0, v1), fmaxf(v2, v3));
      const float e0 = expf(v0 - mx), e1 = expf(v1 - mx), e2 = expf(v2 - mx), e3 = expf(v3 - mx);
      lbs[i] = (e1 + e2 + e3) / (e0 + e1 + e2 + e3);
    }
  }
  float* X = p.out;
  {
    const float4* xp = (const float4*)p.in[0];
    float4* xo = (float4*)X;
    for (int i = gt; i < NPROMPT * DM / 4; i += nt) xo[i] = xp[i];
    const float* xs = p.in[1];
    for (int i = gt; i < 4096 * 256; i += nt) {
      const int t = i >> 8, c = (i & 255) * 4;
      const int part = c >> 8;
      const float pos = (float)((part < 2) ? (t >> 6) : (t & 63));
      float pe[4];
#pragma unroll
      for (int j = 0; j < 4; ++j) {
        const int jj = (c + j) & 255;
        const float freq = expf((-9.210340371976184f * (float)jj) / 256.0f);
        const float arg = pos * freq;
        pe[j] = (part & 1) ? cosf(arg) : sinf(arg);
      }
#pragma unroll
      for (int b = 0; b < 4; ++b) {
        const size_t off = ((size_t)b * 4096 + t) * DM + c;
        float4 v = *(const float4*)(xs + off);
        v.x += pe[0]; v.y += pe[1]; v.z += pe[2]; v.w += pe[3];
        *(float4*)(X + (size_t)NPROMPT * DM + off) = v;
      }
    }
  }
}

DEVINL void phase0b(const Params& p, int bid, int nblk) {
  const int gt = bid * 256 + otid(), nt = nblk * 256;
  const float* modp = (const float*)(p.ws + OFF_MODP);
  float* mod = (float*)(p.ws + OFF_MOD);
  const float* ada_b = p.in[6];
  for (int i = gt; i < 4 * 5 * 6144; i += nt) {
    const int l = i / 30720, col = i % 6144;
    float s = ada_b[l * 6144 + col];
#pragma unroll
    for (int ks = 0; ks < 16; ++ks) s += modp[(size_t)ks * 122880 + i];
    mod[i] = s;
  }
}

DEVINL void norm_phase(const float* __restrict__ X, const float* __restrict__ g, const float* __restrict__ modl,
                       int shift_off, int scale_off, bfr* __restrict__ H, int bid, int nblk) {
  const int tid = otid(); const int lane = tid & 63;
  const int gw = bid * 4 + (tid >> 6), nw = nblk * 4;
  int row = gw;
  if (row >= MTOK) return;
  f32x4 x0, x1, x2, x3;
  {
    const float* xr = X + (size_t)row * DM + lane * 4;
    x0 = *(const f32x4*)(xr); x1 = *(const f32x4*)(xr + 256); x2 = *(const f32x4*)(xr + 512); x3 = *(const f32x4*)(xr + 768);
  }
  for (; row < MTOK; row += nw) {
    const f32x4 c0 = x0, c1 = x1, c2 = x2, c3 = x3;
    if (row + nw < MTOK) {
      const float* xr = X + (size_t)(row + nw) * DM + lane * 4;
      x0 = *(const f32x4*)(xr); x1 = *(const f32x4*)(xr + 256); x2 = *(const f32x4*)(xr + 512); x3 = *(const f32x4*)(xr + 768);
    }
    float ss = 0.f;
#pragma unroll
    for (int j = 0; j < 4; ++j) ss += c0[j] * c0[j] + c1[j] * c1[j] + c2[j] * c2[j] + c3[j] * c3[j];
    ss = wave_sum(ss, lane);
    const float rstd = rsqrtf(ss * (1.f / DM) + EPS);
    const float* mc = modl + cond_of(row) * 6144;
#pragma unroll
    for (int i = 0; i < 4; ++i) {
      const f32x4 xv = (i == 0) ? c0 : (i == 1) ? c1 : (i == 2) ? c2 : c3;
      const int c = i * 256 + lane * 4;
      const float4 gg = *(const float4*)(g + c);
      const float4 sh = *(const float4*)(mc + shift_off + c);
      const float4 sc = *(const float4*)(mc + scale_off + c);
      const float h0 = xv[0] * rstd * gg.x * (1.f + sc.x) + sh.x;
      const float h1 = xv[1] * rstd * gg.y * (1.f + sc.y) + sh.y;
      const float h2 = xv[2] * rstd * gg.z * (1.f + sc.z) + sh.z;
      const float h3 = xv[3] * rstd * gg.w * (1.f + sc.w) + sh.w;
      uint2 o; o.x = pk2(h0, h1); o.y = pk2(h2, h3);
      *(uint2*)(H + (size_t)row * DM + c) = o;
    }
  }
}

DEVINL void final_norm_phase(float* X, const float* __restrict__ g, int bid, int nblk) {
  const int tid = otid(); const int lane = tid & 63;
  const int gw = bid * 4 + (tid >> 6), nw = nblk * 4;
  for (int row = gw; row < MTOK; row += nw) {
    float* xr = X + (size_t)row * DM;
    float4 x[4];
    float ss = 0.f;
#pragma unroll
    for (int i = 0; i < 4; ++i) {
      x[i] = *(const float4*)(xr + i * 256 + lane * 4);
      ss += x[i].x * x[i].x + x[i].y * x[i].y + x[i].z * x[i].z + x[i].w * x[i].w;
    }
    ss = wave_sum(ss, lane);
    const float rstd = rsqrtf(ss * (1.f / DM) + EPS);
#pragma unroll
    for (int i = 0; i < 4; ++i) {
      const int c = i * 256 + lane * 4;
      const float4 gg = *(const float4*)(g + c);
      float4 o;
      o.x = x[i].x * rstd * gg.x; o.y = x[i].y * rstd * gg.y; o.z = x[i].z * rstd * gg.z; o.w = x[i].w * rstd * gg.w;
      *(float4*)(xr + c) = o;
    }
  }
}

DEVINL void shortconv_ew_phase(const bfr* __restrict__ G, const float* __restrict__ wdw, bfr* __restrict__ U, int bid, int nblk) {
  const int gt = bid * 256 + otid(), nt = nblk * 256;
  for (int i = gt; i < MTOK * 128; i += nt) {
    const int m = i >> 7, c = (i & 127) * 8;
    int tl, T; tok_pos(m, tl, T);
    const bfr* gr = G + (size_t)m * 3072;
    const uint4 bg = *(const uint4*)(gr + c);
    float accv[8];
#pragma unroll
    for (int j = 0; j < 8; ++j) accv[j] = 0.f;
#pragma unroll
    for (int tap = 0; tap < 3; ++tap) {
      const int d = tap - 1;
      if ((d < 0 && tl == 0) || (d > 0 && tl == T - 1)) continue;
      const bfr* nr = gr + (ptrdiff_t)d * 3072;
      const uint4 cgv = *(const uint4*)(nr + 1024 + c);
      const uint4 xhv = *(const uint4*)(nr + 2048 + c);
      const float4 w0 = *(const float4*)(wdw + tap * DM + c);
      const float4 w1 = *(const float4*)(wdw + tap * DM + c + 4);
      accv[0] += w0.x * bflo(cgv.x) * bflo(xhv.x); accv[1] += w0.y * bfhi(cgv.x) * bfhi(xhv.x);
      accv[2] += w0.z * bflo(cgv.y) * bflo(xhv.y); accv[3] += w0.w * bfhi(cgv.y) * bfhi(xhv.y);
      accv[4] += w1.x * bflo(cgv.z) * bflo(xhv.z); accv[5] += w1.y * bfhi(cgv.z) * bfhi(xhv.z);
      accv[6] += w1.z * bflo(cgv.w) * bflo(xhv.w); accv[7] += w1.w * bfhi(cgv.w) * bfhi(xhv.w);
    }
    uint4 o;
    o.x = pk2(bflo(bg.x) * accv[0], bfhi(bg.x) * accv[1]);
    o.y = pk2(bflo(bg.y) * accv[2], bfhi(bg.y) * accv[3]);
    o.z = pk2(bflo(bg.z) * accv[4], bfhi(bg.z) * accv[5]);
    o.w = pk2(bflo(bg.w) * accv[6], bfhi(bg.w) * accv[7]);
    *(uint4*)(U + (size_t)m * DM + c) = o;
  }
}

DEVINL void pool_ew_phase(const bfr* __restrict__ H, bfr* __restrict__ P, int bid, int nblk) {
  const int gt = bid * 256 + otid(), nt = nblk * 256;
  for (int i = gt; i < MTOK * 128; i += nt) {
    const int m = i >> 7, ch = i & 127, c = ch * 8;
    int tl, T; tok_pos(m, tl, T);
    const int hw = 1 << (ch >> 5);
    const int lo = max(tl - hw, 0), hi = min(tl + hw, T);
    float s[8];
#pragma unroll
    for (int j = 0; j < 8; ++j) s[j] = 0.f;
    const bfr* base = H + (size_t)(m - tl) * DM + c;
    uint4 wv[16];
#pragma unroll
    for (int j = 0; j < 16; ++j) {
      const int q = tl - hw + j;
      const bool ok = (j < 2 * hw) && (q >= 0) && (q < T);
      wv[j] = ok ? *(const uint4*)(base + (size_t)q * DM) : make_uint4(0u, 0u, 0u, 0u);
    }
#pragma unroll
    for (int j = 0; j < 16; ++j) {
      const uint4 v = wv[j];
      s[0] += bflo(v.x); s[1] += bfhi(v.x); s[2] += bflo(v.y); s[3] += bfhi(v.y);
      s[4] += bflo(v.z); s[5] += bfhi(v.z); s[6] += bflo(v.w); s[7] += bfhi(v.w);
    }
    const float inv = 1.f / (float)(hi - lo);
    const uint4 v = *(const uint4*)(base + (size_t)tl * DM);
    uint4 o;
    o.x = pk2(s[0] * inv - bflo(v.x), s[1] * inv - bfhi(v.x));
    o.y = pk2(s[2] * inv - bflo(v.y), s[3] * inv - bfhi(v.y));
    o.z = pk2(s[4] * inv - bflo(v.z), s[5] * inv - bfhi(v.z));
    o.w = pk2(s[6] * inv - bflo(v.w), s[7] * inv - bfhi(v.w));
    *(uint4*)(P + (size_t)m * DM + c) = o;
  }
}

DEVINL void sgu_norm_phase(bfr* UV, const float* __restrict__ g, int bid, int nblk) {
  const int tid = otid(); const int lane = tid & 63;
  const int gw = bid * 4 + (tid >> 6), nw = nblk * 4;
  for (int row = gw; row < MTOK; row += nw) {
    bfr* vr = UV + (size_t)row * 2048 + 1024;
    float x[4][4];
    float ss = 0.f;
#pragma unroll
    for (int i = 0; i < 4; ++i) {
      const uint2 v = *(const uint2*)(vr + i * 256 + lane * 4);
      x[i][0] = bflo(v.x); x[i][1] = bfhi(v.x); x[i][2] = bflo(v.y); x[i][3] = bfhi(v.y);
      ss += x[i][0] * x[i][0] + x[i][1] * x[i][1] + x[i][2] * x[i][2] + x[i][3] * x[i][3];
    }
    ss = wave_sum(ss, lane);
    const float rstd = rsqrtf(ss * (1.f / DM) + EPS);
#pragma unroll
    for (int i = 0; i < 4; ++i) {
      const int c = i * 256 + lane * 4;
      const float4 gg = *(const float4*)(g + c);
      uint2 o;
      o.x = pk2(x[i][0] * rstd * gg.x, x[i][1] * rstd * gg.y);
      o.y = pk2(x[i][2] * rstd * gg.z, x[i][3] * rstd * gg.w);
      *(uint2*)(vr + c) = o;
    }
  }
}

DEVINL void sgu_spatial_phase(bfr* UV, const float* __restrict__ ws_, const float* __restrict__ bs_, char* smem, int bid, int nblk) {
  bfr* sV = (bfr*)smem;
  bfr* sW = sV + 128 * 136;
  const int tid = otid(), lane = tid & 63, wave = tid >> 6, l15 = lane & 15, quad = lane >> 4;
  for (int item = bid; item < 160 * 8; item += nblk) {
    const int chunk = item >> 3, g = item & 7;
    __syncthreads();
    const float* wg = ws_ + (size_t)g * 16384;
#pragma unroll 4
    for (int i = 0; i < 16; ++i) {
      const int idx = tid + 256 * i;
      const int row = idx >> 5, chn = idx & 31;
      const float4 v = *(const float4*)(wg + row * 128 + chn * 4);
      uint2 o; o.x = pk2(v.x, v.y); o.y = pk2(v.z, v.w);
      *(uint2*)(sW + row * 136 + chn * 4) = o;
    }
#pragma unroll 2
    for (int i = 0; i < 8; ++i) {
      const int idx = tid + 256 * i;
      const int q = idx >> 4, chn = idx & 15;
      const uint4 v = *(const uint4*)(UV + (size_t)(chunk * 128 + q) * 2048 + 1024 + g * 128 + chn * 8);
      bfr* d = sV + (chn * 8) * 136 + q;
      d[0 * 136] = (bfr)(v.x & 0xffff); d[1 * 136] = (bfr)(v.x >> 16);
      d[2 * 136] = (bfr)(v.y & 0xffff); d[3 * 136] = (bfr)(v.y >> 16);
      d[4 * 136] = (bfr)(v.z & 0xffff); d[5 * 136] = (bfr)(v.z >> 16);
      d[6 * 136] = (bfr)(v.w & 0xffff); d[7 * 136] = (bfr)(v.w >> 16);
    }
    __syncthreads();
    f32x4 acc[8][2];
#pragma unroll
    for (int i = 0; i < 8; ++i) { acc[i][0] = f32x4{0.f, 0.f, 0.f, 0.f}; acc[i][1] = f32x4{0.f, 0.f, 0.f, 0.f}; }
#pragma unroll
    for (int kk = 0; kk < 4; ++kk) {
      bf16x8 bw[2];
#pragma unroll
      for (int pt = 0; pt < 2; ++pt) bw[pt] = *(const bf16x8*)(sW + (wave * 32 + pt * 16 + l15) * 136 + kk * 32 + quad * 8);
#pragma unroll
      for (int ct = 0; ct < 8; ++ct) {
        const bf16x8 av = *(const bf16x8*)(sV + (ct * 16 + l15) * 136 + kk * 32 + quad * 8);
#pragma unroll
        for (int pt = 0; pt < 2; ++pt)
          acc[ct][pt] = __builtin_amdgcn_mfma_f32_16x16x32_bf16(av, bw[pt], acc[ct][pt], 0, 0, 0);
      }
    }
#pragma unroll
    for (int pt = 0; pt < 2; ++pt) {
      const int pp = wave * 32 + pt * 16 + l15;
      const float bias = bs_[g * 128 + pp];
      bfr* ur = UV + (size_t)(chunk * 128 + pp) * 2048 + g * 128 + quad * 4;
#pragma unroll
      for (int ct = 0; ct < 8; ++ct) {
        const uint2 u = *(const uint2*)(ur + ct * 16);
        uint2 o;
        o.x = pk2(bflo(u.x) * (acc[ct][pt][0] + bias), bfhi(u.x) * (acc[ct][pt][1] + bias));
        o.y = pk2(bflo(u.y) * (acc[ct][pt][2] + bias), bfhi(u.y) * (acc[ct][pt][3] + bias));
        *(uint2*)(ur + ct * 16) = o;
      }
    }
  }
}

DEVINL void hgrn_scan_phase(const Params& p, char* smem, int bid, int nblk, const int mode) {
  bfr* sQe = (bfr*)smem;
  bfr* sKe = sQe + 32 * 136;
  bfr* sKeT = sKe + 32 * 136;
  bfr* sVT = sKeT + 128 * 40;
  bfr* sP = sVT + 64 * 40;
  bfr* sST = sP + 32 * 40;
  float* sLast = (float*)(sST + 64 * 136);
  float* sTot = sLast + 128;
  const int tid = otid(), lane = tid & 63, wave = tid >> 6, l15 = lane & 15, quad = lane >> 4;
  const int cp = lane, qt = wave, i0 = qt * 8;
  const bfr* QZ = (const bfr*)(p.ws + OFF_BIG);
  bfr* Of = (bfr*)(p.ws + OFF_H);
  bfr* Ob = (bfr*)(p.ws + OFF_BIG + 209715200ull);
  const float* lbs = (const float*)(p.ws + OFF_LBS);
  const float* state_rec = p.in[2];
  float* out_state = p.out + (size_t)MTOK * DM;

  float* SLOC = (float*)(p.ws + OFF_BIG + 251658240ull);
  float* DLOC = (float*)(p.ws + OFF_BIG + 251658240ull + 33554432ull);
  const int nitems = mode ? 1536 : 896;
  for (int item = bid; item < nitems; item += nblk) {
    const int eh = item & 1, dir = (item >> 1) & 1, h = (item >> 2) & 7;
    int base, T, nchunks, pos0, slot, seq;
    bool is_prompt = false;
    if (!mode) {
      const int r = item >> 5, seqb = r / 7, j = r - seqb * 7;
      seq = 16 + seqb; base = NPROMPT + seqb * 4096; T = 4096; nchunks = 16; pos0 = j * 512;
      slot = ((seqb * 8 + j) * 8 + h) * 2 + dir;
    } else if (item < 1024) {
      const int r = item >> 5, seqb = r >> 3, j = r & 7;
      seq = 16 + seqb; base = NPROMPT + seqb * 4096; T = 4096; nchunks = 16; pos0 = j * 512;
      slot = ((seqb * 8 + j) * 8 + h) * 2 + dir;
    } else {
      seq = (item - 1024) >> 5; base = seq * 256; T = 256; nchunks = 8; pos0 = 0; slot = 0;
      is_prompt = true;
    }
    bfr* Od = dir ? Ob : Of;
    const float lbv0 = lbs[dir * 1024 + h * 128 + 2 * cp], lbv1 = lbs[dir * 1024 + h * 128 + 2 * cp + 1];
    const int eloc = wave * 16 + l15;
    const int eglob = eh * 64 + eloc;

    f32x4 S[8];
    if (is_prompt || !mode) {
#pragma unroll
      for (int dt = 0; dt < 8; ++dt) S[dt] = f32x4{0.f, 0.f, 0.f, 0.f};
    } else {
      const float* s0 = SLOC + (size_t)slot * 16384;
#pragma unroll
      for (int dt = 0; dt < 8; ++dt)
#pragma unroll
        for (int j = 0; j < 4; ++j) S[dt][j] = s0[(dt * 16 + quad * 4 + j) * 128 + eglob];
    }
    float cum0 = 1.f, cum1 = 1.f;
    __syncthreads();
#pragma unroll
    for (int dt = 0; dt < 8; ++dt) {
      uint2 o; o.x = pk2(S[dt][0], S[dt][1]); o.y = pk2(S[dt][2], S[dt][3]);
      *(uint2*)(sST + eloc * 136 + dt * 16 + quad * 4) = o;
    }

    const unsigned qoff2 = h * 64 + cp, zoff2 = (1 + dir) * 512 + h * 64 + cp;
    const unsigned voff2 = 1536 + h * 64 + eh * 32 + (cp & 31);
    const uint32_t* __restrict__ QZ32 = (const uint32_t*)QZ;
    uint32_t rq[8], rz[8], rv[8];
#pragma unroll
    for (int ii = 0; ii < 8; ++ii) {
      const int pos = pos0 + i0 + ii;
      const unsigned tok = dir ? base + T - 1 - pos : base + pos;
      const unsigned ri = tok * 2560u;
      rq[ii] = QZ32[ri + qoff2]; rz[ii] = QZ32[ri + zoff2]; rv[ii] = QZ32[ri + voff2];
    }

    for (int c = 0; c < nchunks; ++c) {
      float pc0[8], pc1[8], kv0[8], kv1[8];
      float run0 = 1.f, run1 = 1.f;
#pragma unroll
      for (int ii = 0; ii < 8; ++ii) {
        const float z0 = bflo(rz[ii]), z1 = bfhi(rz[ii]);
        const float f0 = lbv0 + (1.f - lbv0) * frcp(1.f + __expf(-z0));
        const float f1 = lbv1 + (1.f - lbv1) * frcp(1.f + __expf(-z1));
        run0 *= f0; run1 *= f1;
        pc0[ii] = run0; pc1[ii] = run1;
        kv0[ii] = 1.f - f0; kv1[ii] = 1.f - f1;
      }
      *(float2*)(sTot + qt * 128 + 2 * cp) = make_float2(run0, run1);
      __syncthreads();
      {
        float off0 = 1.f, off1 = 1.f, tot0 = 1.f, tot1 = 1.f;
#pragma unroll
        for (int q = 0; q < 4; ++q) {
          const float2 t = *(const float2*)(sTot + q * 128 + 2 * cp);
          if (q < qt) { off0 *= t.x; off1 *= t.y; }
          tot0 *= t.x; tot1 *= t.y;
        }
        uint32_t wk0[4], wk1[4], wv0[4], wv1[4];
#pragma unroll
        for (int ii = 0; ii < 8; ii += 2) {
          uint32_t kp[2];
#pragma unroll
          for (int u = 0; u < 2; ++u) {
            const float e0 = pc0[ii + u] * off0, e1 = pc1[ii + u] * off1;
            kp[u] = pk2(kv0[ii + u] * frcp(e0), kv1[ii + u] * frcp(e1));
            *(uint32_t*)(sKe + (i0 + ii + u) * 136 + 2 * cp) = kp[u];
            if (mode) *(uint32_t*)(sQe + (i0 + ii + u) * 136 + 2 * cp) = pk2(bflo(rq[ii + u]) * e0, bfhi(rq[ii + u]) * e1);
          }
          wk0[ii >> 1] = (kp[0] & 0xffffu) | (kp[1] << 16);
          wk1[ii >> 1] = (kp[0] >> 16) | (kp[1] & 0xffff0000u);
          wv0[ii >> 1] = (rv[ii] & 0xffffu) | (rv[ii + 1] << 16);
          wv1[ii >> 1] = (rv[ii] >> 16) | (rv[ii + 1] & 0xffff0000u);
        }
        *(u32x4*)(sKeT + (2 * cp) * 40 + i0) = u32x4{wk0[0], wk0[1], wk0[2], wk0[3]};
        *(u32x4*)(sKeT + (2 * cp + 1) * 40 + i0) = u32x4{wk1[0], wk1[1], wk1[2], wk1[3]};
        if (cp < 32) {
          *(u32x4*)(sVT + (2 * cp) * 40 + i0) = u32x4{wv0[0], wv0[1], wv0[2], wv0[3]};
          *(u32x4*)(sVT + (2 * cp + 1) * 40 + i0) = u32x4{wv1[0], wv1[1], wv1[2], wv1[3]};
        }
        if (qt == 0) *(float2*)(sLast + 2 * cp) = make_float2(tot0, tot1);
        cum0 *= tot0; cum1 *= tot1;
      }
      if (c + 1 < nchunks) {
#pragma unroll
        for (int ii = 0; ii < 8; ++ii) {
          const int pos = pos0 + (c + 1) * 32 + i0 + ii;
          const unsigned tok = dir ? base + T - 1 - pos : base + pos;
          const unsigned ri = tok * 2560u;
          rq[ii] = QZ32[ri + qoff2]; rz[ii] = QZ32[ri + zoff2]; rv[ii] = QZ32[ri + voff2];
        }
      }
      __syncthreads();
      if (mode) {
        const int ti = wave >> 1, si = wave & 1;
        f32x4 sc = f32x4{0.f, 0.f, 0.f, 0.f};
        if (si <= ti) {
#pragma unroll
          for (int kk = 0; kk < 4; ++kk) {
            const bf16x8 a = *(const bf16x8*)(sQe + (ti * 16 + l15) * 136 + kk * 32 + quad * 8);
            const bf16x8 b = *(const bf16x8*)(sKe + (si * 16 + l15) * 136 + kk * 32 + quad * 8);
            sc = __builtin_amdgcn_mfma_f32_16x16x32_bf16(a, b, sc, 0, 0, 0);
          }
        }
#pragma unroll
        for (int j = 0; j < 4; ++j) {
          const int t = ti * 16 + quad * 4 + j, s2 = si * 16 + l15;
          sP[t * 40 + s2] = (s2 <= t) ? f2bf(sc[j]) : (bfr)0;
        }
      }
      f32x4 oacc[2];
      oacc[0] = f32x4{0.f, 0.f, 0.f, 0.f}; oacc[1] = f32x4{0.f, 0.f, 0.f, 0.f};
      if (mode) {
#pragma unroll
      for (int kk = 0; kk < 4; ++kk) {
        const bf16x8 sb = *(const bf16x8*)(sST + eloc * 136 + kk * 32 + quad * 8);
#pragma unroll
        for (int tt = 0; tt < 2; ++tt) {
          const bf16x8 qa = *(const bf16x8*)(sQe + (tt * 16 + l15) * 136 + kk * 32 + quad * 8);
          oacc[tt] = __builtin_amdgcn_mfma_f32_16x16x32_bf16(sb, qa, oacc[tt], 0, 0, 0);
        }
      }
      }
      __syncthreads();
      {
        const bf16x8 vb = *(const bf16x8*)(sVT + eloc * 40 + quad * 8);
        if (mode) {
#pragma unroll
        for (int tt = 0; tt < 2; ++tt) {
          const bf16x8 pb = *(const bf16x8*)(sP + (tt * 16 + l15) * 40 + quad * 8);
          oacc[tt] = __builtin_amdgcn_mfma_f32_16x16x32_bf16(vb, pb, oacc[tt], 0, 0, 0);
          const int pos = pos0 + c * 32 + tt * 16 + l15;
          const int tok = dir ? base + T - 1 - pos : base + pos;
          uint2 o; o.x = pk2(oacc[tt][0], oacc[tt][1]); o.y = pk2(oacc[tt][2], oacc[tt][3]);
          *(uint2*)(Od + (size_t)tok * DM + h * 128 + eh * 64 + wave * 16 + quad * 4) = o;
        }
        }
#pragma unroll
        for (int dt = 0; dt < 8; ++dt) {
          const bf16x8 ka = *(const bf16x8*)(sKeT + (dt * 16 + l15) * 40 + quad * 8);
          const float4 dl = *(const float4*)(sLast + dt * 16 + quad * 4);
          f32x4 sn = __builtin_amdgcn_mfma_f32_16x16x32_bf16(ka, vb, S[dt], 0, 0, 0);
          sn[0] *= dl.x; sn[1] *= dl.y; sn[2] *= dl.z; sn[3] *= dl.w;
          S[dt] = sn;
          uint2 o; o.x = pk2(sn[0], sn[1]); o.y = pk2(sn[2], sn[3]);
          *(uint2*)(sST + eloc * 136 + dt * 16 + quad * 4) = o;
        }
      }
    }
    if (is_prompt || !mode) {
      float* so = is_prompt ? out_state + ((size_t)(seq * 2 + dir) * 8 + h) * 16384 : SLOC + (size_t)slot * 16384;
#pragma unroll
      for (int dt = 0; dt < 8; ++dt)
#pragma unroll
        for (int j = 0; j < 4; ++j) so[(dt * 16 + quad * 4 + j) * 128 + eglob] = S[dt][j];
      if (!mode && eh == 0 && qt == 0) *(float2*)(DLOC + slot * 128 + 2 * cp) = make_float2(cum0, cum1);
    }
  }
}

DEVINL void hgrn_combine_phase(const Params& p, int bid, int nblk) {
  const int gt = bid * 256 + otid(), nt = nblk * 256;
  float* SLOC = (float*)(p.ws + OFF_BIG + 251658240ull);
  const float* DLOC = (const float*)(p.ws + OFF_BIG + 251658240ull + 33554432ull);
  const float* state_rec = p.in[2];
  for (int idx = gt; idx < 4 * 8 * 2 * 16384; idx += nt) {
    const int de = idx & 16383, r = idx >> 14;
    const int dir = r & 1, h = (r >> 1) & 7, seqb = r >> 4;
    const int d = de >> 7;
    float prev = state_rec[((size_t)(seqb * 2 + dir) * 8 + h) * 16384 + de];
#pragma unroll
    for (int j = 0; j < 8; ++j) {
      const int slot = ((seqb * 8 + j) * 8 + h) * 2 + dir;
      float* ptr = SLOC + (size_t)slot * 16384 + de;
      const float a = (j < 7) ? *ptr : 0.f;
      *ptr = prev;
      if (j < 7) prev = DLOC[slot * 128 + d] * prev + a;
    }
  }
}

DEVINL void hgrn_gate_phase(const Params& p, const float* __restrict__ ng, int bid, int nblk) {
  const int tid = otid(); const int lane = tid & 63;
  const int gw = bid * 4 + (tid >> 6), nw = nblk * 4;
  bfr* Of = (bfr*)(p.ws + OFF_H);
  const bfr* Ob = (const bfr*)(p.ws + OFF_BIG + 209715200ull);
  const bfr* QZ = (const bfr*)(p.ws + OFF_BIG);
  for (int row = gw; row < MTOK; row += nw) {
#pragma unroll
    for (int seg = 0; seg < 4; ++seg) {
      const int c = seg * 256 + lane * 4;
      const uint2 a = *(const uint2*)(Of + (size_t)row * DM + c);
      const uint2 b = *(const uint2*)(Ob + (size_t)row * DM + c);
      const uint2 gq = *(const uint2*)(QZ + (size_t)row * 5120 + 4096 + c);
      const float o0 = bflo(a.x) + bflo(b.x), o1 = bfhi(a.x) + bfhi(b.x), o2 = bflo(a.y) + bflo(b.y), o3 = bfhi(a.y) + bfhi(b.y);
      float ss = o0 * o0 + o1 * o1 + o2 * o2 + o3 * o3;
#pragma unroll
      for (int o = 16; o > 0; o >>= 1) ss += shx(ss, o, lane);
      const float rstd = rsqrtf(ss * (1.f / 128.f) + EPS);
      const float4 gg = *(const float4*)(ng + c);
      uint2 o;
      o.x = pk2(o0 * rstd * gg.x * silu_f(bflo(gq.x)), o1 * rstd * gg.y * silu_f(bfhi(gq.x)));
      o.y = pk2(o2 * rstd * gg.z * silu_f(bflo(gq.y)), o3 * rstd * gg.w * silu_f(bfhi(gq.y)));
      *(uint2*)(Of + (size_t)row * DM + c) = o;
    }
  }
}

DEVINL void ffn_act_phase(const bfr* __restrict__ UP, const float* __restrict__ wdw, int hf, bfr* __restrict__ ACT, int bid, int nblk) {
  const int gt = bid * 256 + otid(), nt = nblk * 256;
  for (int i = gt; i < MTOK * 176; i += nt) {
    const int m = i / 176, j = (i - m * 176) * 8;
    int tl, T; tok_pos(m, tl, T);
    const bfr* ur = UP + (size_t)m * DFF;
    float a[8], b[8];
#pragma unroll
    for (int q = 0; q < 8; ++q) { a[q] = 0.f; b[q] = 0.f; }
#pragma unroll
    for (int tap = 0; tap < 3; ++tap) {
      const int d = tap - 1;
      if ((d < 0 && tl == 0) || (d > 0 && tl == T - 1)) continue;
      const bfr* nr = ur + (ptrdiff_t)d * DFF;
      const uint4 av = *(const uint4*)(nr + j);
      const uint4 bv = *(const uint4*)(nr + HALF_FF + j);
      const float* wa = wdw + tap * (2 * DFF) + hf * HALF_FF + j;
      const float* wb = wdw + tap * (2 * DFF) + DFF + hf * HALF_FF + j;
      const float4 wa0 = *(const float4*)wa, wa1 = *(const float4*)(wa + 4);
      const float4 wb0 = *(const float4*)wb, wb1 = *(const float4*)(wb + 4);
      a[0] += wa0.x * bflo(av.x); a[1] += wa0.y * bfhi(av.x); a[2] += wa0.z * bflo(av.y); a[3] += wa0.w * bfhi(av.y);
      a[4] += wa1.x * bflo(av.z); a[5] += wa1.y * bfhi(av.z); a[6] += wa1.z * bflo(av.w); a[7] += wa1.w * bfhi(av.w);
      b[0] += wb0.x * bflo(bv.x); b[1] += wb0.y * bfhi(bv.x); b[2] += wb0.z * bflo(bv.y); b[3] += wb0.w * bfhi(bv.y);
      b[4] += wb1.x * bflo(bv.z); b[5] += wb1.y * bfhi(bv.z); b[6] += wb1.z * bflo(bv.w); b[7] += wb1.w * bfhi(bv.w);
    }
    uint4 o;
    o.x = pk2(silu_f(a[0]) * b[0], silu_f(a[1]) * b[1]);
    o.y = pk2(silu_f(a[2]) * b[2], silu_f(a[3]) * b[3]);
    o.z = pk2(silu_f(a[4]) * b[4], silu_f(a[5]) * b[5]);
    o.w = pk2(silu_f(a[6]) * b[6], silu_f(a[7]) * b[7]);
    *(uint4*)(ACT + (size_t)m * DFF + hf * HALF_FF + j) = o;
  }
}


#define XB_TMO      128
#define XB_XCNT(j)  (256  + 64 * (j))
#define XB_XSUB(j)  (1280 + 64 * (j))
#define XB_XGEN(j)  (2304 + 64 * (j))
#define XB_TOP      3328
#define XB_TOPGEN   3392
#define XCD_BAR_WORDS 3456
#define XB_SPIN_CAP (1u << 22)
#define LAS __attribute__((address_space(3)))
DEVINL unsigned xb_ld(unsigned* p) { return __hip_atomic_load(p, __ATOMIC_RELAXED, __HIP_MEMORY_SCOPE_AGENT); }
DEVINL unsigned xb_add(unsigned* p, unsigned v) { return __hip_atomic_fetch_add(p, v, __ATOMIC_RELAXED, __HIP_MEMORY_SCOPE_AGENT); }
DEVINL unsigned xb_xcc_id() { return (unsigned)__builtin_amdgcn_s_getreg((3 << 11) | 20) & 0xFu; }
#define XB_SPIN(cond, bar) do { unsigned _sp = 0; while (cond) { __builtin_amdgcn_s_sleep(1); \
    if ((++_sp & 255u) == 0u) { if (xb_ld(&(bar)[XB_TMO])) break; if (_sp > XB_SPIN_CAP) { atomicAdd(&(bar)[XB_TMO], 1u); break; } } } } while (0)
struct XcdBarrier { unsigned* bar; unsigned x; volatile LAS unsigned* st; };
DEVINL XcdBarrier xcd_barrier_post(unsigned* bar, volatile LAS unsigned* st) {
  XcdBarrier b; b.bar = bar; b.x = xb_xcc_id(); b.st = st;
  if (threadIdx.x == 0) (void)xb_add(&bar[XB_XCNT(b.x)], 1u);
  return b;
}
DEVINL void xcd_barrier_complete(unsigned* bar, unsigned x, unsigned& nloc, unsigned& nx) {
  const unsigned G = gridDim.x * gridDim.y * gridDim.z;
  unsigned sum, cnt, mine, sp = 0u;
  for (;;) {
    sum = 0u; cnt = 0u; mine = 0u;
#pragma unroll
    for (unsigned j = 0; j < 16; ++j) { const unsigned c = xb_ld(&bar[XB_XCNT(j)]); sum += c; cnt += (c > 0u) ? 1u : 0u; mine = (j == x) ? c : mine; }
    if (sum == G) break;
    __builtin_amdgcn_s_sleep(1);
    if ((++sp & 255u) == 0u) { if (xb_ld(&bar[XB_TMO])) break; if (sp > XB_SPIN_CAP) { atomicAdd(&bar[XB_TMO], 1u); break; } }
  }
  nloc = mine > 0u ? mine : 1u; nx = cnt > 0u ? cnt : 1u;
}
DEVINL void xcd_barrier(const XcdBarrier& b) {
  asm volatile("s_waitcnt vmcnt(0)" ::: "memory");
  __syncthreads();
  if (threadIdx.x == 0) {
    unsigned* bar = b.bar;
    unsigned bx = b.x;
    asm volatile("" : "+s"(bar), "+s"(bx));
    __builtin_amdgcn_s_waitcnt(0);
    unsigned nloc = b.st[0], nx = b.st[1];
    if (nloc == 0u) { xcd_barrier_complete(bar, bx, nloc, nx); b.st[0] = nloc; b.st[1] = nx; }
    const unsigned old = xb_add(&bar[XB_XSUB(bx)], 1u);
    const unsigned gen = old / nloc;
    if (old + 1u == (gen + 1u) * nloc) {
      __builtin_amdgcn_fence(__ATOMIC_RELEASE, "agent");
      asm volatile("s_waitcnt vmcnt(0)" ::: "memory");
      const unsigned og = xb_add(&bar[XB_TOP], 1u);
      const unsigned tg = og / nx;
      if (og + 1u == (tg + 1u) * nx) xb_add(&bar[XB_TOPGEN], 1u);
      else XB_SPIN(xb_ld(&bar[XB_TOPGEN]) == tg, bar);
      __builtin_amdgcn_fence(__ATOMIC_ACQUIRE, "agent");
      xb_add(&bar[XB_XGEN(bx)], 1u);
      asm volatile("s_waitcnt vmcnt(0)" ::: "memory");
    } else {
      XB_SPIN(xb_ld(&bar[XB_XGEN(bx)]) == gen, bar);
      __builtin_amdgcn_fence(__ATOMIC_ACQUIRE, "agent");
      asm volatile("s_waitcnt vmcnt(0)" ::: "memory");
    }
  }
  __syncthreads();
}

constexpr int SMEM_BYTES = 77824;

__global__ void __launch_bounds__(256, 2) mega_kernel(Params p) {
  __shared__ __attribute__((aligned(16))) char smem[SMEM_BYTES];
  cg::grid_group grid = cg::this_grid();
  __shared__ uint4 xb_words;
  if (threadIdx.x == 0) xb_words = make_uint4(0u, 0u, 0u, 0u);
  __syncthreads();
  XcdBarrier xb = xcd_barrier_post((unsigned*)(p.ws + OFF_BAR), (volatile LAS unsigned*)&xb_words);
  const int bid = blockIdx.x, nblk = gridDim.x;

  phase0a(p, smem, osg(bid), nblk);
  grid.sync();
  phase0b(p, osg(bid), nblk);
  xcd_barrier(xb);

  for (int layer = 0; layer < 4; ++layer) {
    Params q = p;
    {
      size_t oz = 0;
      asm volatile("" : "+s"(oz));
      q.ws = p.ws + oz;
      q.out = p.out + oz;
    }
    float* X = q.out;
    bfr* WB = (bfr*)(q.ws + OFF_WB);
    bfr* H = (bfr*)(q.ws + OFF_H);
    bfr* BIG = (bfr*)(q.ws + OFF_BIG);
    const float* MOD = (const float*)(q.ws + OFF_MOD);
    const float* modl = MOD + layer * 30720;
    if (layer == 0) {
      conv_matrix(q.in[9], 1024, 3072, WB + WB_IN, 0, smem, osg(bid), nblk);
      conv_matrix(q.in[11], 1024, 1024, WB + WB_OUT, 0, smem, osg(bid), nblk);
    } else if (layer == 1) {
      for (int g = 0; g < 4; ++g) conv_matrix(q.in[12] + g * 65536, 256, 256, WB + WB_IN + g * 65536, 0, smem, osg(bid), nblk);
    } else if (layer == 2) {
      conv_matrix(q.in[14], 1024, 2048, WB + WB_IN, 0, smem, osg(bid), nblk);
      conv_matrix(q.in[18], 1024, 1024, WB + WB_OUT, 0, smem, osg(bid), nblk);
    } else {
      conv_matrix(q.in[19], 1024, 5120, WB + WB_IN, 0, smem, osg(bid), nblk);
      conv_matrix(q.in[22], 1024, 1024, WB + WB_OUT, 0, smem, osg(bid), nblk);
    }
    conv_matrix(q.in[23] + (size_t)layer * 1024 * 5632, 1024, 5632, WB + WB_UP, 1, smem, osg(bid), nblk);
    conv_matrix(q.in[25] + (size_t)layer * DFF * 1024, DFF, 1024, WB + WB_DOWN, 0, smem, osg(bid), nblk);
    norm_phase(X, q.in[7] + (layer * 2 + 0) * DM, modl, 0, 1024, H, osg(bid), nblk);
    xcd_barrier(xb);

    if (layer == 0) {
      bfr* G = BIG;
      bfr* U = BIG + (size_t)MTOK * 3072;
      gemm256s_phase(H, DM, WB + WB_IN, 1024, 3072, 1024, EpiStore{G, 3072}, smem, osg(bid), nblk);
      xcd_barrier(xb);
      shortconv_ew_phase(G, q.in[10], U, osg(bid), nblk);
      xcd_barrier(xb);
      gemm_phase(U, DM, WB + WB_OUT, 1024, 1024, 1024, EpiResid{X, modl + 2048, nullptr, 0}, smem, osg(bid), nblk);
      xcd_barrier(xb);
    } else if (layer == 1) {
      bfr* P = BIG;
      pool_ew_phase(H, P, osg(bid), nblk);
      xcd_barrier(xb);
      for (int g = 0; g < 4; ++g)
        gemm_phase(P + g * 256, DM, WB + WB_IN + g * 65536, 256, 256, 256,
                   EpiResid{X, modl + 2048 + g * 256, q.in[13] + g * 256, g * 256}, smem, osg(bid), nblk);
      xcd_barrier(xb);
    } else if (layer == 2) {
      bfr* UV = BIG;
      gemm_phase(H, DM, WB + WB_IN, 1024, 2048, 1024, EpiGelu{UV, 2048}, smem, osg(bid), nblk);
      xcd_barrier(xb);
      sgu_norm_phase(UV, q.in[15], osg(bid), nblk);
      xcd_barrier(xb);
      sgu_spatial_phase(UV, q.in[16], q.in[17], smem, osg(bid), nblk);
      xcd_barrier(xb);
      gemm_phase(UV, 2048, WB + WB_OUT, 1024, 1024, 1024, EpiResid{X, modl + 2048, nullptr, 0}, smem, osg(bid), nblk);
      xcd_barrier(xb);
    } else {
      bfr* QZ = BIG;
      gemm256s_phase(H, DM, WB + WB_IN, 1024, 5120, 1024, EpiStore{QZ, 5120}, smem, osg(bid), nblk);
      xcd_barrier(xb);
      hgrn_scan_phase(q, smem, osg(bid), nblk, 0);
      xcd_barrier(xb);
      hgrn_combine_phase(q, osg(bid), nblk);
      xcd_barrier(xb);
      hgrn_scan_phase(q, smem, osg(bid), nblk, 1);
      xcd_barrier(xb);
      hgrn_gate_phase(q, q.in[21], osg(bid), nblk);
      xcd_barrier(xb);
      gemm_phase(H, DM, WB + WB_OUT, 1024, 1024, 1024, EpiResid{X, modl + 2048, nullptr, 0}, smem, osg(bid), nblk);
      xcd_barrier(xb);
    }

    norm_phase(X, q.in[7] + (layer * 2 + 1) * DM, modl, 3072, 4096, H, osg(bid), nblk);
    xcd_barrier(xb);
    bfr* ACT = BIG;
    float* EDGE = (float*)(q.ws + OFF_BIG + 115343360ull);
    const float* wdw = q.in[24] + (size_t)layer * 3 * 2 * DFF;
    gemm256s_phase(H, DM, WB + WB_UP, 1024, 2 * DFF, 1024, EpiFfnUp{ACT, EDGE, wdw}, smem, osg(bid), nblk);
    xcd_barrier(xb);
    ffn_edge_phase(EDGE, wdw, ACT, osg(bid), nblk);
    xcd_barrier(xb);
    gemm_phase(ACT, DFF, WB + WB_DOWN, DFF, 1024, DFF, EpiResid{X, modl + 5120, nullptr, 0}, smem, osg(bid), nblk);
    xcd_barrier(xb);
  }
  final_norm_phase(p.out, p.in[8], osg(bid), nblk);
}

extern "C" void kernel_launch(void* const* d_in, const int* in_sizes, int n_in, void* d_out, int out_size,
                              void* d_ws, size_t ws_size, hipStream_t stream) {
  static int grid_blocks = 0;
  if (!grid_blocks) {
    int dev = 0, cus = 0, per_cu = 0;
    hipGetDevice(&dev);
    hipDeviceGetAttribute(&cus, hipDeviceAttributeMultiprocessorCount, dev);
    hipOccupancyMaxActiveBlocksPerMultiprocessor(&per_cu, mega_kernel, 256, 0);
    if (per_cu > 2) per_cu = 2;
    if (per_cu < 1) per_cu = 1;
    grid_blocks = cus * per_cu;
  }
  if (ws_size < WS_NEED) { fprintf(stderr, "workspace too small: %zu < %zu\n", ws_size, (size_t)WS_NEED); return; }
  Params p{};
  for (int i = 0; i < 26; ++i) p.in[i] = (const float*)d_in[i];
  p.out = (float*)d_out;
  p.ws = (char*)d_ws;
  hipMemsetAsync((char*)d_ws + OFF_BAR, 0, XCD_BAR_WORDS * 4, stream);
  void* args[] = {&p};
  hipError_t e = hipLaunchCooperativeKernel((void*)mega_kernel, dim3(grid_blocks), dim3(256), args, 0, stream);
  if (e != hipSuccess) fprintf(stderr, "cooperative launch failed: %s (grid %d)\n", hipGetErrorString(e), grid_blocks);
}
```

```cpp
#include <hip/hip_runtime.h>
#include <hip/hip_cooperative_groups.h>
#include <stdint.h>
#include <stdio.h>
namespace cg = cooperative_groups;

#define DEVINL __device__ __forceinline__
typedef unsigned short bfr;
using bf16x8 = __attribute__((ext_vector_type(8))) short;
using f32x4 = __attribute__((ext_vector_type(4))) float;
using u32x4 = __attribute__((ext_vector_type(4))) unsigned int;

constexpr int DM = 1024;
constexpr int MTOK = 20480;
constexpr int NPROMPT = 4096;
constexpr int DFF = 2816;
constexpr int HALF_FF = 1408;
constexpr float EPS = 1e-6f;

constexpr size_t OFF_MODP = 0;
constexpr size_t OFF_MOD = 7864320;
constexpr size_t OFF_LBS = OFF_MOD + 491520;
constexpr size_t OFF_BAR = OFF_LBS + 8192;
constexpr size_t OFF_WB = 8388608;
constexpr size_t OFF_H = 41943040;
constexpr size_t OFF_BIG = 83886080;
constexpr size_t WS_NEED = OFF_BIG + 251658240ull + 33554432ull + 262144ull;
constexpr size_t WB_IN = 0, WB_OUT = 5242880, WB_UP = 6291456, WB_DOWN = 12058624;

struct Params {
  const float* in[26];
  float* out;
  char* ws;
};

DEVINL int otid() { int t = threadIdx.x; asm volatile("" : "+v"(t)); return t; }
DEVINL int osg(int x) { asm volatile("" : "+s"(x)); return x; }
typedef __bf16 hbf16x2 __attribute__((ext_vector_type(2)));
typedef float hf32x2 __attribute__((ext_vector_type(2)));
DEVINL uint32_t pk2(float a, float b) {
  hf32x2 v = {a, b};
  hbf16x2 r = __builtin_convertvector(v, hbf16x2);
  return __builtin_bit_cast(uint32_t, r);
}
DEVINL bfr f2bf(float f) { return (bfr)(pk2(f, 0.f) & 0xffffu); }
DEVINL float bf2f(bfr h) { return __uint_as_float(((uint32_t)h) << 16); }
DEVINL float frcp(float x) { return __builtin_amdgcn_rcpf(x); }
DEVINL float bflo(uint32_t u) { return __uint_as_float(u << 16); }
DEVINL float bfhi(uint32_t u) { return __uint_as_float(u & 0xffff0000u); }
DEVINL int cond_of(int m) { return m < NPROMPT ? 0 : 1 + ((m - NPROMPT) >> 12); }
DEVINL float silu_f(float x) { return x * frcp(1.f + __expf(-x)); }
DEVINL float gelu_tanh_f(float x) {
  float y = 0.7978845608028654f * (x + 0.044715f * x * x * x);
  float t = 1.f - 2.f * frcp(__expf(2.f * y) + 1.f);
  return 0.5f * x * (1.f + t);
}
DEVINL float shx(float v, int o, int lane) {
  return __int_as_float(__builtin_amdgcn_ds_bpermute((lane ^ o) << 2, __float_as_int(v)));
}
DEVINL float wave_sum(float v, int lane) {
#pragma unroll
  for (int o = 32; o > 0; o >>= 1) v += shx(v, o, lane);
  return v;
}

DEVINL void tok_pos(int m, int& tl, int& T) {
  if (m < NPROMPT) { tl = m & 255; T = 256; } else { tl = (m - NPROMPT) & 4095; T = 4096; }
}

struct EpiNoPre {};
#define EPI_ELEMENTWISE_TILE                                                                       \
  typedef EpiNoPre Pre;                                                                             \
  static constexpr bool kLdsEpi = false;                                                            \
  DEVINL Pre pre(int tn, int tid) const { return Pre{}; }                                           \
  DEVINL void tile(const f32x4 (&acc)[4][4], const Pre& pre_, int m0, int n0, int tn, int wm, int wn, int l15, \
                   int quad, int tid, char* smem) const {                                           \
    _Pragma("unroll") for (int mt = 0; mt < 4; ++mt)                                                \
      _Pragma("unroll") for (int nt = 0; nt < 4; ++nt)                                              \
        (*this)(m0 + wm * 64 + mt * 16 + l15, n0 + wn * 64 + nt * 16 + quad * 4, acc[mt][nt]);      \
  }
struct EpiStore {
  bfr* C; int ldc;
  DEVINL void tile256(const f32x4 (&acc)[8][4], const EpiNoPre& pre_, int m0, int n0, int tn, int wm, int wn, int l15,
                      int quad, int tid, char* smem) const {
#pragma unroll
    for (int mt = 0; mt < 8; ++mt)
#pragma unroll
      for (int nt = 0; nt < 4; ++nt)
        (*this)(m0 + wm * 128 + mt * 16 + l15, n0 + wn * 64 + nt * 16 + quad * 4, acc[mt][nt]);
  }
  DEVINL void operator()(int m, int n, f32x4 v) const {
    uint2 o; o.x = pk2(v[0], v[1]); o.y = pk2(v[2], v[3]);
    *(uint2*)(C + (size_t)m * ldc + n) = o;
  }
  EPI_ELEMENTWISE_TILE
};
struct EpiGelu {
  bfr* C; int ldc;
  DEVINL void operator()(int m, int n, f32x4 v) const {
    uint2 o; o.x = pk2(gelu_tanh_f(v[0]), gelu_tanh_f(v[1])); o.y = pk2(gelu_tanh_f(v[2]), gelu_tanh_f(v[3]));
    *(uint2*)(C + (size_t)m * ldc + n) = o;
  }
  EPI_ELEMENTWISE_TILE
};
struct EpiResid {
  float* X; const float* gate; const float* cscale; int coff;
  typedef EpiNoPre Pre;
  static constexpr bool kLdsEpi = false;
  static constexpr bool kSplit = false;
  DEVINL Pre pre(int tn, int tid) const { return Pre{}; }
  DEVINL void tile(const f32x4 (&acc)[4][4], const Pre& pre_, int m0, int n0, int tn, int wm, int wn, int l15,
                   int quad, int tid, char* smem) const {
    const int cond = cond_of(m0);
    const int nb = n0 + wn * 64 + quad * 4;
    f32x4 gs[4];
#pragma unroll
    for (int nt = 0; nt < 4; ++nt) {
      gs[nt] = *(const f32x4*)(gate + cond * 6144 + nb + nt * 16);
      if (cscale) gs[nt] = gs[nt] * *(const f32x4*)(cscale + nb + nt * 16);
    }
    float* xb = X + (size_t)(m0 + wm * 64 + l15) * DM + coff + nb;
#pragma unroll
    for (int hm = 0; hm < 2; ++hm) {
      f32x4 xv[2][4];
#pragma unroll
      for (int mi = 0; mi < 2; ++mi)
#pragma unroll
        for (int nt = 0; nt < 4; ++nt)
          xv[mi][nt] = *(const f32x4*)(xb + (size_t)((hm * 2 + mi) * 16) * DM + nt * 16);
#pragma unroll
      for (int mi = 0; mi < 2; ++mi)
#pragma unroll
        for (int nt = 0; nt < 4; ++nt)
          *(f32x4*)(xb + (size_t)((hm * 2 + mi) * 16) * DM + nt * 16) = xv[mi][nt] + gs[nt] * acc[hm * 2 + mi][nt];
    }
  }
};


#define LDS3 __attribute__((address_space(3)))
DEVINL void lds_barrier() { asm volatile("s_waitcnt lgkmcnt(0)\n\ts_barrier" ::: "memory"); }
template <class Epi>
DEVINL void gemm_phase(const bfr* __restrict__ A, int lda, const bfr* __restrict__ Bt, int ldb, int N, int K,
                       const Epi& epi, char* smem, int bid, int nblk) {
  const int tid = otid(), lane = tid & 63, wave = tid >> 6;
  const int wm = wave >> 1, wn = wave & 1, l15 = lane & 15, quad = lane >> 4;
  const int tilesN = N >> 7;
  const int ntiles = (MTOK >> 7) * tilesN;
  const int nk = K >> 6;
  const int srow0 = wave * 8 + (lane >> 3);
  const int lc = (lane & 7) ^ ((srow0 >> 1) & 7);
  const int fsw = (l15 >> 1) & 7;
  char* const dst0 = smem + wave * 1024 + lane * 16;
#define TILE_DECODE(t_, tm_, tn_) {                                                        \
    const int xcd_ = (t_) & 7, u_ = (t_) >> 3, g16_ = 16 * tilesN;                         \
    int ur_;                                                                               \
    if (u_ < g16_) { const int gs_ = 8 * tilesN; const int g_ = u_ / gs_, r_ = u_ - g_ * gs_; tn_ = r_ >> 3; ur_ = g_ * 8 + (r_ & 7); } \
    else { const int r_ = u_ - g16_; tn_ = r_ >> 2; ur_ = 16 + (r_ & 3); }                 \
    tm_ = ur_ * 8 + xcd_; }
#define GLDS_STAGE(pa_, pb_, st_, kt_)                                                                    \
  {                                                                                                       \
    _Pragma("unroll") for (int i = 0; i < 4; ++i) {                                                       \
      __builtin_amdgcn_global_load_lds((const unsigned*)((pa_) + (size_t)(i * 32) * lda + (kt_) * 64),    \
                                       (LDS3 unsigned*)(dst0 + (st_) * 32768 + i * 4096), 16, 0, 0);      \
      __builtin_amdgcn_global_load_lds((const unsigned*)((pb_) + (size_t)(i * 32) * ldb + (kt_) * 64),    \
                                       (LDS3 unsigned*)(dst0 + (st_) * 32768 + 16384 + i * 4096), 16, 0, 0); \
    }                                                                                                     \
  }
  int tile = bid;
  if (tile >= ntiles) return;
  int tm, tn;
  TILE_DECODE(tile, tm, tn)
  const bfr* gA = A + (size_t)((tm << 7) + srow0) * lda + lc * 8;
  const bfr* gB = Bt + (size_t)((tn << 7) + srow0) * ldb + lc * 8;
  __syncthreads();
  GLDS_STAGE(gA, gB, 0, 0)
  for (; tile < ntiles; tile += nblk) {
    const int m0 = tm << 7, n0 = tn << 7, tn_cur = tn;
    const bool has_next = (tile + nblk < ntiles);
    const bfr* gAn = gA; const bfr* gBn = gB;
    if (has_next) {
      TILE_DECODE(tile + nblk, tm, tn)
      gAn = A + (size_t)((tm << 7) + srow0) * lda + lc * 8;
      gBn = Bt + (size_t)((tn << 7) + srow0) * ldb + lc * 8;
    }
    typename Epi::Pre pre = epi.pre(tn_cur, tid);
    f32x4 acc[4][4];
#pragma unroll
    for (int i = 0; i < 4; ++i)
#pragma unroll
      for (int j = 0; j < 4; ++j) acc[i][j] = f32x4{0.f, 0.f, 0.f, 0.f};
    __syncthreads();
    for (int kt = 0; kt < nk; ++kt) {
      const int st = kt & 1;
      const bool cur = (kt + 1 < nk);
      const bool any = cur || has_next;
      const bfr* sa = cur ? gA + (kt + 1) * 64 : gAn;
      const bfr* sb = cur ? gB + (kt + 1) * 64 : gBn;
      char* sd = dst0 + (cur ? (st ^ 1) : 0) * 32768;
      __builtin_amdgcn_s_setprio(3);
      const char* cA = smem + st * 32768 + (wm * 64 + l15) * 128;
      const char* cB = smem + st * 32768 + 16384 + (wn * 64 + l15) * 128;
      {
        const int co0 = (quad ^ fsw) * 16, co1 = ((4 + quad) ^ fsw) * 16;
        bf16x8 af0[4], bf0[4], af1[4], bf1[4];
#pragma unroll
        for (int i = 0; i < 4; ++i) {
          af0[i] = *(const bf16x8*)(cA + i * 2048 + co0);
          bf0[i] = *(const bf16x8*)(cB + i * 2048 + co0);
        }
#pragma unroll
        for (int i = 0; i < 4; ++i) {
          af1[i] = *(const bf16x8*)(cA + i * 2048 + co1);
          bf1[i] = *(const bf16x8*)(cB + i * 2048 + co1);
        }
        __builtin_amdgcn_sched_barrier(0);
        if (any) {
#pragma unroll
          for (int mt = 0; mt < 4; ++mt) {
            __builtin_amdgcn_global_load_lds((const unsigned*)(sa + (size_t)(mt * 32) * lda), (LDS3 unsigned*)(sd + mt * 4096), 16, 0, 0);
            __builtin_amdgcn_global_load_lds((const unsigned*)(sb + (size_t)(mt * 32) * ldb), (LDS3 unsigned*)(sd + 16384 + mt * 4096), 16, 0, 0);
          }
        }
        __builtin_amdgcn_s_setprio(0);
        __builtin_amdgcn_sched_barrier(0);
#pragma unroll
        for (int mt = 0; mt < 4; ++mt)
#pragma unroll
          for (int nt = 0; nt < 4; ++nt)
            acc[mt][nt] = __builtin_amdgcn_mfma_f32_16x16x32_bf16(bf0[nt], af0[mt], acc[mt][nt], 0, 0, 0);
#pragma unroll
        for (int mt = 0; mt < 4; ++mt)
#pragma unroll
          for (int nt = 0; nt < 4; ++nt)
            acc[mt][nt] = __builtin_amdgcn_mfma_f32_16x16x32_bf16(bf1[nt], af1[mt], acc[mt][nt], 0, 0, 0);
        __builtin_amdgcn_sched_barrier(0);
      }
      if (kt + 1 < nk) __syncthreads();
    }
    epi.tile(acc, pre, m0, n0, tn_cur, wm, wn, l15, quad, tid, smem);
    gA = gAn; gB = gBn;
  }
}

constexpr int EDGE_LD = 2 * DFF;
struct FfnPre { f32x4 wa[3], wb[3]; };
DEVINL void ffn_conv_rows(const bfr* T, const FfnPre& pre_, bfr* ACT, float* EDGE, int m0, int n0, int tn, int tid) {
  const int c4 = (tid & 15) * 4, r0 = (tid >> 4) * 8;
  const int ja = tn * 64 + c4;
  int tl, Tlen; tok_pos(m0, tl, Tlen);
  const bool top_ok = (tl == 0), bot_ok = (tl + 128 == Tlen);
  if (tid < 128) {
    const int e = tid >> 5, c = (tid & 31) * 4;
    const int r = (e < 2) ? e : 124 + e;
    const uint2 v = *(const uint2*)(T + r * 136 + c);
    *(f32x4*)(EDGE + ((size_t)(m0 >> 7) * 4 + e) * EDGE_LD + n0 + c) = f32x4{bflo(v.x), bfhi(v.x), bflo(v.y), bfhi(v.y)};
  }
  const f32x4 zero = f32x4{0.f, 0.f, 0.f, 0.f};
#define LDT(dst, row, col) { const uint2 v_ = *(const uint2*)(T + (row) * 136 + (col)); dst = f32x4{bflo(v_.x), bfhi(v_.x), bflo(v_.y), bfhi(v_.y)}; }
  f32x4 pa = zero, pb = zero, ca, cb, na, nb;
  if (r0 > 0) { LDT(pa, r0 - 1, c4) LDT(pb, r0 - 1, 64 + c4) }
  LDT(ca, r0, c4) LDT(cb, r0, 64 + c4)
#pragma unroll
  for (int i = 0; i < 8; ++i) {
    const int r = r0 + i;
    if (r < 127) { LDT(na, r + 1, c4) LDT(nb, r + 1, 64 + c4) }
    else { na = zero; nb = zero; }
    const bool ok = (r > 0 || top_ok) && (r < 127 || bot_ok);
    if (ok) {
      const f32x4 a = pre_.wa[0] * pa + pre_.wa[1] * ca + pre_.wa[2] * na;
      const f32x4 b = pre_.wb[0] * pb + pre_.wb[1] * cb + pre_.wb[2] * nb;
      uint2 o;
      o.x = pk2(silu_f(a[0]) * b[0], silu_f(a[1]) * b[1]);
      o.y = pk2(silu_f(a[2]) * b[2], silu_f(a[3]) * b[3]);
      *(uint2*)(ACT + (size_t)(m0 + r) * DFF + ja) = o;
    }
    pa = ca; pb = cb; ca = na; cb = nb;
  }
#undef LDT
}
struct EpiFfnUp {
  bfr* ACT; float* EDGE; const float* wdw;
  typedef FfnPre Pre;
  static constexpr bool kLdsEpi = true;
  DEVINL Pre pre(int tn, int tid) const {
    Pre q;
    const int ja = tn * 64 + (tid & 15) * 4;
#pragma unroll
    for (int t = 0; t < 3; ++t) {
      q.wa[t] = *(const f32x4*)(wdw + t * (2 * DFF) + ja);
      q.wb[t] = *(const f32x4*)(wdw + t * (2 * DFF) + DFF + ja);
    }
    return q;
  }
  DEVINL void tile(const f32x4 (&acc)[4][4], const Pre& pre_, int m0, int n0, int tn, int wm, int wn, int l15, int quad,
                   int tid, char* smem) const {
    bfr* T = (bfr*)(smem + 32768);
    lds_barrier();
#pragma unroll
    for (int mt = 0; mt < 4; ++mt)
#pragma unroll
      for (int nt = 0; nt < 4; ++nt) {
        uint2 o; o.x = pk2(acc[mt][nt][0], acc[mt][nt][1]); o.y = pk2(acc[mt][nt][2], acc[mt][nt][3]);
        *(uint2*)(T + (wm * 64 + mt * 16 + l15) * 136 + wn * 64 + nt * 16 + quad * 4) = o;
      }
    lds_barrier();
    ffn_conv_rows(T, pre_, ACT, EDGE, m0, n0, tn, tid);
  }
  DEVINL void tile256(const f32x4 (&acc)[8][4], const Pre& pre_, int m0, int n0, int tn, int wm, int wn, int l15, int quad,
                      int tid, char* smem) const {
    bfr* T = (bfr*)smem;
#pragma unroll
    for (int hh = 0; hh < 2; ++hh) {
      lds_barrier();
      if (wm == hh) {
#pragma unroll
        for (int mt = 0; mt < 8; ++mt)
#pragma unroll
          for (int nt = 0; nt < 4; ++nt) {
            uint2 o; o.x = pk2(acc[mt][nt][0], acc[mt][nt][1]); o.y = pk2(acc[mt][nt][2], acc[mt][nt][3]);
            *(uint2*)(T + (mt * 16 + l15) * 136 + wn * 64 + nt * 16 + quad * 4) = o;
          }
      }
      lds_barrier();
      ffn_conv_rows(T, pre_, ACT, EDGE, m0 + hh * 128, n0, tn, tid);
    }
  }
};


template <class Epi>
DEVINL void gemm256_phase(const bfr* __restrict__ A, int lda, const bfr* __restrict__ Bt, int ldb, int N, int K,
                          const Epi& epi, char* smem, int bid, int nblk) {
  const int tid = otid(), lane = tid & 63, wave = tid >> 6;
  const int wm = wave >> 1, wn = wave & 1, l15 = lane & 15, quad = lane >> 4;
  const int tilesN = N >> 7;
  const int ntiles = (MTOK >> 8) * tilesN;
  const int nk = K >> 5;
  const int srow0 = wave * 16 + (lane >> 2);
  const int lc = (lane & 3) ^ ((0 - (lane >> 4)) & 3);
  const int fsw = (0 - (l15 >> 2)) & 3;
  char* const dst0 = smem + wave * 1024 + lane * 16;
#define TILE_DECODE2(t_, tm_, tn_) { const int xcd_ = (t_) & 7, u_ = (t_) >> 3; const int ur_ = u_ / tilesN; tn_ = u_ - ur_ * tilesN; tm_ = ur_ * 8 + xcd_; }
#define GLDS_STAGE2(pa_, pb_, st_, kt_)                                                                   \
  {                                                                                                       \
    _Pragma("unroll") for (int i = 0; i < 4; ++i)                                                         \
      __builtin_amdgcn_global_load_lds((const unsigned*)((pa_) + (size_t)(i * 64) * lda + (kt_) * 32),    \
                                       (LDS3 unsigned*)(dst0 + (st_) * 24576 + i * 4096), 16, 0, 0);      \
    _Pragma("unroll") for (int i = 0; i < 2; ++i)                                                         \
      __builtin_amdgcn_global_load_lds((const unsigned*)((pb_) + (size_t)(i * 64) * ldb + (kt_) * 32),    \
                                       (LDS3 unsigned*)(dst0 + (st_) * 24576 + 16384 + i * 4096), 16, 0, 0); \
  }
  int tile = bid;
  if (tile >= ntiles) return;
  int tm, tn;
  TILE_DECODE2(tile, tm, tn)
  const bfr* gA = A + (size_t)((tm << 8) + srow0) * lda + lc * 8;
  const bfr* gB = Bt + (size_t)((tn << 7) + srow0) * ldb + lc * 8;
  __syncthreads();
  GLDS_STAGE2(gA, gB, 0, 0)
  for (; tile < ntiles; tile += nblk) {
    const int m0 = tm << 8, n0 = tn << 7, tn_cur = tn;
    const bool has_next = (tile + nblk < ntiles);
    const bfr* gAn = gA; const bfr* gBn = gB;
    if (has_next) {
      TILE_DECODE2(tile + nblk, tm, tn)
      gAn = A + (size_t)((tm << 8) + srow0) * lda + lc * 8;
      gBn = Bt + (size_t)((tn << 7) + srow0) * ldb + lc * 8;
    }
    f32x4 acc[8][4];
#pragma unroll
    for (int i = 0; i < 8; ++i)
#pragma unroll
      for (int j = 0; j < 4; ++j) acc[i][j] = f32x4{0.f, 0.f, 0.f, 0.f};
    __syncthreads();
    for (int kt = 0; kt < nk; ++kt) {
      const int st = kt & 1;
      const bool cur = (kt + 1 < nk);
      const bool any = cur || has_next;
      const bfr* sa = cur ? gA + (kt + 1) * 32 : gAn;
      const bfr* sb = cur ? gB + (kt + 1) * 32 : gBn;
      char* sd = dst0 + (cur ? (st ^ 1) : 0) * 24576;
      const char* cA = smem + st * 24576 + (wm * 128 + l15) * 64 + ((quad ^ fsw) * 16);
      const char* cB = smem + st * 24576 + 16384 + (wn * 64 + l15) * 64 + ((quad ^ fsw) * 16);
      bf16x8 bfg[4];
#pragma unroll
      for (int i = 0; i < 4; ++i) bfg[i] = *(const bf16x8*)(cB + i * 1024);
#pragma unroll
      for (int hm = 0; hm < 2; ++hm) {
        bf16x8 af[4];
#pragma unroll
        for (int i = 0; i < 4; ++i) af[i] = *(const bf16x8*)(cA + (hm * 4 + i) * 1024);
        __builtin_amdgcn_sched_barrier(0);
#pragma unroll
        for (int mt = 0; mt < 4; ++mt) {
#pragma unroll
          for (int nt = 0; nt < 4; ++nt)
            acc[hm * 4 + mt][nt] = __builtin_amdgcn_mfma_f32_16x16x32_bf16(bfg[nt], af[mt], acc[hm * 4 + mt][nt], 0, 0, 0);
          const int g = hm * 4 + mt;
          if (any && g < 4)
            __builtin_amdgcn_global_load_lds((const unsigned*)(sa + (size_t)(g * 64) * lda), (LDS3 unsigned*)(sd + g * 4096), 16, 0, 0);
          else if (any && g < 6)
            __builtin_amdgcn_global_load_lds((const unsigned*)(sb + (size_t)((g - 4) * 64) * ldb), (LDS3 unsigned*)(sd + 16384 + (g - 4) * 4096), 16, 0, 0);
          __builtin_amdgcn_sched_barrier(0);
        }
      }
      if (kt + 1 < nk) __syncthreads();
    }
    {
      typename Epi::Pre pre = epi.pre(tn_cur, tid);
      epi.tile256(acc, pre, m0, n0, tn_cur, wm, wn, l15, quad, tid, smem);
    }
    gA = gAn; gB = gBn;
  }
}


template <class Epi>
DEVINL void gemm256s_phase(const bfr* __restrict__ A, int lda, const bfr* __restrict__ Bt, int ldb, int N, int K,
                           const Epi& epi, char* smem, int bid, int nblk) {
  const int tid = otid(), lane = tid & 63, wave = tid >> 6;
  const int wm = wave >> 1, wn = wave & 1, l15 = lane & 15, quad = lane >> 4;
  const int tilesN = N >> 7;
  const int ntiles = (MTOK >> 8) * tilesN;
  const int nk = K >> 6;
  const int srow0 = wave * 8 + (lane >> 3);
  const int lc = (lane & 7) ^ ((srow0 >> 1) & 7);
  const int fsw = (l15 >> 1) & 7;
  char* const dst0 = smem + wave * 1024 + lane * 16;
#define TILE_DECODE3(t_, tm_, tn_) { const int xcd_ = (t_) & 7, u_ = (t_) >> 3; const int gs_ = 5 * tilesN; const int g_ = u_ / gs_, r_ = u_ - g_ * gs_; \
    tn_ = r_ / 5; tm_ = (g_ * 5 + (r_ - tn_ * 5)) * 8 + xcd_; }
  if (bid >= ntiles) return;
  int ptile = bid, pkt = 0;
  bool pvalid = true;
  int ptm, ptn;
  TILE_DECODE3(ptile, ptm, ptn)
  const bfr* pA = A + (size_t)((ptm << 8) + srow0) * lda + lc * 8;
  const bfr* pB = Bt + (size_t)((ptn << 7) + srow0) * ldb + lc * 8;
#define DMA_B3(buf_)                                                                                      \
  {                                                                                                       \
    _Pragma("unroll") for (int i = 0; i < 4; ++i)                                                         \
      __builtin_amdgcn_global_load_lds((const unsigned*)(pB + (size_t)(i * 32) * ldb + pkt * 64),         \
                                       (LDS3 unsigned*)(dst0 + 34816 + (buf_) * 16384 + i * 4096), 16, 0, 0); \
  }
#define DMA_A3()                                                                                          \
  {                                                                                                       \
    _Pragma("unroll") for (int i = 0; i < 8; ++i)                                                         \
      __builtin_amdgcn_global_load_lds((const unsigned*)(pA + (size_t)(i * 32) * lda + pkt * 64),         \
                                       (LDS3 unsigned*)(dst0 + i * 4096), 16, 0, 0);                      \
    if (++pkt == nk) {                                                                                    \
      pkt = 0; ptile += nblk;                                                                             \
      if (ptile < ntiles) {                                                                               \
        TILE_DECODE3(ptile, ptm, ptn)                                                                     \
        pA = A + (size_t)((ptm << 8) + srow0) * lda + lc * 8;                                             \
        pB = Bt + (size_t)((ptn << 7) + srow0) * ldb + lc * 8;                                            \
      } else pvalid = false;                                                                              \
    }                                                                                                     \
  }
  __syncthreads();
  DMA_B3(0)
  DMA_A3()
  bool deferred = false;
  int bbuf = 0;
  const char* cA = smem + (wm * 128 + l15) * 128;
  const char* cB0 = smem + 34816 + (wn * 64 + l15) * 128;
  for (int tile = bid; tile < ntiles; tile += nblk) {
    int tm, tn;
    TILE_DECODE3(tile, tm, tn)
    const int m0 = tm << 8, n0 = tn << 7;
    if (deferred) { DMA_A3() deferred = false; }
    f32x4 acc[8][4];
#pragma unroll
    for (int i = 0; i < 8; ++i)
#pragma unroll
      for (int j = 0; j < 4; ++j) acc[i][j] = f32x4{0.f, 0.f, 0.f, 0.f};
    for (int kt = 0; kt < nk; ++kt) {
      asm volatile("s_waitcnt vmcnt(0)\n\ts_barrier" ::: "memory");
      __builtin_amdgcn_s_setprio(3);
      const char* cB = cB0 + bbuf * 16384;
      const int co0 = (quad ^ fsw) * 16, co1 = ((4 + quad) ^ fsw) * 16;
      bf16x8 af[8], bfg[4];
#pragma unroll
      for (int i = 0; i < 4; ++i) bfg[i] = *(const bf16x8*)(cB + i * 2048 + co0);
#pragma unroll
      for (int i = 0; i < 8; ++i) af[i] = *(const bf16x8*)(cA + i * 2048 + co0);
      __builtin_amdgcn_sched_barrier(0);
      if (pvalid) DMA_B3(bbuf ^ 1)
      __builtin_amdgcn_s_setprio(0);
      __builtin_amdgcn_sched_barrier(0);
#pragma unroll
      for (int mt = 0; mt < 8; ++mt)
#pragma unroll
        for (int nt = 0; nt < 4; ++nt)
          acc[mt][nt] = __builtin_amdgcn_mfma_f32_16x16x32_bf16(bfg[nt], af[mt], acc[mt][nt], 0, 0, 0);
      __builtin_amdgcn_sched_barrier(0);
      __builtin_amdgcn_s_setprio(3);
#pragma unroll
      for (int i = 0; i < 4; ++i) bfg[i] = *(const bf16x8*)(cB + i * 2048 + co1);
#pragma unroll
      for (int i = 0; i < 8; ++i) af[i] = *(const bf16x8*)(cA + i * 2048 + co1);
      asm volatile("s_waitcnt lgkmcnt(0)\n\ts_barrier" ::: "memory");
      if (pvalid) {
        if (Epi::kLdsEpi && kt == nk - 1) deferred = true;
        else DMA_A3()
      }
      __builtin_amdgcn_s_setprio(0);
      bbuf ^= 1;
      __builtin_amdgcn_sched_barrier(0);
#pragma unroll
      for (int mt = 0; mt < 8; ++mt)
#pragma unroll
        for (int nt = 0; nt < 4; ++nt)
          acc[mt][nt] = __builtin_amdgcn_mfma_f32_16x16x32_bf16(bfg[nt], af[mt], acc[mt][nt], 0, 0, 0);
      __builtin_amdgcn_sched_barrier(0);
    }
    {
      typename Epi::Pre pre = epi.pre(tn, tid);
      epi.tile256(acc, pre, m0, n0, tn, wm, wn, l15, quad, tid, smem);
    }
    if (Epi::kLdsEpi) lds_barrier();
  }
  asm volatile("s_waitcnt vmcnt(0)" ::: "memory");
}

DEVINL void ffn_edge_phase(const float* __restrict__ EDGE, const float* __restrict__ wdw, bfr* __restrict__ ACT, int bid, int nblk) {
  const int gt = bid * 256 + otid(), nt = nblk * 256;
  for (int i = gt; i < 160 * 2 * 704; i += nt) {
    const int cg4 = i % 704, r2 = i / 704, side = r2 & 1, tm = r2 >> 1;
    const int m0 = tm << 7;
    int tl, Tlen; tok_pos(m0, tl, Tlen);
    if (side == 0 ? (tl == 0) : (tl + 128 == Tlen)) continue;
    const int ja = cg4 * 4;
    const int nb_ = ja >> 6, cc = ja & 63;
    const int ea = nb_ * 128 + cc, eb = ea + 64;
    const float* prev; const float* cur; const float* next;
    if (side == 0) {
      prev = EDGE + ((size_t)(tm - 1) * 4 + 3) * EDGE_LD; cur = EDGE + ((size_t)tm * 4 + 0) * EDGE_LD; next = EDGE + ((size_t)tm * 4 + 1) * EDGE_LD;
    } else {
      prev = EDGE + ((size_t)tm * 4 + 2) * EDGE_LD; cur = EDGE + ((size_t)tm * 4 + 3) * EDGE_LD; next = EDGE + ((size_t)(tm + 1) * 4 + 0) * EDGE_LD;
    }
    const f32x4 a = *(const f32x4*)(wdw + ja) * *(const f32x4*)(prev + ea) + *(const f32x4*)(wdw + 2 * DFF + ja) * *(const f32x4*)(cur + ea) +
                    *(const f32x4*)(wdw + 4 * DFF + ja) * *(const f32x4*)(next + ea);
    const f32x4 b = *(const f32x4*)(wdw + DFF + ja) * *(const f32x4*)(prev + eb) + *(const f32x4*)(wdw + 3 * DFF + ja) * *(const f32x4*)(cur + eb) +
                    *(const f32x4*)(wdw + 5 * DFF + ja) * *(const f32x4*)(next + eb);
    uint2 o;
    o.x = pk2(silu_f(a[0]) * b[0], silu_f(a[1]) * b[1]);
    o.y = pk2(silu_f(a[2]) * b[2], silu_f(a[3]) * b[3]);
    const int m = m0 + (side ? 127 : 0);
    *(uint2*)(ACT + (size_t)m * DFF + ja) = o;
  }
}

DEVINL int up_perm(int n0) {
  if (n0 < DFF) return (n0 >> 6) * 128;
  return ((n0 - DFF) >> 6) * 128 + 64;
}
DEVINL void conv_matrix(const float* __restrict__ src, int K, int N, bfr* __restrict__ dst, int perm,
                        char* smem, int bid, int nblk) {
  float* sT = (float*)smem;
  const int tid = otid();
  const int tilesN = N >> 6;
  const int ntiles = (K >> 6) * tilesN;
  const int r = tid >> 4, c4 = tid & 15;
  int t = bid;
  if (t >= ntiles) return;
  f32x4 v0, v1, v2, v3;
  {
    const int tk = t / tilesN, tn = t - tk * tilesN;
    const float* sp = src + (size_t)((tk << 6) + r) * N + (tn << 6) + c4 * 4;
    v0 = *(const f32x4*)(sp); v1 = *(const f32x4*)(sp + (size_t)16 * N);
    v2 = *(const f32x4*)(sp + (size_t)32 * N); v3 = *(const f32x4*)(sp + (size_t)48 * N);
  }
  for (; t < ntiles; t += nblk) {
    const int tk = t / tilesN, tn = t - tk * tilesN;
    const int k0 = tk << 6, n0 = tn << 6;
    __syncthreads();
    {
      float* d = sT + r * 65 + c4 * 4;
      d[0] = v0[0]; d[1] = v0[1]; d[2] = v0[2]; d[3] = v0[3];
      d[16 * 65 + 0] = v1[0]; d[16 * 65 + 1] = v1[1]; d[16 * 65 + 2] = v1[2]; d[16 * 65 + 3] = v1[3];
      d[32 * 65 + 0] = v2[0]; d[32 * 65 + 1] = v2[1]; d[32 * 65 + 2] = v2[2]; d[32 * 65 + 3] = v2[3];
      d[48 * 65 + 0] = v3[0]; d[48 * 65 + 1] = v3[1]; d[48 * 65 + 2] = v3[2]; d[48 * 65 + 3] = v3[3];
    }
    if (t + nblk < ntiles) {
      const int t2 = t + nblk;
      const int tk2 = t2 / tilesN, tn2 = t2 - tk2 * tilesN;
      const float* sp = src + (size_t)((tk2 << 6) + r) * N + (tn2 << 6) + c4 * 4;
      v0 = *(const f32x4*)(sp); v1 = *(const f32x4*)(sp + (size_t)16 * N);
      v2 = *(const f32x4*)(sp + (size_t)32 * N); v3 = *(const f32x4*)(sp + (size_t)48 * N);
    }
    __syncthreads();
    const int n = tid >> 2, kc = tid & 3;
    uint32_t w[8];
#pragma unroll
    for (int j = 0; j < 8; ++j)
      w[j] = pk2(sT[(kc * 16 + 2 * j) * 65 + n], sT[(kc * 16 + 2 * j + 1) * 65 + n]);
    const int nd = (perm ? up_perm(n0) : n0) + n;
    bfr* dp = dst + (size_t)nd * K + k0 + kc * 16;
    *(uint4*)dp = make_uint4(w[0], w[1], w[2], w[3]);
    *(uint4*)(dp + 8) = make_uint4(w[4], w[5], w[6], w[7]);
  }
}

DEVINL void phase0a(const Params& p, char* smem, int bid, int nblk) {
  const int tid = otid();
  float* sc = (float*)smem;
  float* modp = (float*)(p.ws + OFF_MODP);
  const float* cvec = p.in[3];
  const float* cctx = p.in[4];
  const float* ada_w = p.in[5];
  for (int job = bid; job < 384; job += nblk) {
    const int l = job / 96, r = job - l * 96, ks = r / 6, cgp = r - ks * 6;
    __syncthreads();
    for (int i = tid; i < 320; i += 256) {
      const int cond = i >> 6, kk = i & 63;
      const float v = cond == 0 ? cctx[ks * 64 + kk] : cvec[(cond - 1) * DM + ks * 64 + kk];
      sc[i] = silu_f(v);
    }
    __syncthreads();
    const int col = cgp * 1024 + tid * 4;
    const float* wp = ada_w + ((size_t)l * DM + ks * 64) * 6144 + col;
    float a[5][4];
#pragma unroll
    for (int c = 0; c < 5; ++c)
#pragma unroll
      for (int j = 0; j < 4; ++j) a[c][j] = 0.f;
#pragma unroll 8
    for (int kk = 0; kk < 64; ++kk) {
      const float4 w = *(const float4*)(wp + (size_t)kk * 6144);
#pragma unroll
      for (int c = 0; c < 5; ++c) {
        const float s = sc[c * 64 + kk];
        a[c][0] += s * w.x; a[c][1] += s * w.y; a[c][2] += s * w.z; a[c][3] += s * w.w;
      }
    }
#pragma unroll
    for (int c = 0; c < 5; ++c)
      *(float4*)(modp + ((size_t)(ks * 4 + l) * 5 + c) * 6144 + col) = make_float4(a[c][0], a[c][1], a[c][2], a[c][3]);
  }
  const int gt = bid * 256 + tid, nt = nblk * 256;
  {
    const float* lb = p.in[20];
    float* lbs = (float*)(p.ws + OFF_LBS);
    for (int i = gt; i < 2048; i += nt) {
      const float v0 = lb[i], v1 = lb[2048 + i], v2 = lb[4096 + i], v3 = lb[6144 + i];
      const float mx = fmaxf(fmaxf(v0, v1), fmaxf(v2, v3));
      const float e0 = expf(v0 - mx), e1 = expf(v1 - mx), e2 = expf(v2 - mx), e3 = expf(v3 - mx);
      lbs[i] = (e1 + e2 + e3) / (e0 + e1 + e2 + e3);
    }
  }
  float* X = p.out;
  {
    const float4* xp = (const float4*)p.in[0];
    float4* xo = (float4*)X;
    for (int i = gt; i < NPROMPT * DM / 4; i += nt) xo[i] = xp[i];
    const float* xs = p.in[1];
    for (int i = gt; i < 4096 * 256; i += nt) {
      const int t = i >> 8, c = (i & 255) * 4;
      const int part = c >> 8;
      const float pos = (float)((part < 2) ? (t >> 6) : (t & 63));
      float pe[4];
#pragma unroll
      for (int j = 0; j < 4; ++j) {
        const int jj = (c + j) & 255;
        const float freq = expf((-9.210340371976184f * (float)jj) / 256.0f);
        const float arg = pos * freq;
        pe[j] = (part & 1) ? cosf(arg) : sinf(arg);
      }
#pragma unroll
      for (int b = 0; b < 4; ++b) {
        const size_t off = ((size_t)b * 4096 + t) * DM + c;
        float4 v = *(const float4*)(xs + off);
        v.x += pe[0]; v.y += pe[1]; v.z += pe[2]; v.w += pe[3];
        *(float4*)(X + (size_t)NPROMPT * DM + off) = v;
      }
    }
  }
}

DEVINL void phase0b(const Params& p, int bid, int nblk) {
  const int gt = bid * 256 + otid(), nt = nblk * 256;
  const float* modp = (const float*)(p.ws + OFF_MODP);
  float* mod = (float*)(p.ws + OFF_MOD);
  const float* ada_b = p.in[6];
  for (int i = gt; i < 4 * 5 * 6144; i += nt) {
    const int l = i / 30720, col = i % 6144;
    float s = ada_b[l * 6144 + col];
#pragma unroll
    for (int ks = 0; ks < 16; ++ks) s += modp[(size_t)ks * 122880 + i];
    mod[i] = s;
  }
}

DEVINL void norm_phase(const float* __restrict__ X, const float* __restrict__ g, const float* __restrict__ modl,
                       int shift_off, int scale_off, bfr* __restrict__ H, int bid, int nblk) {
  const int tid = otid(); const int lane = tid & 63;
  const int gw = bid * 4 + (tid >> 6), nw = nblk * 4;
  int row = gw;
  if (row >= MTOK) return;
  f32x4 x0, x1, x2, x3;
  {
    const float* xr = X + (size_t)row * DM + lane * 4;
    x0 = *(const f32x4*)(xr); x1 = *(const f32x4*)(xr + 256); x2 = *(const f32x4*)(xr + 512); x3 = *(const f32x4*)(xr + 768);
  }
  for (; row < MTOK; row += nw) {
    const f32x4 c0 = x0, c1 = x1, c2 = x2, c3 = x3;
    if (row + nw < MTOK) {
      const float* xr = X + (size_t)(row + nw) * DM + lane * 4;
      x0 = *(const f32x4*)(xr); x1 = *(const f32x4*)(xr + 256); x2 = *(const f32x4*)(xr + 512); x3 = *(const f32x4*)(xr + 768);
    }
    float ss = 0.f;
#pragma unroll
    for (int j = 0; j < 4; ++j) ss += c0[j] * c0[j] + c1[j] * c1[j] + c2[j] * c2[j] + c3[j] * c3[j];
    ss = wave_sum(ss, lane);
    const float rstd = rsqrtf(ss * (1.f / DM) + EPS);
    const float* mc = modl + cond_of(row) * 6144;
#pragma unroll
    for (int i = 0; i < 4; ++i) {
      const f32x4 xv = (i == 0) ? c0 : (i == 1) ? c1 : (i == 2) ? c2 : c3;
      const int c = i * 256 + lane * 4;
      const float4 gg = *(const float4*)(g + c);
      const float4 sh = *(const float4*)(mc + shift_off + c);
      const float4 sc = *(const float4*)(mc + scale_off + c);
      const float h0 = xv[0] * rstd * gg.x * (1.f + sc.x) + sh.x;
      const float h1 = xv[1] * rstd * gg.y * (1.f + sc.y) + sh.y;
      const float h2 = xv[2] * rstd * gg.z * (1.f + sc.z) + sh.z;
      const float h3 = xv[3] * rstd * gg.w * (1.f + sc.w) + sh.w;
      uint2 o; o.x = pk2(h0, h1); o.y = pk2(h2, h3);
      *(uint2*)(H + (size_t)row * DM + c) = o;
    }
  }
}

DEVINL void final_norm_phase(float* X, const float* __restrict__ g, int bid, int nblk) {
  const int tid = otid(); const int lane = tid & 63;
  const int gw = bid * 4 + (tid >> 6), nw = nblk * 4;
  for (int row = gw; row < MTOK; row += nw) {
    float* xr = X + (size_t)row * DM;
    float4 x[4];
    float ss = 0.f;
#pragma unroll
    for (int i = 0; i < 4; ++i) {
      x[i] = *(const float4*)(xr + i * 256 + lane * 4);
      ss += x[i].x * x[i].x + x[i].y * x[i].y + x[i].z * x[i].z + x[i].w * x[i].w;
    }
    ss = wave_sum(ss, lane);
    const float rstd = rsqrtf(ss * (1.f / DM) + EPS);
#pragma unroll
    for (int i = 0; i < 4; ++i) {
      const int c = i * 256 + lane * 4;
      const float4 gg = *(const float4*)(g + c);
      float4 o;
      o.x = x[i].x * rstd * gg.x; o.y = x[i].y * rstd * gg.y; o.z = x[i].z * rstd * gg.z; o.w = x[i].w * rstd * gg.w;
      *(float4*)(xr + c) = o;
    }
  }
}

DEVINL void shortconv_ew_phase(const bfr* __restrict__ G, const float* __restrict__ wdw, bfr* __restrict__ U, int bid, int nblk) {
  const int gt = bid * 256 + otid(), nt = nblk * 256;
  for (int i = gt; i < MTOK * 128; i += nt) {
    const int m = i >> 7, c = (i & 127) * 8;
    int tl, T; tok_pos(m, tl, T);
    const bfr* gr = G + (size_t)m * 3072;
    const uint4 bg = *(const uint4*)(gr + c);
    float accv[8];
#pragma unroll
    for (int j = 0; j < 8; ++j) accv[j] = 0.f;
#pragma unroll
    for (int tap = 0; tap < 3; ++tap) {
      const int d = tap - 1;
      if ((d < 0 && tl == 0) || (d > 0 && tl == T - 1)) continue;
      const bfr* nr = gr + (ptrdiff_t)d * 3072;
      const uint4 cgv = *(const uint4*)(nr + 1024 + c);
      const uint4 xhv = *(const uint4*)(nr + 2048 + c);
      const float4 w0 = *(const float4*)(wdw + tap * DM + c);
      const float4 w1 = *(const float4*)(wdw + tap * DM + c + 4);
      accv[0] += w0.x * bflo(cgv.x) * bflo(xhv.x); accv[1] += w0.y * bfhi(cgv.x) * bfhi(xhv.x);
      accv[2] += w0.z * bflo(cgv.y) * bflo(xhv.y); accv[3] += w0.w * bfhi(cgv.y) * bfhi(xhv.y);
      accv[4] += w1.x * bflo(cgv.z) * bflo(xhv.z); accv[5] += w1.y * bfhi(cgv.z) * bfhi(xhv.z);
      accv[6] += w1.z * bflo(cgv.w) * bflo(xhv.w); accv[7] += w1.w * bfhi(cgv.w) * bfhi(xhv.w);
    }
    uint4 o;
    o.x = pk2(bflo(bg.x) * accv[0], bfhi(bg.x) * accv[1]);
    o.y = pk2(bflo(bg.y) * accv[2], bfhi(bg.y) * accv[3]);
    o.z = pk2(bflo(bg.z) * accv[4], bfhi(bg.z) * accv[5]);
    o.w = pk2(bflo(bg.w) * accv[6], bfhi(bg.w) * accv[7]);
    *(uint4*)(U + (size_t)m * DM + c) = o;
  }
}

DEVINL void pool_ew_phase(const bfr* __restrict__ H, bfr* __restrict__ P, int bid, int nblk) {
  const int gt = bid * 256 + otid(), nt = nblk * 256;
  for (int i = gt; i < MTOK * 128; i += nt) {
    const int m = i >> 7, ch = i & 127, c = ch * 8;
    int tl, T; tok_pos(m, tl, T);
    const int hw = 1 << (ch >> 5);
    const int lo = max(tl - hw, 0), hi = min(tl + hw, T);
    float s[8];
#pragma unroll
    for (int j = 0; j < 8; ++j) s[j] = 0.f;
    const bfr* base = H + (size_t)(m - tl) * DM + c;
    uint4 wv[16];
#pragma unroll
    for (int j = 0; j < 16; ++j) {
      const int q = tl - hw + j;
      const bool ok = (j < 2 * hw) && (q >= 0) && (q < T);
      wv[j] = ok ? *(const uint4*)(base + (size_t)q * DM) : make_uint4(0u, 0u, 0u, 0u);
    }
#pragma unroll
    for (int j = 0; j < 16; ++j) {
      const uint4 v = wv[j];
      s[0] += bflo(v.x); s[1] += bfhi(v.x); s[2] += bflo(v.y); s[3] += bfhi(v.y);
      s[4] += bflo(v.z); s[5] += bfhi(v.z); s[6] += bflo(v.w); s[7] += bfhi(v.w);
    }
    const float inv = 1.f / (float)(hi - lo);
    const uint4 v = *(const uint4*)(base + (size_t)tl * DM);
    uint4 o;
    o.x = pk2(s[0] * inv - bflo(v.x), s[1] * inv - bfhi(v.x));
    o.y = pk2(s[2] * inv - bflo(v.y), s[3] * inv - bfhi(v.y));
    o.z = pk2(s[4] * inv - bflo(v.z), s[5] * inv - bfhi(v.z));
    o.w = pk2(s[6] * inv - bflo(v.w), s[7] * inv - bfhi(v.w));
    *(uint4*)(P + (size_t)m * DM + c) = o;
  }
}

DEVINL void sgu_norm_phase(bfr* UV, const float* __restrict__ g, int bid, int nblk) {
  const int tid = otid(); const int lane = tid & 63;
  const int gw = bid * 4 + (tid >> 6), nw = nblk * 4;
  for (int row = gw; row < MTOK; row += nw) {
    bfr* vr = UV + (size_t)row * 2048 + 1024;
    float x[4][4];
    float ss = 0.f;
#pragma unroll
    for (int i = 0; i < 4; ++i) {
      const uint2 v = *(const uint2*)(vr + i * 256 + lane * 4);
      x[i][0] = bflo(v.x); x[i][1] = bfhi(v.x); x[i][2] = bflo(v.y); x[i][3] = bfhi(v.y);
      ss += x[i][0] * x[i][0] + x[i][1] * x[i][1] + x[i][2] * x[i][2] + x[i][3] * x[i][3];
    }
    ss = wave_sum(ss, lane);
    const float rstd = rsqrtf(ss * (1.f / DM) + EPS);
#pragma unroll
    for (int i = 0; i < 4; ++i) {
      const int c = i * 256 + lane * 4;
      const float4 gg = *(const float4*)(g + c);
      uint2 o;
      o.x = pk2(x[i][0] * rstd * gg.x, x[i][1] * rstd * gg.y);
      o.y = pk2(x[i][2] * rstd * gg.z, x[i][3] * rstd * gg.w);
      *(uint2*)(vr + c) = o;
    }
  }
}

DEVINL void sgu_spatial_phase(bfr* UV, const float* __restrict__ ws_, const float* __restrict__ bs_, char* smem, int bid, int nblk) {
  bfr* sV = (bfr*)smem;
  bfr* sW = sV + 128 * 136;
  const int tid = otid(), lane = tid & 63, wave = tid >> 6, l15 = lane & 15, quad = lane >> 4;
  for (int item = bid; item < 160 * 8; item += nblk) {
    const int chunk = item >> 3, g = item & 7;
    __syncthreads();
    const float* wg = ws_ + (size_t)g * 16384;
#pragma unroll 4
    for (int i = 0; i < 16; ++i) {
      const int idx = tid + 256 * i;
      const int row = idx >> 5, chn = idx & 31;
      const float4 v = *(const float4*)(wg + row * 128 + chn * 4);
      uint2 o; o.x = pk2(v.x, v.y); o.y = pk2(v.z, v.w);
      *(uint2*)(sW + row * 136 + chn * 4) = o;
    }
#pragma unroll 2
    for (int i = 0; i < 8; ++i) {
      const int idx = tid + 256 * i;
      const int q = idx >> 4, chn = idx & 15;
      const uint4 v = *(const uint4*)(UV + (size_t)(chunk * 128 + q) * 2048 + 1024 + g * 128 + chn * 8);
      bfr* d = sV + (chn * 8) * 136 + q;
      d[0 * 136] = (bfr)(v.x & 0xffff); d[1 * 136] = (bfr)(v.x >> 16);
      d[2 * 136] = (bfr)(v.y & 0xffff); d[3 * 136] = (bfr)(v.y >> 16);
      d[4 * 136] = (bfr)(v.z & 0xffff); d[5 * 136] = (bfr)(v.z >> 16);
      d[6 * 136] = (bfr)(v.w & 0xffff); d[7 * 136] = (bfr)(v.w >> 16);
    }
    __syncthreads();
    f32x4 acc[8][2];
#pragma unroll
    for (int i = 0; i < 8; ++i) { acc[i][0] = f32x4{0.f, 0.f, 0.f, 0.f}; acc[i][1] = f32x4{0.f, 0.f, 0.f, 0.f}; }
#pragma unroll
    for (int kk = 0; kk < 4; ++kk) {
      bf16x8 bw[2];
#pragma unroll
      for (int pt = 0; pt < 2; ++pt) bw[pt] = *(const bf16x8*)(sW + (wave * 32 + pt * 16 + l15) * 136 + kk * 32 + quad * 8);
#pragma unroll
      for (int ct = 0; ct < 8; ++ct) {
        const bf16x8 av = *(const bf16x8*)(sV + (ct * 16 + l15) * 136 + kk * 32 + quad * 8);
#pragma unroll
        for (int pt = 0; pt < 2; ++pt)
          acc[ct][pt] = __builtin_amdgcn_mfma_f32_16x16x32_bf16(av, bw[pt], acc[ct][pt], 0, 0, 0);
      }
    }
#pragma unroll
    for (int pt = 0; pt < 2; ++pt) {
      const int pp = wave * 32 + pt * 16 + l15;
      const float bias = bs_[g * 128 + pp];
      bfr* ur = UV + (size_t)(chunk * 128 + pp) * 2048 + g * 128 + quad * 4;
#pragma unroll
      for (int ct = 0; ct < 8; ++ct) {
        const uint2 u = *(const uint2*)(ur + ct * 16);
        uint2 o;
        o.x = pk2(bflo(u.x) * (acc[ct][pt][0] + bias), bfhi(u.x) * (acc[ct][pt][1] + bias));
        o.y = pk2(bflo(u.y) * (acc[ct][pt][2] + bias), bfhi(u.y) * (acc[ct][pt][3] + bias));
        *(uint2*)(ur + ct * 16) = o;
      }
    }
  }
}

DEVINL void hgrn_scan_phase(const Params& p, char* smem, int bid, int nblk, const int mode) {
  bfr* sQe = (bfr*)smem;
  bfr* sKe = sQe + 32 * 136;
  bfr* sKeT = sKe + 32 * 136;
  bfr* sVT = sKeT + 128 * 40;
  bfr* sP = sVT + 64 * 40;
  bfr* sST = sP + 32 * 40;
  float* sLast = (float*)(sST + 64 * 136);
  float* sTot = sLast + 128;
  const int tid = otid(), lane = tid & 63, wave = tid >> 6, l15 = lane & 15, quad = lane >> 4;
  const int cp = lane, qt = wave, i0 = qt * 8;
  const bfr* QZ = (const bfr*)(p.ws + OFF_BIG);
  bfr* Of = (bfr*)(p.ws + OFF_H);
  bfr* Ob = (bfr*)(p.ws + OFF_BIG + 209715200ull);
  const float* lbs = (const float*)(p.ws + OFF_LBS);
  const float* state_rec = p.in[2];
  float* out_state = p.out + (size_t)MTOK * DM;

  float* SLOC = (float*)(p.ws + OFF_BIG + 251658240ull);
  float* DLOC = (float*)(p.ws + OFF_BIG + 251658240ull + 33554432ull);
  const int nitems = mode ? 1536 : 896;
  for (int item = bid; item < nitems; item += nblk) {
    const int eh = item & 1, dir = (item >> 1) & 1, h = (item >> 2) & 7;
    int base, T, nchunks, pos0, slot, seq;
    bool is_prompt = false;
    if (!mode) {
      const int r = item >> 5, seqb = r / 7, j = r - seqb * 7;
      seq = 16 + seqb; base = NPROMPT + seqb * 4096; T = 4096; nchunks = 16; pos0 = j * 512;
      slot = ((seqb * 8 + j) * 8 + h) * 2 + dir;
    } else if (item < 1024) {
      const int r = item >> 5, seqb = r >> 3, j = r & 7;
      seq = 16 + seqb; base = NPROMPT + seqb * 4096; T = 4096; nchunks = 16; pos0 = j * 512;
      slot = ((seqb * 8 + j) * 8 + h) * 2 + dir;
    } else {
      seq = (item - 1024) >> 5; base = seq * 256; T = 256; nchunks = 8; pos0 = 0; slot = 0;
      is_prompt = true;
    }
    bfr* Od = dir ? Ob : Of;
    const float lbv0 = lbs[dir * 1024 + h * 128 + 2 * cp], lbv1 = lbs[dir * 1024 + h * 128 + 2 * cp + 1];
    const int eloc = wave * 16 + l15;
    const int eglob = eh * 64 + eloc;

    f32x4 S[8];
    if (is_prompt || !mode) {
#pragma unroll
      for (int dt = 0; dt < 8; ++dt) S[dt] = f32x4{0.f, 0.f, 0.f, 0.f};
    } else {
      const float* s0 = SLOC + (size_t)slot * 16384;
#pragma unroll
      for (int dt = 0; dt < 8; ++dt)
#pragma unroll
        for (int j = 0; j < 4; ++j) S[dt][j] = s0[(dt * 16 + quad * 4 + j) * 128 + eglob];
    }
    float cum0 = 1.f, cum1 = 1.f;
    __syncthreads();
#pragma unroll
    for (int dt = 0; dt < 8; ++dt) {
      uint2 o; o.x = pk2(S[dt][0], S[dt][1]); o.y = pk2(S[dt][2], S[dt][3]);
      *(uint2*)(sST + eloc * 136 + dt * 16 + quad * 4) = o;
    }

    const unsigned qoff2 = h * 64 + cp, zoff2 = (1 + dir) * 512 + h * 64 + cp;
    const unsigned voff2 = 1536 + h * 64 + eh * 32 + (cp & 31);
    const uint32_t* __restrict__ QZ32 = (const uint32_t*)QZ;
    uint32_t rq[8], rz[8], rv[8];
#pragma unroll
    for (int ii = 0; ii < 8; ++ii) {
      const int pos = pos0 + i0 + ii;
      const unsigned tok = dir ? base + T - 1 - pos : base + pos;
      const unsigned ri = tok * 2560u;
      rq[ii] = QZ32[ri + qoff2]; rz[ii] = QZ32[ri + zoff2]; rv[ii] = QZ32[ri + voff2];
    }

    for (int c = 0; c < nchunks; ++c) {
      float pc0[8], pc1[8], kv0[8], kv1[8];
      float run0 = 1.f, run1 = 1.f;
#pragma unroll
      for (int ii = 0; ii < 8; ++ii) {
        const float z0 = bflo(rz[ii]), z1 = bfhi(rz[ii]);
        const float f0 = lbv0 + (1.f - lbv0) * frcp(1.f + __expf(-z0));
        const float f1 = lbv1 + (1.f - lbv1) * frcp(1.f + __expf(-z1));
        run0 *= f0; run1 *= f1;
        pc0[ii] = run0; pc1[ii] = run1;
        kv0[ii] = 1.f - f0; kv1[ii] = 1.f - f1;
      }
      *(float2*)(sTot + qt * 128 + 2 * cp) = make_float2(run0, run1);
      __syncthreads();
      {
        float off0 = 1.f, off1 = 1.f, tot0 = 1.f, tot1 = 1.f;
#pragma unroll
        for (int q = 0; q < 4; ++q) {
          const float2 t = *(const float2*)(sTot + q * 128 + 2 * cp);
          if (q < qt) { off0 *= t.x; off1 *= t.y; }
          tot0 *= t.x; tot1 *= t.y;
        }
        uint32_t wk0[4], wk1[4], wv0[4], wv1[4];
#pragma unroll
        for (int ii = 0; ii < 8; ii += 2) {
          uint32_t kp[2];
#pragma unroll
          for (int u = 0; u < 2; ++u) {
            const float e0 = pc0[ii + u] * off0, e1 = pc1[ii + u] * off1;
            kp[u] = pk2(kv0[ii + u] * frcp(e0), kv1[ii + u] * frcp(e1));
            *(uint32_t*)(sKe + (i0 + ii + u) * 136 + 2 * cp) = kp[u];
            if (mode) *(uint32_t*)(sQe + (i0 + ii + u) * 136 + 2 * cp) = pk2(bflo(rq[ii + u]) * e0, bfhi(rq[ii + u]) * e1);
          }
          wk0[ii >> 1] = (kp[0] & 0xffffu) | (kp[1] << 16);
          wk1[ii >> 1] = (kp[0] >> 16) | (kp[1] & 0xffff0000u);
          wv0[ii >> 1] = (rv[ii] & 0xffffu) | (rv[ii + 1] << 16);
          wv1[ii >> 1] = (rv[ii] >> 16) | (rv[ii + 1] & 0xffff0000u);
        }
        *(u32x4*)(sKeT + (2 * cp) * 40 + i0) = u32x4{wk0[0], wk0[1], wk0[2], wk0[3]};
        *(u32x4*)(sKeT + (2 * cp + 1) * 40 + i0) = u32x4{wk1[0], wk1[1], wk1[2], wk1[3]};
        if (cp < 32) {
          *(u32x4*)(sVT + (2 * cp) * 40 + i0) = u32x4{wv0[0], wv0[1], wv0[2], wv0[3]};
          *(u32x4*)(sVT + (2 * cp + 1) * 40 + i0) = u32x4{wv1[0], wv1[1], wv1[2], wv1[3]};
        }
        if (qt == 0) *(float2*)(sLast + 2 * cp) = make_float2(tot0, tot1);
        cum0 *= tot0; cum1 *= tot1;
      }
      if (c + 1 < nchunks) {
#pragma unroll
        for (int ii = 0; ii < 8; ++ii) {
          const int pos = pos0 + (c + 1) * 32 + i0 + ii;
          const unsigned tok = dir ? base + T - 1 - pos : base + pos;
          const unsigned ri = tok * 2560u;
          rq[ii] = QZ32[ri + qoff2]; rz[ii] = QZ32[ri + zoff2]; rv[ii] = QZ32[ri + voff2];
        }
      }
      __syncthreads();
      if (mode) {
        const int ti = wave >> 1, si = wave & 1;
        f32x4 sc = f32x4{0.f, 0.f, 0.f, 0.f};
        if (si <= ti) {
#pragma unroll
          for (int kk = 0; kk < 4; ++kk) {
            const bf16x8 a = *(const bf16x8*)(sQe + (ti * 16 + l15) * 136 + kk * 32 + quad * 8);
            const bf16x8 b = *(const bf16x8*)(sKe + (si * 16 + l15) * 136 + kk * 32 + quad * 8);
            sc = __builtin_amdgcn_mfma_f32_16x16x32_bf16(a, b, sc, 0, 0, 0);
          }
        }
#pragma unroll
        for (int j = 0; j < 4; ++j) {
          const int t = ti * 16 + quad * 4 + j, s2 = si * 16 + l15;
          sP[t * 40 + s2] = (s2 <= t) ? f2bf(sc[j]) : (bfr)0;
        }
      }
      f32x4 oacc[2];
      oacc[0] = f32x4{0.f, 0.f, 0.f, 0.f}; oacc[1] = f32x4{0.f, 0.f, 0.f, 0.f};
      if (mode) {
#pragma unroll
      for (int kk = 0; kk < 4; ++kk) {
        const bf16x8 sb = *(const bf16x8*)(sST + eloc * 136 + kk * 32 + quad * 8);
#pragma unroll
        for (int tt = 0; tt < 2; ++tt) {
          const bf16x8 qa = *(const bf16x8*)(sQe + (tt * 16 + l15) * 136 + kk * 32 + quad * 8);
          oacc[tt] = __builtin_amdgcn_mfma_f32_16x16x32_bf16(sb, qa, oacc[tt], 0, 0, 0);
        }
      }
      }
      __syncthreads();
      {
        const bf16x8 vb = *(const bf16x8*)(sVT + eloc * 40 + quad * 8);
        if (mode) {
#pragma unroll
        for (int tt = 0; tt < 2; ++tt) {
          const bf16x8 pb = *(const bf16x8*)(sP + (tt * 16 + l15) * 40 + quad * 8);
          oacc[tt] = __builtin_amdgcn_mfma_f32_16x16x32_bf16(vb, pb, oacc[tt], 0, 0, 0);
          const int pos = pos0 + c * 32 + tt * 16 + l15;
          const int tok = dir ? base + T - 1 - pos : base + pos;
          uint2 o; o.x = pk2(oacc[tt][0], oacc[tt][1]); o.y = pk2(oacc[tt][2], oacc[tt][3]);
          *(uint2*)(Od + (size_t)tok * DM + h * 128 + eh * 64 + wave * 16 + quad * 4) = o;
        }
        }
#pragma unroll
        for (int dt = 0; dt < 8; ++dt) {
          const bf16x8 ka = *(const bf16x8*)(sKeT + (dt * 16 + l15) * 40 + quad * 8);
          const float4 dl = *(const float4*)(sLast + dt * 16 + quad * 4);
          f32x4 sn = __builtin_amdgcn_mfma_f32_16x16x32_bf16(ka, vb, S[dt], 0, 0, 0);
          sn[0] *= dl.x; sn[1] *= dl.y; sn[2] *= dl.z; sn[3] *= dl.w;
          S[dt] = sn;
          uint2 o; o.x = pk2(sn[0], sn[1]); o.y = pk2(sn[2], sn[3]);
          *(uint2*)(sST + eloc * 136 + dt * 16 + quad * 4) = o;
        }
      }
    }
    if (is_prompt || !mode) {
      float* so = is_prompt ? out_state + ((size_t)(seq * 2 + dir) * 8 + h) * 16384 : SLOC + (size_t)slot * 16384;
#pragma unroll
      for (int dt = 0; dt < 8; ++dt)
#pragma unroll
        for (int j = 0; j < 4; ++j) so[(dt * 16 + quad * 4 + j) * 128 + eglob] = S[dt][j];
      if (!mode && eh == 0 && qt == 0) *(float2*)(DLOC + slot * 128 + 2 * cp) = make_float2(cum0, cum1);
    }
  }
}

DEVINL void hgrn_combine_phase(const Params& p, int bid, int nblk) {
  const int gt = bid * 256 + otid(), nt = nblk * 256;
  float* SLOC = (float*)(p.ws + OFF_BIG + 251658240ull);
  const float* DLOC = (const float*)(p.ws + OFF_BIG + 251658240ull + 33554432ull);
  const float* state_rec = p.in[2];
  for (int idx = gt; idx < 4 * 8 * 2 * 16384; idx += nt) {
    const int de = idx & 16383, r = idx >> 14;
    const int dir = r & 1, h = (r >> 1) & 7, seqb = r >> 4;
    const int d = de >> 7;
    float prev = state_rec[((size_t)(seqb * 2 + dir) * 8 + h) * 16384 + de];
#pragma unroll
    for (int j = 0; j < 8; ++j) {
      const int slot = ((seqb * 8 + j) * 8 + h) * 2 + dir;
      float* ptr = SLOC + (size_t)slot * 16384 + de;
      const float a = (j < 7) ? *ptr : 0.f;
      *ptr = prev;
      if (j < 7) prev = DLOC[slot * 128 + d] * prev + a;
    }
  }
}

DEVINL void hgrn_gate_phase(const Params& p, const float* __restrict__ ng, int bid, int nblk) {
  const int tid = otid(); const int lane = tid & 63;
  const int gw = bid * 4 + (tid >> 6), nw = nblk * 4;
  bfr* Of = (bfr*)(p.ws + OFF_H);
  const bfr* Ob = (const bfr*)(p.ws + OFF_BIG + 209715200ull);
  const bfr* QZ = (const bfr*)(p.ws + OFF_BIG);
  for (int row = gw; row < MTOK; row += nw) {
#pragma unroll
    for (int seg = 0; seg < 4; ++seg) {
      const int c = seg * 256 + lane * 4;
      const uint2 a = *(const uint2*)(Of + (size_t)row * DM + c);
      const uint2 b = *(const uint2*)(Ob + (size_t)row * DM + c);
      const uint2 gq = *(const uint2*)(QZ + (size_t)row * 5120 + 4096 + c);
      const float o0 = bflo(a.x) + bflo(b.x), o1 = bfhi(a.x) + bfhi(b.x), o2 = bflo(a.y) + bflo(b.y), o3 = bfhi(a.y) + bfhi(b.y);
      float ss = o0 * o0 + o1 * o1 + o2 * o2 + o3 * o3;
#pragma unroll
      for (int o = 16; o > 0; o >>= 1) ss += shx(ss, o, lane);
      const float rstd = rsqrtf(ss * (1.f / 128.f) + EPS);
      const float4 gg = *(const float4*)(ng + c);
      uint2 o;
      o.x = pk2(o0 * rstd * gg.x * silu_f(bflo(gq.x)), o1 * rstd * gg.y * silu_f(bfhi(gq.x)));
      o.y = pk2(o2 * rstd * gg.z * silu_f(bflo(gq.y)), o3 * rstd * gg.w * silu_f(bfhi(gq.y)));
      *(uint2*)(Of + (size_t)row * DM + c) = o;
    }
  }
}

DEVINL void ffn_act_phase(const bfr* __restrict__ UP, const float* __restrict__ wdw, int hf, bfr* __restrict__ ACT, int bid, int nblk) {
  const int gt = bid * 256 + otid(), nt = nblk * 256;
  for (int i = gt; i < MTOK * 176; i += nt) {
    const int m = i / 176, j = (i - m * 176) * 8;
    int tl, T; tok_pos(m, tl, T);
    const bfr* ur = UP + (size_t)m * DFF;
    float a[8], b[8];
#pragma unroll
    for (int q = 0; q < 8; ++q) { a[q] = 0.f; b[q] = 0.f; }
#pragma unroll
    for (int tap = 0; tap < 3; ++tap) {
      const int d = tap - 1;
      if ((d < 0 && tl == 0) || (d > 0 && tl == T - 1)) continue;
      const bfr* nr = ur + (ptrdiff_t)d * DFF;
      const uint4 av = *(const uint4*)(nr + j);
      const uint4 bv = *(const uint4*)(nr + HALF_FF + j);
      const float* wa = wdw + tap * (2 * DFF) + hf * HALF_FF + j;
      const float* wb = wdw + tap * (2 * DFF) + DFF + hf * HALF_FF + j;
      const float4 wa0 = *(const float4*)wa, wa1 = *(const float4*)(wa + 4);
      const float4 wb0 = *(const float4*)wb, wb1 = *(const float4*)(wb + 4);
      a[0] += wa0.x * bflo(av.x); a[1] += wa0.y * bfhi(av.x); a[2] += wa0.z * bflo(av.y); a[3] += wa0.w * bfhi(av.y);
      a[4] += wa1.x * bflo(av.z); a[5] += wa1.y * bfhi(av.z); a[6] += wa1.z * bflo(av.w); a[7] += wa1.w * bfhi(av.w);
      b[0] += wb0.x * bflo(bv.x); b[1] += wb0.y * bfhi(bv.x); b[2] += wb0.z * bflo(bv.y); b[3] += wb0.w * bfhi(bv.y);
      b[4] += wb1.x * bflo(bv.z); b[5] += wb1.y * bfhi(bv.z); b[6] += wb1.z * bflo(bv.w); b[7] += wb1.w * bfhi(bv.w);
    }
    uint4 o;
    o.x = pk2(silu_f(a[0]) * b[0], silu_f(a[1]) * b[1]);
    o.y = pk2(silu_f(a[2]) * b[2], silu_f(a[3]) * b[3]);
    o.z = pk2(silu_f(a[4]) * b[4], silu_f(a[5]) * b[5]);
    o.w = pk2(silu_f(a[6]) * b[6], silu_f(a[7]) * b[7]);
    *(uint4*)(ACT + (size_t)m * DFF + hf * HALF_FF + j) = o;
  }
}


#define XB_TMO      128
#define XB_XCNT(j)  (256  + 64 * (j))
#define XB_XSUB(j)  (1280 + 64 * (j))
#define XB_XGEN(j)  (2304 + 64 * (j))
#define XB_TOP      3328
#define XB_TOPGEN   3392
#define XCD_BAR_WORDS 3456
#define XB_SPIN_CAP (1u << 22)
#define LAS __attribute__((address_space(3)))
DEVINL unsigned xb_ld(unsigned* p) { return __hip_atomic_load(p, __ATOMIC_RELAXED, __HIP_MEMORY_SCOPE_AGENT); }
DEVINL unsigned xb_add(unsigned* p, unsigned v) { return __hip_atomic_fetch_add(p, v, __ATOMIC_RELAXED, __HIP_MEMORY_SCOPE_AGENT); }
DEVINL unsigned xb_xcc_id() { return (unsigned)__builtin_amdgcn_s_getreg((3 << 11) | 20) & 0xFu; }
#define XB_SPIN(cond, bar) do { unsigned _sp = 0; while (cond) { __builtin_amdgcn_s_sleep(1); \
    if ((++_sp & 255u) == 0u) { if (xb_ld(&(bar)[XB_TMO])) break; if (_sp > XB_SPIN_CAP) { atomicAdd(&(bar)[XB_TMO], 1u); break; } } } } while (0)
struct XcdBarrier { unsigned* bar; unsigned x; volatile LAS unsigned* st; };
DEVINL XcdBarrier xcd_barrier_post(unsigned* bar, volatile LAS unsigned* st) {
  XcdBarrier b; b.bar = bar; b.x = xb_xcc_id(); b.st = st;
  if (threadIdx.x == 0) (void)xb_add(&bar[XB_XCNT(b.x)], 1u);
  return b;
}
DEVINL void xcd_barrier_complete(unsigned* bar, unsigned x, unsigned& nloc, unsigned& nx) {
  const unsigned G = gridDim.x * gridDim.y * gridDim.z;
  unsigned sum, cnt, mine, sp = 0u;
  for (;;) {
    sum = 0u; cnt = 0u; mine = 0u;
#pragma unroll
    for (unsigned j = 0; j < 16; ++j) { const unsigned c = xb_ld(&bar[XB_XCNT(j)]); sum += c; cnt += (c > 0u) ? 1u : 0u; mine = (j == x) ? c : mine; }
    if (sum == G) break;
    __builtin_amdgcn_s_sleep(1);
    if ((++sp & 255u) == 0u) { if (xb_ld(&bar[XB_TMO])) break; if (sp > XB_SPIN_CAP) { atomicAdd(&bar[XB_TMO], 1u); break; } }
  }
  nloc = mine > 0u ? mine : 1u; nx = cnt > 0u ? cnt : 1u;
}
DEVINL void xcd_barrier(const XcdBarrier& b) {
  asm volatile("s_waitcnt vmcnt(0)" ::: "memory");
  __syncthreads();
  if (threadIdx.x == 0) {
    unsigned* bar = b.bar;
    unsigned bx = b.x;
    asm volatile("" : "+s"(bar), "+s"(bx));
    __builtin_amdgcn_s_waitcnt(0);
    unsigned nloc = b.st[0], nx = b.st[1];
    if (nloc == 0u) { xcd_barrier_complete(bar, bx, nloc, nx); b.st[0] = nloc; b.st[1] = nx; }
    const unsigned old = xb_add(&bar[XB_XSUB(bx)], 1u);
    const unsigned gen = old / nloc;
    if (old + 1u == (gen + 1u) * nloc) {
      __builtin_amdgcn_fence(__ATOMIC_RELEASE, "agent");
      asm volatile("s_waitcnt vmcnt(0)" ::: "memory");
      const unsigned og = xb_add(&bar[XB_TOP], 1u);
      const unsigned tg = og / nx;
      if (og + 1u == (tg + 1u) * nx) xb_add(&bar[XB_TOPGEN], 1u);
      else XB_SPIN(xb_ld(&bar[XB_TOPGEN]) == tg, bar);
      __builtin_amdgcn_fence(__ATOMIC_ACQUIRE, "agent");
      xb_add(&bar[XB_XGEN(bx)], 1u);
      asm volatile("s_waitcnt vmcnt(0)" ::: "memory");
    } else {
      XB_SPIN(xb_ld(&bar[XB_XGEN(bx)]) == gen, bar);
      __builtin_amdgcn_fence(__ATOMIC_ACQUIRE, "agent");
      asm volatile("s_waitcnt vmcnt(0)" ::: "memory");
    }
  }
  __syncthreads();
}

constexpr int SMEM_BYTES = 77824;

__global__ void __launch_bounds__(256, 2) mega_kernel(Params p) {
  __shared__ __attribute__((aligned(16))) char smem[SMEM_BYTES];
  cg::grid_group grid = cg::this_grid();
  __shared__ uint4 xb_words;
  if (threadIdx.x == 0) xb_words = make_uint4(0u, 0u, 0u, 0u);
  __syncthreads();
  XcdBarrier xb = xcd_barrier_post((unsigned*)(p.ws + OFF_BAR), (volatile LAS unsigned*)&xb_words);
  const int bid = blockIdx.x, nblk = gridDim.x;

  phase0a(p, smem, osg(bid), nblk);
  grid.sync();
  phase0b(p, osg(bid), nblk);
  xcd_barrier(xb);

  for (int layer = 0; layer < 4; ++layer) {
    Params q = p;
    {
      size_t oz = 0;
      asm volatile("" : "+s"(oz));
      q.ws = p.ws + oz;
      q.out = p.out + oz;
    }
    float* X = q.out;
    bfr* WB = (bfr*)(q.ws + OFF_WB);
    bfr* H = (bfr*)(q.ws + OFF_H);
    bfr* BIG = (bfr*)(q.ws + OFF_BIG);
    const float* MOD = (const float*)(q.ws + OFF_MOD);
    const float* modl = MOD + layer * 30720;
    if (layer == 0) {
      conv_matrix(q.in[9], 1024, 3072, WB + WB_IN, 0, smem, osg(bid), nblk);
      conv_matrix(q.in[11], 1024, 1024, WB + WB_OUT, 0, smem, osg(bid), nblk);
    } else if (layer == 1) {
      for (int g = 0; g < 4; ++g) conv_matrix(q.in[12] + g * 65536, 256, 256, WB + WB_IN + g * 65536, 0, smem, osg(bid), nblk);
    } else if (layer == 2) {
      conv_matrix(q.in[14], 1024, 2048, WB + WB_IN, 0, smem, osg(bid), nblk);
      conv_matrix(q.in[18], 1024, 1024, WB + WB_OUT, 0, smem, osg(bid), nblk);
    } else {
      conv_matrix(q.in[19], 1024, 5120, WB + WB_IN, 0, smem, osg(bid), nblk);
      conv_matrix(q.in[22], 1024, 1024, WB + WB_OUT, 0, smem, osg(bid), nblk);
    }
    conv_matrix(q.in[23] + (size_t)layer * 1024 * 5632, 1024, 5632, WB + WB_UP, 1, smem, osg(bid), nblk);
    conv_matrix(q.in[25] + (size_t)layer * DFF * 1024, DFF, 1024, WB + WB_DOWN, 0, smem, osg(bid), nblk);
    norm_phase(X, q.in[7] + (layer * 2 + 0) * DM, modl, 0, 1024, H, osg(bid), nblk);
    xcd_barrier(xb);

    if (layer == 0) {
      bfr* G = BIG;
      bfr* U = BIG + (size_t)MTOK * 3072;
      gemm256s_phase(H, DM, WB + WB_IN, 1024, 3072, 1024, EpiStore{G, 3072}, smem, osg(bid), nblk);
      xcd_barrier(xb);
      shortconv_ew_phase(G, q.in[10], U, osg(bid), nblk);
      xcd_barrier(xb);
      gemm_phase(U, DM, WB + WB_OUT, 1024, 1024, 1024, EpiResid{X, modl + 2048, nullptr, 0}, smem, osg(bid), nblk);
      xcd_barrier(xb);
    } else if (layer == 1) {
      bfr* P = BIG;
      pool_ew_phase(H, P, osg(bid), nblk);
      xcd_barrier(xb);
      for (int g = 0; g < 4; ++g)
        gemm_phase(P + g * 256, DM, WB + WB_IN + g * 65536, 256, 256, 256,
                   EpiResid{X, modl + 2048 + g * 256, q.in[13] + g * 256, g * 256}, smem, osg(bid), nblk);
      xcd_barrier(xb);
    } else if (layer == 2) {
      bfr* UV = BIG;
      gemm_phase(H, DM, WB + WB_IN, 1024, 2048, 1024, EpiGelu{UV, 2048}, smem, osg(bid), nblk);
      xcd_barrier(xb);
      sgu_norm_phase(UV, q.in[15], osg(bid), nblk);
      xcd_barrier(xb);
      sgu_spatial_phase(UV, q.in[16], q.in[17], smem, osg(bid), nblk);
      xcd_barrier(xb);
      gemm_phase(UV, 2048, WB + WB_OUT, 1024, 1024, 1024, EpiResid{X, modl + 2048, nullptr, 0}, smem, osg(bid), nblk);
      xcd_barrier(xb);
    } else {
      bfr* QZ = BIG;
      gemm256s_phase(H, DM, WB + WB_IN, 1024, 5120, 1024, EpiStore{QZ, 5120}, smem, osg(bid), nblk);
      xcd_barrier(xb);
      hgrn_scan_phase(q, smem, osg(bid), nblk, 0);
      xcd_barrier(xb);
      hgrn_combine_phase(q, osg(bid), nblk);
      xcd_barrier(xb);
      hgrn_scan_phase(q, smem, osg(bid), nblk, 1);
      xcd_barrier(xb);
      hgrn_gate_phase(q, q.in[21], osg(bid), nblk);
      xcd_barrier(xb);
      gemm_phase(H, DM, WB + WB_OUT, 1024, 1024, 1024, EpiResid{X, modl + 2048, nullptr, 0}, smem, osg(bid), nblk);
      xcd_barrier(xb);
    }

    norm_phase(X, q.in[7] + (layer * 2 + 1) * DM, modl, 3072, 4096, H, osg(bid), nblk);
    xcd_barrier(xb);
    bfr* ACT = BIG;
    float* EDGE = (float*)(q.ws + OFF_BIG + 115343360ull);
    const float* wdw = q.in[24] + (size_t)layer * 3 * 2 * DFF;
    gemm256s_phase(H, DM, WB + WB_UP, 1024, 2 * DFF, 1024, EpiFfnUp{ACT, EDGE, wdw}, smem, osg(bid), nblk);
    xcd_barrier(xb);
    ffn_edge_phase(EDGE, wdw, ACT, osg(bid), nblk);
    xcd_barrier(xb);
    gemm_phase(ACT, DFF, WB + WB_DOWN, DFF, 1024, DFF, EpiResid{X, modl + 5120, nullptr, 0}, smem, osg(bid), nblk);
    xcd_barrier(xb);
  }
  final_norm_phase(p.out, p.in[8], osg(bid), nblk);
}

extern "C" void kernel_launch(void* const* d_in, const int* in_sizes, int n_in, void* d_out, int out_size,
                              void* d_ws, size_t ws_size, hipStream_t stream) {
  static int grid_blocks = 0;
  if (!grid_blocks) {
    int dev = 0, cus = 0, per_cu = 0;
    hipGetDevice(&dev);
    hipDeviceGetAttribute(&cus, hipDeviceAttributeMultiprocessorCount, dev);
    hipOccupancyMaxActiveBlocksPerMultiprocessor(&per_cu, mega_kernel, 256, 0);
    if (per_cu > 2) per_cu = 2;
    if (per_cu < 1) per_cu = 1;
    grid_blocks = cus * per_cu;
  }
  if (ws_size < WS_NEED) { fprintf(stderr, "workspace too small: %zu < %zu\n", ws_size, (size_t)WS_NEED); return; }
  Params p{};
  for (int i = 0; i < 26; ++i) p.in[i] = (const float*)d_in[i];
  p.out = (float*)d_out;
  p.ws = (char*)d_ws;
  hipMemsetAsync((char*)d_ws + OFF_BAR, 0, XCD_BAR_WORDS * 4, stream);
  void* args[] = {&p};
  hipError_t e = hipLaunchCooperativeKernel((void*)mega_kernel, dim3(grid_blocks), dim3(256), args, 0, stream);
  if (e != hipSuccess) fprintf(stderr, "cooperative launch failed: %s (grid %d)\n", hipGetErrorString(e), grid_blocks);
}
```

```cpp
#include <hip/hip_runtime.h>
#include <hip/hip_cooperative_groups.h>
#include <stdint.h>
#include <stdio.h>
namespace cg = cooperative_groups;

#define DEVINL __device__ __forceinline__
typedef unsigned short bfr;
using bf16x8 = __attribute__((ext_vector_type(8))) short;
using f32x4 = __attribute__((ext_vector_type(4))) float;
using u32x4 = __attribute__((ext_vector_type(4))) unsigned int;

constexpr int DM = 1024;
constexpr int MTOK = 20480;
constexpr int NPROMPT = 4096;
constexpr int DFF = 2816;
constexpr int HALF_FF = 1408;
constexpr float EPS = 1e-6f;

constexpr size_t OFF_MODP = 0;
constexpr size_t OFF_MOD = 7864320;
constexpr size_t OFF_LBS = OFF_MOD + 491520;
constexpr size_t OFF_BAR = OFF_LBS + 8192;
constexpr size_t OFF_WB = 8388608;
constexpr size_t OFF_H = 41943040;
constexpr size_t OFF_BIG = 83886080;
constexpr size_t WS_NEED = OFF_BIG + 251658240ull + 33554432ull + 262144ull;
constexpr size_t WB_IN = 0, WB_OUT = 5242880, WB_UP = 6291456, WB_DOWN = 12058624;

struct Params {
  const float* in[26];
  float* out;
  char* ws;
};

DEVINL int otid() { int t = threadIdx.x; asm volatile("" : "+v"(t)); return t; }
DEVINL int osg(int x) { asm volatile("" : "+s"(x)); return x; }
typedef __bf16 hbf16x2 __attribute__((ext_vector_type(2)));
typedef float hf32x2 __attribute__((ext_vector_type(2)));
DEVINL uint32_t pk2(float a, float b) {
  hf32x2 v = {a, b};
  hbf16x2 r = __builtin_convertvector(v, hbf16x2);
  return __builtin_bit_cast(uint32_t, r);
}
DEVINL bfr f2bf(float f) { return (bfr)(pk2(f, 0.f) & 0xffffu); }
DEVINL float bf2f(bfr h) { return __uint_as_float(((uint32_t)h) << 16); }
DEVINL float frcp(float x) { return __builtin_amdgcn_rcpf(x); }
DEVINL float bflo(uint32_t u) { return __uint_as_float(u << 16); }
DEVINL float bfhi(uint32_t u) { return __uint_as_float(u & 0xffff0000u); }
DEVINL int cond_of(int m) { return m < NPROMPT ? 0 : 1 + ((m - NPROMPT) >> 12); }
DEVINL float silu_f(float x) { return x * frcp(1.f + __expf(-x)); }
DEVINL float gelu_tanh_f(float x) {
  float y = 0.7978845608028654f * (x + 0.044715f * x * x * x);
  float t = 1.f - 2.f * frcp(__expf(2.f * y) + 1.f);
  return 0.5f * x * (1.f + t);
}
DEVINL float shx(float v, int o, int lane) {
  return __int_as_float(__builtin_amdgcn_ds_bpermute((lane ^ o) << 2, __float_as_int(v)));
}
DEVINL float wave_sum(float v, int lane) {
#pragma unroll
  for (int o = 32; o > 0; o >>= 1) v += shx(v, o, lane);
  return v;
}

DEVINL void tok_pos(int m, int& tl, int& T) {
  if (m < NPROMPT) { tl = m & 255; T = 256; } else { tl = (m - NPROMPT) & 4095; T = 4096; }
}

struct EpiNoPre {};
#define EPI_ELEMENTWISE_TILE                                                                       \
  typedef EpiNoPre Pre;                                                                             \
  static constexpr bool kLdsEpi = false;                                                            \
  DEVINL Pre pre(int tn, int tid) const { return Pre{}; }                                           \
  DEVINL void tile(const f32x4 (&acc)[4][4], const Pre& pre_, int m0, int n0, int tn, int wm, int wn, int l15, \
                   int quad, int tid, char* smem) const {                                           \
    _Pragma("unroll") for (int mt = 0; mt < 4; ++mt)                                                \
      _Pragma("unroll") for (int nt = 0; nt < 4; ++nt)                                              \
        (*this)(m0 + wm * 64 + mt * 16 + l15, n0 + wn * 64 + nt * 16 + quad * 4, acc[mt][nt]);      \
  }
struct EpiStore {
  bfr* C; int ldc;
  DEVINL void tile256(const f32x4 (&acc)[8][4], const EpiNoPre& pre_, int m0, int n0, int tn, int wm, int wn, int l15,
                      int quad, int tid, char* smem) const {
#pragma unroll
    for (int mt = 0; mt < 8; ++mt)
#pragma unroll
      for (int nt = 0; nt < 4; ++nt)
        (*this)(m0 + wm * 128 + mt * 16 + l15, n0 + wn * 64 + nt * 16 + quad * 4, acc[mt][nt]);
  }
  DEVINL void operator()(int m, int n, f32x4 v) const {
    uint2 o; o.x = pk2(v[0], v[1]); o.y = pk2(v[2], v[3]);
    *(uint2*)(C + (size_t)m * ldc + n) = o;
  }
  EPI_ELEMENTWISE_TILE
};
struct EpiGelu {
  bfr* C; int ldc;
  DEVINL void operator()(int m, int n, f32x4 v) const {
    uint2 o; o.x = pk2(gelu_tanh_f(v[0]), gelu_tanh_f(v[1])); o.y = pk2(gelu_tanh_f(v[2]), gelu_tanh_f(v[3]));
    *(uint2*)(C + (size_t)m * ldc + n) = o;
  }
  EPI_ELEMENTWISE_TILE
};
struct EpiResid {
  float* X; const float* gate; const float* cscale; int coff;
  typedef EpiNoPre Pre;
  static constexpr bool kLdsEpi = false;
  static constexpr bool kSplit = false;
  DEVINL Pre pre(int tn, int tid) const { return Pre{}; }
  DEVINL void tile(const f32x4 (&acc)[4][4], const Pre& pre_, int m0, int n0, int tn, int wm, int wn, int l15,
                   int quad, int tid, char* smem) const {
    const int cond = cond_of(m0);
    const int nb = n0 + wn * 64 + quad * 4;
    f32x4 gs[4];
#pragma unroll
    for (int nt = 0; nt < 4; ++nt) {
      gs[nt] = *(const f32x4*)(gate + cond * 6144 + nb + nt * 16);
      if (cscale) gs[nt] = gs[nt] * *(const f32x4*)(cscale + nb + nt * 16);
    }
    float* xb = X + (size_t)(m0 + wm * 64 + l15) * DM + coff + nb;
#pragma unroll
    for (int hm = 0; hm < 2; ++hm) {
      f32x4 xv[2][4];
#pragma unroll
      for (int mi = 0; mi < 2; ++mi)
#pragma unroll
        for (int nt = 0; nt < 4; ++nt)
          xv[mi][nt] = *(const f32x4*)(xb + (size_t)((hm * 2 + mi) * 16) * DM + nt * 16);
#pragma unroll
      for (int mi = 0; mi < 2; ++mi)
#pragma unroll
        for (int nt = 0; nt < 4; ++nt)
          *(f32x4*)(xb + (size_t)((hm * 2 + mi) * 16) * DM + nt * 16) = xv[mi][nt] + gs[nt] * acc[hm * 2 + mi][nt];
    }
  }
};


#define LDS3 __attribute__((address_space(3)))
DEVINL void lds_barrier() { asm volatile("s_waitcnt lgkmcnt(0)\n\ts_barrier" ::: "memory"); }
template <class Epi>
DEVINL void gemm_phase(const bfr* __restrict__ A, int lda, const bfr* __restrict__ Bt, int ldb, int N, int K,
                       const Epi& epi, char* smem, int bid, int nblk) {
  const int tid = otid(), lane = tid & 63, wave = tid >> 6;
  const int wm = wave >> 1, wn = wave & 1, l15 = lane & 15, quad = lane >> 4;
  const int tilesN = N >> 7;
  const int ntiles = (MTOK >> 7) * tilesN;
  const int nk = K >> 6;
  const int srow0 = wave * 8 + (lane >> 3);
  const int lc = (lane & 7) ^ ((srow0 >> 1) & 7);
  const int fsw = (l15 >> 1) & 7;
  char* const dst0 = smem + wave * 1024 + lane * 16;
#define TILE_DECODE(t_, tm_, tn_) {                                                        \
    const int xcd_ = (t_) & 7, u_ = (t_) >> 3, g16_ = 16 * tilesN;                         \
    int ur_;                                                                               \
    if (u_ < g16_) { const int gs_ = 8 * tilesN; const int g_ = u_ / gs_, r_ = u_ - g_ * gs_; tn_ = r_ >> 3; ur_ = g_ * 8 + (r_ & 7); } \
    else { const int r_ = u_ - g16_; tn_ = r_ >> 2; ur_ = 16 + (r_ & 3); }                 \
    tm_ = ur_ * 8 + xcd_; }
#define GLDS_STAGE(pa_, pb_, st_, kt_)                                                                    \
  {                                                                                                       \
    _Pragma("unroll") for (int i = 0; i < 4; ++i) {                                                       \
      __builtin_amdgcn_global_load_lds((const unsigned*)((pa_) + (size_t)(i * 32) * lda + (kt_) * 64),    \
                                       (LDS3 unsigned*)(dst0 + (st_) * 32768 + i * 4096), 16, 0, 0);      \
      __builtin_amdgcn_global_load_lds((const unsigned*)((pb_) + (size_t)(i * 32) * ldb + (kt_) * 64),    \
                                       (LDS3 unsigned*)(dst0 + (st_) * 32768 + 16384 + i * 4096), 16, 0, 0); \
    }                                                                                                     \
  }
  int tile = bid;
  if (tile >= ntiles) return;
  int tm, tn;
  TILE_DECODE(tile, tm, tn)
  const bfr* gA = A + (size_t)((tm << 7) + srow0) * lda + lc * 8;
  const bfr* gB = Bt + (size_t)((tn << 7) + srow0) * ldb + lc * 8;
  __syncthreads();
  GLDS_STAGE(gA, gB, 0, 0)
  for (; tile < ntiles; tile += nblk) {
    const int m0 = tm << 7, n0 = tn << 7, tn_cur = tn;
    const bool has_next = (tile + nblk < ntiles);
    const bfr* gAn = gA; const bfr* gBn = gB;
    if (has_next) {
      TILE_DECODE(tile + nblk, tm, tn)
      gAn = A + (size_t)((tm << 7) + srow0) * lda + lc * 8;
      gBn = Bt + (size_t)((tn << 7) + srow0) * ldb + lc * 8;
    }
    typename Epi::Pre pre = epi.pre(tn_cur, tid);
    f32x4 acc[4][4];
#pragma unroll
    for (int i = 0; i < 4; ++i)
#pragma unroll
      for (int j = 0; j < 4; ++j) acc[i][j] = f32x4{0.f, 0.f, 0.f, 0.f};
    __syncthreads();
    for (int kt = 0; kt < nk; ++kt) {
      const int st = kt & 1;
      const bool cur = (kt + 1 < nk);
      const bool any = cur || has_next;
      const bfr* sa = cur ? gA + (kt + 1) * 64 : gAn;
      const bfr* sb = cur ? gB + (kt + 1) * 64 : gBn;
      char* sd = dst0 + (cur ? (st ^ 1) : 0) * 32768;
      __builtin_amdgcn_s_setprio(3);
      const char* cA = smem + st * 32768 + (wm * 64 + l15) * 128;
      const char* cB = smem + st * 32768 + 16384 + (wn * 64 + l15) * 128;
      {
        const int co0 = (quad ^ fsw) * 16, co1 = ((4 + quad) ^ fsw) * 16;
        bf16x8 af0[4], bf0[4], af1[4], bf1[4];
#pragma unroll
        for (int i = 0; i < 4; ++i) {
          af0[i] = *(const bf16x8*)(cA + i * 2048 + co0);
          bf0[i] = *(const bf16x8*)(cB + i * 2048 + co0);
        }
#pragma unroll
        for (int i = 0; i < 4; ++i) {
          af1[i] = *(const bf16x8*)(cA + i * 2048 + co1);
          bf1[i] = *(const bf16x8*)(cB + i * 2048 + co1);
        }
        __builtin_amdgcn_sched_barrier(0);
        if (any) {
#pragma unroll
          for (int mt = 0; mt < 4; ++mt) {
            __builtin_amdgcn_global_load_lds((const unsigned*)(sa + (size_t)(mt * 32) * lda), (LDS3 unsigned*)(sd + mt * 4096), 16, 0, 0);
            __builtin_amdgcn_global_load_lds((const unsigned*)(sb + (size_t)(mt * 32) * ldb), (LDS3 unsigned*)(sd + 16384 + mt * 4096), 16, 0, 0);
          }
        }
        __builtin_amdgcn_s_setprio(0);
        __builtin_amdgcn_sched_barrier(0);
#pragma unroll
        for (int mt = 0; mt < 4; ++mt)
#pragma unroll
          for (int nt = 0; nt < 4; ++nt)
            acc[mt][nt] = __builtin_amdgcn_mfma_f32_16x16x32_bf16(bf0[nt], af0[mt], acc[mt][nt], 0, 0, 0);
#pragma unroll
        for (int mt = 0; mt < 4; ++mt)
#pragma unroll
          for (int nt = 0; nt < 4; ++nt)
            acc[mt][nt] = __builtin_amdgcn_mfma_f32_16x16x32_bf16(bf1[nt], af1[mt], acc[mt][nt], 0, 0, 0);
        __builtin_amdgcn_sched_barrier(0);
      }
      if (kt + 1 < nk) __syncthreads();
    }
    epi.tile(acc, pre, m0, n0, tn_cur, wm, wn, l15, quad, tid, smem);
    gA = gAn; gB = gBn;
  }
}

constexpr int EDGE_LD = 2 * DFF;
struct FfnPre { f32x4 wa[3], wb[3]; };
DEVINL void ffn_conv_rows(const bfr* T, const FfnPre& pre_, bfr* ACT, float* EDGE, int m0, int n0, int tn, int tid) {
  const int c4 = (tid & 15) * 4, r0 = (tid >> 4) * 8;
  const int ja = tn * 64 + c4;
  int tl, Tlen; tok_pos(m0, tl, Tlen);
  const bool top_ok = (tl == 0), bot_ok = (tl + 128 == Tlen);
  if (tid < 128) {
    const int e = tid >> 5, c = (tid & 31) * 4;
    const int r = (e < 2) ? e : 124 + e;
    const uint2 v = *(const uint2*)(T + r * 136 + c);
    *(f32x4*)(EDGE + ((size_t)(m0 >> 7) * 4 + e) * EDGE_LD + n0 + c) = f32x4{bflo(v.x), bfhi(v.x), bflo(v.y), bfhi(v.y)};
  }
  const f32x4 zero = f32x4{0.f, 0.f, 0.f, 0.f};
#define LDT(dst, row, col) { const uint2 v_ = *(const uint2*)(T + (row) * 136 + (col)); dst = f32x4{bflo(v_.x), bfhi(v_.x), bflo(v_.y), bfhi(v_.y)}; }
  f32x4 pa = zero, pb = zero, ca, cb, na, nb;
  if (r0 > 0) { LDT(pa, r0 - 1, c4) LDT(pb, r0 - 1, 64 + c4) }
  LDT(ca, r0, c4) LDT(cb, r0, 64 + c4)
#pragma unroll
  for (int i = 0; i < 8; ++i) {
    const int r = r0 + i;
    if (r < 127) { LDT(na, r + 1, c4) LDT(nb, r + 1, 64 + c4) }
    else { na = zero; nb = zero; }
    const bool ok = (r > 0 || top_ok) && (r < 127 || bot_ok);
    if (ok) {
      const f32x4 a = pre_.wa[0] * pa + pre_.wa[1] * ca + pre_.wa[2] * na;
      const f32x4 b = pre_.wb[0] * pb + pre_.wb[1] * cb + pre_.wb[2] * nb;
      uint2 o;
      o.x = pk2(silu_f(a[0]) * b[0], silu_f(a[1]) * b[1]);
      o.y = pk2(silu_f(a[2]) * b[2], silu_f(a[3]) * b[3]);
      *(uint2*)(ACT + (size_t)(m0 + r) * DFF + ja) = o;
    }
    pa = ca; pb = cb; ca = na; cb = nb;
  }
#undef LDT
}
struct EpiFfnUp {
  bfr* ACT; float* EDGE; const float* wdw;
  typedef FfnPre Pre;
  static constexpr bool kLdsEpi = true;
  DEVINL Pre pre(int tn, int tid) const {
    Pre q;
    const int ja = tn * 64 + (tid & 15) * 4;
#pragma unroll
    for (int t = 0; t < 3; ++t) {
      q.wa[t] = *(const f32x4*)(wdw + t * (2 * DFF) + ja);
      q.wb[t] = *(const f32x4*)(wdw + t * (2 * DFF) + DFF + ja);
    }
    return q;
  }
  DEVINL void tile(const f32x4 (&acc)[4][4], const Pre& pre_, int m0, int n0, int tn, int wm, int wn, int l15, int quad,
                   int tid, char* smem) const {
    bfr* T = (bfr*)(smem + 32768);
    lds_barrier();
#pragma unroll
    for (int mt = 0; mt < 4; ++mt)
#pragma unroll
      for (int nt = 0; nt < 4; ++nt) {
        uint2 o; o.x = pk2(acc[mt][nt][0], acc[mt][nt][1]); o.y = pk2(acc[mt][nt][2], acc[mt][nt][3]);
        *(uint2*)(T + (wm * 64 + mt * 16 + l15) * 136 + wn * 64 + nt * 16 + quad * 4) = o;
      }
    lds_barrier();
    ffn_conv_rows(T, pre_, ACT, EDGE, m0, n0, tn, tid);
  }
  DEVINL void tile256(const f32x4 (&acc)[8][4], const Pre& pre_, int m0, int n0, int tn, int wm, int wn, int l15, int quad,
                      int tid, char* smem) const {
    bfr* T = (bfr*)smem;
#pragma unroll
    for (int hh = 0; hh < 2; ++hh) {
      lds_barrier();
      if (wm == hh) {
#pragma unroll
        for (int mt = 0; mt < 8; ++mt)
#pragma unroll
          for (int nt = 0; nt < 4; ++nt) {
            uint2 o; o.x = pk2(acc[mt][nt][0], acc[mt][nt][1]); o.y = pk2(acc[mt][nt][2], acc[mt][nt][3]);
            *(uint2*)(T + (mt * 16 + l15) * 136 + wn * 64 + nt * 16 + quad * 4) = o;
          }
      }
      lds_barrier();
      ffn_conv_rows(T, pre_, ACT, EDGE, m0 + hh * 128, n0, tn, tid);
    }
  }
};


template <class Epi>
DEVINL void gemm256_phase(const bfr* __restrict__ A, int lda, const bfr* __restrict__ Bt, int ldb, int N, int K,
                          const Epi& epi, char* smem, int bid, int nblk) {
  const int tid = otid(), lane = tid & 63, wave = tid >> 6;
  const int wm = wave >> 1, wn = wave & 1, l15 = lane & 15, quad = lane >> 4;
  const int tilesN = N >> 7;
  const int ntiles = (MTOK >> 8) * tilesN;
  const int nk = K >> 5;
  const int srow0 = wave * 16 + (lane >> 2);
  const int lc = (lane & 3) ^ ((0 - (lane >> 4)) & 3);
  const int fsw = (0 - (l15 >> 2)) & 3;
  char* const dst0 = smem + wave * 1024 + lane * 16;
#define TILE_DECODE2(t_, tm_, tn_) { const int xcd_ = (t_) & 7, u_ = (t_) >> 3; const int ur_ = u_ / tilesN; tn_ = u_ - ur_ * tilesN; tm_ = ur_ * 8 + xcd_; }
#define GLDS_STAGE2(pa_, pb_, st_, kt_)                                                                   \
  {                                                                                                       \
    _Pragma("unroll") for (int i = 0; i < 4; ++i)                                                         \
      __builtin_amdgcn_global_load_lds((const unsigned*)((pa_) + (size_t)(i * 64) * lda + (kt_) * 32),    \
                                       (LDS3 unsigned*)(dst0 + (st_) * 24576 + i * 4096), 16, 0, 0);      \
    _Pragma("unroll") for (int i = 0; i < 2; ++i)                                                         \
      __builtin_amdgcn_global_load_lds((const unsigned*)((pb_) + (size_t)(i * 64) * ldb + (kt_) * 32),    \
                                       (LDS3 unsigned*)(dst0 + (st_) * 24576 + 16384 + i * 4096), 16, 0, 0); \
  }
  int tile = bid;
  if (tile >= ntiles) return;
  int tm, tn;
  TILE_DECODE2(tile, tm, tn)
  const bfr* gA = A + (size_t)((tm << 8) + srow0) * lda + lc * 8;
  const bfr* gB = Bt + (size_t)((tn << 7) + srow0) * ldb + lc * 8;
  __syncthreads();
  GLDS_STAGE2(gA, gB, 0, 0)
  for (; tile < ntiles; tile += nblk) {
    const int m0 = tm << 8, n0 = tn << 7, tn_cur = tn;
    const bool has_next = (tile + nblk < ntiles);
    const bfr* gAn = gA; const bfr* gBn = gB;
    if (has_next) {
      TILE_DECODE2(tile + nblk, tm, tn)
      gAn = A + (size_t)((tm << 8) + srow0) * lda + lc * 8;
      gBn = Bt + (size_t)((tn << 7) + srow0) * ldb + lc * 8;
    }
    f32x4 acc[8][4];
#pragma unroll
    for (int i = 0; i < 8; ++i)
#pragma unroll
      for (int j = 0; j < 4; ++j) acc[i][j] = f32x4{0.f, 0.f, 0.f, 0.f};
    __syncthreads();
    for (int kt = 0; kt < nk; ++kt) {
      const int st = kt & 1;
      const bool cur = (kt + 1 < nk);
      const bool any = cur || has_next;
      const bfr* sa = cur ? gA + (kt + 1) * 32 : gAn;
      const bfr* sb = cur ? gB + (kt + 1) * 32 : gBn;
      char* sd = dst0 + (cur ? (st ^ 1) : 0) * 24576;
      const char* cA = smem + st * 24576 + (wm * 128 + l15) * 64 + ((quad ^ fsw) * 16);
      const char* cB = smem + st * 24576 + 16384 + (wn * 64 + l15) * 64 + ((quad ^ fsw) * 16);
      bf16x8 bfg[4];
#pragma unroll
      for (int i = 0; i < 4; ++i) bfg[i] = *(const bf16x8*)(cB + i * 1024);
#pragma unroll
      for (int hm = 0; hm < 2; ++hm) {
        bf16x8 af[4];
#pragma unroll
        for (int i = 0; i < 4; ++i) af[i] = *(const bf16x8*)(cA + (hm * 4 + i) * 1024);
        __builtin_amdgcn_sched_barrier(0);
#pragma unroll
        for (int mt = 0; mt < 4; ++mt) {
#pragma unroll
          for (int nt = 0; nt < 4; ++nt)
            acc[hm * 4 + mt][nt] = __builtin_amdgcn_mfma_f32_16x16x32_bf16(bfg[nt], af[mt], acc[hm * 4 + mt][nt], 0, 0, 0);
          const int g = hm * 4 + mt;
          if (any && g < 4)
            __builtin_amdgcn_global_load_lds((const unsigned*)(sa + (size_t)(g * 64) * lda), (LDS3 unsigned*)(sd + g * 4096), 16, 0, 0);
          else if (any && g < 6)
            __builtin_amdgcn_global_load_lds((const unsigned*)(sb + (size_t)((g - 4) * 64) * ldb), (LDS3 unsigned*)(sd + 16384 + (g - 4) * 4096), 16, 0, 0);
          __builtin_amdgcn_sched_barrier(0);
        }
      }
      if (kt + 1 < nk) __syncthreads();
    }
    {
      typename Epi::Pre pre = epi.pre(tn_cur, tid);
      epi.tile256(acc, pre, m0, n0, tn_cur, wm, wn, l15, quad, tid, smem);
    }
    gA = gAn; gB = gBn;
  }
}


template <class Epi>
DEVINL void gemm256s_phase(const bfr* __restrict__ A, int lda, const bfr* __restrict__ Bt, int ldb, int N, int K,
                           const Epi& epi, char* smem, int bid, int nblk) {
  const int tid = otid(), lane = tid & 63, wave = tid >> 6;
  const int wm = wave >> 1, wn = wave & 1, l15 = lane & 15, quad = lane >> 4;
  const int tilesN = N >> 7;
  const int ntiles = (MTOK >> 8) * tilesN;
  const int nk = K >> 6;
  const int srow0 = wave * 8 + (lane >> 3);
  const int lc = (lane & 7) ^ ((srow0 >> 1) & 7);
  const int fsw = (l15 >> 1) & 7;
  char* const dst0 = smem + wave * 1024 + lane * 16;
#define TILE_DECODE3(t_, tm_, tn_) { const int xcd_ = (t_) & 7, u_ = (t_) >> 3; const int gs_ = 5 * tilesN; const int g_ = u_ / gs_, r_ = u_ - g_ * gs_; \
    tn_ = r_ / 5; tm_ = (g_ * 5 + (r_ - tn_ * 5)) * 8 + xcd_; }
  if (bid >= ntiles) return;
  int ptile = bid, pkt = 0;
  bool pvalid = true;
  int ptm, ptn;
  TILE_DECODE3(ptile, ptm, ptn)
  const bfr* pA = A + (size_t)((ptm << 8) + srow0) * lda + lc * 8;
  const bfr* pB = Bt + (size_t)((ptn << 7) + srow0) * ldb + lc * 8;
#define DMA_B3(buf_)                                                                                      \
  {                                                                                                       \
    _Pragma("unroll") for (int i = 0; i < 4; ++i)                                                         \
      __builtin_amdgcn_global_load_lds((const unsigned*)(pB + (size_t)(i * 32) * ldb + pkt * 64),         \
                                       (LDS3 unsigned*)(dst0 + 34816 + (buf_) * 16384 + i * 4096), 16, 0, 0); \
  }
#define DMA_A3()                                                                                          \
  {                                                                                                       \
    _Pragma("unroll") for (int i = 0; i < 8; ++i)                                                         \
      __builtin_amdgcn_global_load_lds((const unsigned*)(pA + (size_t)(i * 32) * lda + pkt * 64),         \
                                       (LDS3 unsigned*)(dst0 + i * 4096), 16, 0, 0);                      \
    if (++pkt == nk) {                                                                                    \
      pkt = 0; ptile += nblk;                                                                             \
      if (ptile < ntiles) {                                                                               \
        TILE_DECODE3(ptile, ptm, ptn)                                                                     \
        pA = A + (size_t)((ptm << 8) + srow0) * lda + lc * 8;                                             \
        pB = Bt + (size_t)((ptn << 7) + srow0) * ldb + lc * 8;                                            \
      } else pvalid = false;                                                                              \
    }                                                                                                     \
  }
  __syncthreads();
  DMA_B3(0)
  DMA_A3()
  bool deferred = false;
  int bbuf = 0;
  const char* cA = smem + (wm * 128 + l15) * 128;
  const char* cB0 = smem + 34816 + (wn * 64 + l15) * 128;
  for (int tile = bid; tile < ntiles; tile += nblk) {
    int tm, tn;
    TILE_DECODE3(tile, tm, tn)
    const int m0 = tm << 8, n0 = tn << 7;
    if (deferred) { DMA_A3() deferred = false; }
    f32x4 acc[8][4];
#pragma unroll
    for (int i = 0; i < 8; ++i)
#pragma unroll
      for (int j = 0; j < 4; ++j) acc[i][j] = f32x4{0.f, 0.f, 0.f, 0.f};
    for (int kt = 0; kt < nk; ++kt) {
      asm volatile("s_waitcnt vmcnt(0)\n\ts_barrier" ::: "memory");
      __builtin_amdgcn_s_setprio(3);
      const char* cB = cB0 + bbuf * 16384;
      const int co0 = (quad ^ fsw) * 16, co1 = ((4 + quad) ^ fsw) * 16;
      bf16x8 af[8], bfg[4];
#pragma unroll
      for (int i = 0; i < 4; ++i) bfg[i] = *(const bf16x8*)(cB + i * 2048 + co0);
#pragma unroll
      for (int i = 0; i < 8; ++i) af[i] = *(const bf16x8*)(cA + i * 2048 + co0);
      __builtin_amdgcn_sched_barrier(0);
      if (pvalid) DMA_B3(bbuf ^ 1)
      __builtin_amdgcn_s_setprio(0);
      __builtin_amdgcn_sched_barrier(0);
#pragma unroll
      for (int mt = 0; mt < 8; ++mt)
#pragma unroll
        for (int nt = 0; nt < 4; ++nt)
          acc[mt][nt] = __builtin_amdgcn_mfma_f32_16x16x32_bf16(bfg[nt], af[mt], acc[mt][nt], 0, 0, 0);
      __builtin_amdgcn_sched_barrier(0);
      __builtin_amdgcn_s_setprio(3);
#pragma unroll
      for (int i = 0; i < 4; ++i) bfg[i] = *(const bf16x8*)(cB + i * 2048 + co1);
#pragma unroll
      for (int i = 0; i < 8; ++i) af[i] = *(const bf16x8*)(cA + i * 2048 + co1);
      asm volatile("s_waitcnt lgkmcnt(0)\n\ts_barrier" ::: "memory");
      if (pvalid) {
        if (Epi::kLdsEpi && kt == nk - 1) deferred = true;
        else DMA_A3()
      }
      __builtin_amdgcn_s_setprio(0);
      bbuf ^= 1;
      __builtin_amdgcn_sched_barrier(0);
#pragma unroll
      for (int mt = 0; mt < 8; ++mt)
#pragma unroll
        for (int nt = 0; nt < 4; ++nt)
          acc[mt][nt] = __builtin_amdgcn_mfma_f32_16x16x32_bf16(bfg[nt], af[mt], acc[mt][nt], 0, 0, 0);
      __builtin_amdgcn_sched_barrier(0);
    }
    __builtin_amdgcn_s_setprio(3);
    {
      typename Epi::Pre pre = epi.pre(tn, tid);
      epi.tile256(acc, pre, m0, n0, tn, wm, wn, l15, quad, tid, smem);
    }
    if (Epi::kLdsEpi) lds_barrier();
    __builtin_amdgcn_s_setprio(0);
  }
  asm volatile("s_waitcnt vmcnt(0)" ::: "memory");
}

DEVINL void ffn_edge_phase(const float* __restrict__ EDGE, const float* __restrict__ wdw, bfr* __restrict__ ACT, int bid, int nblk) {
  const int gt = bid * 256 + otid(), nt = nblk * 256;
  for (int i = gt; i < 160 * 2 * 704; i += nt) {
    const int cg4 = i % 704, r2 = i / 704, side = r2 & 1, tm = r2 >> 1;
    const int m0 = tm << 7;
    int tl, Tlen; tok_pos(m0, tl, Tlen);
    if (side == 0 ? (tl == 0) : (tl + 128 == Tlen)) continue;
    const int ja = cg4 * 4;
    const int nb_ = ja >> 6, cc = ja & 63;
    const int ea = nb_ * 128 + cc, eb = ea + 64;
    const float* prev; const float* cur; const float* next;
    if (side == 0) {
      prev = EDGE + ((size_t)(tm - 1) * 4 + 3) * EDGE_LD; cur = EDGE + ((size_t)tm * 4 + 0) * EDGE_LD; next = EDGE + ((size_t)tm * 4 + 1) * EDGE_LD;
    } else {
      prev = EDGE + ((size_t)tm * 4 + 2) * EDGE_LD; cur = EDGE + ((size_t)tm * 4 + 3) * EDGE_LD; next = EDGE + ((size_t)(tm + 1) * 4 + 0) * EDGE_LD;
    }
    const f32x4 a = *(const f32x4*)(wdw + ja) * *(const f32x4*)(prev + ea) + *(const f32x4*)(wdw + 2 * DFF + ja) * *(const f32x4*)(cur + ea) +
                    *(const f32x4*)(wdw + 4 * DFF + ja) * *(const f32x4*)(next + ea);
    const f32x4 b = *(const f32x4*)(wdw + DFF + ja) * *(const f32x4*)(prev + eb) + *(const f32x4*)(wdw + 3 * DFF + ja) * *(const f32x4*)(cur + eb) +
                    *(const f32x4*)(wdw + 5 * DFF + ja) * *(const f32x4*)(next + eb);
    uint2 o;
    o.x = pk2(silu_f(a[0]) * b[0], silu_f(a[1]) * b[1]);
    o.y = pk2(silu_f(a[2]) * b[2], silu_f(a[3]) * b[3]);
    const int m = m0 + (side ? 127 : 0);
    *(uint2*)(ACT + (size_t)m * DFF + ja) = o;
  }
}

DEVINL int up_perm(int n0) {
  if (n0 < DFF) return (n0 >> 6) * 128;
  return ((n0 - DFF) >> 6) * 128 + 64;
}
DEVINL void conv_matrix(const float* __restrict__ src, int K, int N, bfr* __restrict__ dst, int perm,
                        char* smem, int bid, int nblk) {
  float* sT = (float*)smem;
  const int tid = otid();
  const int tilesN = N >> 6;
  const int ntiles = (K >> 6) * tilesN;
  const int r = tid >> 4, c4 = tid & 15;
  int t = bid;
  if (t >= ntiles) return;
  f32x4 v0, v1, v2, v3;
  {
    const int tk = t / tilesN, tn = t - tk * tilesN;
    const float* sp = src + (size_t)((tk << 6) + r) * N + (tn << 6) + c4 * 4;
    v0 = *(const f32x4*)(sp); v1 = *(const f32x4*)(sp + (size_t)16 * N);
    v2 = *(const f32x4*)(sp + (size_t)32 * N); v3 = *(const f32x4*)(sp + (size_t)48 * N);
  }
  for (; t < ntiles; t += nblk) {
    const int tk = t / tilesN, tn = t - tk * tilesN;
    const int k0 = tk << 6, n0 = tn << 6;
    __syncthreads();
    {
      float* d = sT + r * 65 + c4 * 4;
      d[0] = v0[0]; d[1] = v0[1]; d[2] = v0[2]; d[3] = v0[3];
      d[16 * 65 + 0] = v1[0]; d[16 * 65 + 1] = v1[1]; d[16 * 65 + 2] = v1[2]; d[16 * 65 + 3] = v1[3];
      d[32 * 65 + 0] = v2[0]; d[32 * 65 + 1] = v2[1]; d[32 * 65 + 2] = v2[2]; d[32 * 65 + 3] = v2[3];
      d[48 * 65 + 0] = v3[0]; d[48 * 65 + 1] = v3[1]; d[48 * 65 + 2] = v3[2]; d[48 * 65 + 3] = v3[3];
    }
    if (t + nblk < ntiles) {
      const int t2 = t + nblk;
      const int tk2 = t2 / tilesN, tn2 = t2 - tk2 * tilesN;
      const float* sp = src + (size_t)((tk2 << 6) + r) * N + (tn2 << 6) + c4 * 4;
      v0 = *(const f32x4*)(sp); v1 = *(const f32x4*)(sp + (size_t)16 * N);
      v2 = *(const f32x4*)(sp + (size_t)32 * N); v3 = *(const f32x4*)(sp + (size_t)48 * N);
    }
    __syncthreads();
    const int n = tid >> 2, kc = tid & 3;
    uint32_t w[8];
#pragma unroll
    for (int j = 0; j < 8; ++j)
      w[j] = pk2(sT[(kc * 16 + 2 * j) * 65 + n], sT[(kc * 16 + 2 * j + 1) * 65 + n]);
    const int nd = (perm ? up_perm(n0) : n0) + n;
    bfr* dp = dst + (size_t)nd * K + k0 + kc * 16;
    *(uint4*)dp = make_uint4(w[0], w[1], w[2], w[3]);
    *(uint4*)(dp + 8) = make_uint4(w[4], w[5], w[6], w[7]);
  }
}

DEVINL void phase0a(const Params& p, char* smem, int bid, int nblk) {
  const int tid = otid();
  float* sc = (float*)smem;
  float* modp = (float*)(p.ws + OFF_MODP);
  const float* cvec = p.in[3];
  const float* cctx = p.in[4];
  const float* ada_w = p.in[5];
  for (int job = bid; job < 384; job += nblk) {
    const int l = job / 96, r = job - l * 96, ks = r / 6, cgp = r - ks * 6;
    __syncthreads();
    for (int i = tid; i < 320; i += 256) {
      const int cond = i >> 6, kk = i & 63;
      const float v = cond == 0 ? cctx[ks * 64 + kk] : cvec[(cond - 1) * DM + ks * 64 + kk];
      sc[i] = silu_f(v);
    }
    __syncthreads();
    const int col = cgp * 1024 + tid * 4;
    const float* wp = ada_w + ((size_t)l * DM + ks * 64) * 6144 + col;
    float a[5][4];
#pragma unroll
    for (int c = 0; c < 5; ++c)
#pragma unroll
      for (int j = 0; j < 4; ++j) a[c][j] = 0.f;
#pragma unroll 8
    for (int kk = 0; kk < 64; ++kk) {
      const float4 w = *(const float4*)(wp + (size_t)kk * 6144);
#pragma unroll
      for (int c = 0; c < 5; ++c) {
        const float s = sc[c * 64 + kk];
        a[c][0] += s * w.x; a[c][1] += s * w.y; a[c][2] += s * w.z; a[c][3] += s * w.w;
      }
    }
#pragma unroll
    for (int c = 0; c < 5; ++c)
      *(float4*)(modp + ((size_t)(ks * 4 + l) * 5 + c) * 6144 + col) = make_float4(a[c][0], a[c][1], a[c][2], a[c][3]);
  }
  const int gt = bid * 256 + tid, nt = nblk * 256;
  {
    const float* lb = p.in[20];
    float* lbs = (float*)(p.ws + OFF_LBS);
    for (int i = gt; i < 2048; i += nt) {
      const float v0 = lb[i], v1 = lb[2048 + i], v2 = lb[4096 + i], v3 = lb[6144 + i];
      const float mx = fmaxf(fmaxf(v0, v1), fmaxf(v2, v3));
      const float e0 = expf(v0 - mx), e1 = expf(v1 - mx), e2 = expf(v2 - mx), e3 = expf(v3 - mx);
      lbs[i] = (e1 + e2 + e3) / (e0 + e1 + e2 + e3);
    }
  }
  float* X = p.out;
  {
    const float4* xp = (const float4*)p.in[0];
    float4* xo = (float4*)X;
    for (int i = gt; i < NPROMPT * DM / 4; i += nt) xo[i] = xp[i];
    const float* xs = p.in[1];
    for (int i = gt; i < 4096 * 256; i += nt) {
      const int t = i >> 8, c = (i & 255) * 4;
      const int part = c >> 8;
      const float pos = (float)((part < 2) ? (t >> 6) : (t & 63));
      float pe[4];
#pragma unroll
      for (int j = 0; j < 4; ++j) {
        const int jj = (c + j) & 255;
        const float freq = expf((-9.210340371976184f * (float)jj) / 256.0f);
        const float arg = pos * freq;
        pe[j] = (part & 1) ? cosf(arg) : sinf(arg);
      }
#pragma unroll
      for (int b = 0; b < 4; ++b) {
        const size_t off = ((size_t)b * 4096 + t) * DM + c;
        float4 v = *(const float4*)(xs + off);
        v.x += pe[0]; v.y += pe[1]; v.z += pe[2]; v.w += pe[3];
        *(float4*)(X + (size_t)NPROMPT * DM + off) = v;
      }
    }
  }
}

DEVINL void phase0b(const Params& p, int bid, int nblk) {
  const int gt = bid * 256 + otid(), nt = nblk * 256;
  const float* modp = (const float*)(p.ws + OFF_MODP);
  float* mod = (float*)(p.ws + OFF_MOD);
  const float* ada_b = p.in[6];
  for (int i = gt; i < 4 * 5 * 6144; i += nt) {
    const int l = i / 30720, col = i % 6144;
    float s = ada_b[l * 6144 + col];
#pragma unroll
    for (int ks = 0; ks < 16; ++ks) s += modp[(size_t)ks * 122880 + i];
    mod[i] = s;
  }
}

DEVINL void norm_phase(const float* __restrict__ X, const float* __restrict__ g, const float* __restrict__ modl,
                       int shift_off, int scale_off, bfr* __restrict__ H, int bid, int nblk) {
  const int tid = otid(); const int lane = tid & 63;
  const int gw = bid * 4 + (tid >> 6), nw = nblk * 4;
  int row = gw;
  if (row >= MTOK) return;
  f32x4 x0, x1, x2, x3;
  {
    const float* xr = X + (size_t)row * DM + lane * 4;
    x0 = *(const f32x4*)(xr); x1 = *(const f32x4*)(xr + 256); x2 = *(const f32x4*)(xr + 512); x3 = *(const f32x4*)(xr + 768);
  }
  for (; row < MTOK; row += nw) {
    const f32x4 c0 = x0, c1 = x1, c2 = x2, c3 = x3;
    if (row + nw < MTOK) {
      const float* xr = X + (size_t)(row + nw) * DM + lane * 4;
      x0 = *(const f32x4*)(xr); x1 = *(const f32x4*)(xr + 256); x2 = *(const f32x4*)(xr + 512); x3 = *(const f32x4*)(xr + 768);
    }
    float ss = 0.f;
#pragma unroll
    for (int j = 0; j < 4; ++j) ss += c0[j] * c0[j] + c1[j] * c1[j] + c2[j] * c2[j] + c3[j] * c3[j];
    ss = wave_sum(ss, lane);
    const float rstd = rsqrtf(ss * (1.f / DM) + EPS);
    const float* mc = modl + cond_of(row) * 6144;
#pragma unroll
    for (int i = 0; i < 4; ++i) {
      const f32x4 xv = (i == 0) ? c0 : (i == 1) ? c1 : (i == 2) ? c2 : c3;
      const int c = i * 256 + lane * 4;
      const float4 gg = *(const float4*)(g + c);
      const float4 sh = *(const float4*)(mc + shift_off + c);
      const float4 sc = *(const float4*)(mc + scale_off + c);
      const float h0 = xv[0] * rstd * gg.x * (1.f + sc.x) + sh.x;
      const float h1 = xv[1] * rstd * gg.y * (1.f + sc.y) + sh.y;
      const float h2 = xv[2] * rstd * gg.z * (1.f + sc.z) + sh.z;
      const float h3 = xv[3] * rstd * gg.w * (1.f + sc.w) + sh.w;
      uint2 o; o.x = pk2(h0, h1); o.y = pk2(h2, h3);
      *(uint2*)(H + (size_t)row * DM + c) = o;
    }
  }
}

DEVINL void final_norm_phase(float* X, const float* __restrict__ g, int bid, int nblk) {
  const int tid = otid(); const int lane = tid & 63;
  const int gw = bid * 4 + (tid >> 6), nw = nblk * 4;
  for (int row = gw; row < MTOK; row += nw) {
    float* xr = X + (size_t)row * DM;
    float4 x[4];
    float ss = 0.f;
#pragma unroll
    for (int i = 0; i < 4; ++i) {
      x[i] = *(const float4*)(xr + i * 256 + lane * 4);
      ss += x[i].x * x[i].x + x[i].y * x[i].y + x[i].z * x[i].z + x[i].w * x[i].w;
    }
    ss = wave_sum(ss, lane);
    const float rstd = rsqrtf(ss * (1.f / DM) + EPS);
#pragma unroll
    for (int i = 0; i < 4; ++i) {
      const int c = i * 256 + lane * 4;
      const float4 gg = *(const float4*)(g + c);
      float4 o;
      o.x = x[i].x * rstd * gg.x; o.y = x[i].y * rstd * gg.y; o.z = x[i].z * rstd * gg.z; o.w = x[i].w * rstd * gg.w;
      *(float4*)(xr + c) = o;
    }
  }
}

DEVINL void shortconv_ew_phase(const bfr* __restrict__ G, const float* __restrict__ wdw, bfr* __restrict__ U, int bid, int nblk) {
  const int gt = bid * 256 + otid(), nt = nblk * 256;
  for (int i = gt; i < MTOK * 128; i += nt) {
    const int m = i >> 7, c = (i & 127) * 8;
    int tl, T; tok_pos(m, tl, T);
    const bfr* gr = G + (size_t)m * 3072;
    const uint4 bg = *(const uint4*)(gr + c);
    float accv[8];
#pragma unroll
    for (int j = 0; j < 8; ++j) accv[j] = 0.f;
#pragma unroll
    for (int tap = 0; tap < 3; ++tap) {
      const int d = tap - 1;
      if ((d < 0 && tl == 0) || (d > 0 && tl == T - 1)) continue;
      const bfr* nr = gr + (ptrdiff_t)d * 3072;
      const uint4 cgv = *(const uint4*)(nr + 1024 + c);
      const uint4 xhv = *(const uint4*)(nr + 2048 + c);
      const float4 w0 = *(const float4*)(wdw + tap * DM + c);
      const float4 w1 = *(const float4*)(wdw + tap * DM + c + 4);
      accv[0] += w0.x * bflo(cgv.x) * bflo(xhv.x); accv[1] += w0.y * bfhi(cgv.x) * bfhi(xhv.x);
      accv[2] += w0.z * bflo(cgv.y) * bflo(xhv.y); accv[3] += w0.w * bfhi(cgv.y) * bfhi(xhv.y);
      accv[4] += w1.x * bflo(cgv.z) * bflo(xhv.z); accv[5] += w1.y * bfhi(cgv.z) * bfhi(xhv.z);
      accv[6] += w1.z * bflo(cgv.w) * bflo(xhv.w); accv[7] += w1.w * bfhi(cgv.w) * bfhi(xhv.w);
    }
    uint4 o;
    o.x = pk2(bflo(bg.x) * accv[0], bfhi(bg.x) * accv[1]);
    o.y = pk2(bflo(bg.y) * accv[2], bfhi(bg.y) * accv[3]);
    o.z = pk2(bflo(bg.z) * accv[4], bfhi(bg.z) * accv[5]);
    o.w = pk2(bflo(bg.w) * accv[6], bfhi(bg.w) * accv[7]);
    *(uint4*)(U + (size_t)m * DM + c) = o;
  }
}

DEVINL void pool_ew_phase(const bfr* __restrict__ H, bfr* __restrict__ P, int bid, int nblk) {
  const int gt = bid * 256 + otid(), nt = nblk * 256;
  for (int i = gt; i < MTOK * 128; i += nt) {
    const int m = i >> 7, ch = i & 127, c = ch * 8;
    int tl, T; tok_pos(m, tl, T);
    const int hw = 1 << (ch >> 5);
    const int lo = max(tl - hw, 0), hi = min(tl + hw, T);
    float s[8];
#pragma unroll
    for (int j = 0; j < 8; ++j) s[j] = 0.f;
    const bfr* base = H + (size_t)(m - tl) * DM + c;
    uint4 wv[16];
#pragma unroll
    for (int j = 0; j < 16; ++j) {
      const int q = tl - hw + j;
      const bool ok = (j < 2 * hw) && (q >= 0) && (q < T);
      wv[j] = ok ? *(const uint4*)(base + (size_t)q * DM) : make_uint4(0u, 0u, 0u, 0u);
    }
#pragma unroll
    for (int j = 0; j < 16; ++j) {
      const uint4 v = wv[j];
      s[0] += bflo(v.x); s[1] += bfhi(v.x); s[2] += bflo(v.y); s[3] += bfhi(v.y);
      s[4] += bflo(v.z); s[5] += bfhi(v.z); s[6] += bflo(v.w); s[7] += bfhi(v.w);
    }
    const float inv = 1.f / (float)(hi - lo);
    const uint4 v = *(const uint4*)(base + (size_t)tl * DM);
    uint4 o;
    o.x = pk2(s[0] * inv - bflo(v.x), s[1] * inv - bfhi(v.x));
    o.y = pk2(s[2] * inv - bflo(v.y), s[3] * inv - bfhi(v.y));
    o.z = pk2(s[4] * inv - bflo(v.z), s[5] * inv - bfhi(v.z));
    o.w = pk2(s[6] * inv - bflo(v.w), s[7] * inv - bfhi(v.w));
    *(uint4*)(P + (size_t)m * DM + c) = o;
  }
}

DEVINL void sgu_norm_phase(bfr* UV, const float* __restrict__ g, int bid, int nblk) {
  const int tid = otid(); const int lane = tid & 63;
  const int gw = bid * 4 + (tid >> 6), nw = nblk * 4;
  for (int row = gw; row < MTOK; row += nw) {
    bfr* vr = UV + (size_t)row * 2048 + 1024;
    float x[4][4];
    float ss = 0.f;
#pragma unroll
    for (int i = 0; i < 4; ++i) {
      const uint2 v = *(const uint2*)(vr + i * 256 + lane * 4);
      x[i][0] = bflo(v.x); x[i][1] = bfhi(v.x); x[i][2] = bflo(v.y); x[i][3] = bfhi(v.y);
      ss += x[i][0] * x[i][0] + x[i][1] * x[i][1] + x[i][2] * x[i][2] + x[i][3] * x[i][3];
    }
    ss = wave_sum(ss, lane);
    const float rstd = rsqrtf(ss * (1.f / DM) + EPS);
#pragma unroll
    for (int i = 0; i < 4; ++i) {
      const int c = i * 256 + lane * 4;
      const float4 gg = *(const float4*)(g + c);
      uint2 o;
      o.x = pk2(x[i][0] * rstd * gg.x, x[i][1] * rstd * gg.y);
      o.y = pk2(x[i][2] * rstd * gg.z, x[i][3] * rstd * gg.w);
      *(uint2*)(vr + c) = o;
    }
  }
}

DEVINL void sgu_spatial_phase(bfr* UV, const float* __restrict__ ws_, const float* __restrict__ bs_, char* smem, int bid, int nblk) {
  bfr* sV = (bfr*)smem;
  bfr* sW = sV + 128 * 136;
  const int tid = otid(), lane = tid & 63, wave = tid >> 6, l15 = lane & 15, quad = lane >> 4;
  for (int item = bid; item < 160 * 8; item += nblk) {
    const int chunk = item >> 3, g = item & 7;
    __syncthreads();
    const float* wg = ws_ + (size_t)g * 16384;
#pragma unroll 4
    for (int i = 0; i < 16; ++i) {
      const int idx = tid + 256 * i;
      const int row = idx >> 5, chn = idx & 31;
      const float4 v = *(const float4*)(wg + row * 128 + chn * 4);
      uint2 o; o.x = pk2(v.x, v.y); o.y = pk2(v.z, v.w);
      *(uint2*)(sW + row * 136 + chn * 4) = o;
    }
#pragma unroll 2
    for (int i = 0; i < 8; ++i) {
      const int idx = tid + 256 * i;
      const int q = idx >> 4, chn = idx & 15;
      const uint4 v = *(const uint4*)(UV + (size_t)(chunk * 128 + q) * 2048 + 1024 + g * 128 + chn * 8);
      bfr* d = sV + (chn * 8) * 136 + q;
      d[0 * 136] = (bfr)(v.x & 0xffff); d[1 * 136] = (bfr)(v.x >> 16);
      d[2 * 136] = (bfr)(v.y & 0xffff); d[3 * 136] = (bfr)(v.y >> 16);
      d[4 * 136] = (bfr)(v.z & 0xffff); d[5 * 136] = (bfr)(v.z >> 16);
      d[6 * 136] = (bfr)(v.w & 0xffff); d[7 * 136] = (bfr)(v.w >> 16);
    }
    __syncthreads();
    f32x4 acc[8][2];
#pragma unroll
    for (int i = 0; i < 8; ++i) { acc[i][0] = f32x4{0.f, 0.f, 0.f, 0.f}; acc[i][1] = f32x4{0.f, 0.f, 0.f, 0.f}; }
#pragma unroll
    for (int kk = 0; kk < 4; ++kk) {
      bf16x8 bw[2];
#pragma unroll
      for (int pt = 0; pt < 2; ++pt) bw[pt] = *(const bf16x8*)(sW + (wave * 32 + pt * 16 + l15) * 136 + kk * 32 + quad * 8);
#pragma unroll
      for (int ct = 0; ct < 8; ++ct) {
        const bf16x8 av = *(const bf16x8*)(sV + (ct * 16 + l15) * 136 + kk * 32 + quad * 8);
#pragma unroll
        for (int pt = 0; pt < 2; ++pt)
          acc[ct][pt] = __builtin_amdgcn_mfma_f32_16x16x32_bf16(av, bw[pt], acc[ct][pt], 0, 0, 0);
      }
    }
#pragma unroll
    for (int pt = 0; pt < 2; ++pt) {
      const int pp = wave * 32 + pt * 16 + l15;
      const float bias = bs_[g * 128 + pp];
      bfr* ur = UV + (size_t)(chunk * 128 + pp) * 2048 + g * 128 + quad * 4;
#pragma unroll
      for (int ct = 0; ct < 8; ++ct) {
        const uint2 u = *(const uint2*)(ur + ct * 16);
        uint2 o;
        o.x = pk2(bflo(u.x) * (acc[ct][pt][0] + bias), bfhi(u.x) * (acc[ct][pt][1] + bias));
        o.y = pk2(bflo(u.y) * (acc[ct][pt][2] + bias), bfhi(u.y) * (acc[ct][pt][3] + bias));
        *(uint2*)(ur + ct * 16) = o;
      }
    }
  }
}

DEVINL void hgrn_scan_phase(const Params& p, char* smem, int bid, int nblk, const int mode) {
  bfr* sQe = (bfr*)smem;
  bfr* sKe = sQe + 32 * 136;
  bfr* sKeT = sKe + 32 * 136;
  bfr* sVT = sKeT + 128 * 40;
  bfr* sP = sVT + 64 * 40;
  bfr* sST = sP + 32 * 40;
  float* sLast = (float*)(sST + 64 * 136);
  float* sTot = sLast + 128;
  const int tid = otid(), lane = tid & 63, wave = tid >> 6, l15 = lane & 15, quad = lane >> 4;
  const int cp = lane, qt = wave, i0 = qt * 8;
  const bfr* QZ = (const bfr*)(p.ws + OFF_BIG);
  bfr* Of = (bfr*)(p.ws + OFF_H);
  bfr* Ob = (bfr*)(p.ws + OFF_BIG + 209715200ull);
  const float* lbs = (const float*)(p.ws + OFF_LBS);
  const float* state_rec = p.in[2];
  float* out_state = p.out + (size_t)MTOK * DM;

  float* SLOC = (float*)(p.ws + OFF_BIG + 251658240ull);
  float* DLOC = (float*)(p.ws + OFF_BIG + 251658240ull + 33554432ull);
  const int nitems = mode ? 1536 : 896;
  for (int item = bid; item < nitems; item += nblk) {
    const int eh = item & 1, dir = (item >> 1) & 1, h = (item >> 2) & 7;
    int base, T, nchunks, pos0, slot, seq;
    bool is_prompt = false;
    if (!mode) {
      const int r = item >> 5, seqb = r / 7, j = r - seqb * 7;
      seq = 16 + seqb; base = NPROMPT + seqb * 4096; T = 4096; nchunks = 16; pos0 = j * 512;
      slot = ((seqb * 8 + j) * 8 + h) * 2 + dir;
    } else if (item < 1024) {
      const int r = item >> 5, seqb = r >> 3, j = r & 7;
      seq = 16 + seqb; base = NPROMPT + seqb * 4096; T = 4096; nchunks = 16; pos0 = j * 512;
      slot = ((seqb * 8 + j) * 8 + h) * 2 + dir;
    } else {
      seq = (item - 1024) >> 5; base = seq * 256; T = 256; nchunks = 8; pos0 = 0; slot = 0;
      is_prompt = true;
    }
    bfr* Od = dir ? Ob : Of;
    const float lbv0 = lbs[dir * 1024 + h * 128 + 2 * cp], lbv1 = lbs[dir * 1024 + h * 128 + 2 * cp + 1];
    const int eloc = wave * 16 + l15;
    const int eglob = eh * 64 + eloc;

    f32x4 S[8];
    if (is_prompt || !mode) {
#pragma unroll
      for (int dt = 0; dt < 8; ++dt) S[dt] = f32x4{0.f, 0.f, 0.f, 0.f};
    } else {
      const float* s0 = SLOC + (size_t)slot * 16384;
#pragma unroll
      for (int dt = 0; dt < 8; ++dt)
#pragma unroll
        for (int j = 0; j < 4; ++j) S[dt][j] = s0[(dt * 16 + quad * 4 + j) * 128 + eglob];
    }
    float cum0 = 1.f, cum1 = 1.f;
    __syncthreads();
#pragma unroll
    for (int dt = 0; dt < 8; ++dt) {
      uint2 o; o.x = pk2(S[dt][0], S[dt][1]); o.y = pk2(S[dt][2], S[dt][3]);
      *(uint2*)(sST + eloc * 136 + dt * 16 + quad * 4) = o;
    }

    const unsigned qoff2 = h * 64 + cp, zoff2 = (1 + dir) * 512 + h * 64 + cp;
    const unsigned voff2 = 1536 + h * 64 + eh * 32 + (cp & 31);
    const uint32_t* __restrict__ QZ32 = (const uint32_t*)QZ;
    uint32_t rq[8], rz[8], rv[8];
#pragma unroll
    for (int ii = 0; ii < 8; ++ii) {
      const int pos = pos0 + i0 + ii;
      const unsigned tok = dir ? base + T - 1 - pos : base + pos;
      const unsigned ri = tok * 2560u;
      rq[ii] = QZ32[ri + qoff2]; rz[ii] = QZ32[ri + zoff2]; rv[ii] = QZ32[ri + voff2];
    }

    for (int c = 0; c < nchunks; ++c) {
      float pc0[8], pc1[8], kv0[8], kv1[8];
      float run0 = 1.f, run1 = 1.f;
#pragma unroll
      for (int ii = 0; ii < 8; ++ii) {
        const float z0 = bflo(rz[ii]), z1 = bfhi(rz[ii]);
        const float f0 = lbv0 + (1.f - lbv0) * frcp(1.f + __expf(-z0));
        const float f1 = lbv1 + (1.f - lbv1) * frcp(1.f + __expf(-z1));
        run0 *= f0; run1 *= f1;
        pc0[ii] = run0; pc1[ii] = run1;
        kv0[ii] = 1.f - f0; kv1[ii] = 1.f - f1;
      }
      *(float2*)(sTot + qt * 128 + 2 * cp) = make_float2(run0, run1);
      __syncthreads();
      {
        float off0 = 1.f, off1 = 1.f, tot0 = 1.f, tot1 = 1.f;
#pragma unroll
        for (int q = 0; q < 4; ++q) {
          const float2 t = *(const float2*)(sTot + q * 128 + 2 * cp);
          if (q < qt) { off0 *= t.x; off1 *= t.y; }
          tot0 *= t.x; tot1 *= t.y;
        }
        uint32_t wk0[4], wk1[4], wv0[4], wv1[4];
#pragma unroll
        for (int ii = 0; ii < 8; ii += 2) {
          uint32_t kp[2];
#pragma unroll
          for (int u = 0; u < 2; ++u) {
            const float e0 = pc0[ii + u] * off0, e1 = pc1[ii + u] * off1;
            kp[u] = pk2(kv0[ii + u] * frcp(e0), kv1[ii + u] * frcp(e1));
            *(uint32_t*)(sKe + (i0 + ii + u) * 136 + 2 * cp) = kp[u];
            if (mode) *(uint32_t*)(sQe + (i0 + ii + u) * 136 + 2 * cp) = pk2(bflo(rq[ii + u]) * e0, bfhi(rq[ii + u]) * e1);
          }
          wk0[ii >> 1] = (kp[0] & 0xffffu) | (kp[1] << 16);
          wk1[ii >> 1] = (kp[0] >> 16) | (kp[1] & 0xffff0000u);
          wv0[ii >> 1] = (rv[ii] & 0xffffu) | (rv[ii + 1] << 16);
          wv1[ii >> 1] = (rv[ii] >> 16) | (rv[ii + 1] & 0xffff0000u);
        }
        *(u32x4*)(sKeT + (2 * cp) * 40 + i0) = u32x4{wk0[0], wk0[1], wk0[2], wk0[3]};
        *(u32x4*)(sKeT + (2 * cp + 1) * 40 + i0) = u32x4{wk1[0], wk1[1], wk1[2], wk1[3]};
        if (cp < 32) {
          *(u32x4*)(sVT + (2 * cp) * 40 + i0) = u32x4{wv0[0], wv0[1], wv0[2], wv0[3]};
          *(u32x4*)(sVT + (2 * cp + 1) * 40 + i0) = u32x4{wv1[0], wv1[1], wv1[2], wv1[3]};
        }
        if (qt == 0) *(float2*)(sLast + 2 * cp) = make_float2(tot0, tot1);
        cum0 *= tot0; cum1 *= tot1;
      }
      if (c + 1 < nchunks) {
#pragma unroll
        for (int ii = 0; ii < 8; ++ii) {
          const int pos = pos0 + (c + 1) * 32 + i0 + ii;
          const unsigned tok = dir ? base + T - 1 - pos : base + pos;
          const unsigned ri = tok * 2560u;
          rq[ii] = QZ32[ri + qoff2]; rz[ii] = QZ32[ri + zoff2]; rv[ii] = QZ32[ri + voff2];
        }
      }
      __syncthreads();
      if (mode) {
        const int ti = wave >> 1, si = wave & 1;
        f32x4 sc = f32x4{0.f, 0.f, 0.f, 0.f};
        if (si <= ti) {
#pragma unroll
          for (int kk = 0; kk < 4; ++kk) {
            const bf16x8 a = *(const bf16x8*)(sQe + (ti * 16 + l15) * 136 + kk * 32 + quad * 8);
            const bf16x8 b = *(const bf16x8*)(sKe + (si * 16 + l15) * 136 + kk * 32 + quad * 8);
            sc = __builtin_amdgcn_mfma_f32_16x16x32_bf16(a, b, sc, 0, 0, 0);
          }
        }
#pragma unroll
        for (int j = 0; j < 4; ++j) {
          const int t = ti * 16 + quad * 4 + j, s2 = si * 16 + l15;
          sP[t * 40 + s2] = (s2 <= t) ? f2bf(sc[j]) : (bfr)0;
        }
      }
      f32x4 oacc[2];
      oacc[0] = f32x4{0.f, 0.f, 0.f, 0.f}; oacc[1] = f32x4{0.f, 0.f, 0.f, 0.f};
      if (mode) {
#pragma unroll
      for (int kk = 0; kk < 4; ++kk) {
        const bf16x8 sb = *(const bf16x8*)(sST + eloc * 136 + kk * 32 + quad * 8);
#pragma unroll
        for (int tt = 0; tt < 2; ++tt) {
          const bf16x8 qa = *(const bf16x8*)(sQe + (tt * 16 + l15) * 136 + kk * 32 + quad * 8);
          oacc[tt] = __builtin_amdgcn_mfma_f32_16x16x32_bf16(sb, qa, oacc[tt], 0, 0, 0);
        }
      }
      }
      __syncthreads();
      {
        const bf16x8 vb = *(const bf16x8*)(sVT + eloc * 40 + quad * 8);
        if (mode) {
#pragma unroll
        for (int tt = 0; tt < 2; ++tt) {
          const bf16x8 pb = *(const bf16x8*)(sP + (tt * 16 + l15) * 40 + quad * 8);
          oacc[tt] = __builtin_amdgcn_mfma_f32_16x16x32_bf16(vb, pb, oacc[tt], 0, 0, 0);
          const int pos = pos0 + c * 32 + tt * 16 + l15;
          const int tok = dir ? base + T - 1 - pos : base + pos;
          uint2 o; o.x = pk2(oacc[tt][0], oacc[tt][1]); o.y = pk2(oacc[tt][2], oacc[tt][3]);
          *(uint2*)(Od + (size_t)tok * DM + h * 128 + eh * 64 + wave * 16 + quad * 4) = o;
        }
        }
#pragma unroll
        for (int dt = 0; dt < 8; ++dt) {
          const bf16x8 ka = *(const bf16x8*)(sKeT + (dt * 16 + l15) * 40 + quad * 8);
          const float4 dl = *(const float4*)(sLast + dt * 16 + quad * 4);
          f32x4 sn = __builtin_amdgcn_mfma_f32_16x16x32_bf16(ka, vb, S[dt], 0, 0, 0);
          sn[0] *= dl.x; sn[1] *= dl.y; sn[2] *= dl.z; sn[3] *= dl.w;
          S[dt] = sn;
          uint2 o; o.x = pk2(sn[0], sn[1]); o.y = pk2(sn[2], sn[3]);
          *(uint2*)(sST + eloc * 136 + dt * 16 + quad * 4) = o;
        }
      }
    }
    if (is_prompt || !mode) {
      float* so = is_prompt ? out_state + ((size_t)(seq * 2 + dir) * 8 + h) * 16384 : SLOC + (size_t)slot * 16384;
#pragma unroll
      for (int dt = 0; dt < 8; ++dt)
#pragma unroll
        for (int j = 0; j < 4; ++j) so[(dt * 16 + quad * 4 + j) * 128 + eglob] = S[dt][j];
      if (!mode && eh == 0 && qt == 0) *(float2*)(DLOC + slot * 128 + 2 * cp) = make_float2(cum0, cum1);
    }
  }
}

DEVINL void hgrn_combine_phase(const Params& p, int bid, int nblk) {
  const int gt = bid * 256 + otid(), nt = nblk * 256;
  float* SLOC = (float*)(p.ws + OFF_BIG + 251658240ull);
  const float* DLOC = (const float*)(p.ws + OFF_BIG + 251658240ull + 33554432ull);
  const float* state_rec = p.in[2];
  for (int idx = gt; idx < 4 * 8 * 2 * 16384; idx += nt) {
    const int de = idx & 16383, r = idx >> 14;
    const int dir = r & 1, h = (r >> 1) & 7, seqb = r >> 4;
    const int d = de >> 7;
    float prev = state_rec[((size_t)(seqb * 2 + dir) * 8 + h) * 16384 + de];
#pragma unroll
    for (int j = 0; j < 8; ++j) {
      const int slot = ((seqb * 8 + j) * 8 + h) * 2 + dir;
      float* ptr = SLOC + (size_t)slot * 16384 + de;
      const float a = (j < 7) ? *ptr : 0.f;
      *ptr = prev;
      if (j < 7) prev = DLOC[slot * 128 + d] * prev + a;
    }
  }
}

DEVINL void hgrn_gate_phase(const Params& p, const float* __restrict__ ng, int bid, int nblk) {
  const int tid = otid(); const int lane = tid & 63;
  const int gw = bid * 4 + (tid >> 6), nw = nblk * 4;
  bfr* Of = (bfr*)(p.ws + OFF_H);
  const bfr* Ob = (const bfr*)(p.ws + OFF_BIG + 209715200ull);
  const bfr* QZ = (const bfr*)(p.ws + OFF_BIG);
  for (int row = gw; row < MTOK; row += nw) {
#pragma unroll
    for (int seg = 0; seg < 4; ++seg) {
      const int c = seg * 256 + lane * 4;
      const uint2 a = *(const uint2*)(Of + (size_t)row * DM + c);
      const uint2 b = *(const uint2*)(Ob + (size_t)row * DM + c);
      const uint2 gq = *(const uint2*)(QZ + (size_t)row * 5120 + 4096 + c);
      const float o0 = bflo(a.x) + bflo(b.x), o1 = bfhi(a.x) + bfhi(b.x), o2 = bflo(a.y) + bflo(b.y), o3 = bfhi(a.y) + bfhi(b.y);
      float ss = o0 * o0 + o1 * o1 + o2 * o2 + o3 * o3;
#pragma unroll
      for (int o = 16; o > 0; o >>= 1) ss += shx(ss, o, lane);
      const float rstd = rsqrtf(ss * (1.f / 128.f) + EPS);
      const float4 gg = *(const float4*)(ng + c);
      uint2 o;
      o.x = pk2(o0 * rstd * gg.x * silu_f(bflo(gq.x)), o1 * rstd * gg.y * silu_f(bfhi(gq.x)));
      o.y = pk2(o2 * rstd * gg.z * silu_f(bflo(gq.y)), o3 * rstd * gg.w * silu_f(bfhi(gq.y)));
      *(uint2*)(Of + (size_t)row * DM + c) = o;
    }
  }
}

DEVINL void ffn_act_phase(const bfr* __restrict__ UP, const float* __restrict__ wdw, int hf, bfr* __restrict__ ACT, int bid, int nblk) {
  const int gt = bid * 256 + otid(), nt = nblk * 256;
  for (int i = gt; i < MTOK * 176; i += nt) {
    const int m = i / 176, j = (i - m * 176) * 8;
    int tl, T; tok_pos(m, tl, T);
    const bfr* ur = UP + (size_t)m * DFF;
    float a[8], b[8];
#pragma unroll
    for (int q = 0; q < 8; ++q) { a[q] = 0.f; b[q] = 0.f; }
#pragma unroll
    for (int tap = 0; tap < 3; ++tap) {
      const int d = tap - 1;
      if ((d < 0 && tl == 0) || (d > 0 && tl == T - 1)) continue;
      const bfr* nr = ur + (ptrdiff_t)d * DFF;
      const uint4 av = *(const uint4*)(nr + j);
      const uint4 bv = *(const uint4*)(nr + HALF_FF + j);
      const float* wa = wdw + tap * (2 * DFF) + hf * HALF_FF + j;
      const float* wb = wdw + tap * (2 * DFF) + DFF + hf * HALF_FF + j;
      const float4 wa0 = *(const float4*)wa, wa1 = *(const float4*)(wa + 4);
      const float4 wb0 = *(const float4*)wb, wb1 = *(const float4*)(wb + 4);
      a[0] += wa0.x * bflo(av.x); a[1] += wa0.y * bfhi(av.x); a[2] += wa0.z * bflo(av.y); a[3] += wa0.w * bfhi(av.y);
      a[4] += wa1.x * bflo(av.z); a[5] += wa1.y * bfhi(av.z); a[6] += wa1.z * bflo(av.w); a[7] += wa1.w * bfhi(av.w);
      b[0] += wb0.x * bflo(bv.x); b[1] += wb0.y * bfhi(bv.x); b[2] += wb0.z * bflo(bv.y); b[3] += wb0.w * bfhi(bv.y);
      b[4] += wb1.x * bflo(bv.z); b[5] += wb1.y * bfhi(bv.z); b[6] += wb1.z * bflo(bv.w); b[7] += wb1.w * bfhi(bv.w);
    }
    uint4 o;
    o.x = pk2(silu_f(a[0]) * b[0], silu_f(a[1]) * b[1]);
    o.y = pk2(silu_f(a[2]) * b[2], silu_f(a[3]) * b[3]);
    o.z = pk2(silu_f(a[4]) * b[4], silu_f(a[5]) * b[5]);
    o.w = pk2(silu_f(a[6]) * b[6], silu_f(a[7]) * b[7]);
    *(uint4*)(ACT + (size_t)m * DFF + hf * HALF_FF + j) = o;
  }
}


#define XB_TMO      128
#define XB_XCNT(j)  (256  + 64 * (j))
#define XB_XSUB(j)  (1280 + 64 * (j))
#define XB_XGEN(j)  (2304 + 64 * (j))
#define XB_TOP      3328
#define XB_TOPGEN   3392
#define XCD_BAR_WORDS 3456
#define XB_SPIN_CAP (1u << 22)
#define LAS __attribute__((address_space(3)))
DEVINL unsigned xb_ld(unsigned* p) { return __hip_atomic_load(p, __ATOMIC_RELAXED, __HIP_MEMORY_SCOPE_AGENT); }
DEVINL unsigned xb_add(unsigned* p, unsigned v) { return __hip_atomic_fetch_add(p, v, __ATOMIC_RELAXED, __HIP_MEMORY_SCOPE_AGENT); }
DEVINL unsigned xb_xcc_id() { return (unsigned)__builtin_amdgcn_s_getreg((3 << 11) | 20) & 0xFu; }
#define XB_SPIN(cond, bar) do { unsigned _sp = 0; while (cond) { __builtin_amdgcn_s_sleep(1); \
    if ((++_sp & 255u) == 0u) { if (xb_ld(&(bar)[XB_TMO])) break; if (_sp > XB_SPIN_CAP) { atomicAdd(&(bar)[XB_TMO], 1u); break; } } } } while (0)
struct XcdBarrier { unsigned* bar; unsigned x; volatile LAS unsigned* st; };
DEVINL XcdBarrier xcd_barrier_post(unsigned* bar, volatile LAS unsigned* st) {
  XcdBarrier b; b.bar = bar; b.x = xb_xcc_id(); b.st = st;
  if (threadIdx.x == 0) (void)xb_add(&bar[XB_XCNT(b.x)], 1u);
  return b;
}
DEVINL void xcd_barrier_complete(unsigned* bar, unsigned x, unsigned& nloc, unsigned& nx) {
  const unsigned G = gridDim.x * gridDim.y * gridDim.z;
  unsigned sum, cnt, mine, sp = 0u;
  for (;;) {
    sum = 0u; cnt = 0u; mine = 0u;
#pragma unroll
    for (unsigned j = 0; j < 16; ++j) { const unsigned c = xb_ld(&bar[XB_XCNT(j)]); sum += c; cnt += (c > 0u) ? 1u : 0u; mine = (j == x) ? c : mine; }
    if (sum == G) break;
    __builtin_amdgcn_s_sleep(1);
    if ((++sp & 255u) == 0u) { if (xb_ld(&bar[XB_TMO])) break; if (sp > XB_SPIN_CAP) { atomicAdd(&bar[XB_TMO], 1u); break; } }
  }
  nloc = mine > 0u ? mine : 1u; nx = cnt > 0u ? cnt : 1u;
}
DEVINL void xcd_barrier(const XcdBarrier& b) {
  asm volatile("s_waitcnt vmcnt(0)" ::: "memory");
  __syncthreads();
  if (threadIdx.x == 0) {
    unsigned* bar = b.bar;
    unsigned bx = b.x;
    asm volatile("" : "+s"(bar), "+s"(bx));
    __builtin_amdgcn_s_waitcnt(0);
    unsigned nloc = b.st[0], nx = b.st[1];
    if (nloc == 0u) { xcd_barrier_complete(bar, bx, nloc, nx); b.st[0] = nloc; b.st[1] = nx; }
    const unsigned old = xb_add(&bar[XB_XSUB(bx)], 1u);
    const unsigned gen = old / nloc;
    if (old + 1u == (gen + 1u) * nloc) {
      __builtin_amdgcn_fence(__ATOMIC_RELEASE, "agent");
      asm volatile("s_waitcnt vmcnt(0)" ::: "memory");
      const unsigned og = xb_add(&bar[XB_TOP], 1u);
      const unsigned tg = og / nx;
      if (og + 1u == (tg + 1u) * nx) xb_add(&bar[XB_TOPGEN], 1u);
      else XB_SPIN(xb_ld(&bar[XB_TOPGEN]) == tg, bar);
      __builtin_amdgcn_fence(__ATOMIC_ACQUIRE, "agent");
      xb_add(&bar[XB_XGEN(bx)], 1u);
      asm volatile("s_waitcnt vmcnt(0)" ::: "memory");
    } else {
      XB_SPIN(xb_ld(&bar[XB_XGEN(bx)]) == gen, bar);
      __builtin_amdgcn_fence(__ATOMIC_ACQUIRE, "agent");
      asm volatile("s_waitcnt vmcnt(0)" ::: "memory");
    }
  }
  __syncthreads();
}

constexpr int SMEM_BYTES = 77824;

__global__ void __launch_bounds__(256, 2) mega_kernel(Params p) {
  __shared__ __attribute__((aligned(16))) char smem[SMEM_BYTES];
  cg::grid_group grid = cg::this_grid();
  __shared__ uint4 xb_words;
  if (threadIdx.x == 0) xb_words = make_uint4(0u, 0u, 0u, 0u);
  __syncthreads();
  XcdBarrier xb = xcd_barrier_post((unsigned*)(p.ws + OFF_BAR), (volatile LAS unsigned*)&xb_words);
  const int bid = blockIdx.x, nblk = gridDim.x;

  phase0a(p, smem, osg(bid), nblk);
  grid.sync();
  phase0b(p, osg(bid), nblk);
  xcd_barrier(xb);

  for (int layer = 0; layer < 4; ++layer) {
    Params q = p;
    {
      size_t oz = 0;
      asm volatile("" : "+s"(oz));
      q.ws = p.ws + oz;
      q.out = p.out + oz;
    }
    float* X = q.out;
    bfr* WB = (bfr*)(q.ws + OFF_WB);
    bfr* H = (bfr*)(q.ws + OFF_H);
    bfr* BIG = (bfr*)(q.ws + OFF_BIG);
    const float* MOD = (const float*)(q.ws + OFF_MOD);
    const float* modl = MOD + layer * 30720;
    if (layer == 0) {
      conv_matrix(q.in[9], 1024, 3072, WB + WB_IN, 0, smem, osg(bid), nblk);
      conv_matrix(q.in[11], 1024, 1024, WB + WB_OUT, 0, smem, osg(bid), nblk);
    } else if (layer == 1) {
      for (int g = 0; g < 4; ++g) conv_matrix(q.in[12] + g * 65536, 256, 256, WB + WB_IN + g * 65536, 0, smem, osg(bid), nblk);
    } else if (layer == 2) {
      conv_matrix(q.in[14], 1024, 2048, WB + WB_IN, 0, smem, osg(bid), nblk);
      conv_matrix(q.in[18], 1024, 1024, WB + WB_OUT, 0, smem, osg(bid), nblk);
    } else {
      conv_matrix(q.in[19], 1024, 5120, WB + WB_IN, 0, smem, osg(bid), nblk);
      conv_matrix(q.in[22], 1024, 1024, WB + WB_OUT, 0, smem, osg(bid), nblk);
    }
    conv_matrix(q.in[23] + (size_t)layer * 1024 * 5632, 1024, 5632, WB + WB_UP, 1, smem, osg(bid), nblk);
    conv_matrix(q.in[25] + (size_t)layer * DFF * 1024, DFF, 1024, WB + WB_DOWN, 0, smem, osg(bid), nblk);
    norm_phase(X, q.in[7] + (layer * 2 + 0) * DM, modl, 0, 1024, H, osg(bid), nblk);
    xcd_barrier(xb);

    if (layer == 0) {
      bfr* G = BIG;
      bfr* U = BIG + (size_t)MTOK * 3072;
      gemm256s_phase(H, DM, WB + WB_IN, 1024, 3072, 1024, EpiStore{G, 3072}, smem, osg(bid), nblk);
      xcd_barrier(xb);
      shortconv_ew_phase(G, q.in[10], U, osg(bid), nblk);
      xcd_barrier(xb);
      gemm_phase(U, DM, WB + WB_OUT, 1024, 1024, 1024, EpiResid{X, modl + 2048, nullptr, 0}, smem, osg(bid), nblk);
      xcd_barrier(xb);
    } else if (layer == 1) {
      bfr* P = BIG;
      pool_ew_phase(H, P, osg(bid), nblk);
      xcd_barrier(xb);
      for (int g = 0; g < 4; ++g)
        gemm_phase(P + g * 256, DM, WB + WB_IN + g * 65536, 256, 256, 256,
                   EpiResid{X, modl + 2048 + g * 256, q.in[13] + g * 256, g * 256}, smem, osg(bid), nblk);
      xcd_barrier(xb);
    } else if (layer == 2) {
      bfr* UV = BIG;
      gemm_phase(H, DM, WB + WB_IN, 1024, 2048, 1024, EpiGelu{UV, 2048}, smem, osg(bid), nblk);
      xcd_barrier(xb);
      sgu_norm_phase(UV, q.in[15], osg(bid), nblk);
      xcd_barrier(xb);
      sgu_spatial_phase(UV, q.in[16], q.in[17], smem, osg(bid), nblk);
      xcd_barrier(xb);
      gemm_phase(UV, 2048, WB + WB_OUT, 1024, 1024, 1024, EpiResid{X, modl + 2048, nullptr, 0}, smem, osg(bid), nblk);
      xcd_barrier(xb);
    } else {
      bfr* QZ = BIG;
      gemm256s_phase(H, DM, WB + WB_IN, 1024, 5120, 1024, EpiStore{QZ, 5120}, smem, osg(bid), nblk);
      xcd_barrier(xb);
      hgrn_scan_phase(q, smem, osg(bid), nblk, 0);
      xcd_barrier(xb);
      hgrn_combine_phase(q, osg(bid), nblk);
      xcd_barrier(xb);
      hgrn_scan_phase(q, smem, osg(bid), nblk, 1);
      xcd_barrier(xb);
      hgrn_gate_phase(q, q.in[21], osg(bid), nblk);
      xcd_barrier(xb);
      gemm_phase(H, DM, WB + WB_OUT, 1024, 1024, 1024, EpiResid{X, modl + 2048, nullptr, 0}, smem, osg(bid), nblk);
      xcd_barrier(xb);
    }

    norm_phase(X, q.in[7] + (layer * 2 + 1) * DM, modl, 3072, 4096, H, osg(bid), nblk);
    xcd_barrier(xb);
    bfr* ACT = BIG;
    float* EDGE = (float*)(q.ws + OFF_BIG + 115343360ull);
    const float* wdw = q.in[24] + (size_t)layer * 3 * 2 * DFF;
    gemm256s_phase(H, DM, WB + WB_UP, 1024, 2 * DFF, 1024, EpiFfnUp{ACT, EDGE, wdw}, smem, osg(bid), nblk);
    xcd_barrier(xb);
    ffn_edge_phase(EDGE, wdw, ACT, osg(bid), nblk);
    xcd_barrier(xb);
    gemm_phase(ACT, DFF, WB + WB_DOWN, DFF, 1024, DFF, EpiResid{X, modl + 5120, nullptr, 0}, smem, osg(bid), nblk);
    xcd_barrier(xb);
  }
  final_norm_phase(p.out, p.in[8], osg(bid), nblk);
}

extern "C" void kernel_launch(void* const* d_in, const int* in_sizes, int n_in, void* d_out, int out_size,
                              void* d_ws, size_t ws_size, hipStream_t stream) {
  static int grid_blocks = 0;
  if (!grid_blocks) {
    int dev = 0, cus = 0, per_cu = 0;
    hipGetDevice(&dev);
    hipDeviceGetAttribute(&cus, hipDeviceAttributeMultiprocessorCount, dev);
    hipOccupancyMaxActiveBlocksPerMultiprocessor(&per_cu, mega_kernel, 256, 0);
    if (per_cu > 2) per_cu = 2;
    if (per_cu < 1) per_cu = 1;
    grid_blocks = cus * per_cu;
  }
  if (ws_size < WS_NEED) { fprintf(stderr, "workspace too small: %zu < %zu\n", ws_size, (size_t)WS_NEED); return; }
  Params p{};
  for (int i = 0; i < 26; ++i) p.in[i] = (const float*)d_in[i];
  p.out = (float*)d_out;
  p.ws = (char*)d_ws;
  hipMemsetAsync((char*)d_ws + OFF_BAR, 0, XCD_BAR_WORDS * 4, stream);
  void* args[] = {&p};
  hipError_t e = hipLaunchCooperativeKernel((void*)mega_kernel, dim3(grid_blocks), dim3(256), args, 0, stream);
  if (e != hipSuccess) fprintf(stderr, "cooperative launch failed: %s (grid %d)\n", hipGetErrorString(e), grid_blocks);
}
```

```cpp
#include <hip/hip_runtime.h>
#include <hip/hip_cooperative_groups.h>
#include <stdint.h>
#include <stdio.h>
namespace cg = cooperative_groups;

#define DEVINL __device__ __forceinline__
typedef unsigned short bfr;
using bf16x8 = __attribute__((ext_vector_type(8))) short;
using f32x4 = __attribute__((ext_vector_type(4))) float;
using u32x4 = __attribute__((ext_vector_type(4))) unsigned int;

constexpr int DM = 1024;
constexpr int MTOK = 20480;
constexpr int NPROMPT = 4096;
constexpr int DFF = 2816;
constexpr int HALF_FF = 1408;
constexpr float EPS = 1e-6f;

constexpr size_t OFF_MODP = 0;
constexpr size_t OFF_MOD = 7864320;
constexpr size_t OFF_LBS = OFF_MOD + 491520;
constexpr size_t OFF_BAR = OFF_LBS + 8192;
constexpr size_t OFF_WB = 8388608;
constexpr size_t OFF_H = 41943040;
constexpr size_t OFF_BIG = 83886080;
constexpr size_t WS_NEED = OFF_BIG + 251658240ull + 33554432ull + 262144ull;
constexpr size_t WB_IN = 0, WB_OUT = 5242880, WB_UP = 6291456, WB_DOWN = 12058624;

struct Params {
  const float* in[26];
  float* out;
  char* ws;
};

DEVINL int otid() { int t = threadIdx.x; asm volatile("" : "+v"(t)); return t; }
DEVINL int osg(int x) { asm volatile("" : "+s"(x)); return x; }
typedef __bf16 hbf16x2 __attribute__((ext_vector_type(2)));
typedef float hf32x2 __attribute__((ext_vector_type(2)));
DEVINL uint32_t pk2(float a, float b) {
  hf32x2 v = {a, b};
  hbf16x2 r = __builtin_convertvector(v, hbf16x2);
  return __builtin_bit_cast(uint32_t, r);
}
DEVINL bfr f2bf(float f) { return (bfr)(pk2(f, 0.f) & 0xffffu); }
DEVINL float bf2f(bfr h) { return __uint_as_float(((uint32_t)h) << 16); }
DEVINL float frcp(float x) { return __builtin_amdgcn_rcpf(x); }
DEVINL float bflo(uint32_t u) { return __uint_as_float(u << 16); }
DEVINL float bfhi(uint32_t u) { return __uint_as_float(u & 0xffff0000u); }
DEVINL int cond_of(int m) { return m < NPROMPT ? 0 : 1 + ((m - NPROMPT) >> 12); }
DEVINL float silu_f(float x) { return x * frcp(1.f + __expf(-x)); }
DEVINL float gelu_tanh_f(float x) {
  float y = 0.7978845608028654f * (x + 0.044715f * x * x * x);
  float t = 1.f - 2.f * frcp(__expf(2.f * y) + 1.f);
  return 0.5f * x * (1.f + t);
}
DEVINL float shx(float v, int o, int lane) {
  return __int_as_float(__builtin_amdgcn_ds_bpermute((lane ^ o) << 2, __float_as_int(v)));
}
DEVINL float wave_sum(float v, int lane) {
#pragma unroll
  for (int o = 32; o > 0; o >>= 1) v += shx(v, o, lane);
  return v;
}

DEVINL void tok_pos(int m, int& tl, int& T) {
  if (m < NPROMPT) { tl = m & 255; T = 256; } else { tl = (m - NPROMPT) & 4095; T = 4096; }
}

struct EpiNoPre {};
#define EPI_ELEMENTWISE_TILE                                                                       \
  typedef EpiNoPre Pre;                                                                             \
  static constexpr bool kLdsEpi = false;                                                            \
  DEVINL Pre pre(int tn, int tid) const { return Pre{}; }                                           \
  DEVINL void tile(const f32x4 (&acc)[4][4], const Pre& pre_, int m0, int n0, int tn, int wm, int wn, int l15, \
                   int quad, int tid, char* smem) const {                                           \
    _Pragma("unroll") for (int mt = 0; mt < 4; ++mt)                                                \
      _Pragma("unroll") for (int nt = 0; nt < 4; ++nt)                                              \
        (*this)(m0 + wm * 64 + mt * 16 + l15, n0 + wn * 64 + nt * 16 + quad * 4, acc[mt][nt]);      \
  }
struct EpiStore {
  bfr* C; int ldc;
  DEVINL void tile256(const f32x4 (&acc)[8][4], const EpiNoPre& pre_, int m0, int n0, int tn, int wm, int wn, int l15,
                      int quad, int tid, char* smem) const {
#pragma unroll
    for (int mt = 0; mt < 8; ++mt)
#pragma unroll
      for (int nt = 0; nt < 4; ++nt)
        (*this)(m0 + wm * 128 + mt * 16 + l15, n0 + wn * 64 + nt * 16 + quad * 4, acc[mt][nt]);
  }
  DEVINL void operator()(int m, int n, f32x4 v) const {
    uint2 o; o.x = pk2(v[0], v[1]); o.y = pk2(v[2], v[3]);
    *(uint2*)(C + (size_t)m * ldc + n) = o;
  }
  EPI_ELEMENTWISE_TILE
};
struct EpiGelu {
  bfr* C; int ldc;
  DEVINL void operator()(int m, int n, f32x4 v) const {
    uint2 o; o.x = pk2(gelu_tanh_f(v[0]), gelu_tanh_f(v[1])); o.y = pk2(gelu_tanh_f(v[2]), gelu_tanh_f(v[3]));
    *(uint2*)(C + (size_t)m * ldc + n) = o;
  }
  EPI_ELEMENTWISE_TILE
};
struct EpiResid {
  float* X; const float* gate; const float* cscale; int coff;
  typedef EpiNoPre Pre;
  static constexpr bool kLdsEpi = false;
  static constexpr bool kSplit = false;
  DEVINL Pre pre(int tn, int tid) const { return Pre{}; }
  DEVINL void tile(const f32x4 (&acc)[4][4], const Pre& pre_, int m0, int n0, int tn, int wm, int wn, int l15,
                   int quad, int tid, char* smem) const {
    const int cond = cond_of(m0);
    const int nb = n0 + wn * 64 + quad * 4;
    f32x4 gs[4];
#pragma unroll
    for (int nt = 0; nt < 4; ++nt) {
      gs[nt] = *(const f32x4*)(gate + cond * 6144 + nb + nt * 16);
      if (cscale) gs[nt] = gs[nt] * *(const f32x4*)(cscale + nb + nt * 16);
    }
    float* xb = X + (size_t)(m0 + wm * 64 + l15) * DM + coff + nb;
#pragma unroll
    for (int hm = 0; hm < 2; ++hm) {
      f32x4 xv[2][4];
#pragma unroll
      for (int mi = 0; mi < 2; ++mi)
#pragma unroll
        for (int nt = 0; nt < 4; ++nt)
          xv[mi][nt] = *(const f32x4*)(xb + (size_t)((hm * 2 + mi) * 16) * DM + nt * 16);
#pragma unroll
      for (int mi = 0; mi < 2; ++mi)
#pragma unroll
        for (int nt = 0; nt < 4; ++nt)
          *(f32x4*)(xb + (size_t)((hm * 2 + mi) * 16) * DM + nt * 16) = xv[mi][nt] + gs[nt] * acc[hm * 2 + mi][nt];
    }
  }
};


#define LDS3 __attribute__((address_space(3)))
DEVINL void lds_barrier() { asm volatile("s_waitcnt lgkmcnt(0)\n\ts_barrier" ::: "memory"); }
template <class Epi>
DEVINL void gemm_phase(const bfr* __restrict__ A, int lda, const bfr* __restrict__ Bt, int ldb, int N, int K,
                       const Epi& epi, char* smem, int bid, int nblk) {
  const int tid = otid(), lane = tid & 63, wave = tid >> 6;
  const int wm = wave >> 1, wn = wave & 1, l15 = lane & 15, quad = lane >> 4;
  const int tilesN = N >> 7;
  const int ntiles = (MTOK >> 7) * tilesN;
  const int nk = K >> 6;
  const int srow0 = wave * 8 + (lane >> 3);
  const int lc = (lane & 7) ^ ((srow0 >> 1) & 7);
  const int fsw = (l15 >> 1) & 7;
  char* const dst0 = smem + __builtin_amdgcn_readfirstlane(wave) * 1024;
  const __amdgpu_buffer_rsrc_t rsA = __builtin_amdgcn_make_buffer_rsrc((void*)A, 0, 0x7fffffff, 0x00020000);
  const __amdgpu_buffer_rsrc_t rsB = __builtin_amdgcn_make_buffer_rsrc((void*)Bt, 0, 0x7fffffff, 0x00020000);
  const int lda2 = lda * 2, ldb2 = ldb * 2;
  const int laneA = (srow0 * lda + lc * 8) * 2;
  const int laneB = (srow0 * ldb + lc * 8) * 2;
#define TILE_DECODE(t_, tm_, tn_) {                                                        \
    const int xcd_ = (t_) & 7, u_ = (t_) >> 3, g16_ = 16 * tilesN;                         \
    int ur_;                                                                               \
    if (u_ < g16_) { const int gs_ = 8 * tilesN; const int g_ = u_ / gs_, r_ = u_ - g_ * gs_; tn_ = r_ >> 3; ur_ = g_ * 8 + (r_ & 7); } \
    else { const int r_ = u_ - g16_; tn_ = r_ >> 2; ur_ = 16 + (r_ & 3); }                 \
    tm_ = ur_ * 8 + xcd_; }
#define GLDS_STAGE(pa_, pb_, st_, kt_)                                                                    \
  {                                                                                                       \
    _Pragma("unroll") for (int i = 0; i < 4; ++i) {                                                       \
      __builtin_amdgcn_raw_ptr_buffer_load_lds(rsA, (LDS3 void*)(dst0 + (st_) * 32768 + i * 4096), 16,    \
                                               laneA, (pa_) + i * 32 * lda2 + (kt_) * 128, 0, 0);         \
      __builtin_amdgcn_raw_ptr_buffer_load_lds(rsB, (LDS3 void*)(dst0 + (st_) * 32768 + 16384 + i * 4096), 16, \
                                               laneB, (pb_) + i * 32 * ldb2 + (kt_) * 128, 0, 0);         \
    }                                                                                                     \
  }
  int tile = bid;
  if (tile >= ntiles) return;
  int tm, tn;
  TILE_DECODE(tile, tm, tn)
  int gA = (tm << 7) * lda2;
  int gB = (tn << 7) * ldb2;
  __syncthreads();
  GLDS_STAGE(gA, gB, 0, 0)
  for (; tile < ntiles; tile += nblk) {
    const int m0 = tm << 7, n0 = tn << 7, tn_cur = tn;
    const bool has_next = (tile + nblk < ntiles);
    int gAn = gA, gBn = gB;
    if (has_next) {
      TILE_DECODE(tile + nblk, tm, tn)
      gAn = (tm << 7) * lda2;
      gBn = (tn << 7) * ldb2;
    }
    typename Epi::Pre pre = epi.pre(tn_cur, tid);
    f32x4 acc[4][4];
#pragma unroll
    for (int i = 0; i < 4; ++i)
#pragma unroll
      for (int j = 0; j < 4; ++j) acc[i][j] = f32x4{0.f, 0.f, 0.f, 0.f};
    __syncthreads();
    for (int kt = 0; kt < nk; ++kt) {
      const int st = kt & 1;
      const bool cur = (kt + 1 < nk);
      const bool any = cur || has_next;
      const int sa = cur ? gA + (kt + 1) * 128 : gAn;
      const int sb = cur ? gB + (kt + 1) * 128 : gBn;
      char* sd = dst0 + (cur ? (st ^ 1) : 0) * 32768;
      __builtin_amdgcn_s_setprio(3);
      const char* cA = smem + st * 32768 + (wm * 64 + l15) * 128;
      const char* cB = smem + st * 32768 + 16384 + (wn * 64 + l15) * 128;
      {
        const int co0 = (quad ^ fsw) * 16, co1 = ((4 + quad) ^ fsw) * 16;
        bf16x8 af0[4], bf0[4], af1[4], bf1[4];
#pragma unroll
        for (int i = 0; i < 4; ++i) {
          af0[i] = *(const bf16x8*)(cA + i * 2048 + co0);
          bf0[i] = *(const bf16x8*)(cB + i * 2048 + co0);
        }
#pragma unroll
        for (int i = 0; i < 4; ++i) {
          af1[i] = *(const bf16x8*)(cA + i * 2048 + co1);
          bf1[i] = *(const bf16x8*)(cB + i * 2048 + co1);
        }
        __builtin_amdgcn_sched_barrier(0);
        if (any) {
#pragma unroll
          for (int mt = 0; mt < 4; ++mt) {
            __builtin_amdgcn_raw_ptr_buffer_load_lds(rsA, (LDS3 void*)(sd + mt * 4096), 16, laneA, sa + mt * 32 * lda2, 0, 0);
            __builtin_amdgcn_raw_ptr_buffer_load_lds(rsB, (LDS3 void*)(sd + 16384 + mt * 4096), 16, laneB, sb + mt * 32 * ldb2, 0, 0);
          }
        }
        __builtin_amdgcn_s_setprio(0);
        __builtin_amdgcn_sched_barrier(0);
#pragma unroll
        for (int mt = 0; mt < 4; ++mt)
#pragma unroll
          for (int nt = 0; nt < 4; ++nt)
            acc[mt][nt] = __builtin_amdgcn_mfma_f32_16x16x32_bf16(bf0[nt], af0[mt], acc[mt][nt], 0, 0, 0);
#pragma unroll
        for (int mt = 0; mt < 4; ++mt)
#pragma unroll
          for (int nt = 0; nt < 4; ++nt)
            acc[mt][nt] = __builtin_amdgcn_mfma_f32_16x16x32_bf16(bf1[nt], af1[mt], acc[mt][nt], 0, 0, 0);
        __builtin_amdgcn_sched_barrier(0);
      }
      if (kt + 1 < nk) __syncthreads();
    }
    epi.tile(acc, pre, m0, n0, tn_cur, wm, wn, l15, quad, tid, smem);
    gA = gAn; gB = gBn;
  }
}

constexpr int EDGE_LD = 2 * DFF;
struct FfnPre { f32x4 wa[3], wb[3]; };
DEVINL void ffn_conv_rows(const bfr* T, const FfnPre& pre_, bfr* ACT, float* EDGE, int m0, int n0, int tn, int tid) {
  const int c4 = (tid & 15) * 4, r0 = (tid >> 4) * 8;
  const int ja = tn * 64 + c4;
  int tl, Tlen; tok_pos(m0, tl, Tlen);
  const bool top_ok = (tl == 0), bot_ok = (tl + 128 == Tlen);
  if (tid < 128) {
    const int e = tid >> 5, c = (tid & 31) * 4;
    const int r = (e < 2) ? e : 124 + e;
    const uint2 v = *(const uint2*)(T + r * 136 + c);
    *(f32x4*)(EDGE + ((size_t)(m0 >> 7) * 4 + e) * EDGE_LD + n0 + c) = f32x4{bflo(v.x), bfhi(v.x), bflo(v.y), bfhi(v.y)};
  }
  const f32x4 zero = f32x4{0.f, 0.f, 0.f, 0.f};
#define LDT(dst, row, col) { const uint2 v_ = *(const uint2*)(T + (row) * 136 + (col)); dst = f32x4{bflo(v_.x), bfhi(v_.x), bflo(v_.y), bfhi(v_.y)}; }
  f32x4 pa = zero, pb = zero, ca, cb, na, nb;
  if (r0 > 0) { LDT(pa, r0 - 1, c4) LDT(pb, r0 - 1, 64 + c4) }
  LDT(ca, r0, c4) LDT(cb, r0, 64 + c4)
#pragma unroll
  for (int i = 0; i < 8; ++i) {
    const int r = r0 + i;
    if (r < 127) { LDT(na, r + 1, c4) LDT(nb, r + 1, 64 + c4) }
    else { na = zero; nb = zero; }
    const bool ok = (r > 0 || top_ok) && (r < 127 || bot_ok);
    if (ok) {
      const f32x4 a = pre_.wa[0] * pa + pre_.wa[1] * ca + pre_.wa[2] * na;
      const f32x4 b = pre_.wb[0] * pb + pre_.wb[1] * cb + pre_.wb[2] * nb;
      uint2 o;
      o.x = pk2(silu_f(a[0]) * b[0], silu_f(a[1]) * b[1]);
      o.y = pk2(silu_f(a[2]) * b[2], silu_f(a[3]) * b[3]);
      *(uint2*)(ACT + (size_t)(m0 + r) * DFF + ja) = o;
    }
    pa = ca; pb = cb; ca = na; cb = nb;
  }
#undef LDT
}
struct EpiFfnUp {
  bfr* ACT; float* EDGE; const float* wdw;
  typedef FfnPre Pre;
  static constexpr bool kLdsEpi = true;
  DEVINL Pre pre(int tn, int tid) const {
    Pre q;
    const int ja = tn * 64 + (tid & 15) * 4;
#pragma unroll
    for (int t = 0; t < 3; ++t) {
      q.wa[t] = *(const f32x4*)(wdw + t * (2 * DFF) + ja);
      q.wb[t] = *(const f32x4*)(wdw + t * (2 * DFF) + DFF + ja);
    }
    return q;
  }
  DEVINL void tile(const f32x4 (&acc)[4][4], const Pre& pre_, int m0, int n0, int tn, int wm, int wn, int l15, int quad,
                   int tid, char* smem) const {
    bfr* T = (bfr*)(smem + 32768);
    lds_barrier();
#pragma unroll
    for (int mt = 0; mt < 4; ++mt)
#pragma unroll
      for (int nt = 0; nt < 4; ++nt) {
        uint2 o; o.x = pk2(acc[mt][nt][0], acc[mt][nt][1]); o.y = pk2(acc[mt][nt][2], acc[mt][nt][3]);
        *(uint2*)(T + (wm * 64 + mt * 16 + l15) * 136 + wn * 64 + nt * 16 + quad * 4) = o;
      }
    lds_barrier();
    ffn_conv_rows(T, pre_, ACT, EDGE, m0, n0, tn, tid);
  }
  DEVINL void tile256(const f32x4 (&acc)[8][4], const Pre& pre_, int m0, int n0, int tn, int wm, int wn, int l15, int quad,
                      int tid, char* smem) const {
    bfr* T = (bfr*)smem;
#pragma unroll
    for (int hh = 0; hh < 2; ++hh) {
      lds_barrier();
      if (wm == hh) {
#pragma unroll
        for (int mt = 0; mt < 8; ++mt)
#pragma unroll
          for (int nt = 0; nt < 4; ++nt) {
            uint2 o; o.x = pk2(acc[mt][nt][0], acc[mt][nt][1]); o.y = pk2(acc[mt][nt][2], acc[mt][nt][3]);
            *(uint2*)(T + (mt * 16 + l15) * 136 + wn * 64 + nt * 16 + quad * 4) = o;
          }
      }
      lds_barrier();
      ffn_conv_rows(T, pre_, ACT, EDGE, m0 + hh * 128, n0, tn, tid);
    }
  }
};


template <class Epi>
DEVINL void gemm256_phase(const bfr* __restrict__ A, int lda, const bfr* __restrict__ Bt, int ldb, int N, int K,
                          const Epi& epi, char* smem, int bid, int nblk) {
  const int tid = otid(), lane = tid & 63, wave = tid >> 6;
  const int wm = wave >> 1, wn = wave & 1, l15 = lane & 15, quad = lane >> 4;
  const int tilesN = N >> 7;
  const int ntiles = (MTOK >> 8) * tilesN;
  const int nk = K >> 5;
  const int srow0 = wave * 16 + (lane >> 2);
  const int lc = (lane & 3) ^ ((0 - (lane >> 4)) & 3);
  const int fsw = (0 - (l15 >> 2)) & 3;
  char* const dst0 = smem + wave * 1024 + lane * 16;
#define TILE_DECODE2(t_, tm_, tn_) { const int xcd_ = (t_) & 7, u_ = (t_) >> 3; const int ur_ = u_ / tilesN; tn_ = u_ - ur_ * tilesN; tm_ = ur_ * 8 + xcd_; }
#define GLDS_STAGE2(pa_, pb_, st_, kt_)                                                                   \
  {                                                                                                       \
    _Pragma("unroll") for (int i = 0; i < 4; ++i)                                                         \
      __builtin_amdgcn_global_load_lds((const unsigned*)((pa_) + (size_t)(i * 64) * lda + (kt_) * 32),    \
                                       (LDS3 unsigned*)(dst0 + (st_) * 24576 + i * 4096), 16, 0, 0);      \
    _Pragma("unroll") for (int i = 0; i < 2; ++i)                                                         \
      __builtin_amdgcn_global_load_lds((const unsigned*)((pb_) + (size_t)(i * 64) * ldb + (kt_) * 32),    \
                                       (LDS3 unsigned*)(dst0 + (st_) * 24576 + 16384 + i * 4096), 16, 0, 0); \
  }
  int tile = bid;
  if (tile >= ntiles) return;
  int tm, tn;
  TILE_DECODE2(tile, tm, tn)
  const bfr* gA = A + (size_t)((tm << 8) + srow0) * lda + lc * 8;
  const bfr* gB = Bt + (size_t)((tn << 7) + srow0) * ldb + lc * 8;
  __syncthreads();
  GLDS_STAGE2(gA, gB, 0, 0)
  for (; tile < ntiles; tile += nblk) {
    const int m0 = tm << 8, n0 = tn << 7, tn_cur = tn;
    const bool has_next = (tile + nblk < ntiles);
    const bfr* gAn = gA; const bfr* gBn = gB;
    if (has_next) {
      TILE_DECODE2(tile + nblk, tm, tn)
      gAn = A + (size_t)((tm << 8) + srow0) * lda + lc * 8;
      gBn = Bt + (size_t)((tn << 7) + srow0) * ldb + lc * 8;
    }
    f32x4 acc[8][4];
#pragma unroll
    for (int i = 0; i < 8; ++i)
#pragma unroll
      for (int j = 0; j < 4; ++j) acc[i][j] = f32x4{0.f, 0.f, 0.f, 0.f};
    __syncthreads();
    for (int kt = 0; kt < nk; ++kt) {
      const int st = kt & 1;
      const bool cur = (kt + 1 < nk);
      const bool any = cur || has_next;
      const bfr* sa = cur ? gA + (kt + 1) * 32 : gAn;
      const bfr* sb = cur ? gB + (kt + 1) * 32 : gBn;
      char* sd = dst0 + (cur ? (st ^ 1) : 0) * 24576;
      const char* cA = smem + st * 24576 + (wm * 128 + l15) * 64 + ((quad ^ fsw) * 16);
      const char* cB = smem + st * 24576 + 16384 + (wn * 64 + l15) * 64 + ((quad ^ fsw) * 16);
      bf16x8 bfg[4];
#pragma unroll
      for (int i = 0; i < 4; ++i) bfg[i] = *(const bf16x8*)(cB + i * 1024);
#pragma unroll
      for (int hm = 0; hm < 2; ++hm) {
        bf16x8 af[4];
#pragma unroll
        for (int i = 0; i < 4; ++i) af[i] = *(const bf16x8*)(cA + (hm * 4 + i) * 1024);
        __builtin_amdgcn_sched_barrier(0);
#pragma unroll
        for (int mt = 0; mt < 4; ++mt) {
#pragma unroll
          for (int nt = 0; nt < 4; ++nt)
            acc[hm * 4 + mt][nt] = __builtin_amdgcn_mfma_f32_16x16x32_bf16(bfg[nt], af[mt], acc[hm * 4 + mt][nt], 0, 0, 0);
          const int g = hm * 4 + mt;
          if (any && g < 4)
            __builtin_amdgcn_global_load_lds((const unsigned*)(sa + (size_t)(g * 64) * lda), (LDS3 unsigned*)(sd + g * 4096), 16, 0, 0);
          else if (any && g < 6)
            __builtin_amdgcn_global_load_lds((const unsigned*)(sb + (size_t)((g - 4) * 64) * ldb), (LDS3 unsigned*)(sd + 16384 + (g - 4) * 4096), 16, 0, 0);
          __builtin_amdgcn_sched_barrier(0);
        }
      }
      if (kt + 1 < nk) __syncthreads();
    }
    {
      typename Epi::Pre pre = epi.pre(tn_cur, tid);
      epi.tile256(acc, pre, m0, n0, tn_cur, wm, wn, l15, quad, tid, smem);
    }
    gA = gAn; gB = gBn;
  }
}


template <class Epi>
DEVINL void gemm256s_phase(const bfr* __restrict__ A, int lda, const bfr* __restrict__ Bt, int ldb, int N, int K,
                           const Epi& epi, char* smem, int bid, int nblk) {
  const int tid = otid(), lane = tid & 63, wave = tid >> 6;
  const int wm = wave >> 1, wn = wave & 1, l15 = lane & 15, quad = lane >> 4;
  const int tilesN = N >> 7;
  const int ntiles = (MTOK >> 8) * tilesN;
  const int nk = K >> 6;
  const int srow0 = wave * 8 + (lane >> 3);
  const int lc = (lane & 7) ^ ((srow0 >> 1) & 7);
  const int fsw = (l15 >> 1) & 7;
  char* const dst0 = smem + __builtin_amdgcn_readfirstlane(wave) * 1024;
#define TILE_DECODE3(t_, tm_, tn_) { const int xcd_ = (t_) & 7, u_ = (t_) >> 3; const int gs_ = 5 * tilesN; const int g_ = u_ / gs_, r_ = u_ - g_ * gs_; \
    tn_ = r_ / 5; tm_ = (g_ * 5 + (r_ - tn_ * 5)) * 8 + xcd_; }
  if (bid >= ntiles) return;
  int ptile = bid, pkt = 0;
  bool pvalid = true;
  int ptm, ptn;
  TILE_DECODE3(ptile, ptm, ptn)
  const __amdgpu_buffer_rsrc_t rsA = __builtin_amdgcn_make_buffer_rsrc((void*)A, 0, 0x7fffffff, 0x00020000);
  const __amdgpu_buffer_rsrc_t rsB = __builtin_amdgcn_make_buffer_rsrc((void*)Bt, 0, 0x7fffffff, 0x00020000);
  const int lda2 = lda * 2, ldb2 = ldb * 2;
  const int laneA = (srow0 * lda + lc * 8) * 2;
  const int laneB = (srow0 * ldb + lc * 8) * 2;
  int sAo = (ptm << 8) * lda2;
  int sBo = (ptn << 7) * ldb2;
#define DMA_B3(buf_)                                                                                      \
  {                                                                                                       \
    _Pragma("unroll") for (int i = 0; i < 4; ++i)                                                         \
      __builtin_amdgcn_raw_ptr_buffer_load_lds(rsB, (LDS3 void*)(dst0 + 34816 + (buf_) * 16384 + i * 4096), 16, \
                                               laneB, sBo + i * 32 * ldb2 + pkt * 128, 0, 0);             \
  }
#define DMA_A3()                                                                                          \
  {                                                                                                       \
    _Pragma("unroll") for (int i = 0; i < 8; ++i)                                                         \
      __builtin_amdgcn_raw_ptr_buffer_load_lds(rsA, (LDS3 void*)(dst0 + i * 4096), 16,                    \
                                               laneA, sAo + i * 32 * lda2 + pkt * 128, 0, 0);             \
    if (++pkt == nk) {                                                                                    \
      pkt = 0; ptile += nblk;                                                                             \
      if (ptile < ntiles) {                                                                               \
        TILE_DECODE3(ptile, ptm, ptn)                                                                     \
        sAo = (ptm << 8) * lda2;                                                                          \
        sBo = (ptn << 7) * ldb2;                                                                          \
      } else pvalid = false;                                                                              \
    }                                                                                                     \
  }
  __syncthreads();
  DMA_B3(0)
  DMA_A3()
  bool deferred = false;
  int bbuf = 0;
  const char* cA = smem + (wm * 128 + l15) * 128;
  const char* cB0 = smem + 34816 + (wn * 64 + l15) * 128;
  for (int tile = bid; tile < ntiles; tile += nblk) {
    int tm, tn;
    TILE_DECODE3(tile, tm, tn)
    const int m0 = tm << 8, n0 = tn << 7;
    if (deferred) { DMA_A3() deferred = false; }
    f32x4 acc[8][4];
#pragma unroll
    for (int i = 0; i < 8; ++i)
#pragma unroll
      for (int j = 0; j < 4; ++j) acc[i][j] = f32x4{0.f, 0.f, 0.f, 0.f};
    for (int kt = 0; kt < nk; ++kt) {
      asm volatile("s_waitcnt vmcnt(0)\n\ts_barrier" ::: "memory");
      __builtin_amdgcn_s_setprio(3);
      const char* cB = cB0 + bbuf * 16384;
      const int co0 = (quad ^ fsw) * 16, co1 = ((4 + quad) ^ fsw) * 16;
      bf16x8 af[8], bfg[4];
#pragma unroll
      for (int i = 0; i < 4; ++i) bfg[i] = *(const bf16x8*)(cB + i * 2048 + co0);
#pragma unroll
      for (int i = 0; i < 8; ++i) af[i] = *(const bf16x8*)(cA + i * 2048 + co0);
      __builtin_amdgcn_sched_barrier(0);
      if (pvalid) DMA_B3(bbuf ^ 1)
      __builtin_amdgcn_s_setprio(0);
      __builtin_amdgcn_sched_barrier(0);
#pragma unroll
      for (int mt = 0; mt < 8; ++mt)
#pragma unroll
        for (int nt = 0; nt < 4; ++nt)
          acc[mt][nt] = __builtin_amdgcn_mfma_f32_16x16x32_bf16(bfg[nt], af[mt], acc[mt][nt], 0, 0, 0);
      __builtin_amdgcn_sched_barrier(0);
      __builtin_amdgcn_s_setprio(3);
#pragma unroll
      for (int i = 0; i < 4; ++i) bfg[i] = *(const bf16x8*)(cB + i * 2048 + co1);
#pragma unroll
      for (int i = 0; i < 8; ++i) af[i] = *(const bf16x8*)(cA + i * 2048 + co1);
      asm volatile("s_waitcnt lgkmcnt(0)\n\ts_barrier" ::: "memory");
      if (pvalid) {
        if (Epi::kLdsEpi && kt == nk - 1) deferred = true;
        else DMA_A3()
      }
      __builtin_amdgcn_s_setprio(0);
      bbuf ^= 1;
      __builtin_amdgcn_sched_barrier(0);
#pragma unroll
      for (int mt = 0; mt < 8; ++mt)
#pragma unroll
        for (int nt = 0; nt < 4; ++nt)
          acc[mt][nt] = __builtin_amdgcn_mfma_f32_16x16x32_bf16(bfg[nt], af[mt], acc[mt][nt], 0, 0, 0);
      __builtin_amdgcn_sched_barrier(0);
    }
    __builtin_amdgcn_s_setprio(3);
    {
      typename Epi::Pre pre = epi.pre(tn, tid);
      epi.tile256(acc, pre, m0, n0, tn, wm, wn, l15, quad, tid, smem);
    }
    if (Epi::kLdsEpi) lds_barrier();
    __builtin_amdgcn_s_setprio(0);
  }
  asm volatile("s_waitcnt vmcnt(0)" ::: "memory");
}

DEVINL void ffn_edge_phase(const float* __restrict__ EDGE, const float* __restrict__ wdw, bfr* __restrict__ ACT, int bid, int nblk) {
  const int gt = bid * 256 + otid(), nt = nblk * 256;
  for (int i = gt; i < 160 * 2 * 704; i += nt) {
    const int cg4 = i % 704, r2 = i / 704, side = r2 & 1, tm = r2 >> 1;
    const int m0 = tm << 7;
    int tl, Tlen; tok_pos(m0, tl, Tlen);
    if (side == 0 ? (tl == 0) : (tl + 128 == Tlen)) continue;
    const int ja = cg4 * 4;
    const int nb_ = ja >> 6, cc = ja & 63;
    const int ea = nb_ * 128 + cc, eb = ea + 64;
    const float* prev; const float* cur; const float* next;
    if (side == 0) {
      prev = EDGE + ((size_t)(tm - 1) * 4 + 3) * EDGE_LD; cur = EDGE + ((size_t)tm * 4 + 0) * EDGE_LD; next = EDGE + ((size_t)tm * 4 + 1) * EDGE_LD;
    } else {
      prev = EDGE + ((size_t)tm * 4 + 2) * EDGE_LD; cur = EDGE + ((size_t)tm * 4 + 3) * EDGE_LD; next = EDGE + ((size_t)(tm + 1) * 4 + 0) * EDGE_LD;
    }
    const f32x4 a = *(const f32x4*)(wdw + ja) * *(const f32x4*)(prev + ea) + *(const f32x4*)(wdw + 2 * DFF + ja) * *(const f32x4*)(cur + ea) +
                    *(const f32x4*)(wdw + 4 * DFF + ja) * *(const f32x4*)(next + ea);
    const f32x4 b = *(const f32x4*)(wdw + DFF + ja) * *(const f32x4*)(prev + eb) + *(const f32x4*)(wdw + 3 * DFF + ja) * *(const f32x4*)(cur + eb) +
                    *(const f32x4*)(wdw + 5 * DFF + ja) * *(const f32x4*)(next + eb);
    uint2 o;
    o.x = pk2(silu_f(a[0]) * b[0], silu_f(a[1]) * b[1]);
    o.y = pk2(silu_f(a[2]) * b[2], silu_f(a[3]) * b[3]);
    const int m = m0 + (side ? 127 : 0);
    *(uint2*)(ACT + (size_t)m * DFF + ja) = o;
  }
}

DEVINL int up_perm(int n0) {
  if (n0 < DFF) return (n0 >> 6) * 128;
  return ((n0 - DFF) >> 6) * 128 + 64;
}
DEVINL void conv_matrix(const float* __restrict__ src, int K, int N, bfr* __restrict__ dst, int perm,
                        char* smem, int bid, int nblk) {
  float* sT = (float*)smem;
  const int tid = otid();
  const int tilesN = N >> 6;
  const int ntiles = (K >> 6) * tilesN;
  const int r = tid >> 4, c4 = tid & 15;
  int t = bid;
  if (t >= ntiles) return;
  f32x4 v0, v1, v2, v3;
  {
    const int tk = t / tilesN, tn = t - tk * tilesN;
    const float* sp = src + (size_t)((tk << 6) + r) * N + (tn << 6) + c4 * 4;
    v0 = *(const f32x4*)(sp); v1 = *(const f32x4*)(sp + (size_t)16 * N);
    v2 = *(const f32x4*)(sp + (size_t)32 * N); v3 = *(const f32x4*)(sp + (size_t)48 * N);
  }
  for (; t < ntiles; t += nblk) {
    const int tk = t / tilesN, tn = t - tk * tilesN;
    const int k0 = tk << 6, n0 = tn << 6;
    __syncthreads();
    {
      float* d = sT + r * 65 + c4 * 4;
      d[0] = v0[0]; d[1] = v0[1]; d[2] = v0[2]; d[3] = v0[3];
      d[16 * 65 + 0] = v1[0]; d[16 * 65 + 1] = v1[1]; d[16 * 65 + 2] = v1[2]; d[16 * 65 + 3] = v1[3];
      d[32 * 65 + 0] = v2[0]; d[32 * 65 + 1] = v2[1]; d[32 * 65 + 2] = v2[2]; d[32 * 65 + 3] = v2[3];
      d[48 * 65 + 0] = v3[0]; d[48 * 65 + 1] = v3[1]; d[48 * 65 + 2] = v3[2]; d[48 * 65 + 3] = v3[3];
    }
    if (t + nblk < ntiles) {
      const int t2 = t + nblk;
      const int tk2 = t2 / tilesN, tn2 = t2 - tk2 * tilesN;
      const float* sp = src + (size_t)((tk2 << 6) + r) * N + (tn2 << 6) + c4 * 4;
      v0 = *(const f32x4*)(sp); v1 = *(const f32x4*)(sp + (size_t)16 * N);
      v2 = *(const f32x4*)(sp + (size_t)32 * N); v3 = *(const f32x4*)(sp + (size_t)48 * N);
    }
    __syncthreads();
    const int n = tid >> 2, kc = tid & 3;
    uint32_t w[8];
#pragma unroll
    for (int j = 0; j < 8; ++j)
      w[j] = pk2(sT[(kc * 16 + 2 * j) * 65 + n], sT[(kc * 16 + 2 * j + 1) * 65 + n]);
    const int nd = (perm ? up_perm(n0) : n0) + n;
    bfr* dp = dst + (size_t)nd * K + k0 + kc * 16;
    *(uint4*)dp = make_uint4(w[0], w[1], w[2], w[3]);
    *(uint4*)(dp + 8) = make_uint4(w[4], w[5], w[6], w[7]);
  }
}

DEVINL void phase0a(const Params& p, char* smem, int bid, int nblk) {
  const int tid = otid();
  float* sc = (float*)smem;
  float* modp = (float*)(p.ws + OFF_MODP);
  const float* cvec = p.in[3];
  const float* cctx = p.in[4];
  const float* ada_w = p.in[5];
  for (int job = bid; job < 384; job += nblk) {
    const int l = job / 96, r = job - l * 96, ks = r / 6, cgp = r - ks * 6;
    __syncthreads();
    for (int i = tid; i < 320; i += 256) {
      const int cond = i >> 6, kk = i & 63;
      const float v = cond == 0 ? cctx[ks * 64 + kk] : cvec[(cond - 1) * DM + ks * 64 + kk];
      sc[i] = silu_f(v);
    }
    __syncthreads();
    const int col = cgp * 1024 + tid * 4;
    const float* wp = ada_w + ((size_t)l * DM + ks * 64) * 6144 + col;
    float a[5][4];
#pragma unroll
    for (int c = 0; c < 5; ++c)
#pragma unroll
      for (int j = 0; j < 4; ++j) a[c][j] = 0.f;
#pragma unroll 8
    for (int kk = 0; kk < 64; ++kk) {
      const float4 w = *(const float4*)(wp + (size_t)kk * 6144);
#pragma unroll
      for (int c = 0; c < 5; ++c) {
        const float s = sc[c * 64 + kk];
        a[c][0] += s * w.x; a[c][1] += s * w.y; a[c][2] += s * w.z; a[c][3] += s * w.w;
      }
    }
#pragma unroll
    for (int c = 0; c < 5; ++c)
      *(float4*)(modp + ((size_t)(ks * 4 + l) * 5 + c) * 6144 + col) = make_float4(a[c][0], a[c][1], a[c][2], a[c][3]);
  }
  const int gt = bid * 256 + tid, nt = nblk * 256;
  {
    const float* lb = p.in[20];
    float* lbs = (float*)(p.ws + OFF_LBS);
    for (int i = gt; i < 2048; i += nt) {
      const float v0 = lb[i], v1 = lb[2048 + i], v2 = lb[4096 + i], v3 = lb[6144 + i];
      const float mx = fmaxf(fmaxf(v0, v1), fmaxf(v2, v3));
      const float e0 = expf(v0 - mx), e1 = expf(v1 - mx), e2 = expf(v2 - mx), e3 = expf(v3 - mx);
      lbs[i] = (e1 + e2 + e3) / (e0 + e1 + e2 + e3);
    }
  }
  float* X = p.out;
  {
    const float4* xp = (const float4*)p.in[0];
    float4* xo = (float4*)X;
    for (int i = gt; i < NPROMPT * DM / 4; i += nt) xo[i] = xp[i];
    const float* xs = p.in[1];
    for (int i = gt; i < 4096 * 256; i += nt) {
      const int t = i >> 8, c = (i & 255) * 4;
      const int part = c >> 8;
      const float pos = (float)((part < 2) ? (t >> 6) : (t & 63));
      float pe[4];
#pragma unroll
      for (int j = 0; j < 4; ++j) {
        const int jj = (c + j) & 255;
        const float freq = expf((-9.210340371976184f * (float)jj) / 256.0f);
        const float arg = pos * freq;
        pe[j] = (part & 1) ? cosf(arg) : sinf(arg);
      }
#pragma unroll
      for (int b = 0; b < 4; ++b) {
        const size_t off = ((size_t)b * 4096 + t) * DM + c;
        float4 v = *(const float4*)(xs + off);
        v.x += pe[0]; v.y += pe[1]; v.z += pe[2]; v.w += pe[3];
        *(float4*)(X + (size_t)NPROMPT * DM + off) = v;
      }
    }
  }
}

DEVINL void phase0b(const Params& p, int bid, int nblk) {
  const int gt = bid * 256 + otid(), nt = nblk * 256;
  const float* modp = (const float*)(p.ws + OFF_MODP);
  float* mod = (float*)(p.ws + OFF_MOD);
  const float* ada_b = p.in[6];
  for (int i = gt; i < 4 * 5 * 6144; i += nt) {
    const int l = i / 30720, col = i % 6144;
    float s = ada_b[l * 6144 + col];
#pragma unroll
    for (int ks = 0; ks < 16; ++ks) s += modp[(size_t)ks * 122880 + i];
    mod[i] = s;
  }
}

DEVINL void norm_phase(const float* __restrict__ X, const float* __restrict__ g, const float* __restrict__ modl,
                       int shift_off, int scale_off, bfr* __restrict__ H, int bid, int nblk) {
  const int tid = otid(); const int lane = tid & 63;
  const int gw = bid * 4 + (tid >> 6), nw = nblk * 4;
  int row = gw;
  if (row >= MTOK) return;
  f32x4 x0, x1, x2, x3;
  {
    const float* xr = X + (size_t)row * DM + lane * 4;
    x0 = *(const f32x4*)(xr); x1 = *(const f32x4*)(xr + 256); x2 = *(const f32x4*)(xr + 512); x3 = *(const f32x4*)(xr + 768);
  }
  for (; row < MTOK; row += nw) {
    const f32x4 c0 = x0, c1 = x1, c2 = x2, c3 = x3;
    if (row + nw < MTOK) {
      const float* xr = X + (size_t)(row + nw) * DM + lane * 4;
      x0 = *(const f32x4*)(xr); x1 = *(const f32x4*)(xr + 256); x2 = *(const f32x4*)(xr + 512); x3 = *(const f32x4*)(xr + 768);
    }
    float ss = 0.f;
#pragma unroll
    for (int j = 0; j < 4; ++j) ss += c0[j] * c0[j] + c1[j] * c1[j] + c2[j] * c2[j] + c3[j] * c3[j];
    ss = wave_sum(ss, lane);
    const float rstd = rsqrtf(ss * (1.f / DM) + EPS);
    const float* mc = modl + cond_of(row) * 6144;
#pragma unroll
    for (int i = 0; i < 4; ++i) {
      const f32x4 xv = (i == 0) ? c0 : (i == 1) ? c1 : (i == 2) ? c2 : c3;
      const int c = i * 256 + lane * 4;
      const float4 gg = *(const float4*)(g + c);
      const float4 sh = *(const float4*)(mc + shift_off + c);
      const float4 sc = *(const float4*)(mc + scale_off + c);
      const float h0 = xv[0] * rstd * gg.x * (1.f + sc.x) + sh.x;
      const float h1 = xv[1] * rstd * gg.y * (1.f + sc.y) + sh.y;
      const float h2 = xv[2] * rstd * gg.z * (1.f + sc.z) + sh.z;
      const float h3 = xv[3] * rstd * gg.w * (1.f + sc.w) + sh.w;
      uint2 o; o.x = pk2(h0, h1); o.y = pk2(h2, h3);
      *(uint2*)(H + (size_t)row * DM + c) = o;
    }
  }
}

DEVINL void final_norm_phase(float* X, const float* __restrict__ g, int bid, int nblk) {
  const int tid = otid(); const int lane = tid & 63;
  const int gw = bid * 4 + (tid >> 6), nw = nblk * 4;
  for (int row = gw; row < MTOK; row += nw) {
    float* xr = X + (size_t)row * DM;
    float4 x[4];
    float ss = 0.f;
#pragma unroll
    for (int i = 0; i < 4; ++i) {
      x[i] = *(const float4*)(xr + i * 256 + lane * 4);
      ss += x[i].x * x[i].x + x[i].y * x[i].y + x[i].z * x[i].z + x[i].w * x[i].w;
    }
    ss = wave_sum(ss, lane);
    const float rstd = rsqrtf(ss * (1.f / DM) + EPS);
#pragma unroll
    for (int i = 0; i < 4; ++i) {
      const int c = i * 256 + lane * 4;
      const float4 gg = *(const float4*)(g + c);
      float4 o;
      o.x = x[i].x * rstd * gg.x; o.y = x[i].y * rstd * gg.y; o.z = x[i].z * rstd * gg.z; o.w = x[i].w * rstd * gg.w;
      *(float4*)(xr + c) = o;
    }
  }
}

DEVINL void shortconv_ew_phase(const bfr* __restrict__ G, const float* __restrict__ wdw, bfr* __restrict__ U, int bid, int nblk) {
  const int gt = bid * 256 + otid(), nt = nblk * 256;
  for (int i = gt; i < MTOK * 128; i += nt) {
    const int m = i >> 7, c = (i & 127) * 8;
    int tl, T; tok_pos(m, tl, T);
    const bfr* gr = G + (size_t)m * 3072;
    const uint4 bg = *(const uint4*)(gr + c);
    float accv[8];
#pragma unroll
    for (int j = 0; j < 8; ++j) accv[j] = 0.f;
#pragma unroll
    for (int tap = 0; tap < 3; ++tap) {
      const int d = tap - 1;
      if ((d < 0 && tl == 0) || (d > 0 && tl == T - 1)) continue;
      const bfr* nr = gr + (ptrdiff_t)d * 3072;
      const uint4 cgv = *(const uint4*)(nr + 1024 + c);
      const uint4 xhv = *(const uint4*)(nr + 2048 + c);
      const float4 w0 = *(const float4*)(wdw + tap * DM + c);
      const float4 w1 = *(const float4*)(wdw + tap * DM + c + 4);
      accv[0] += w0.x * bflo(cgv.x) * bflo(xhv.x); accv[1] += w0.y * bfhi(cgv.x) * bfhi(xhv.x);
      accv[2] += w0.z * bflo(cgv.y) * bflo(xhv.y); accv[3] += w0.w * bfhi(cgv.y) * bfhi(xhv.y);
      accv[4] += w1.x * bflo(cgv.z) * bflo(xhv.z); accv[5] += w1.y * bfhi(cgv.z) * bfhi(xhv.z);
      accv[6] += w1.z * bflo(cgv.w) * bflo(xhv.w); accv[7] += w1.w * bfhi(cgv.w) * bfhi(xhv.w);
    }
    uint4 o;
    o.x = pk2(bflo(bg.x) * accv[0], bfhi(bg.x) * accv[1]);
    o.y = pk2(bflo(bg.y) * accv[2], bfhi(bg.y) * accv[3]);
    o.z = pk2(bflo(bg.z) * accv[4], bfhi(bg.z) * accv[5]);
    o.w = pk2(bflo(bg.w) * accv[6], bfhi(bg.w) * accv[7]);
    *(uint4*)(U + (size_t)m * DM + c) = o;
  }
}

DEVINL void pool_ew_phase(const bfr* __restrict__ H, bfr* __restrict__ P, int bid, int nblk) {
  const int gt = bid * 256 + otid(), nt = nblk * 256;
  for (int i = gt; i < MTOK * 128; i += nt) {
    const int m = i >> 7, ch = i & 127, c = ch * 8;
    int tl, T; tok_pos(m, tl, T);
    const int hw = 1 << (ch >> 5);
    const int lo = max(tl - hw, 0), hi = min(tl + hw, T);
    float s[8];
#pragma unroll
    for (int j = 0; j < 8; ++j) s[j] = 0.f;
    const bfr* base = H + (size_t)(m - tl) * DM + c;
    uint4 wv[16];
#pragma unroll
    for (int j = 0; j < 16; ++j) {
      const int q = tl - hw + j;
      const bool ok = (j < 2 * hw) && (q >= 0) && (q < T);
      wv[j] = ok ? *(const uint4*)(base + (size_t)q * DM) : make_uint4(0u, 0u, 0u, 0u);
    }
#pragma unroll
    for (int j = 0; j < 16; ++j) {
      const uint4 v = wv[j];
      s[0] += bflo(v.x); s[1] += bfhi(v.x); s[2] += bflo(v.y); s[3] += bfhi(v.y);
      s[4] += bflo(v.z); s[5] += bfhi(v.z); s[6] += bflo(v.w); s[7] += bfhi(v.w);
    }
    const float inv = 1.f / (float)(hi - lo);
    const uint4 v = *(const uint4*)(base + (size_t)tl * DM);
    uint4 o;
    o.x = pk2(s[0] * inv - bflo(v.x), s[1] * inv - bfhi(v.x));
    o.y = pk2(s[2] * inv - bflo(v.y), s[3] * inv - bfhi(v.y));
    o.z = pk2(s[4] * inv - bflo(v.z), s[5] * inv - bfhi(v.z));
    o.w = pk2(s[6] * inv - bflo(v.w), s[7] * inv - bfhi(v.w));
    *(uint4*)(P + (size_t)m * DM + c) = o;
  }
}

DEVINL void sgu_norm_phase(bfr* UV, const float* __restrict__ g, int bid, int nblk) {
  const int tid = otid(); const int lane = tid & 63;
  const int gw = bid * 4 + (tid >> 6), nw = nblk * 4;
  for (int row = gw; row < MTOK; row += nw) {
    bfr* vr = UV + (size_t)row * 2048 + 1024;
    float x[4][4];
    float ss = 0.f;
#pragma unroll
    for (int i = 0; i < 4; ++i) {
      const uint2 v = *(const uint2*)(vr + i * 256 + lane * 4);
      x[i][0] = bflo(v.x); x[i][1] = bfhi(v.x); x[i][2] = bflo(v.y); x[i][3] = bfhi(v.y);
      ss += x[i][0] * x[i][0] + x[i][1] * x[i][1] + x[i][2] * x[i][2] + x[i][3] * x[i][3];
    }
    ss = wave_sum(ss, lane);
    const float rstd = rsqrtf(ss * (1.f / DM) + EPS);
#pragma unroll
    for (int i = 0; i < 4; ++i) {
      const int c = i * 256 + lane * 4;
      const float4 gg = *(const float4*)(g + c);
      uint2 o;
      o.x = pk2(x[i][0] * rstd * gg.x, x[i][1] * rstd * gg.y);
      o.y = pk2(x[i][2] * rstd * gg.z, x[i][3] * rstd * gg.w);
      *(uint2*)(vr + c) = o;
    }
  }
}

DEVINL void sgu_spatial_phase(bfr* UV, const float* __restrict__ ws_, const float* __restrict__ bs_, char* smem, int bid, int nblk) {
  bfr* sV = (bfr*)smem;
  bfr* sW = sV + 128 * 136;
  const int tid = otid(), lane = tid & 63, wave = tid >> 6, l15 = lane & 15, quad = lane >> 4;
  for (int item = bid; item < 160 * 8; item += nblk) {
    const int chunk = item >> 3, g = item & 7;
    __syncthreads();
    const float* wg = ws_ + (size_t)g * 16384;
#pragma unroll 4
    for (int i = 0; i < 16; ++i) {
      const int idx = tid + 256 * i;
      const int row = idx >> 5, chn = idx & 31;
      const float4 v = *(const float4*)(wg + row * 128 + chn * 4);
      uint2 o; o.x = pk2(v.x, v.y); o.y = pk2(v.z, v.w);
      *(uint2*)(sW + row * 136 + chn * 4) = o;
    }
#pragma unroll 2
    for (int i = 0; i < 8; ++i) {
      const int idx = tid + 256 * i;
      const int q = idx >> 4, chn = idx & 15;
      const uint4 v = *(const uint4*)(UV + (size_t)(chunk * 128 + q) * 2048 + 1024 + g * 128 + chn * 8);
      bfr* d = sV + (chn * 8) * 136 + q;
      d[0 * 136] = (bfr)(v.x & 0xffff); d[1 * 136] = (bfr)(v.x >> 16);
      d[2 * 136] = (bfr)(v.y & 0xffff); d[3 * 136] = (bfr)(v.y >> 16);
      d[4 * 136] = (bfr)(v.z & 0xffff); d[5 * 136] = (bfr)(v.z >> 16);
      d[6 * 136] = (bfr)(v.w & 0xffff); d[7 * 136] = (bfr)(v.w >> 16);
    }
    __syncthreads();
    f32x4 acc[8][2];
#pragma unroll
    for (int i = 0; i < 8; ++i) { acc[i][0] = f32x4{0.f, 0.f, 0.f, 0.f}; acc[i][1] = f32x4{0.f, 0.f, 0.f, 0.f}; }
#pragma unroll
    for (int kk = 0; kk < 4; ++kk) {
      bf16x8 bw[2];
#pragma unroll
      for (int pt = 0; pt < 2; ++pt) bw[pt] = *(const bf16x8*)(sW + (wave * 32 + pt * 16 + l15) * 136 + kk * 32 + quad * 8);
#pragma unroll
      for (int ct = 0; ct < 8; ++ct) {
        const bf16x8 av = *(const bf16x8*)(sV + (ct * 16 + l15) * 136 + kk * 32 + quad * 8);
#pragma unroll
        for (int pt = 0; pt < 2; ++pt)
          acc[ct][pt] = __builtin_amdgcn_mfma_f32_16x16x32_bf16(av, bw[pt], acc[ct][pt], 0, 0, 0);
      }
    }
#pragma unroll
    for (int pt = 0; pt < 2; ++pt) {
      const int pp = wave * 32 + pt * 16 + l15;
      const float bias = bs_[g * 128 + pp];
      bfr* ur = UV + (size_t)(chunk * 128 + pp) * 2048 + g * 128 + quad * 4;
#pragma unroll
      for (int ct = 0; ct < 8; ++ct) {
        const uint2 u = *(const uint2*)(ur + ct * 16);
        uint2 o;
        o.x = pk2(bflo(u.x) * (acc[ct][pt][0] + bias), bfhi(u.x) * (acc[ct][pt][1] + bias));
        o.y = pk2(bflo(u.y) * (acc[ct][pt][2] + bias), bfhi(u.y) * (acc[ct][pt][3] + bias));
        *(uint2*)(ur + ct * 16) = o;
      }
    }
  }
}

DEVINL void hgrn_scan_phase(const Params& p, char* smem, int bid, int nblk, const int mode) {
  bfr* sQe = (bfr*)smem;
  bfr* sKe = sQe + 32 * 136;
  bfr* sKeT = sKe + 32 * 136;
  bfr* sVT = sKeT + 128 * 40;
  bfr* sP = sVT + 64 * 40;
  bfr* sST = sP + 32 * 40;
  float* sLast = (float*)(sST + 64 * 136);
  float* sTot = sLast + 128;
  const int tid = otid(), lane = tid & 63, wave = tid >> 6, l15 = lane & 15, quad = lane >> 4;
  const int cp = lane, qt = wave, i0 = qt * 8;
  const bfr* QZ = (const bfr*)(p.ws + OFF_BIG);
  bfr* Of = (bfr*)(p.ws + OFF_H);
  bfr* Ob = (bfr*)(p.ws + OFF_BIG + 209715200ull);
  const float* lbs = (const float*)(p.ws + OFF_LBS);
  const float* state_rec = p.in[2];
  float* out_state = p.out + (size_t)MTOK * DM;

  float* SLOC = (float*)(p.ws + OFF_BIG + 251658240ull);
  float* DLOC = (float*)(p.ws + OFF_BIG + 251658240ull + 33554432ull);
  const int nitems = mode ? 1536 : 896;
  for (int item = bid; item < nitems; item += nblk) {
    const int eh = item & 1, dir = (item >> 1) & 1, h = (item >> 2) & 7;
    int base, T, nchunks, pos0, slot, seq;
    bool is_prompt = false;
    if (!mode) {
      const int r = item >> 5, seqb = r / 7, j = r - seqb * 7;
      seq = 16 + seqb; base = NPROMPT + seqb * 4096; T = 4096; nchunks = 16; pos0 = j * 512;
      slot = ((seqb * 8 + j) * 8 + h) * 2 + dir;
    } else if (item < 1024) {
      const int r = item >> 5, seqb = r >> 3, j = r & 7;
      seq = 16 + seqb; base = NPROMPT + seqb * 4096; T = 4096; nchunks = 16; pos0 = j * 512;
      slot = ((seqb * 8 + j) * 8 + h) * 2 + dir;
    } else {
      seq = (item - 1024) >> 5; base = seq * 256; T = 256; nchunks = 8; pos0 = 0; slot = 0;
      is_prompt = true;
    }
    bfr* Od = dir ? Ob : Of;
    const float lbv0 = lbs[dir * 1024 + h * 128 + 2 * cp], lbv1 = lbs[dir * 1024 + h * 128 + 2 * cp + 1];
    const int eloc = wave * 16 + l15;
    const int eglob = eh * 64 + eloc;

    f32x4 S[8];
    if (is_prompt || !mode) {
#pragma unroll
      for (int dt = 0; dt < 8; ++dt) S[dt] = f32x4{0.f, 0.f, 0.f, 0.f};
    } else {
      const float* s0 = SLOC + (size_t)slot * 16384;
#pragma unroll
      for (int dt = 0; dt < 8; ++dt)
#pragma unroll
        for (int j = 0; j < 4; ++j) S[dt][j] = s0[(dt * 16 + quad * 4 + j) * 128 + eglob];
    }
    float cum0 = 1.f, cum1 = 1.f;
    __syncthreads();
#pragma unroll
    for (int dt = 0; dt < 8; ++dt) {
      uint2 o; o.x = pk2(S[dt][0], S[dt][1]); o.y = pk2(S[dt][2], S[dt][3]);
      *(uint2*)(sST + eloc * 136 + dt * 16 + quad * 4) = o;
    }

    const unsigned qoff2 = h * 64 + cp, zoff2 = (1 + dir) * 512 + h * 64 + cp;
    const unsigned voff2 = 1536 + h * 64 + eh * 32 + (cp & 31);
    const uint32_t* __restrict__ QZ32 = (const uint32_t*)QZ;
    uint32_t rq[8], rz[8], rv[8];
#pragma unroll
    for (int ii = 0; ii < 8; ++ii) {
      const int pos = pos0 + i0 + ii;
      const unsigned tok = dir ? base + T - 1 - pos : base + pos;
      const unsigned ri = tok * 2560u;
      rq[ii] = QZ32[ri + qoff2]; rz[ii] = QZ32[ri + zoff2]; rv[ii] = QZ32[ri + voff2];
    }

    for (int c = 0; c < nchunks; ++c) {
      float pc0[8], pc1[8], kv0[8], kv1[8];
      float run0 = 1.f, run1 = 1.f;
#pragma unroll
      for (int ii = 0; ii < 8; ++ii) {
        const float z0 = bflo(rz[ii]), z1 = bfhi(rz[ii]);
        const float f0 = lbv0 + (1.f - lbv0) * frcp(1.f + __expf(-z0));
        const float f1 = lbv1 + (1.f - lbv1) * frcp(1.f + __expf(-z1));
        run0 *= f0; run1 *= f1;
        pc0[ii] = run0; pc1[ii] = run1;
        kv0[ii] = 1.f - f0; kv1[ii] = 1.f - f1;
      }
      *(float2*)(sTot + qt * 128 + 2 * cp) = make_float2(run0, run1);
      __syncthreads();
      {
        float off0 = 1.f, off1 = 1.f, tot0 = 1.f, tot1 = 1.f;
#pragma unroll
        for (int q = 0; q < 4; ++q) {
          const float2 t = *(const float2*)(sTot + q * 128 + 2 * cp);
          if (q < qt) { off0 *= t.x; off1 *= t.y; }
          tot0 *= t.x; tot1 *= t.y;
        }
        uint32_t wk0[4], wk1[4], wv0[4], wv1[4];
#pragma unroll
        for (int ii = 0; ii < 8; ii += 2) {
          uint32_t kp[2];
#pragma unroll
          for (int u = 0; u < 2; ++u) {
            const float e0 = pc0[ii + u] * off0, e1 = pc1[ii + u] * off1;
            kp[u] = pk2(kv0[ii + u] * frcp(e0), kv1[ii + u] * frcp(e1));
            *(uint32_t*)(sKe + (i0 + ii + u) * 136 + 2 * cp) = kp[u];
            if (mode) *(uint32_t*)(sQe + (i0 + ii + u) * 136 + 2 * cp) = pk2(bflo(rq[ii + u]) * e0, bfhi(rq[ii + u]) * e1);
          }
          wk0[ii >> 1] = (kp[0] & 0xffffu) | (kp[1] << 16);
          wk1[ii >> 1] = (kp[0] >> 16) | (kp[1] & 0xffff0000u);
          wv0[ii >> 1] = (rv[ii] & 0xffffu) | (rv[ii + 1] << 16);
          wv1[ii >> 1] = (rv[ii] >> 16) | (rv[ii + 1] & 0xffff0000u);
        }
        *(u32x4*)(sKeT + (2 * cp) * 40 + i0) = u32x4{wk0[0], wk0[1], wk0[2], wk0[3]};
        *(u32x4*)(sKeT + (2 * cp + 1) * 40 + i0) = u32x4{wk1[0], wk1[1], wk1[2], wk1[3]};
        if (cp < 32) {
          *(u32x4*)(sVT + (2 * cp) * 40 + i0) = u32x4{wv0[0], wv0[1], wv0[2], wv0[3]};
          *(u32x4*)(sVT + (2 * cp + 1) * 40 + i0) = u32x4{wv1[0], wv1[1], wv1[2], wv1[3]};
        }
        if (qt == 0) *(float2*)(sLast + 2 * cp) = make_float2(tot0, tot1);
        cum0 *= tot0; cum1 *= tot1;
      }
      if (c + 1 < nchunks) {
#pragma unroll
        for (int ii = 0; ii < 8; ++ii) {
          const int pos = pos0 + (c + 1) * 32 + i0 + ii;
          const unsigned tok = dir ? base + T - 1 - pos : base + pos;
          const unsigned ri = tok * 2560u;
          rq[ii] = QZ32[ri + qoff2]; rz[ii] = QZ32[ri + zoff2]; rv[ii] = QZ32[ri + voff2];
        }
      }
      __syncthreads();
      if (mode) {
        const int ti = wave >> 1, si = wave & 1;
        f32x4 sc = f32x4{0.f, 0.f, 0.f, 0.f};
        if (si <= ti) {
#pragma unroll
          for (int kk = 0; kk < 4; ++kk) {
            const bf16x8 a = *(const bf16x8*)(sQe + (ti * 16 + l15) * 136 + kk * 32 + quad * 8);
            const bf16x8 b = *(const bf16x8*)(sKe + (si * 16 + l15) * 136 + kk * 32 + quad * 8);
            sc = __builtin_amdgcn_mfma_f32_16x16x32_bf16(a, b, sc, 0, 0, 0);
          }
        }
#pragma unroll
        for (int j = 0; j < 4; ++j) {
          const int t = ti * 16 + quad * 4 + j, s2 = si * 16 + l15;
          sP[t * 40 + s2] = (s2 <= t) ? f2bf(sc[j]) : (bfr)0;
        }
      }
      f32x4 oacc[2];
      oacc[0] = f32x4{0.f, 0.f, 0.f, 0.f}; oacc[1] = f32x4{0.f, 0.f, 0.f, 0.f};
      if (mode) {
#pragma unroll
      for (int kk = 0; kk < 4; ++kk) {
        const bf16x8 sb = *(const bf16x8*)(sST + eloc * 136 + kk * 32 + quad * 8);
#pragma unroll
        for (int tt = 0; tt < 2; ++tt) {
          const bf16x8 qa = *(const bf16x8*)(sQe + (tt * 16 + l15) * 136 + kk * 32 + quad * 8);
          oacc[tt] = __builtin_amdgcn_mfma_f32_16x16x32_bf16(sb, qa, oacc[tt], 0, 0, 0);
        }
      }
      }
      __syncthreads();
      {
        const bf16x8 vb = *(const bf16x8*)(sVT + eloc * 40 + quad * 8);
        if (mode) {
#pragma unroll
        for (int tt = 0; tt < 2; ++tt) {
          const bf16x8 pb = *(const bf16x8*)(sP + (tt * 16 + l15) * 40 + quad * 8);
          oacc[tt] = __builtin_amdgcn_mfma_f32_16x16x32_bf16(vb, pb, oacc[tt], 0, 0, 0);
          const int pos = pos0 + c * 32 + tt * 16 + l15;
          const int tok = dir ? base + T - 1 - pos : base + pos;
          uint2 o; o.x = pk2(oacc[tt][0], oacc[tt][1]); o.y = pk2(oacc[tt][2], oacc[tt][3]);
          *(uint2*)(Od + (size_t)tok * DM + h * 128 + eh * 64 + wave * 16 + quad * 4) = o;
        }
        }
#pragma unroll
        for (int dt = 0; dt < 8; ++dt) {
          const bf16x8 ka = *(const bf16x8*)(sKeT + (dt * 16 + l15) * 40 + quad * 8);
          const float4 dl = *(const float4*)(sLast + dt * 16 + quad * 4);
          f32x4 sn = __builtin_amdgcn_mfma_f32_16x16x32_bf16(ka, vb, S[dt], 0, 0, 0);
          sn[0] *= dl.x; sn[1] *= dl.y; sn[2] *= dl.z; sn[3] *= dl.w;
          S[dt] = sn;
          uint2 o; o.x = pk2(sn[0], sn[1]); o.y = pk2(sn[2], sn[3]);
          *(uint2*)(sST + eloc * 136 + dt * 16 + quad * 4) = o;
        }
      }
    }
    if (is_prompt || !mode) {
      float* so = is_prompt ? out_state + ((size_t)(seq * 2 + dir) * 8 + h) * 16384 : SLOC + (size_t)slot * 16384;
#pragma unroll
      for (int dt = 0; dt < 8; ++dt)
#pragma unroll
        for (int j = 0; j < 4; ++j) so[(dt * 16 + quad * 4 + j) * 128 + eglob] = S[dt][j];
      if (!mode && eh == 0 && qt == 0) *(float2*)(DLOC + slot * 128 + 2 * cp) = make_float2(cum0, cum1);
    }
  }
}

DEVINL void hgrn_combine_phase(const Params& p, int bid, int nblk) {
  const int gt = bid * 256 + otid(), nt = nblk * 256;
  float* SLOC = (float*)(p.ws + OFF_BIG + 251658240ull);
  const float* DLOC = (const float*)(p.ws + OFF_BIG + 251658240ull + 33554432ull);
  const float* state_rec = p.in[2];
  for (int idx = gt; idx < 4 * 8 * 2 * 16384; idx += nt) {
    const int de = idx & 16383, r = idx >> 14;
    const int dir = r & 1, h = (r >> 1) & 7, seqb = r >> 4;
    const int d = de >> 7;
    float prev = state_rec[((size_t)(seqb * 2 + dir) * 8 + h) * 16384 + de];
#pragma unroll
    for (int j = 0; j < 8; ++j) {
      const int slot = ((seqb * 8 + j) * 8 + h) * 2 + dir;
      float* ptr = SLOC + (size_t)slot * 16384 + de;
      const float a = (j < 7) ? *ptr : 0.f;
      *ptr = prev;
      if (j < 7) prev = DLOC[slot * 128 + d] * prev + a;
    }
  }
}

DEVINL void hgrn_gate_phase(const Params& p, const float* __restrict__ ng, int bid, int nblk) {
  const int tid = otid(); const int lane = tid & 63;
  const int gw = bid * 4 + (tid >> 6), nw = nblk * 4;
  bfr* Of = (bfr*)(p.ws + OFF_H);
  const bfr* Ob = (const bfr*)(p.ws + OFF_BIG + 209715200ull);
  const bfr* QZ = (const bfr*)(p.ws + OFF_BIG);
  for (int row = gw; row < MTOK; row += nw) {
#pragma unroll
    for (int seg = 0; seg < 4; ++seg) {
      const int c = seg * 256 + lane * 4;
      const uint2 a = *(const uint2*)(Of + (size_t)row * DM + c);
      const uint2 b = *(const uint2*)(Ob + (size_t)row * DM + c);
      const uint2 gq = *(const uint2*)(QZ + (size_t)row * 5120 + 4096 + c);
      const float o0 = bflo(a.x) + bflo(b.x), o1 = bfhi(a.x) + bfhi(b.x), o2 = bflo(a.y) + bflo(b.y), o3 = bfhi(a.y) + bfhi(b.y);
      float ss = o0 * o0 + o1 * o1 + o2 * o2 + o3 * o3;
#pragma unroll
      for (int o = 16; o > 0; o >>= 1) ss += shx(ss, o, lane);
      const float rstd = rsqrtf(ss * (1.f / 128.f) + EPS);
      const float4 gg = *(const float4*)(ng + c);
      uint2 o;
      o.x = pk2(o0 * rstd * gg.x * silu_f(bflo(gq.x)), o1 * rstd * gg.y * silu_f(bfhi(gq.x)));
      o.y = pk2(o2 * rstd * gg.z * silu_f(bflo(gq.y)), o3 * rstd * gg.w * silu_f(bfhi(gq.y)));
      *(uint2*)(Of + (size_t)row * DM + c) = o;
    }
  }
}

DEVINL void ffn_act_phase(const bfr* __restrict__ UP, const float* __restrict__ wdw, int hf, bfr* __restrict__ ACT, int bid, int nblk) {
  const int gt = bid * 256 + otid(), nt = nblk * 256;
  for (int i = gt; i < MTOK * 176; i += nt) {
    const int m = i / 176, j = (i - m * 176) * 8;
    int tl, T; tok_pos(m, tl, T);
    const bfr* ur = UP + (size_t)m * DFF;
    float a[8], b[8];
#pragma unroll
    for (int q = 0; q < 8; ++q) { a[q] = 0.f; b[q] = 0.f; }
#pragma unroll
    for (int tap = 0; tap < 3; ++tap) {
      const int d = tap - 1;
      if ((d < 0 && tl == 0) || (d > 0 && tl == T - 1)) continue;
      const bfr* nr = ur + (ptrdiff_t)d * DFF;
      const uint4 av = *(const uint4*)(nr + j);
      const uint4 bv = *(const uint4*)(nr + HALF_FF + j);
      const float* wa = wdw + tap * (2 * DFF) + hf * HALF_FF + j;
      const float* wb = wdw + tap * (2 * DFF) + DFF + hf * HALF_FF + j;
      const float4 wa0 = *(const float4*)wa, wa1 = *(const float4*)(wa + 4);
      const float4 wb0 = *(const float4*)wb, wb1 = *(const float4*)(wb + 4);
      a[0] += wa0.x * bflo(av.x); a[1] += wa0.y * bfhi(av.x); a[2] += wa0.z * bflo(av.y); a[3] += wa0.w * bfhi(av.y);
      a[4] += wa1.x * bflo(av.z); a[5] += wa1.y * bfhi(av.z); a[6] += wa1.z * bflo(av.w); a[7] += wa1.w * bfhi(av.w);
      b[0] += wb0.x * bflo(bv.x); b[1] += wb0.y * bfhi(bv.x); b[2] += wb0.z * bflo(bv.y); b[3] += wb0.w * bfhi(bv.y);
      b[4] += wb1.x * bflo(bv.z); b[5] += wb1.y * bfhi(bv.z); b[6] += wb1.z * bflo(bv.w); b[7] += wb1.w * bfhi(bv.w);
    }
    uint4 o;
    o.x = pk2(silu_f(a[0]) * b[0], silu_f(a[1]) * b[1]);
    o.y = pk2(silu_f(a[2]) * b[2], silu_f(a[3]) * b[3]);
    o.z = pk2(silu_f(a[4]) * b[4], silu_f(a[5]) * b[5]);
    o.w = pk2(silu_f(a[6]) * b[6], silu_f(a[7]) * b[7]);
    *(uint4*)(ACT + (size_t)m * DFF + hf * HALF_FF + j) = o;
  }
}


#define XB_TMO      128
#define XB_XCNT(j)  (256  + 64 * (j))
#define XB_XSUB(j)  (1280 + 64 * (j))
#define XB_XGEN(j)  (2304 + 64 * (j))
#define XB_TOP      3328
#define XB_TOPGEN   3392
#define XCD_BAR_WORDS 3456
#define XB_SPIN_CAP (1u << 22)
#define LAS __attribute__((address_space(3)))
DEVINL unsigned xb_ld(unsigned* p) { return __hip_atomic_load(p, __ATOMIC_RELAXED, __HIP_MEMORY_SCOPE_AGENT); }
DEVINL unsigned xb_add(unsigned* p, unsigned v) { return __hip_atomic_fetch_add(p, v, __ATOMIC_RELAXED, __HIP_MEMORY_SCOPE_AGENT); }
DEVINL unsigned xb_xcc_id() { return (unsigned)__builtin_amdgcn_s_getreg((3 << 11) | 20) & 0xFu; }
#define XB_SPIN(cond, bar) do { unsigned _sp = 0; while (cond) { __builtin_amdgcn_s_sleep(1); \
    if ((++_sp & 255u) == 0u) { if (xb_ld(&(bar)[XB_TMO])) break; if (_sp > XB_SPIN_CAP) { atomicAdd(&(bar)[XB_TMO], 1u); break; } } } } while (0)
struct XcdBarrier { unsigned* bar; unsigned x; volatile LAS unsigned* st; };
DEVINL XcdBarrier xcd_barrier_post(unsigned* bar, volatile LAS unsigned* st) {
  XcdBarrier b; b.bar = bar; b.x = xb_xcc_id(); b.st = st;
  if (threadIdx.x == 0) (void)xb_add(&bar[XB_XCNT(b.x)], 1u);
  return b;
}
DEVINL void xcd_barrier_complete(unsigned* bar, unsigned x, unsigned& nloc, unsigned& nx) {
  const unsigned G = gridDim.x * gridDim.y * gridDim.z;
  unsigned sum, cnt, mine, sp = 0u;
  for (;;) {
    sum = 0u; cnt = 0u; mine = 0u;
#pragma unroll
    for (unsigned j = 0; j < 16; ++j) { const unsigned c = xb_ld(&bar[XB_XCNT(j)]); sum += c; cnt += (c > 0u) ? 1u : 0u; mine = (j == x) ? c : mine; }
    if (sum == G) break;
    __builtin_amdgcn_s_sleep(1);
    if ((++sp & 255u) == 0u) { if (xb_ld(&bar[XB_TMO])) break; if (sp > XB_SPIN_CAP) { atomicAdd(&bar[XB_TMO], 1u); break; } }
  }
  nloc = mine > 0u ? mine : 1u; nx = cnt > 0u ? cnt : 1u;
}
DEVINL void xcd_barrier(const XcdBarrier& b) {
  asm volatile("s_waitcnt vmcnt(0)" ::: "memory");
  __syncthreads();
  if (threadIdx.x == 0) {
    unsigned* bar = b.bar;
    unsigned bx = b.x;
    asm volatile("" : "+s"(bar), "+s"(bx));
    __builtin_amdgcn_s_waitcnt(0);
    unsigned nloc = b.st[0], nx = b.st[1];
    if (nloc == 0u) { xcd_barrier_complete(bar, bx, nloc, nx); b.st[0] = nloc; b.st[1] = nx; }
    const unsigned old = xb_add(&bar[XB_XSUB(bx)], 1u);
    const unsigned gen = old / nloc;
    if (old + 1u == (gen + 1u) * nloc) {
      __builtin_amdgcn_fence(__ATOMIC_RELEASE, "agent");
      asm volatile("s_waitcnt vmcnt(0)" ::: "memory");
      const unsigned og = xb_add(&bar[XB_TOP], 1u);
      const unsigned tg = og / nx;
      if (og + 1u == (tg + 1u) * nx) xb_add(&bar[XB_TOPGEN], 1u);
      else XB_SPIN(xb_ld(&bar[XB_TOPGEN]) == tg, bar);
      __builtin_amdgcn_fence(__ATOMIC_ACQUIRE, "agent");
      xb_add(&bar[XB_XGEN(bx)], 1u);
      asm volatile("s_waitcnt vmcnt(0)" ::: "memory");
    } else {
      XB_SPIN(xb_ld(&bar[XB_XGEN(bx)]) == gen, bar);
      __builtin_amdgcn_fence(__ATOMIC_ACQUIRE, "agent");
      asm volatile("s_waitcnt vmcnt(0)" ::: "memory");
    }
  }
  __syncthreads();
}

constexpr int SMEM_BYTES = 77824;

__global__ void __launch_bounds__(256, 2) mega_kernel(Params p) {
  __shared__ __attribute__((aligned(16))) char smem[SMEM_BYTES];
  cg::grid_group grid = cg::this_grid();
  __shared__ uint4 xb_words;
  if (threadIdx.x == 0) xb_words = make_uint4(0u, 0u, 0u, 0u);
  __syncthreads();
  XcdBarrier xb = xcd_barrier_post((unsigned*)(p.ws + OFF_BAR), (volatile LAS unsigned*)&xb_words);
  const int bid = blockIdx.x, nblk = gridDim.x;

  phase0a(p, smem, osg(bid), nblk);
  grid.sync();
  phase0b(p, osg(bid), nblk);
  xcd_barrier(xb);

  for (int layer = 0; layer < 4; ++layer) {
    Params q = p;
    {
      size_t oz = 0;
      asm volatile("" : "+s"(oz));
      q.ws = p.ws + oz;
      q.out = p.out + oz;
    }
    float* X = q.out;
    bfr* WB = (bfr*)(q.ws + OFF_WB);
    bfr* H = (bfr*)(q.ws + OFF_H);
    bfr* BIG = (bfr*)(q.ws + OFF_BIG);
    const float* MOD = (const float*)(q.ws + OFF_MOD);
    const float* modl = MOD + layer * 30720;
    if (layer == 0) {
      conv_matrix(q.in[9], 1024, 3072, WB + WB_IN, 0, smem, osg(bid), nblk);
      conv_matrix(q.in[11], 1024, 1024, WB + WB_OUT, 0, smem, osg(bid), nblk);
    } else if (layer == 1) {
      for (int g = 0; g < 4; ++g) conv_matrix(q.in[12] + g * 65536, 256, 256, WB + WB_IN + g * 65536, 0, smem, osg(bid), nblk);
    } else if (layer == 2) {
      conv_matrix(q.in[14], 1024, 2048, WB + WB_IN, 0, smem, osg(bid), nblk);
      conv_matrix(q.in[18], 1024, 1024, WB + WB_OUT, 0, smem, osg(bid), nblk);
    } else {
      conv_matrix(q.in[19], 1024, 5120, WB + WB_IN, 0, smem, osg(bid), nblk);
      conv_matrix(q.in[22], 1024, 1024, WB + WB_OUT, 0, smem, osg(bid), nblk);
    }
    conv_matrix(q.in[23] + (size_t)layer * 1024 * 5632, 1024, 5632, WB + WB_UP, 1, smem, osg(bid), nblk);
    conv_matrix(q.in[25] + (size_t)layer * DFF * 1024, DFF, 1024, WB + WB_DOWN, 0, smem, osg(bid), nblk);
    norm_phase(X, q.in[7] + (layer * 2 + 0) * DM, modl, 0, 1024, H, osg(bid), nblk);
    xcd_barrier(xb);

    if (layer == 0) {
      bfr* G = BIG;
      bfr* U = BIG + (size_t)MTOK * 3072;
      gemm256s_phase(H, DM, WB + WB_IN, 1024, 3072, 1024, EpiStore{G, 3072}, smem, osg(bid), nblk);
      xcd_barrier(xb);
      shortconv_ew_phase(G, q.in[10], U, osg(bid), nblk);
      xcd_barrier(xb);
      gemm_phase(U, DM, WB + WB_OUT, 1024, 1024, 1024, EpiResid{X, modl + 2048, nullptr, 0}, smem, osg(bid), nblk);
      xcd_barrier(xb);
    } else if (layer == 1) {
      bfr* P = BIG;
      pool_ew_phase(H, P, osg(bid), nblk);
      xcd_barrier(xb);
      for (int g = 0; g < 4; ++g)
        gemm_phase(P + g * 256, DM, WB + WB_IN + g * 65536, 256, 256, 256,
                   EpiResid{X, modl + 2048 + g * 256, q.in[13] + g * 256, g * 256}, smem, osg(bid), nblk);
      xcd_barrier(xb);
    } else if (layer == 2) {
      bfr* UV = BIG;
      gemm_phase(H, DM, WB + WB_IN, 1024, 2048, 1024, EpiGelu{UV, 2048}, smem, osg(bid), nblk);
      xcd_barrier(xb);
      sgu_norm_phase(UV, q.in[15], osg(bid), nblk);
      xcd_barrier(xb);
      sgu_spatial_phase(UV, q.in[16], q.in[17], smem, osg(bid), nblk);
      xcd_barrier(xb);
      gemm_phase(UV, 2048, WB + WB_OUT, 1024, 1024, 1024, EpiResid{X, modl + 2048, nullptr, 0}, smem, osg(bid), nblk);
      xcd_barrier(xb);
    } else {
      bfr* QZ = BIG;
      gemm256s_phase(H, DM, WB + WB_IN, 1024, 5120, 1024, EpiStore{QZ, 5120}, smem, osg(bid), nblk);
      xcd_barrier(xb);
      hgrn_scan_phase(q, smem, osg(bid), nblk, 0);
      xcd_barrier(xb);
      hgrn_combine_phase(q, osg(bid), nblk);
      xcd_barrier(xb);
      hgrn_scan_phase(q, smem, osg(bid), nblk, 1);
      xcd_barrier(xb);
      hgrn_gate_phase(q, q.in[21], osg(bid), nblk);
      xcd_barrier(xb);
      gemm_phase(H, DM, WB + WB_OUT, 1024, 1024, 1024, EpiResid{X, modl + 2048, nullptr, 0}, smem, osg(bid), nblk);
      xcd_barrier(xb);
    }

    norm_phase(X, q.in[7] + (layer * 2 + 1) * DM, modl, 3072, 4096, H, osg(bid), nblk);
    xcd_barrier(xb);
    bfr* ACT = BIG;
    float* EDGE = (float*)(q.ws + OFF_BIG + 115343360ull);
    const float* wdw = q.in[24] + (size_t)layer * 3 * 2 * DFF;
    gemm256s_phase(H, DM, WB + WB_UP, 1024, 2 * DFF, 1024, EpiFfnUp{ACT, EDGE, wdw}, smem, osg(bid), nblk);
    xcd_barrier(xb);
    ffn_edge_phase(EDGE, wdw, ACT, osg(bid), nblk);
    xcd_barrier(xb);
    gemm_phase(ACT, DFF, WB + WB_DOWN, DFF, 1024, DFF, EpiResid{X, modl + 5120, nullptr, 0}, smem, osg(bid), nblk);
    xcd_barrier(xb);
  }
  final_norm_phase(p.out, p.in[8], osg(bid), nblk);
}

extern "C" void kernel_launch(void* const* d_in, const int* in_sizes, int n_in, void* d_out, int out_size,
                              void* d_ws, size_t ws_size, hipStream_t stream) {
  static int grid_blocks = 0;
  if (!grid_blocks) {
    int dev = 0, cus = 0, per_cu = 0;
    hipGetDevice(&dev);
    hipDeviceGetAttribute(&cus, hipDeviceAttributeMultiprocessorCount, dev);
    hipOccupancyMaxActiveBlocksPerMultiprocessor(&per_cu, mega_kernel, 256, 0);
    if (per_cu > 2) per_cu = 2;
    if (per_cu < 1) per_cu = 1;
    grid_blocks = cus * per_cu;
  }
  if (ws_size < WS_NEED) { fprintf(stderr, "workspace too small: %zu < %zu\n", ws_size, (size_t)WS_NEED); return; }
  Params p{};
  for (int i = 0; i < 26; ++i) p.in[i] = (const float*)d_in[i];
  p.out = (float*)d_out;
  p.ws = (char*)d_ws;
  hipMemsetAsync((char*)d_ws + OFF_BAR, 0, XCD_BAR_WORDS * 4, stream);
  void* args[] = {&p};
  hipError_t e = hipLaunchCooperativeKernel((void*)mega_kernel, dim3(grid_blocks), dim3(256), args, 0, stream);
  if (e != hipSuccess) fprintf(stderr, "cooperative launch failed: %s (grid %d)\n", hipGetErrorString(e), grid_blocks);
}
```
